# Optimizing an MI355X kernel written in HIP

```python
import math
import jax, jax.numpy as jnp
from jax import lax
import numpy as np

D_MODEL = 2048
BATCH = 4
SEQ = 4096
DEPTH = 4

DIFF_HEADS = 4
DIFF_DK = 64
DIFF_DV = 2 * DIFF_DK
MLA_HEADS = 4
MLA_Q_RANK = 512
MLA_KV_RANK = 256
MLA_NOPE = 128
MLA_ROPE = 64
MLA_DV = 128
ROPE_THETA = 10000.0
SWA_Q_HEADS = 8
SWA_KV_HEADS = 2
SWA_DH = 64
SWA_WINDOW = 128
SWA_BLOCK = 128
MOBA_HEADS = 4
MOBA_DH = 128
MOBA_BLOCK = 256
MOBA_TOPK = 3
MOBA_QCHUNK = 64
Q_BLOCK = 128
REL_BUCKETS = 32
REL_MAX_DIST = 128
BIAS_A0, BIAS_A1 = 0, DIFF_HEADS
BIAS_C0, BIAS_C1 = DIFF_HEADS, DIFF_HEADS + SWA_Q_HEADS
BIAS_D0, BIAS_D1 = DIFF_HEADS + SWA_Q_HEADS, DIFF_HEADS + SWA_Q_HEADS + MOBA_HEADS
BIAS_HEADS = BIAS_D1
N_BRANCH = 4
BRANCH_W = 512
FFN_DIM = 5632
CONV_W = 3
EPS = 1e-6
NEG_INF = -1e30

IN_SPLITS = (
    DIFF_HEADS * 2 * DIFF_DK, DIFF_HEADS * 2 * DIFF_DK, DIFF_HEADS * DIFF_DV,
    MLA_Q_RANK, MLA_KV_RANK, MLA_ROPE,
    SWA_Q_HEADS * SWA_DH, SWA_KV_HEADS * SWA_DH, SWA_KV_HEADS * SWA_DH,
    MOBA_HEADS * MOBA_DH, MOBA_HEADS * MOBA_DH, MOBA_HEADS * MOBA_DH,
    N_BRANCH * D_MODEL,
)
IN_COLS = sum(IN_SPLITS)

kernel_name = 'hybrid_gated_diff_mla_swa_moba_convglu'

F32 = jnp.float32


def rms_norm(x, g):
    xf = x.astype(F32)
    y = xf * lax.rsqrt(jnp.mean(xf * xf, axis=-1, keepdims=True) + EPS)
    return (y * g.astype(F32)).astype(x.dtype)


def t5_bucket(rel):
    n = jnp.maximum(rel, 0)
    max_exact = REL_BUCKETS // 2
    nf = jnp.maximum(n, 1).astype(F32)
    large = max_exact + (jnp.log(nf / max_exact) / math.log(REL_MAX_DIST / max_exact)
                         * (REL_BUCKETS - max_exact)).astype(jnp.int32)
    return jnp.where(n < max_exact, n, jnp.minimum(large, REL_BUCKETS - 1))


def rope(x, positions):
    dr = x.shape[-1]
    inv = ROPE_THETA ** (-jnp.arange(0, dr, 2, dtype=F32) / dr)
    ang = positions.astype(F32)[:, None] * inv[None, :]
    cos, sin = jnp.cos(ang), jnp.sin(ang)
    xf = x.astype(F32)
    x1, x2 = xf[..., : dr // 2], xf[..., dr // 2:]
    return jnp.concatenate([x1 * cos - x2 * sin, x1 * sin + x2 * cos], axis=-1).astype(x.dtype)


def dense_causal_attention(q, k, v, scale, positions, bias_tab):
    B, H, S, _ = q.shape
    kidx = jnp.arange(S)

    def block(i):
        start = i * Q_BLOCK
        qb = lax.dynamic_slice_in_dim(q, start, Q_BLOCK, axis=2)
        s = jnp.einsum('bhqd,bhkd->bhqk', qb, k, preferred_element_type=F32) * scale
        qidx = start + jnp.arange(Q_BLOCK)
        if bias_tab is not None:
            qpos = lax.dynamic_slice_in_dim(positions, start, Q_BLOCK)
            bkt = t5_bucket(qpos[:, None] - positions[None, :])
            s = s + jnp.moveaxis(bias_tab[bkt].astype(F32), -1, 0)[None]
        s = jnp.where(kidx[None, :] <= qidx[:, None], s, NEG_INF)
        p = jax.nn.softmax(s, axis=-1)
        return jnp.einsum('bhqk,bhkd->bhqd', p.astype(v.dtype), v)

    out = lax.map(block, jnp.arange(S // Q_BLOCK))
    return jnp.moveaxis(out, 0, 2).reshape(B, H, S, v.shape[-1])


def diff_attention(zq, zk, zv, lam_vecs, subln_g, lam_init, positions, bias_tab):
    B, S, _ = zq.shape
    H = DIFF_HEADS
    q = zq.reshape(B, S, H * 2, DIFF_DK).transpose(0, 2, 1, 3)
    k = zk.reshape(B, S, H * 2, DIFF_DK).transpose(0, 2, 1, 3)
    v = zv.reshape(B, S, H, DIFF_DV).transpose(0, 2, 1, 3)
    v = jnp.repeat(v, 2, axis=1)
    o = dense_causal_attention(q, k, v, DIFF_DK ** -0.5, positions, jnp.repeat(bias_tab, 2, axis=1))
    o = o.reshape(B, H, 2, S, DIFF_DV).astype(F32)
    lv = lam_vecs.astype(F32)
    lam = jnp.exp(jnp.sum(lv[0] * lv[1])) - jnp.exp(jnp.sum(lv[2] * lv[3])) + lam_init
    o = o[:, :, 0] - lam * o[:, :, 1]
    o = rms_norm(o, subln_g) * (1.0 - lam_init)
    return o.transpose(0, 2, 1, 3).reshape(B, S, H * DIFF_DV).astype(zq.dtype)


def mla_attention(zcq, zckv, zkr, gq, w_uq, gkv, w_ukv, positions):
    B, S, _ = zcq.shape
    H = MLA_HEADS
    cq = rms_norm(zcq, gq)
    q = (cq @ w_uq).reshape(B, S, H, MLA_NOPE + MLA_ROPE).transpose(0, 2, 1, 3)
    q = jnp.concatenate([q[..., :MLA_NOPE], rope(q[..., MLA_NOPE:], positions)], axis=-1)
    ckv = rms_norm(zckv, gkv)
    kv = (ckv @ w_ukv).reshape(B, S, H, MLA_NOPE + MLA_DV).transpose(0, 2, 1, 3)
    k_rope = jnp.broadcast_to(rope(zkr, positions)[:, None], (B, H, S, MLA_ROPE))
    k = jnp.concatenate([kv[..., :MLA_NOPE], k_rope], axis=-1)
    v = kv[..., MLA_NOPE:]
    o = dense_causal_attention(q, k, v, (MLA_NOPE + MLA_ROPE) ** -0.5, positions, None)
    return o.transpose(0, 2, 1, 3).reshape(B, S, H * MLA_DV)


def swa_sink_attention(zq, zk, zv, sinks, positions, bias_tab):
    B, S, _ = zq.shape
    KVH, G, L, d = SWA_KV_HEADS, SWA_Q_HEADS // SWA_KV_HEADS, SWA_BLOCK, SWA_DH
    nb = S // L
    q = zq.reshape(B, nb, L, KVH, G, d)

    def band(t):
        tb = jnp.pad(t, ((0, 0), (L, 0), (0, 0), (0, 0))).reshape(B, nb + 1, L, KVH, d)
        return jnp.concatenate([tb[:, :-1], tb[:, 1:]], axis=2)

    k = band(zk.reshape(B, S, KVH, d))
    v = band(zv.reshape(B, S, KVH, d))
    s = jnp.einsum('bnqhgd,bnkhd->bhgnqk', q, k, preferred_element_type=F32) * d ** -0.5
    qidx = jnp.arange(nb)[:, None] * L + jnp.arange(L)[None, :]
    kidx = jnp.arange(nb)[:, None] * L - L + jnp.arange(2 * L)[None, :]
    dist = qidx[:, :, None] - kidx[:, None, :]
    valid = (dist >= 0) & (dist < SWA_WINDOW) & (kidx[:, None, :] >= 0)
    pos_p = jnp.pad(positions, (L, 0))
    bkt = t5_bucket(positions[qidx][:, :, None] - pos_p[kidx + L][:, None, :])
    bias = bias_tab[bkt].astype(F32).reshape(nb, L, 2 * L, KVH, G).transpose(3, 4, 0, 1, 2)
    s = jnp.where(valid, s + bias, NEG_INF)
    sink = sinks.astype(F32).reshape(KVH, G)[:, :, None, None, None]
    m = jnp.maximum(jnp.max(s, axis=-1, keepdims=True), sink)
    p = jnp.exp(s - m)
    p = p / (jnp.sum(p, axis=-1, keepdims=True) + jnp.exp(sink - m))
    o = jnp.einsum('bhgnqk,bnkhd->bnqhgd', p.astype(v.dtype), v)
    return o.reshape(B, S, SWA_Q_HEADS * d)


def moba_attention(zq, zk, zv, positions, bias_tab):
    B, S, _ = zq.shape
    H, d, L, QC = MOBA_HEADS, MOBA_DH, MOBA_BLOCK, MOBA_QCHUNK
    nblk = -(-S // L)
    Sp = nblk * L
    n_sel = min(MOBA_TOPK, nblk - 1)

    def to_heads(t):
        return t.reshape(B, S, H, d).transpose(0, 2, 1, 3)

    pad = ((0, 0), (0, 0), (0, Sp - S), (0, 0))
    q = to_heads(zq)
    k = jnp.pad(to_heads(zk), pad)
    v = jnp.pad(to_heads(zv), pad)
    pos_p = jnp.pad(positions, (0, Sp - S))
    k_blocks = k.reshape(B, H, nblk, L, d)
    v_blocks = v.reshape(B, H, nblk, L, d)
    k_mean = jnp.mean(k_blocks.astype(F32), axis=3)
    bias_T = bias_tab.astype(F32).T
    b_ix = jnp.arange(B)[:, None, None, None]
    h_ix = jnp.arange(H)[None, :, None, None]
    scale = d ** -0.5

    def chunk(c):
        start = c * QC
        qc = lax.dynamic_slice_in_dim(q, start, QC, axis=2)
        qidx = start + jnp.arange(QC)
        qpos = lax.dynamic_slice_in_dim(positions, start, QC)
        blk = start // L
        ks = lax.dynamic_slice_in_dim(k, blk * L, L, axis=2)
        vs = lax.dynamic_slice_in_dim(v, blk * L, L, axis=2)
        kidx = blk * L + jnp.arange(L)
        s_own = jnp.einsum('bhqd,bhkd->bhqk', qc, ks, preferred_element_type=F32) * scale
        s_own = s_own + bias_T[:, t5_bucket(qpos[:, None] - pos_p[kidx][None, :])][None]
        s_own = jnp.where(kidx[None, :] <= qidx[:, None], s_own, NEG_INF)
        if n_sel == 0:
            p = jax.nn.softmax(s_own, axis=-1)
            return jnp.einsum('bhqk,bhkd->bhqd', p.astype(vs.dtype), vs)
        gate = jnp.einsum('bhqd,bhnd->bhqn', qc.astype(F32), k_mean)
        gate = jnp.where(jnp.arange(nblk) < blk, gate, NEG_INF)
        _, sel = lax.top_k(gate, n_sel)
        sel_ok = jnp.repeat(jnp.arange(n_sel) < blk, L)
        k_sel = k_blocks[b_ix, h_ix, sel].reshape(B, H, QC, n_sel * L, d)
        v_sel = v_blocks[b_ix, h_ix, sel].reshape(B, H, QC, n_sel * L, d)
        s_sel = jnp.einsum('bhqd,bhqkd->bhqk', qc, k_sel, preferred_element_type=F32) * scale
        kidx_sel = (sel[..., None] * L + jnp.arange(L)).reshape(B, H, QC, n_sel * L)
        bkt = t5_bucket(qpos[:, None] - pos_p[kidx_sel])
        s_sel = jnp.where(sel_ok, s_sel + bias_T[jnp.arange(H)[:, None, None], bkt], NEG_INF)
        p = jax.nn.softmax(jnp.concatenate([s_sel, s_own], axis=-1), axis=-1)
        p_sel = p[..., : n_sel * L].astype(v_sel.dtype)
        p_own = p[..., n_sel * L:].astype(vs.dtype)
        return (jnp.einsum('bhqk,bhqkd->bhqd', p_sel, v_sel)
                + jnp.einsum('bhqk,bhkd->bhqd', p_own, vs))

    out = lax.map(chunk, jnp.arange(S // QC))
    out = jnp.moveaxis(out, 0, 2).reshape(B, H, S, d)
    return out.transpose(0, 2, 1, 3).reshape(B, S, H * d)


def conv_glu(h, w_up, conv_w, conv_b, w_down):
    S = h.shape[1]
    u = h @ w_up
    a, val = u[..., :FFN_DIM], u[..., FFN_DIM:]
    ap = jnp.pad(a, ((0, 0), (CONV_W - 1, 0), (0, 0)))
    a = conv_b + conv_w[0] * ap[:, 0:S]
    for j in range(1, CONV_W):
        a = a + conv_w[j] * ap[:, j:j + S]
    return (jax.nn.gelu(a, approximate=False) * val) @ w_down


def setup_inputs(seed: int = 0) -> dict:
    key = jax.random.key(seed)
    ks = jax.random.split(key, 20)

    def nrm(k, shape, scale):
        return jax.random.normal(k, shape, F32) * scale

    def gain(k, shape):
        return 1.0 + 0.02 * jax.random.normal(k, shape, F32)

    return {
        'x': nrm(ks[0], (BATCH, SEQ, D_MODEL), 1.0),
        'positions': jnp.arange(SEQ, dtype=jnp.int32),
        'rel_bias': nrm(ks[1], (REL_BUCKETS, BIAS_HEADS), 0.5),
        'norm1_g': gain(ks[2], (DEPTH, D_MODEL)),
        'w_in': nrm(ks[3], (DEPTH, D_MODEL, IN_COLS), D_MODEL ** -0.5),
        'diff_lambda': nrm(ks[4], (DEPTH, 4, DIFF_DK), 0.1),
        'diff_subln_g': gain(ks[5], (DEPTH, DIFF_DV)),
        'mla_q_norm_g': gain(ks[6], (DEPTH, MLA_Q_RANK)),
        'mla_w_uq': nrm(ks[7], (DEPTH, MLA_Q_RANK, MLA_HEADS * (MLA_NOPE + MLA_ROPE)), MLA_Q_RANK ** -0.5),
        'mla_kv_norm_g': gain(ks[8], (DEPTH, MLA_KV_RANK)),
        'mla_w_ukv': nrm(ks[9], (DEPTH, MLA_KV_RANK, MLA_HEADS * (MLA_NOPE + MLA_DV)), MLA_KV_RANK ** -0.5),
        'swa_sinks': nrm(ks[10], (DEPTH, SWA_Q_HEADS), 0.5),
        'w_branch': nrm(ks[11], (DEPTH, N_BRANCH, BRANCH_W, D_MODEL), BRANCH_W ** -0.5),
        'w_out': nrm(ks[12], (DEPTH, D_MODEL, D_MODEL), D_MODEL ** -0.5),
        'norm2_g': gain(ks[13], (DEPTH, D_MODEL)),
        'ffn_w_up': nrm(ks[14], (DEPTH, D_MODEL, 2 * FFN_DIM), D_MODEL ** -0.5),
        'ffn_conv_w': nrm(ks[15], (DEPTH, CONV_W, FFN_DIM), CONV_W ** -0.5),
        'ffn_conv_b': nrm(ks[16], (DEPTH, FFN_DIM), 0.01),
        'ffn_w_down': nrm(ks[17], (DEPTH, FFN_DIM, D_MODEL), FFN_DIM ** -0.5),
        'final_norm_g': gain(ks[18], (D_MODEL,)),
    }


def reference(x, positions, rel_bias, norm1_g, w_in, diff_lambda, diff_subln_g,
              mla_q_norm_g, mla_w_uq, mla_kv_norm_g, mla_w_ukv, swa_sinks, w_branch,
              w_out, norm2_g, ffn_w_up, ffn_conv_w, ffn_conv_b, ffn_w_down, final_norm_g):
    B, S, D = x.shape
    split_points = [int(i) for i in np.cumsum(IN_SPLITS)[:-1]]
    bias_a = rel_bias[:, BIAS_A0:BIAS_A1]
    bias_c = rel_bias[:, BIAS_C0:BIAS_C1]
    bias_d = rel_bias[:, BIAS_D0:BIAS_D1]
    for l in range(DEPTH):
        lam_init = 0.8 - 0.6 * math.exp(-0.3 * l)
        h = rms_norm(x, norm1_g[l])
        z = h @ w_in[l]
        (aq, ak, av, cq, ckv, kr, sq, sk, sv, mq, mk, mv, zg) = jnp.split(z, split_points, axis=-1)
        branches = (
            diff_attention(aq, ak, av, diff_lambda[l], diff_subln_g[l], lam_init, positions, bias_a),
            mla_attention(cq, ckv, kr, mla_q_norm_g[l], mla_w_uq[l], mla_kv_norm_g[l], mla_w_ukv[l], positions),
            swa_sink_attention(sq, sk, sv, swa_sinks[l], positions, bias_c),
            moba_attention(mq, mk, mv, positions, bias_d),
        )
        gates = jax.nn.sigmoid(zg.astype(F32)).astype(x.dtype).reshape(B, S, N_BRANCH, D)
        merged = gates[:, :, 0] * (branches[0] @ w_branch[l, 0])
        for i in range(1, N_BRANCH):
            merged = merged + gates[:, :, i] * (branches[i] @ w_branch[l, i])
        x = x + merged @ w_out[l]
        x = x + conv_glu(rms_norm(x, norm2_g[l]), ffn_w_up[l], ffn_conv_w[l], ffn_conv_b[l], ffn_w_down[l])
    return rms_norm(x, final_norm_g)
```

```cpp
#include <hip/hip_runtime.h>
#include <cstdio>
#include <cstdint>

#ifndef MK_N_LAUNCHES
#define MK_N_LAUNCHES 0
#endif

#define GAS __attribute__((address_space(1)))
#define LAS __attribute__((address_space(3)))
typedef unsigned short bf16_t;
typedef short bf16x8 __attribute__((ext_vector_type(8)));
typedef short s16x4 __attribute__((ext_vector_type(4)));
typedef float f32x2 __attribute__((ext_vector_type(2)));
typedef float f32x4 __attribute__((ext_vector_type(4)));
typedef float f32x16 __attribute__((ext_vector_type(16)));
typedef unsigned u32x2 __attribute__((ext_vector_type(2)));
typedef unsigned u32x4 __attribute__((ext_vector_type(4)));
typedef int i32x4 __attribute__((ext_vector_type(4)));

constexpr int DM = 2048, NB = 4, SEQ = 4096, DEPTH = 4, M = NB * SEQ;
constexpr int IN_COLS = 12864, ZLD = 13056;
constexpr int ZQA = 0, ZKA = 512, ZVA = 1024, ZCQ = 1536, ZCKV = 2048, ZKR = 2304, ZSQ = 2560, ZSK = 3072, ZSV = 3200, ZMQ = 3328, ZMK = 3840, ZMV = 4352, ZG = 4864;
constexpr int FFN = 5632, UP_N = 2 * FFN;
constexpr float LOG2E = 1.4426950408889634f;
constexpr float EPS = 1e-6f;
constexpr float NEG_INF = -__builtin_huge_valf();

__device__ __forceinline__ unsigned cvt_pk_bf16(float lo, float hi) { unsigned r; asm volatile("v_cvt_pk_bf16_f32 %0, %1, %2" : "=v"(r) : "v"(lo), "v"(hi)); return r; }
__device__ __forceinline__ float bf2f(unsigned short h) { return __uint_as_float(((unsigned)h) << 16); }
__device__ __forceinline__ float bflo(unsigned w) { return __uint_as_float(w << 16); }
__device__ __forceinline__ float bfhi(unsigned w) { return __uint_as_float(w & 0xffff0000u); }
__device__ __forceinline__ float wave_sum(float v) {
#pragma unroll
    for (int o = 1; o < 64; o <<= 1) v += __shfl_xor(v, o);
    return v;
}
__device__ __forceinline__ int opaque_tid() { int t = threadIdx.x; asm volatile("" : "+v"(t)); return t; }
__device__ __forceinline__ int opaque_s(int x) { asm volatile("" : "+s"(x)); return x; }
__device__ __forceinline__ float fast_sigmoid(float x) { return __builtin_amdgcn_rcpf(1.0f + __builtin_amdgcn_exp2f(-x * LOG2E)); }

namespace pg8 {
constexpr int BM = 256, BK = 64, HALF = 128, HTB = HALF * BK * 2, STAGE_BYTES = 8 * HTB, NXCD = 8, WGM = 8;
__host__ __device__ __forceinline__ int lds_byte(int r, int c) { const int st = (r >> 4) * 2 + (c >> 5), rr = r & 15, cc = c & 31, ob = rr * 64 + cc * 2; return st * 1024 + (ob ^ (((ob >> 9) & 1) << 5)); }
__host__ __device__ __forceinline__ void stage_rc(int b, int& R, int& C) { const int st = b / 1024, sb = b % 1024, swz = sb ^ (((sb >> 9) & 1) << 5); R = (st >> 1) * 16 + swz / 64; C = (st & 1) * 32 + (swz % 64) / 2; }
__host__ __device__ __forceinline__ int perm32(int rho) { const int n = rho >> 4, i = rho & 15; return 8 * (i >> 2) + 4 * n + (i & 3); }

struct Unit { int pm, pn, z; };
struct Gemm { const bf16_t* A; const bf16_t* Bt; int M, N, K, lda; size_t zA, zB; };

struct StaticOrder {
    int nM, nN, nwg, G, c, nZ;
    __device__ void init(int M_, int N_, int G_, int c_, int nZ_ = 1) { nM = M_ / BM; nN = N_ / BM; nwg = nM * nN; G = G_; c = c_; nZ = nZ_; }
    __device__ bool next(int i, Unit& u) const {
        const int it = i / nZ; u.z = i - it * nZ;
        const long L = (long)it * G + c; if (L >= nwg) return false;
        int wgid = (int)L; { const int q = nwg / NXCD, r = nwg % NXCD, xcd = wgid % NXCD, off = wgid / NXCD; wgid = (xcd < r ? xcd * (q + 1) : r * (q + 1) + (xcd - r) * q) + off; }
        const int nig = WGM * nN, gid = wgid / nig, fm = gid * WGM, gsz = (nM - fm) < WGM ? (nM - fm) : WGM;
        u.pm = fm + ((wgid % nig) % gsz); u.pn = (wgid % nig) / gsz; return true;
    }
};


struct EpiBf16 {
    bf16_t* O; int ldc; int kind;
    float sc;
    __device__ __forceinline__ void operator()(const f32x4 (&acc)[2][2][4][2], const Unit& u, int wr, int wc, int fr, int fq) const {
        float s = sc; bool sig = false;
        if (kind == 0) {
            const int pn = u.pn;
            s = 1.0f;
            if (pn < 2 || pn == 10 || pn == 11) s = 0.125f * LOG2E;
            else if (pn == 13 || pn == 14) s = 0.08838834764831845f * LOG2E;
            sig = pn >= 19;
        }
        const int row0 = u.pm * BM + wr * 64 + fr, col0 = u.pn * BM + wc * 32 + 8 * fq;
#pragma unroll
        for (int ai = 0; ai < 2; ++ai)
#pragma unroll
            for (int m = 0; m < 4; ++m) { bf16_t* rowp = O + (size_t)(row0 + ai * HALF + m * 16) * ldc + col0;
#pragma unroll
                for (int bj = 0; bj < 2; ++bj) { f32x4 v0 = acc[ai][bj][m][0], v1 = acc[ai][bj][m][1];
                    if (sig) {
#pragma unroll
                        for (int e = 0; e < 4; ++e) { v0[e] = fast_sigmoid(v0[e]); v1[e] = fast_sigmoid(v1[e]); }
                    } else { v0 = v0 * s; v1 = v1 * s; }
                    u32x4 w; w.x = cvt_pk_bf16(v0[0], v0[1]); w.y = cvt_pk_bf16(v0[2], v0[3]); w.z = cvt_pk_bf16(v1[0], v1[1]); w.w = cvt_pk_bf16(v1[2], v1[3]);
                    *(u32x4*)(rowp + bj * HALF) = w; } }
    }
};
struct EpiResF32 {
    const float* base; float* out; int ldc;
    __device__ __forceinline__ void operator()(const f32x4 (&acc)[2][2][4][2], const Unit& u, int wr, int wc, int fr, int fq) const {
        const int row0 = u.pm * BM + wr * 64 + fr, col0 = u.pn * BM + wc * 32 + 8 * fq;
#pragma unroll
        for (int ai = 0; ai < 2; ++ai)
#pragma unroll
            for (int m = 0; m < 4; ++m) { const size_t off = (size_t)(row0 + ai * HALF + m * 16) * ldc + col0;
#pragma unroll
                for (int bj = 0; bj < 2; ++bj) {
                    const f32x4 b0 = *(const f32x4*)(base + off + bj * HALF), b1 = *(const f32x4*)(base + off + bj * HALF + 4);
                    *(f32x4*)(out + off + bj * HALF) = b0 + acc[ai][bj][m][0]; *(f32x4*)(out + off + bj * HALF + 4) = b1 + acc[ai][bj][m][1]; }
                asm volatile("" ::: "memory"); }
    }
};
struct EpiMerge {
    const bf16_t* gate; int ldg;
    float* T; bf16_t* Mg;
    __device__ __forceinline__ void operator()(const f32x4 (&acc)[2][2][4][2], const Unit& u, int wr, int wc, int fr, int fq) const {
        const int row0 = u.pm * BM + wr * 64 + fr, col0 = u.pn * BM + wc * 32 + 8 * fq, z = u.z;
#pragma unroll
        for (int ai = 0; ai < 2; ++ai)
#pragma unroll
            for (int m = 0; m < 4; ++m) { const int row = row0 + ai * HALF + m * 16; const size_t off = (size_t)row * DM + col0;
#pragma unroll
                for (int bj = 0; bj < 2; ++bj) {
                    const u32x4 g = *(const u32x4*)(gate + (size_t)row * ldg + z * DM + col0 + bj * HALF);
                    f32x4 t0 = (f32x4){0.f, 0.f, 0.f, 0.f}, t1 = t0;
                    if (z > 0) { t0 = *(const f32x4*)(T + off + bj * HALF); t1 = *(const f32x4*)(T + off + bj * HALF + 4); }
                    const f32x4 g0 = (f32x4){bflo(g.x), bfhi(g.x), bflo(g.y), bfhi(g.y)}, g1 = (f32x4){bflo(g.z), bfhi(g.z), bflo(g.w), bfhi(g.w)};
                    t0 = t0 + g0 * acc[ai][bj][m][0]; t1 = t1 + g1 * acc[ai][bj][m][1];
                    if (z < 3) { *(f32x4*)(T + off + bj * HALF) = t0; *(f32x4*)(T + off + bj * HALF + 4) = t1; }
                    else { u32x4 w; w.x = cvt_pk_bf16(t0[0], t0[1]); w.y = cvt_pk_bf16(t0[2], t0[3]); w.z = cvt_pk_bf16(t1[0], t1[1]); w.w = cvt_pk_bf16(t1[2], t1[3]);
                        *(u32x4*)(Mg + off + bj * HALF) = w; } }
                asm volatile("" ::: "memory"); }
    }
};

template <class Epi, class Sched, bool ALIGN_EPI>
__device__ __forceinline__ void gemm_phase(LAS unsigned char* lds, const Gemm g, const Sched& S, const Epi& E) {
    const int tid = opaque_tid(), wid = __builtin_amdgcn_readfirstlane(tid >> 6), lane = tid & 63, wr = wid >> 2, wc = wid & 3, fr = lane & 15, fq = lane >> 4;
    const int K = g.K, nt = K / BK, lda = g.lda;
    unsigned voffA[2], voffB[2];
#pragma unroll
    for (int i = 0; i < 2; ++i) { int R, C; stage_rc(tid * 16 + i * 8192, R, C); const int Rb = (R & ~31) + perm32(R & 31);
        voffA[i] = (unsigned)(R * lda + C) * 2u; voffB[i] = (unsigned)(Rb * K + C) * 2u; }
    const size_t kstep = (size_t)(BK * 2);
    const size_t hstepA = (size_t)HALF * lda * 2, hstepB = (size_t)HALF * K * 2;
    const size_t tstepA = 2 * hstepA, tstepB = 2 * hstepB;
    const unsigned ldsw = (unsigned)wid * 1024u;
    const int aoff = lds_byte(wr * 64 + fr, fq * 8), boff = lds_byte(wc * 32 + fr, fq * 8);
#define PG8_SA(b, h) (((b) * 2 + (h)) * HTB)
#define PG8_SB(b, h) ((4 + (b) * 2 + (h)) * HTB)
#define PG8_STAGE(bufoff, gbase, voff) do { _Pragma("unroll") for (int _i = 0; _i < 2; ++_i) \
        __builtin_amdgcn_global_load_lds((const unsigned*)((const char*)(gbase) + (voff)[_i]), (LAS unsigned*)(lds + (bufoff) + ldsw + _i * 8192), 16, 0, 0); } while (0)
#define PG8_LDA(dst, b, h) do { _Pragma("unroll") for (int m = 0; m < 4; ++m) _Pragma("unroll") for (int k = 0; k < 2; ++k) dst[m][k] = *(const LAS bf16x8*)(lds + PG8_SA(b, h) + aoff + m * 2048 + k * 1024); } while (0)
#define PG8_LDB(dst, b, h) do { _Pragma("unroll") for (int n = 0; n < 2; ++n) _Pragma("unroll") for (int k = 0; k < 2; ++k) dst[n][k] = *(const LAS bf16x8*)(lds + PG8_SB(b, h) + boff + n * 2048 + k * 1024); } while (0)
#define PG8_MMA(ai, bj, At, Bt) do { __builtin_amdgcn_s_setprio(1); _Pragma("unroll") for (int m = 0; m < 4; ++m) _Pragma("unroll") for (int n = 0; n < 2; ++n) _Pragma("unroll") for (int k = 0; k < 2; ++k) \
        acc[ai][bj][m][n] = __builtin_amdgcn_mfma_f32_16x16x32_bf16(Bt[n][k], At[m][k], acc[ai][bj][m][n], 0, 0, 0); __builtin_amdgcn_s_setprio(0); } while (0)
#define PG8_WAIT_V(n) asm volatile("s_waitcnt vmcnt(" #n ")" ::: "memory")
#define PG8_WAIT_L(n) asm volatile("s_waitcnt lgkmcnt(" #n ")" ::: "memory")
#define PG8_BAR __builtin_amdgcn_s_barrier()
#define PG8_SCHED __builtin_amdgcn_sched_barrier(0)
    Unit cur, nxt; int ui = 0;
    if (!S.next(0, cur)) return;
    f32x4 acc[2][2][4][2];
#pragma unroll
    for (int a = 0; a < 2; ++a)
#pragma unroll
        for (int b = 0; b < 2; ++b)
#pragma unroll
            for (int m = 0; m < 4; ++m)
#pragma unroll
                for (int n = 0; n < 2; ++n) acc[a][b][m][n] = (f32x4){0.f, 0.f, 0.f, 0.f};
    bf16x8 At[4][2], B0[2][2], B1[2][2];
    const char* cA = (const char*)g.A + (size_t)cur.pm * tstepA + (size_t)cur.z * g.zA; const char* cB = (const char*)g.Bt + (size_t)cur.pn * tstepB + (size_t)cur.z * g.zB;
    PG8_STAGE(PG8_SB(0, 0), cB, voffB); PG8_STAGE(PG8_SB(0, 1), cB + hstepB, voffB); PG8_STAGE(PG8_SA(0, 0), cA, voffA); PG8_STAGE(PG8_SA(0, 1), cA + hstepA, voffA);
    if (wr == 1) PG8_BAR;
    PG8_WAIT_V(2); PG8_BAR;
    PG8_STAGE(PG8_SB(1, 0), cB + kstep, voffB); PG8_STAGE(PG8_SA(1, 0), cA + kstep, voffA); PG8_STAGE(PG8_SB(1, 1), cB + hstepB + kstep, voffB);
    PG8_WAIT_V(6); PG8_BAR;
    for (;;) {
        const bool has_next = S.next(ui + 1, nxt);
        const char* nA = has_next ? (const char*)g.A + (size_t)nxt.pm * tstepA + (size_t)nxt.z * g.zA : cA; const char* nB = has_next ? (const char*)g.Bt + (size_t)nxt.pn * tstepB + (size_t)nxt.z * g.zB : cB;
        for (int t = 0; t < nt; t += 2) {
            const bool last = (t == nt - 2);
            const char* a1 = cA + (size_t)(t + 1) * kstep;
            const char* a2 = last ? nA : cA + (size_t)(t + 2) * kstep; const char* b2 = last ? nB : cB + (size_t)(t + 2) * kstep;
            const char* a3 = a2 + kstep; const char* b3 = b2 + kstep;
            PG8_LDB(B0, 0, 0); PG8_LDB(B1, 0, 1); PG8_SCHED; PG8_LDA(At, 0, 0); PG8_STAGE(PG8_SA(1, 1), a1 + hstepA, voffA);
            PG8_WAIT_V(8); PG8_WAIT_L(0); PG8_BAR; PG8_MMA(0, 0, At, B0); PG8_MMA(0, 1, At, B1); PG8_BAR; PG8_SCHED;
            PG8_LDA(At, 0, 1); PG8_STAGE(PG8_SB(0, 0), b2, voffB); PG8_STAGE(PG8_SB(0, 1), b2 + hstepB, voffB); PG8_STAGE(PG8_SA(0, 0), a2, voffA);
            PG8_WAIT_V(8); PG8_WAIT_L(0); PG8_BAR; PG8_MMA(1, 0, At, B0); PG8_MMA(1, 1, At, B1); PG8_BAR; PG8_SCHED;
            PG8_LDB(B0, 1, 0); PG8_LDB(B1, 1, 1); PG8_SCHED; PG8_LDA(At, 1, 0); PG8_STAGE(PG8_SA(0, 1), a2 + hstepA, voffA);
            PG8_WAIT_V(8); PG8_WAIT_L(0); PG8_BAR; PG8_MMA(0, 0, At, B0); PG8_MMA(0, 1, At, B1); PG8_BAR; PG8_SCHED;
            PG8_LDA(At, 1, 1); PG8_STAGE(PG8_SB(1, 0), b3, voffB); PG8_STAGE(PG8_SB(1, 1), b3 + hstepB, voffB); PG8_STAGE(PG8_SA(1, 0), a3, voffA);
            PG8_WAIT_V(8); PG8_WAIT_L(0); PG8_BAR; PG8_MMA(1, 0, At, B0); PG8_MMA(1, 1, At, B1); PG8_BAR; PG8_SCHED;
        }
        if constexpr (ALIGN_EPI) { if (wr == 0) PG8_BAR; }
        E(acc, cur, wr, wc, fr, fq);
        if (!has_next) break;
#pragma unroll
        for (int a = 0; a < 2; ++a)
#pragma unroll
            for (int b = 0; b < 2; ++b)
#pragma unroll
                for (int m = 0; m < 4; ++m)
#pragma unroll
                    for (int n = 0; n < 2; ++n) acc[a][b][m][n] = (f32x4){0.f, 0.f, 0.f, 0.f};
        cur = nxt; cA = nA; cB = nB; ++ui;
        if constexpr (ALIGN_EPI) { if (wr == 1) PG8_BAR; }
    }
    PG8_WAIT_V(0);
    if constexpr (!ALIGN_EPI) { if (wr == 0) PG8_BAR; }
    PG8_BAR;
#undef PG8_SA
#undef PG8_SB
#undef PG8_STAGE
#undef PG8_LDA
#undef PG8_LDB
#undef PG8_MMA
#undef PG8_WAIT_V
#undef PG8_WAIT_L
#undef PG8_BAR
#undef PG8_SCHED
}
}

constexpr size_t MiB = 1u << 20;
constexpr size_t WS_CTL = 0, CTL_ZERO_BYTES = 1 * MiB;
constexpr size_t WS_ROPE = 1 * MiB;
constexpr size_t WS_BTAB = 2 * MiB;
constexpr size_t WS_PMM = WS_BTAB + 16 * 132 * 4;
constexpr size_t WS_LAM = WS_PMM + 128 * 2 * 4;
constexpr size_t WS_KMEAN = 3 * MiB;
constexpr size_t WS_W = 4 * MiB;
constexpr size_t W_IN = 0, W_UQ = 51 * MiB, W_UKV = W_UQ + 768 * 512 * 2, W_BR = W_UKV + 1024 * 256 * 2, W_OUT = W_BR + 8 * MiB, W_UP = W_OUT + 8 * MiB, W_DN = W_UP + 44 * MiB, W_LAYER = W_DN + 22 * MiB;
constexpr size_t WS_X = WS_W + DEPTH * W_LAYER;
constexpr size_t WS_XN = WS_X + 128 * MiB;
constexpr size_t WS_MG = WS_XN + 64 * MiB;
constexpr size_t WS_Z = WS_MG + 64 * MiB;
constexpr size_t WS_CQN = WS_Z + 408 * MiB;
constexpr size_t WS_CKVN = WS_CQN + 16 * MiB;
constexpr size_t WS_KR = WS_CKVN + 8 * MiB;
constexpr size_t WS_QMLA = WS_KR + 2 * MiB;
constexpr size_t WS_KVMLA = WS_QMLA + 24 * MiB;
constexpr size_t WS_BRO = WS_KVMLA + 32 * MiB;
constexpr size_t WS_T = WS_BRO + 64 * MiB;
constexpr size_t WS_DSCR = WS_T + 176 * MiB;
constexpr size_t WS_END = WS_DSCR + 32 * MiB;
static_assert(W_LAYER * 1 == (size_t)(51 * MiB + 768 * 512 * 2 + 1024 * 256 * 2 + 82 * MiB), "weight map");
static_assert((size_t)M * ZLD * 2 == 408 * MiB && (size_t)M * UP_N * 2 <= 408 * MiB && (size_t)M * FFN * 2 == 176 * MiB, "buffer sizes");
constexpr int CW_TMO = 0;
constexpr int CW_QUEUE = 1024;
constexpr int CW_BAR = 4096;

constexpr int RING_OFF = 0, RING_BYTES = 131072;
constexpr int LDSCTL_OFF = RING_BYTES, MISC_OFF = LDSCTL_OFF + 320;
constexpr int LDS_BYTES = 147456;
constexpr int NWAVES = 8;

typedef GAS unsigned gu32;
#define RLX_AGENT __ATOMIC_RELAXED, __HIP_MEMORY_SCOPE_AGENT
#define LDS_WAIT() asm volatile("s_waitcnt lgkmcnt(0)" ::: "memory")
#define XB_TMO      128
#define XB_XCNT(j)  (256  + 64 * (j))
#define XB_XSUB(j)  (1280 + 64 * (j))
#define XB_XGEN(j)  (2304 + 64 * (j))
#define XB_TOP      3328
#define XB_TOPGEN   3392
#define XCD_BAR_WORDS 3456
#define XB_SPIN_CAP (1u << 22)
__device__ __forceinline__ unsigned xb_ld(unsigned* p)              { return __hip_atomic_load(p, __ATOMIC_RELAXED, __HIP_MEMORY_SCOPE_AGENT); }
__device__ __forceinline__ unsigned xb_add(unsigned* p, unsigned v) { return __hip_atomic_fetch_add(p, v, __ATOMIC_RELAXED, __HIP_MEMORY_SCOPE_AGENT); }
__device__ __forceinline__ unsigned xb_xcc_id() { return (unsigned)__builtin_amdgcn_s_getreg((3 << 11) | 20) & 0xFu; }
#define XB_SPIN(cond, bar) do { unsigned _sp = 0; while (cond) { __builtin_amdgcn_s_sleep(1); \
    if ((++_sp & 255u) == 0u) { if (xb_ld(&(bar)[XB_TMO])) break; if (_sp > XB_SPIN_CAP) { atomicAdd(&(bar)[XB_TMO], 1u); break; } } } } while (0)
struct XcdBarrier { unsigned* bar; unsigned x; volatile LAS unsigned* st; };
__device__ __forceinline__ XcdBarrier xcd_barrier_post(unsigned* bar, volatile LAS unsigned* st) {
    XcdBarrier b; b.bar = bar; b.x = xb_xcc_id(); b.st = st;
    if (threadIdx.x == 0) (void)xb_add(&bar[XB_XCNT(b.x)], 1u);
    return b;
}
__device__ __forceinline__ void xcd_barrier_complete(unsigned* bar, unsigned x, unsigned& nloc, unsigned& nx) {
    const unsigned G = gridDim.x * gridDim.y * gridDim.z;
    unsigned sum, cnt, mine, sp = 0u;
    for (;;) {
        sum = 0u; cnt = 0u; mine = 0u;
#pragma unroll
        for (unsigned j = 0; j < 16; ++j) { const unsigned c = xb_ld(&bar[XB_XCNT(j)]); sum += c; cnt += (c > 0u) ? 1u : 0u; mine = (j == x) ? c : mine; }
        if (sum == G) break;
        __builtin_amdgcn_s_sleep(1);
        if ((++sp & 255u) == 0u) { if (xb_ld(&bar[XB_TMO])) break; if (sp > XB_SPIN_CAP) { atomicAdd(&bar[XB_TMO], 1u); break; } }
    }
    nloc = mine > 0u ? mine : 1u; nx = cnt > 0u ? cnt : 1u;
}
__device__ __forceinline__ void xcd_barrier(const XcdBarrier& b) {
    asm volatile("s_waitcnt vmcnt(0)" ::: "memory");
    __syncthreads();
    if (threadIdx.x == 0) {
        unsigned* bar = b.bar;
        __builtin_amdgcn_s_waitcnt(0);
        unsigned nloc = b.st[0], nx = b.st[1];
        if (nloc == 0u) { xcd_barrier_complete(bar, b.x, nloc, nx); b.st[0] = nloc; b.st[1] = nx; }
        const unsigned old = xb_add(&bar[XB_XSUB(b.x)], 1u);
        const unsigned gen = old / nloc;
        if (old + 1u == (gen + 1u) * nloc) {
            __builtin_amdgcn_fence(__ATOMIC_RELEASE, "agent");
            asm volatile("s_waitcnt vmcnt(0)" ::: "memory");
            const unsigned og = xb_add(&bar[XB_TOP], 1u);
            const unsigned tg = og / nx;
            if (og + 1u == (tg + 1u) * nx) xb_add(&bar[XB_TOPGEN], 1u);
            else XB_SPIN(xb_ld(&bar[XB_TOPGEN]) == tg, bar);
            __builtin_amdgcn_fence(__ATOMIC_ACQUIRE, "agent");
            xb_add(&bar[XB_XGEN(b.x)], 1u);
            asm volatile("s_waitcnt vmcnt(0)" ::: "memory");
        } else {
            XB_SPIN(xb_ld(&bar[XB_XGEN(b.x)]) == gen, bar);
            __builtin_amdgcn_fence(__ATOMIC_ACQUIRE, "agent");
            asm volatile("s_waitcnt vmcnt(0)" ::: "memory");
        }
    }
    __syncthreads();
}

namespace att {
template <int DK0_, int DK1_, int DV_> struct Cfg {
    static constexpr int DK0 = DK0_, DK1 = DK1_, DK = DK0_ + DK1_, DV = DV_;
    static constexpr int KP = DK * 2 + 16, VP = DV * 2 + 64;
    static constexpr int KOFF = 0, VOFF = 64 * KP, POFF = VOFF + 64 * VP, BUFB = POFF + 256;
    static constexpr int NKC = (64 * DK / 8) / 512, NVC = (64 * DV / 8) / 512;
    static constexpr int ND = DK / 16, NO = DV / 32;
};
constexpr int BTAB_OFF = 94208, KMEAN_OFF = 94208 + 1024;
struct Src { const bf16_t* k0; int pk0; const bf16_t* k1; int pk1; const bf16_t* v; int pv; const int* pos; };
struct WaveCtx { int lane, r32, hi, wid, tid; };

template <class C, bool WITH_POS> struct Stage {
    u32x4 kr[C::NKC]; u32x4 vr[C::NVC]; int pr;
    __device__ __forceinline__ void load(const Src& s, int t, int tid) {
        const int kb = t * 64;
#pragma unroll
        for (int i = 0; i < C::NKC; ++i) { const int id = tid + 512 * i, row = id / (C::DK / 8), c = id % (C::DK / 8);
            const bf16_t* p = (C::DK1 == 0 || c < C::DK0 / 8) ? s.k0 + (size_t)(kb + row) * s.pk0 + c * 8 : s.k1 + (size_t)(kb + row) * s.pk1 + (c - C::DK0 / 8) * 8;
            kr[i] = *(const u32x4*)p; }
#pragma unroll
        for (int i = 0; i < C::NVC; ++i) { const int id = tid + 512 * i, row = id / (C::DV / 8), c = id % (C::DV / 8);
            vr[i] = *(const u32x4*)(s.v + (size_t)(kb + row) * s.pv + c * 8); }
        pr = (WITH_POS && tid < 64) ? s.pos[kb + tid] : 0;
    }
    __device__ __forceinline__ void store(LAS unsigned char* buf, int tid) const {
#pragma unroll
        for (int i = 0; i < C::NKC; ++i) { const int id = tid + 512 * i, row = id / (C::DK / 8), c = id % (C::DK / 8); *(LAS u32x4*)(buf + C::KOFF + row * C::KP + c * 16) = kr[i]; }
#pragma unroll
        for (int i = 0; i < C::NVC; ++i) { const int id = tid + 512 * i, row = id / (C::DV / 8), c = id % (C::DV / 8); *(LAS u32x4*)(buf + C::VOFF + row * C::VP + c * 16) = vr[i]; }
        if (WITH_POS && tid < 64) *(LAS int*)(buf + C::POFF + tid * 4) = pr;
    }
};
__device__ __forceinline__ s16x4 vtr(const LAS unsigned char* p) { typedef short v4i16_t __attribute__((ext_vector_type(4))); return __builtin_bit_cast(s16x4, __builtin_amdgcn_ds_read_tr16_b64_v4i16((LAS v4i16_t*)p)); }

struct RowState { float m, l; };

template <class C, int KIND, bool BIAS>
__device__ __forceinline__ void tile_compute(const LAS unsigned char* buf, const LAS float* btab, const bf16x8 (&qf)[C::ND], f32x16 (&O)[C::NO], RowState& st,
                                             int k0, int qw, int posq, int pminq, const int* pmm, unsigned selmask, int blk, const WaveCtx& w) {
    const int qi = qw + w.r32;
#pragma unroll
    for (int p = 0; p < 2; ++p) {
        const int ks = k0 + 32 * p;
        bool causal_tile = true, sel_lane = true, skip = false, fast = false;
        if (KIND == 0) { skip = ks > qw + 31; fast = (ks + 31 <= qw); }
        if (KIND == 1) { skip = (ks > qw + 31) || (ks + 31 < qw - 127); }
        if (KIND == 2) {
            const int n = ks >> 8;
            if (n < blk) { causal_tile = false; sel_lane = ((selmask >> n) & 1u) != 0u; skip = !__any(sel_lane); fast = (bool)__all(sel_lane); }
            else { skip = ks > qw + 31; fast = (ks + 31 <= qw); }
        }
        if (skip) continue;
        if (BIAS && fast) { const int pmaxk = pmm[(ks >> 5) * 2 + 1]; fast = (pminq - pmaxk >= 128); }
        f32x16 sc;
#pragma unroll
        for (int r = 0; r < 16; ++r) sc[r] = 0.f;
        const LAS unsigned char* kb = buf + C::KOFF + (32 * p + w.r32) * C::KP + w.hi * 16;
#pragma unroll
        for (int d0 = 0; d0 < C::ND; ++d0) {
            const bf16x8 a0 = *(const LAS bf16x8*)(kb + d0 * 32);
            sc = __builtin_amdgcn_mfma_f32_32x32x16_bf16(a0, qf[d0], sc, 0, 0, 0);
        }
        if (fast) {
            if (BIAS) { const float bc = btab[128];
#pragma unroll
                for (int r = 0; r < 16; ++r) sc[r] += bc; }
        } else {
#pragma unroll
            for (int g4 = 0; g4 < 4; ++g4) {
                i32x4 pk = (i32x4){0, 0, 0, 0};
                if (BIAS) pk = *(const LAS i32x4*)(buf + C::POFF + (32 * p + 8 * g4 + 4 * w.hi) * 4);
#pragma unroll
                for (int e = 0; e < 4; ++e) {
                    const int r = 4 * g4 + e, kv = ks + 8 * g4 + 4 * w.hi + e;
                    float v = sc[r];
                    if (BIAS) { int d = posq - pk[e]; d = d < 0 ? 0 : (d > 128 ? 128 : d); v += btab[d]; }
                    bool valid;
                    if (KIND == 0) valid = kv <= qi;
                    else if (KIND == 1) valid = (unsigned)(qi - kv) < 128u;
                    else valid = causal_tile ? (kv <= qi) : sel_lane;
                    sc[r] = valid ? v : NEG_INF;
                }
            }
        }
        float tmax = sc[0];
#pragma unroll
        for (int r = 1; r < 16; ++r) tmax = fmaxf(tmax, sc[r]);
        tmax = fmaxf(tmax, __shfl_xor(tmax, 32));
        const float mn = fmaxf(st.m, tmax);
        const float alpha = __builtin_amdgcn_exp2f(st.m - mn);
        st.m = mn;
        float ps = 0.f;
#pragma unroll
        for (int r = 0; r < 16; ++r) { sc[r] = __builtin_amdgcn_exp2f(sc[r] - mn); ps += sc[r]; }
        st.l = st.l * alpha + ps;
        if (__any(alpha != 1.0f)) {
#pragma unroll
            for (int d = 0; d < C::NO; ++d)
#pragma unroll
                for (int r = 0; r < 16; ++r) O[d][r] *= alpha;
        }
        const LAS unsigned char* vb = buf + C::VOFF + (32 * p + 4 * w.hi + ((w.lane & 15) >> 2)) * C::VP + (16 * ((w.lane >> 4) & 1) + 4 * (w.lane & 3)) * 2;
#pragma unroll
        for (int s = 0; s < 2; ++s) {
            u32x4 t; const int b = 8 * s;
            t.x = cvt_pk_bf16(sc[b], sc[b + 1]); t.y = cvt_pk_bf16(sc[b + 2], sc[b + 3]); t.z = cvt_pk_bf16(sc[b + 4], sc[b + 5]); t.w = cvt_pk_bf16(sc[b + 6], sc[b + 7]);
            const bf16x8 pf = __builtin_bit_cast(bf16x8, t);
#pragma unroll
            for (int d = 0; d < C::NO; ++d) {
                const s16x4 lo = vtr(vb + (16 * s) * C::VP + d * 64), hi4 = vtr(vb + (16 * s + 8) * C::VP + d * 64);
                const bf16x8 vf = (bf16x8){lo[0], lo[1], lo[2], lo[3], hi4[0], hi4[1], hi4[2], hi4[3]};
                O[d] = __builtin_amdgcn_mfma_f32_32x32x16_bf16(vf, pf, O[d], 0, 0, 0);
            }
        }
    }
}

template <class C, int KIND, bool BIAS>
__device__ __forceinline__ void run_tiles(LAS unsigned char* lds, const Src& src, int t0, int t1, const bf16x8 (&qf)[C::ND], f32x16 (&O)[C::NO], RowState& st,
                                          int qw, int posq, int pminq, const int* pmm, unsigned selmask, int blk, const WaveCtx& w) {
    Stage<C, BIAS> sg;
    const LAS float* btab = (const LAS float*)(lds + BTAB_OFF);
    if (t0 < t1) sg.load(src, t0, w.tid);
    int it = 0;
    for (int t = t0; t < t1; ++t, ++it) {
        LAS unsigned char* buf = lds + (it & 1) * C::BUFB;
        sg.store(buf, w.tid);
        __syncthreads();
        if (t + 1 < t1) sg.load(src, t + 1, w.tid);
        tile_compute<C, KIND, BIAS>(buf, btab, qf, O, st, t * 64, qw, posq, pminq, pmm, selmask, blk, w);
    }
    __syncthreads();
}
template <int ND> __device__ __forceinline__ void load_q(bf16x8 (&qf)[ND], const bf16_t* qrow, int hi) {
#pragma unroll
    for (int d0 = 0; d0 < ND; ++d0) qf[d0] = *(const bf16x8*)(qrow + d0 * 16 + hi * 8);
}
template <int NO> __device__ __forceinline__ void store_o(const f32x16 (&O)[NO], bf16_t* orow, int hi) {
#pragma unroll
    for (int d = 0; d < NO; ++d)
#pragma unroll
        for (int g = 0; g < 4; ++g) { u32x2 v; v.x = cvt_pk_bf16(O[d][4 * g], O[d][4 * g + 1]); v.y = cvt_pk_bf16(O[d][4 * g + 2], O[d][4 * g + 3]); *(u32x2*)(orow + 32 * d + 8 * g + 4 * hi) = v; }
}
}

struct Args { const float* in[20]; float* out; unsigned char* ws; int ph_lo, ph_hi; };
constexpr int PH_PER_LAYER = 12, N_PHASES = 2 + DEPTH * PH_PER_LAYER;

struct Frame {
    LAS unsigned char* lds; volatile LAS unsigned* MISC; unsigned* ctl;
    int tid, lane, wave, G, vcu;
    unsigned char* ws;
};

__device__ __forceinline__ void transpose_item(const float* W, int K, int Nsrc, bf16_t* WT, int Ndst, int pad_lo, int pad_hi, int shift, LAS float* scr, int item, int lane) {
    const int nblk = Ndst / 32, kb = item / nblk, nb = item % nblk, k0 = 64 * kb, n0 = 32 * nb;
    const bool pad = (n0 >= pad_lo && n0 < pad_hi);
    const int ns0 = n0 - (n0 >= pad_hi ? shift : 0);
    if (!pad) {
#pragma unroll 8
        for (int i = 0; i < 32; ++i) { const int kk = 2 * i + (lane >> 5); scr[kk * 33 + (lane & 31)] = W[(size_t)(k0 + kk) * Nsrc + ns0 + (lane & 31)]; }
    }
    LDS_WAIT(); asm volatile("" ::: "memory");
    const int c = lane & 7;
#pragma unroll
    for (int j = 0; j < 4; ++j) { const int n = (lane >> 3) + 8 * j; const LAS float* s = scr + (8 * c) * 33 + n;
        u32x4 o = (u32x4){0u, 0u, 0u, 0u};
        if (!pad) { o.x = cvt_pk_bf16(s[0 * 33], s[1 * 33]); o.y = cvt_pk_bf16(s[2 * 33], s[3 * 33]); o.z = cvt_pk_bf16(s[4 * 33], s[5 * 33]); o.w = cvt_pk_bf16(s[6 * 33], s[7 * 33]); }
        *(u32x4*)(WT + (size_t)(n0 + n) * K + k0 + 8 * c) = o; }
    LDS_WAIT(); asm volatile("" ::: "memory");
}
__device__ __forceinline__ int t5_bucket(int n) {
    if (n < 16) return n;
    int b = 16;
    b += (n >= 19); b += (n >= 21); b += (n >= 24); b += (n >= 27); b += (n >= 31); b += (n >= 35); b += (n >= 40); b += (n >= 46);
    b += (n >= 52); b += (n >= 59); b += (n >= 67); b += (n >= 77); b += (n >= 87); b += (n >= 99); b += (n >= 113);
    return b;
}
__device__ __forceinline__ void rms_row_bf16(const float* xrow, const float* g, bf16_t* orow, int lane) {
    f32x4 v[8]; float s = 0.f;
#pragma unroll
    for (int j = 0; j < 8; ++j) { v[j] = *((const f32x4*)xrow + lane + 64 * j); s += (v[j].x * v[j].x + v[j].y * v[j].y) + (v[j].z * v[j].z + v[j].w * v[j].w); }
    const float rstd = 1.0f / sqrtf(wave_sum(s) * (1.0f / DM) + EPS);
#pragma unroll
    for (int j = 0; j < 8; ++j) { const f32x4 gg = *((const f32x4*)g + lane + 64 * j);
        u32x2 o; o.x = cvt_pk_bf16(v[j].x * rstd * gg.x, v[j].y * rstd * gg.y); o.y = cvt_pk_bf16(v[j].z * rstd * gg.z, v[j].w * rstd * gg.w);
        *((u32x2*)orow + lane + 64 * j) = o; }
}
__device__ __forceinline__ void rms_row_f32(const float* xrow, const float* g, float* orow, int lane) {
    f32x4 v[8]; float s = 0.f;
#pragma unroll
    for (int j = 0; j < 8; ++j) { v[j] = *((const f32x4*)xrow + lane + 64 * j); s += (v[j].x * v[j].x + v[j].y * v[j].y) + (v[j].z * v[j].z + v[j].w * v[j].w); }
    const float rstd = 1.0f / sqrtf(wave_sum(s) * (1.0f / DM) + EPS);
#pragma unroll
    for (int j = 0; j < 8; ++j) { const f32x4 gg = *((const f32x4*)g + lane + 64 * j); *((f32x4*)orow + lane + 64 * j) = v[j] * rstd * gg; }
}

__device__ __forceinline__ float gelu_f(float v) {
    const float av = fabsf(v), d = av * 0.2316418882f + 1.0f;
    const float t = __builtin_amdgcn_rcpf(d);
    float q = t * 0.5307027145f + (-0.7265760135f); q = q * t + 0.7107068705f; q = q * t + (-0.142248368f); q = q * t + 0.127414796f; q = q * t;
    const float e = __builtin_amdgcn_exp2f((v * v) * (-0.72134752044f));
    const float m = v * (q * e), r = v - m;
    return v < 0.f ? m : r;
}

__device__ __forceinline__ void p_prologue(Frame& F, const Args& a) {
    const int otid = opaque_tid(), olane = otid & 63;
    LAS float* scr = (LAS float*)(F.lds + RING_OFF + F.wave * 16384);
    const int gw = F.vcu * NWAVES + F.wave, NGW = F.G * NWAVES;
    constexpr int I_IN = (DM / 64) * (ZLD / 32), I_UQ = (512 / 64) * (768 / 32), I_UKV = (256 / 64) * (1024 / 32), I_BR1 = (512 / 64) * (DM / 32), I_BR = 4 * I_BR1,
                  I_OUT = (DM / 64) * (DM / 32), I_UP = (DM / 64) * (UP_N / 32), I_DN = (FFN / 64) * (DM / 32);
    constexpr int I_LAYER = I_IN + I_UQ + I_UKV + I_BR + I_OUT + I_UP + I_DN;
    for (int it = gw; it < DEPTH * I_LAYER; it += NGW) {
        const int l = it / I_LAYER; int r = it - l * I_LAYER;
        unsigned char* wl = F.ws + WS_W + (size_t)l * W_LAYER;
        if (r < I_IN) { transpose_item(a.in[4] + (size_t)l * DM * IN_COLS, DM, IN_COLS, (bf16_t*)(wl + W_IN), ZLD, 2368, 2560, 192, scr, r, olane); continue; } r -= I_IN;
        if (r < I_UQ) { transpose_item(a.in[8] + (size_t)l * 512 * 768, 512, 768, (bf16_t*)(wl + W_UQ), 768, 1 << 30, 1 << 30, 0, scr, r, olane); continue; } r -= I_UQ;
        if (r < I_UKV) { transpose_item(a.in[10] + (size_t)l * 256 * 1024, 256, 1024, (bf16_t*)(wl + W_UKV), 1024, 1 << 30, 1 << 30, 0, scr, r, olane); continue; } r -= I_UKV;
        if (r < I_BR) { const int i = r / I_BR1; transpose_item(a.in[12] + ((size_t)l * 4 + i) * 512 * DM, 512, DM, (bf16_t*)(wl + W_BR) + (size_t)i * DM * 512, DM, 1 << 30, 1 << 30, 0, scr, r - i * I_BR1, olane); continue; } r -= I_BR;
        if (r < I_OUT) { transpose_item(a.in[13] + (size_t)l * DM * DM, DM, DM, (bf16_t*)(wl + W_OUT), DM, 1 << 30, 1 << 30, 0, scr, r, olane); continue; } r -= I_OUT;
        if (r < I_UP) { transpose_item(a.in[15] + (size_t)l * DM * UP_N, DM, UP_N, (bf16_t*)(wl + W_UP), UP_N, 1 << 30, 1 << 30, 0, scr, r, olane); continue; } r -= I_UP;
        transpose_item(a.in[18] + (size_t)l * FFN * DM, FFN, DM, (bf16_t*)(wl + W_DN), DM, 1 << 30, 1 << 30, 0, scr, r, olane);
    }
    const int* pos = (const int*)a.in[1];
    const int gt = F.vcu * (NWAVES * 64) + otid, NGT = F.G * NWAVES * 64;
    f32x2* rope = (f32x2*)(F.ws + WS_ROPE);
    for (int e = gt; e < SEQ * 32; e += NGT) {
        const int s = e >> 5, i = e & 31;
        const float inv = (float)exp2((double)(-i) * (13.287712379549449 / 32.0));
        const float ang = (float)pos[s] * inv;
        const double rev = (double)ang * 0.15915494309189535;
        const float fr = (float)(rev - rint(rev));
        rope[e] = (f32x2){__builtin_amdgcn_cosf(fr), __builtin_amdgcn_sinf(fr)};
    }
    float* btab = (float*)(F.ws + WS_BTAB);
    for (int e = gt; e < 16 * 132; e += NGT) { const int hd = e / 132, n = e - hd * 132; btab[e] = (n <= 128) ? a.in[2][t5_bucket(n) * 16 + hd] * LOG2E : 0.f; }
    int* pmm = (int*)(F.ws + WS_PMM);
    for (int e = gt; e < 128; e += NGT) { int mn = pos[e * 32], mx = mn;
        for (int j = 1; j < 32; ++j) { const int p = pos[e * 32 + j]; mn = p < mn ? p : mn; mx = p > mx ? p : mx; }
        pmm[2 * e] = mn; pmm[2 * e + 1] = mx; }
    if (gt < DEPTH) {
        const float* lv = a.in[5] + (size_t)gt * 4 * 64; float s01 = 0.f, s23 = 0.f;
        for (int j = 0; j < 64; ++j) { s01 += lv[j] * lv[64 + j]; s23 += lv[128 + j] * lv[192 + j]; }
        const double li[4] = {0.20000000000000007, 0.35550906759096934, 0.4707130183435842, 0.5560582041556406};
        const float lam_init = (float)(gt == 0 ? li[0] : gt == 1 ? li[1] : gt == 2 ? li[2] : li[3]);
        ((float*)(F.ws + WS_LAM))[gt] = expf(s01) - expf(s23) + lam_init;
    }
}

__device__ __forceinline__ void p_prep(Frame& F, const Args& a, int l) {
    const int otid = opaque_tid(), lane = otid & 63;
    const int gw = F.vcu * NWAVES + F.wave, NGW = F.G * NWAVES;
    const bf16_t* Z = (const bf16_t*)(F.ws + WS_Z);
    bf16_t* CQN = (bf16_t*)(F.ws + WS_CQN); bf16_t* CKVN = (bf16_t*)(F.ws + WS_CKVN); bf16_t* KR = (bf16_t*)(F.ws + WS_KR);
    const float* gq = a.in[7] + (size_t)l * 512; const float* gkv = a.in[9] + (size_t)l * 256;
    const f32x2* rope = (const f32x2*)(F.ws + WS_ROPE);
    for (int m = gw; m < M; m += NGW) {
        const bf16_t* zr = Z + (size_t)m * ZLD;
        {
            const u32x4 v = *(const u32x4*)(zr + ZCQ + lane * 8);
            float x[8] = {bflo(v.x), bfhi(v.x), bflo(v.y), bfhi(v.y), bflo(v.z), bfhi(v.z), bflo(v.w), bfhi(v.w)};
            float s = 0.f;
#pragma unroll
            for (int j = 0; j < 8; ++j) s += x[j] * x[j];
            const float rstd = 1.0f / sqrtf(wave_sum(s) * (1.0f / 512.0f) + EPS);
            const f32x4 g0 = *(const f32x4*)(gq + lane * 8), g1 = *(const f32x4*)(gq + lane * 8 + 4);
            u32x4 o; o.x = cvt_pk_bf16(x[0] * rstd * g0.x, x[1] * rstd * g0.y); o.y = cvt_pk_bf16(x[2] * rstd * g0.z, x[3] * rstd * g0.w);
            o.z = cvt_pk_bf16(x[4] * rstd * g1.x, x[5] * rstd * g1.y); o.w = cvt_pk_bf16(x[6] * rstd * g1.z, x[7] * rstd * g1.w);
            *(u32x4*)(CQN + (size_t)m * 512 + lane * 8) = o;
        }
        {
            const u32x2 v = *(const u32x2*)(zr + ZCKV + lane * 4);
            const float x0 = bflo(v.x), x1 = bfhi(v.x), x2 = bflo(v.y), x3 = bfhi(v.y);
            const float rstd = 1.0f / sqrtf(wave_sum((x0 * x0 + x1 * x1) + (x2 * x2 + x3 * x3)) * (1.0f / 256.0f) + EPS);
            const f32x4 g = *(const f32x4*)(gkv + lane * 4);
            u32x2 o; o.x = cvt_pk_bf16(x0 * rstd * g.x, x1 * rstd * g.y); o.y = cvt_pk_bf16(x2 * rstd * g.z, x3 * rstd * g.w);
            *(u32x2*)(CKVN + (size_t)m * 256 + lane * 4) = o;
        }
        if (lane < 32) {
            const float x1 = bf2f(zr[ZKR + lane]), x2 = bf2f(zr[ZKR + 32 + lane]);
            const f32x2 cs = rope[(m & (SEQ - 1)) * 32 + lane];
            KR[(size_t)m * 64 + lane] = (bf16_t)(cvt_pk_bf16(x1 * cs.x - x2 * cs.y, 0.f) & 0xffffu);
            KR[(size_t)m * 64 + 32 + lane] = (bf16_t)(cvt_pk_bf16(x1 * cs.y + x2 * cs.x, 0.f) & 0xffffu);
        }
    }
    LAS float* scr = (LAS float*)(F.lds + RING_OFF);
    float* KM = (float*)(F.ws + WS_KMEAN);
    for (int it = F.vcu; it < NB * 4 * 16; it += F.G) {
        const int b = it >> 6, h = (it >> 4) & 3, n = it & 15;
        const int c8 = otid & 15, rg = otid >> 4;
        float acc[8];
#pragma unroll
        for (int j = 0; j < 8; ++j) acc[j] = 0.f;
        for (int j = 0; j < 8; ++j) {
            const u32x4 v = *(const u32x4*)(Z + (size_t)(b * SEQ + n * 256 + rg + 32 * j) * ZLD + ZMK + h * 128 + c8 * 8);
            acc[0] += bflo(v.x); acc[1] += bfhi(v.x); acc[2] += bflo(v.y); acc[3] += bfhi(v.y); acc[4] += bflo(v.z); acc[5] += bfhi(v.z); acc[6] += bflo(v.w); acc[7] += bfhi(v.w);
        }
#pragma unroll
        for (int j = 0; j < 8; ++j) scr[rg * 132 + c8 * 8 + j] = acc[j];
        __syncthreads();
        if (otid < 128) { float s = 0.f; for (int r = 0; r < 32; ++r) s += scr[r * 132 + otid]; KM[(size_t)it * 128 + otid] = s * (1.0f / 256.0f); }
        __syncthreads();
    }
}

__device__ __forceinline__ void p_convglu(Frame& F, const Args& a, int l) {
    const int lane = opaque_tid() & 63;
    const int gw = F.vcu * NWAVES + F.wave, NGW = F.G * NWAVES;
    const bf16_t* U = (const bf16_t*)(F.ws + WS_Z); bf16_t* Gb = (bf16_t*)(F.ws + WS_T);
    const float* cw = a.in[16] + (size_t)l * 3 * FFN; const float* cb = a.in[17] + (size_t)l * FFN;
    constexpr int NCG = FFN / 512;
    for (int it = gw; it < (M / 16) * NCG; it += NGW) {
        const int rb = it / NCG, cg = it - rb * NCG, ch0 = (cg * 64 + lane) * 8, m0 = rb * 16;
        float w0[8], w1[8], w2[8], bb[8];
#pragma unroll
        for (int h = 0; h < 2; ++h) { const f32x4 t0 = *(const f32x4*)(cw + ch0 + 4 * h), t1 = *(const f32x4*)(cw + FFN + ch0 + 4 * h), t2 = *(const f32x4*)(cw + 2 * FFN + ch0 + 4 * h), t3 = *(const f32x4*)(cb + ch0 + 4 * h);
#pragma unroll
            for (int e = 0; e < 4; ++e) { w0[4 * h + e] = t0[e]; w1[4 * h + e] = t1[e]; w2[4 * h + e] = t2[e]; bb[4 * h + e] = t3[e]; } }
        float am1[8], am2[8];
        if ((m0 & (SEQ - 1)) == 0) {
#pragma unroll
            for (int e = 0; e < 8; ++e) { am1[e] = 0.f; am2[e] = 0.f; }
        } else {
            const u32x4 p1 = *(const u32x4*)(U + (size_t)(m0 - 1) * UP_N + ch0), p2 = *(const u32x4*)(U + (size_t)(m0 - 2) * UP_N + ch0);
            am1[0] = bflo(p1.x); am1[1] = bfhi(p1.x); am1[2] = bflo(p1.y); am1[3] = bfhi(p1.y); am1[4] = bflo(p1.z); am1[5] = bfhi(p1.z); am1[6] = bflo(p1.w); am1[7] = bfhi(p1.w);
            am2[0] = bflo(p2.x); am2[1] = bfhi(p2.x); am2[2] = bflo(p2.y); am2[3] = bfhi(p2.y); am2[4] = bflo(p2.z); am2[5] = bfhi(p2.z); am2[6] = bflo(p2.w); am2[7] = bfhi(p2.w);
        }
        for (int r = 0; r < 16; ++r) {
            const size_t row = (size_t)(m0 + r);
            const u32x4 pa = *(const u32x4*)(U + row * UP_N + ch0), pv = *(const u32x4*)(U + row * UP_N + FFN + ch0);
            float a0[8] = {bflo(pa.x), bfhi(pa.x), bflo(pa.y), bfhi(pa.y), bflo(pa.z), bfhi(pa.z), bflo(pa.w), bfhi(pa.w)};
            float vv[8] = {bflo(pv.x), bfhi(pv.x), bflo(pv.y), bfhi(pv.y), bflo(pv.z), bfhi(pv.z), bflo(pv.w), bfhi(pv.w)};
            float o[8];
#pragma unroll
            for (int e = 0; e < 8; ++e) { const float c = bb[e] + w0[e] * am2[e] + w1[e] * am1[e] + w2[e] * a0[e]; o[e] = gelu_f(c) * vv[e]; am2[e] = am1[e]; am1[e] = a0[e]; }
            u32x4 w; w.x = cvt_pk_bf16(o[0], o[1]); w.y = cvt_pk_bf16(o[2], o[3]); w.z = cvt_pk_bf16(o[4], o[5]); w.w = cvt_pk_bf16(o[6], o[7]);
            *(u32x4*)(Gb + row * FFN + ch0) = w;
        }
    }
}

struct AttnEnv { const bf16_t* Z; const bf16_t* QMLA; const bf16_t* KVMLA; const bf16_t* KR; bf16_t* BRO; const int* pos; const int* pmm; const float* btabg; const f32x2* rope; const float* kmean;
                 const float* subln_g; const float* sinks; float* dscr; float lam, one_m_li; };

__device__ __forceinline__ void load_btab(LAS unsigned char* lds, const float* src, int tid) { if (tid < 132) ((LAS float*)(lds + att::BTAB_OFF))[tid] = src[tid]; }

__device__ __forceinline__ void unit_diff(LAS unsigned char* lds, const AttnEnv& E, int b, int h, int qb, const att::WaveCtx& w) {
    typedef att::Cfg<64, 0, 128> C;
    const int qw = qb * 256 + 32 * w.wid, qi = qw + w.r32; const size_t grow = (size_t)b * SEQ + qi;
    load_btab(lds, E.btabg + (0 + h) * 132, w.tid);
    const int posq = E.pos[qi], pminq = E.pmm[(qw >> 5) * 2];
    f32x16 O[4];
    f32x4* park = (f32x4*)(E.dscr + ((size_t)blockIdx.x * 512 + w.tid) * 64);
#pragma unroll
    for (int mp = 0; mp < 2; ++mp) {
        att::Src src; src.k0 = E.Z + (size_t)b * SEQ * ZLD + ZKA + (2 * h + mp) * 64; src.pk0 = ZLD; src.k1 = src.k0; src.pk1 = ZLD; src.v = E.Z + (size_t)b * SEQ * ZLD + ZVA + h * 128; src.pv = ZLD; src.pos = E.pos;
        bf16x8 qf[4]; att::load_q<4>(qf, E.Z + grow * ZLD + ZQA + (2 * h + mp) * 64, w.hi);
#pragma unroll
        for (int d = 0; d < 4; ++d)
#pragma unroll
            for (int r = 0; r < 16; ++r) O[d][r] = 0.f;
        att::RowState st; st.m = -1e30f; st.l = 0.f;
        att::run_tiles<C, 0, true>(lds, src, 0, 4 * (qb + 1), qf, O, st, qw, posq, pminq, E.pmm, 0u, 0, w);
        const float inv = 1.0f / (st.l + __shfl_xor(st.l, 32));
        if (mp == 0) {
#pragma unroll
            for (int d = 0; d < 4; ++d)
#pragma unroll
                for (int g = 0; g < 4; ++g) park[d * 4 + g] = (f32x4){O[d][4 * g] * inv, O[d][4 * g + 1] * inv, O[d][4 * g + 2] * inv, O[d][4 * g + 3] * inv};
        } else {
            const float li = E.lam * inv;
#pragma unroll
            for (int d = 0; d < 4; ++d)
#pragma unroll
                for (int g = 0; g < 4; ++g) { const f32x4 pv = park[d * 4 + g];
#pragma unroll
                    for (int e = 0; e < 4; ++e) O[d][4 * g + e] = pv[e] - li * O[d][4 * g + e]; }
        }
    }
    float ss = 0.f;
#pragma unroll
    for (int d = 0; d < 4; ++d)
#pragma unroll
        for (int r = 0; r < 16; ++r) ss += O[d][r] * O[d][r];
    ss += __shfl_xor(ss, 32);
    const float sc = (1.0f / sqrtf(ss * (1.0f / 128.0f) + EPS)) * E.one_m_li;
#pragma unroll
    for (int d = 0; d < 4; ++d)
#pragma unroll
        for (int g = 0; g < 4; ++g) { const f32x4 gg = *(const f32x4*)(E.subln_g + 32 * d + 8 * g + 4 * w.hi);
#pragma unroll
            for (int e = 0; e < 4; ++e) O[d][4 * g + e] *= sc * gg[e]; }
    att::store_o<4>(O, E.BRO + grow * DM + h * 128, w.hi);
}

__device__ __forceinline__ void unit_mla(LAS unsigned char* lds, const AttnEnv& E, int b, int h, int qb, const att::WaveCtx& w) {
    typedef att::Cfg<128, 64, 128> C;
    const int qw = qb * 256 + 32 * w.wid, qi = qw + w.r32; const size_t grow = (size_t)b * SEQ + qi;
    att::Src src; src.k0 = E.KVMLA + (size_t)b * SEQ * 1024 + h * 256; src.pk0 = 1024; src.k1 = E.KR + (size_t)b * SEQ * 64; src.pk1 = 64; src.v = E.KVMLA + (size_t)b * SEQ * 1024 + h * 256 + 128; src.pv = 1024; src.pos = E.pos;
    bf16x8 qf[12]; att::load_q<12>(qf, E.QMLA + grow * 768 + h * 192, w.hi);
#pragma unroll
    for (int dd = 0; dd < 2; ++dd) {
        const f32x2* cs = E.rope + (size_t)qi * 32 + 16 * dd + 8 * w.hi;
        unsigned o1[4], o2[4];
#pragma unroll
        for (int jp = 0; jp < 4; ++jp) {
            const f32x4 c2 = *(const f32x4*)(cs + 2 * jp);
            const float a0 = bf2f((unsigned short)qf[8 + dd][2 * jp]), a1 = bf2f((unsigned short)qf[8 + dd][2 * jp + 1]);
            const float b0 = bf2f((unsigned short)qf[10 + dd][2 * jp]), b1 = bf2f((unsigned short)qf[10 + dd][2 * jp + 1]);
            o1[jp] = cvt_pk_bf16(a0 * c2[0] - b0 * c2[1], a1 * c2[2] - b1 * c2[3]);
            o2[jp] = cvt_pk_bf16(a0 * c2[1] + b0 * c2[0], a1 * c2[3] + b1 * c2[2]);
        }
        qf[8 + dd] = __builtin_bit_cast(bf16x8, (u32x4){o1[0], o1[1], o1[2], o1[3]});
        qf[10 + dd] = __builtin_bit_cast(bf16x8, (u32x4){o2[0], o2[1], o2[2], o2[3]});
    }
    f32x16 O[4];
#pragma unroll
    for (int d = 0; d < 4; ++d)
#pragma unroll
        for (int r = 0; r < 16; ++r) O[d][r] = 0.f;
    att::RowState st; st.m = -1e30f; st.l = 0.f;
    att::run_tiles<C, 0, false>(lds, src, 0, 4 * (qb + 1), qf, O, st, qw, 0, 0, E.pmm, 0u, 0, w);
    const float inv = 1.0f / (st.l + __shfl_xor(st.l, 32));
#pragma unroll
    for (int d = 0; d < 4; ++d)
#pragma unroll
        for (int r = 0; r < 16; ++r) O[d][r] *= inv;
    att::store_o<4>(O, E.BRO + grow * DM + 512 + h * 128, w.hi);
}

__device__ __forceinline__ void unit_swa(LAS unsigned char* lds, const AttnEnv& E, int b, int qh, int qb, const att::WaveCtx& w) {
    typedef att::Cfg<64, 0, 64> C;
    const int qw = qb * 256 + 32 * w.wid, qi = qw + w.r32; const size_t grow = (size_t)b * SEQ + qi; const int kvh = qh >> 2;
    load_btab(lds, E.btabg + (4 + qh) * 132, w.tid);
    const int posq = E.pos[qi], pminq = E.pmm[(qw >> 5) * 2];
    att::Src src; src.k0 = E.Z + (size_t)b * SEQ * ZLD + ZSK + kvh * 64; src.pk0 = ZLD; src.k1 = src.k0; src.pk1 = ZLD; src.v = E.Z + (size_t)b * SEQ * ZLD + ZSV + kvh * 64; src.pv = ZLD; src.pos = E.pos;
    bf16x8 qf[4]; att::load_q<4>(qf, E.Z + grow * ZLD + ZSQ + qh * 64, w.hi);
    f32x16 O[2];
#pragma unroll
    for (int d = 0; d < 2; ++d)
#pragma unroll
        for (int r = 0; r < 16; ++r) O[d][r] = 0.f;
    att::RowState st; st.m = E.sinks[qh] * LOG2E; st.l = (w.hi == 0) ? 1.0f : 0.0f;
    const int t0 = qb == 0 ? 0 : 4 * qb - 2;
    att::run_tiles<C, 1, true>(lds, src, t0, 4 * (qb + 1), qf, O, st, qw, posq, pminq, E.pmm, 0u, 0, w);
    const float inv = 1.0f / (st.l + __shfl_xor(st.l, 32));
#pragma unroll
    for (int d = 0; d < 2; ++d)
#pragma unroll
        for (int r = 0; r < 16; ++r) O[d][r] *= inv;
    att::store_o<2>(O, E.BRO + grow * DM + 1024 + qh * 64, w.hi);
}

__device__ __forceinline__ void unit_moba(LAS unsigned char* lds, const AttnEnv& E, int b, int h, int blk, const att::WaveCtx& w) {
    typedef att::Cfg<128, 0, 128> C;
    const int qw = blk * 256 + 32 * w.wid, qi = qw + w.r32; const size_t grow = (size_t)b * SEQ + qi;
    load_btab(lds, E.btabg + (12 + h) * 132, w.tid);
    LAS float* km = (LAS float*)(lds + att::KMEAN_OFF);
    for (int e = w.tid; e < blk * 128; e += 512) km[e] = E.kmean[(size_t)((b * 4 + h) * 16) * 128 + e];
    const int posq = E.pos[qi], pminq = E.pmm[(qw >> 5) * 2];
    att::Src src; src.k0 = E.Z + (size_t)b * SEQ * ZLD + ZMK + h * 128; src.pk0 = ZLD; src.k1 = src.k0; src.pk1 = ZLD; src.v = E.Z + (size_t)b * SEQ * ZLD + ZMV + h * 128; src.pv = ZLD; src.pos = E.pos;
    bf16x8 qf[8]; att::load_q<8>(qf, E.Z + grow * ZLD + ZMQ + h * 128, w.hi);
    __syncthreads();
    unsigned selmask;
    if (blk <= 3) selmask = (1u << blk) - 1u;
    else {
        float v1 = NEG_INF, v2 = NEG_INF, v3 = NEG_INF; int i1 = 31, i2 = 31, i3 = 31;
        for (int n = 0; n < blk; ++n) {
            float part = 0.f;
#pragma unroll
            for (int d0 = 0; d0 < 8; ++d0) {
                const f32x4 k0 = *(const LAS f32x4*)(km + n * 128 + 16 * d0 + 8 * w.hi), k1 = *(const LAS f32x4*)(km + n * 128 + 16 * d0 + 8 * w.hi + 4);
#pragma unroll
                for (int j = 0; j < 4; ++j) part += bf2f((unsigned short)qf[d0][j]) * k0[j] + bf2f((unsigned short)qf[d0][4 + j]) * k1[j];
            }
            const float g = part + __shfl_xor(part, 32);
            if (g > v1) { v3 = v2; i3 = i2; v2 = v1; i2 = i1; v1 = g; i1 = n; }
            else if (g > v2) { v3 = v2; i3 = i2; v2 = g; i2 = n; }
            else if (g > v3) { v3 = g; i3 = n; }
        }
        selmask = (1u << i1) | (1u << i2) | (1u << i3);
    }
    f32x16 O[4];
#pragma unroll
    for (int d = 0; d < 4; ++d)
#pragma unroll
        for (int r = 0; r < 16; ++r) O[d][r] = 0.f;
    att::RowState st; st.m = -1e30f; st.l = 0.f;
    att::run_tiles<C, 2, true>(lds, src, 0, 4 * (blk + 1), qf, O, st, qw, posq, pminq, E.pmm, selmask, blk, w);
    const float inv = 1.0f / (st.l + __shfl_xor(st.l, 32));
#pragma unroll
    for (int d = 0; d < 4; ++d)
#pragma unroll
        for (int r = 0; r < 16; ++r) O[d][r] *= inv;
    att::store_o<4>(O, E.BRO + grow * DM + 1536 + h * 128, w.hi);
}

__device__ __forceinline__ int queue_next(Frame& F, unsigned* head) {
    __syncthreads();
    if (threadIdx.x == 0) F.MISC[4] = __hip_atomic_fetch_add(head, 1u, RLX_AGENT);
    __syncthreads();
    return (int)F.MISC[4];
}

__global__ void __launch_bounds__(NWAVES * 64, 2) trunk_fwd(Args args) {
    extern __shared__ __attribute__((aligned(16))) unsigned char lds_raw[];
    Frame F;
    F.lds = (LAS unsigned char*)lds_raw;
    F.MISC = (volatile LAS unsigned*)(F.lds + MISC_OFF);
    F.tid = threadIdx.x; F.lane = F.tid & 63; F.wave = __builtin_amdgcn_readfirstlane(F.tid >> 6);
    F.G = gridDim.x; { const int bx = blockIdx.x; F.vcu = (F.G % 8 == 0) ? (bx % 8) * (F.G / 8) + bx / 8 : bx; }
    F.ws = args.ws; F.ctl = (unsigned*)(args.ws + WS_CTL);
    for (int u = F.tid; u < (LDS_BYTES - LDSCTL_OFF) / 4; u += NWAVES * 64) ((LAS unsigned*)(F.lds + LDSCTL_OFF))[u] = 0u;
    __syncthreads();
    const int lo = args.ph_lo, hi = args.ph_hi;
    XcdBarrier bar; bar.bar = F.ctl + CW_BAR; bar.x = 0; bar.st = nullptr;
    if (hi - lo > 1) bar = xcd_barrier_post(F.ctl + CW_BAR, F.MISC + 8);
#ifndef DBG_MASK
#define DBG_MASK 0xFFFFu
#endif
#define EN(j) (((DBG_MASK) >> (j)) & 1u)
#ifndef DBG_ATT
#define DBG_ATT 0xFu
#endif
#define ENA(j) (((DBG_ATT) >> (j)) & 1u)
#define IN(k) (lo <= (k) && (k) < hi)
#define SEAM(k) do { if ((k) + 1 < hi) xcd_barrier(bar); } while (0)
    const int gw = F.vcu * NWAVES + F.wave, NGW = F.G * NWAVES;
    unsigned char* ws = F.ws;
    float* X = (float*)(ws + WS_X); bf16_t* XN = (bf16_t*)(ws + WS_XN); bf16_t* MG = (bf16_t*)(ws + WS_MG); bf16_t* Z = (bf16_t*)(ws + WS_Z);
    bf16_t* U = (bf16_t*)(ws + WS_Z); bf16_t* Gb = (bf16_t*)(ws + WS_T); float* T = (float*)(ws + WS_T);

    if (EN(12) && IN(0)) { p_prologue(F, args); SEAM(0); }

    for (int l = 0; l < DEPTH; ++l) {
        const int p0 = 1 + l * PH_PER_LAYER;
        if (hi <= p0 || lo >= p0 + PH_PER_LAYER) continue;
        unsigned char* wl = ws + WS_W + (size_t)l * W_LAYER;
        const float* xin = (l == 0) ? args.in[0] : X;
        if (EN(0) && IN(p0 + 0)) { const int ol = opaque_tid() & 63; const float* g = args.in[3] + (size_t)l * DM; for (int m = opaque_s(gw); m < M; m += NGW) rms_row_bf16(xin + (size_t)m * DM, g, XN + (size_t)m * DM, ol); SEAM(p0 + 0); }
        if (EN(1) && IN(p0 + 1)) {
            pg8::Gemm g{XN, (const bf16_t*)(wl + W_IN), M, ZLD, DM, DM, 0, 0}; pg8::StaticOrder S; S.init(M, ZLD, F.G, (int)blockIdx.x);
            pg8::EpiBf16 E{Z, ZLD, 0, 1.0f};
            pg8::gemm_phase<pg8::EpiBf16, pg8::StaticOrder, true>(F.lds + RING_OFF, g, S, E);
            SEAM(p0 + 1);
        }
        if (EN(2) && IN(p0 + 2)) { p_prep(F, args, l); SEAM(p0 + 2); }
        if (EN(3) && IN(p0 + 3)) {
            pg8::Gemm g{(const bf16_t*)(ws + WS_CQN), (const bf16_t*)(wl + W_UQ), M, 768, 512, 512, 0, 0}; pg8::StaticOrder S; S.init(M, 768, F.G, (int)blockIdx.x);
            pg8::EpiBf16 E{(bf16_t*)(ws + WS_QMLA), 768, 1, 0.07216878364870322f * LOG2E};
            pg8::gemm_phase<pg8::EpiBf16, pg8::StaticOrder, true>(F.lds + RING_OFF, g, S, E);
            SEAM(p0 + 3);
        }
        if (EN(4) && IN(p0 + 4)) {
            pg8::Gemm g{(const bf16_t*)(ws + WS_CKVN), (const bf16_t*)(wl + W_UKV), M, 1024, 256, 256, 0, 0}; pg8::StaticOrder S; S.init(M, 1024, F.G, (int)blockIdx.x);
            pg8::EpiBf16 E{(bf16_t*)(ws + WS_KVMLA), 1024, 1, 1.0f};
            pg8::gemm_phase<pg8::EpiBf16, pg8::StaticOrder, true>(F.lds + RING_OFF, g, S, E);
            SEAM(p0 + 4);
        }
        if (EN(5) && IN(p0 + 5)) {
            const double li[4] = {0.20000000000000007, 0.35550906759096934, 0.4707130183435842, 0.5560582041556406};
            AttnEnv E; E.Z = Z; E.QMLA = (const bf16_t*)(ws + WS_QMLA); E.KVMLA = (const bf16_t*)(ws + WS_KVMLA); E.KR = (const bf16_t*)(ws + WS_KR); E.BRO = (bf16_t*)(ws + WS_BRO);
            E.pos = (const int*)args.in[1]; E.pmm = (const int*)(ws + WS_PMM); E.btabg = (const float*)(ws + WS_BTAB); E.rope = (const f32x2*)(ws + WS_ROPE); E.kmean = (const float*)(ws + WS_KMEAN);
            E.dscr = (float*)(ws + WS_DSCR); E.subln_g = args.in[6] + (size_t)l * 128; E.sinks = args.in[11] + (size_t)l * 8; E.lam = ((const float*)(ws + WS_LAM))[l];
            E.one_m_li = 1.0f - (float)(l == 0 ? li[0] : l == 1 ? li[1] : l == 2 ? li[2] : li[3]);
            unsigned* qh = F.ctl + CW_QUEUE + 64 * (l * 4);
            if (ENA(0)) for (;;) { const int i = queue_next(F, qh + 0); if (i >= 256) break; { const int ot = opaque_tid(); const att::WaveCtx wctx{ot & 63, ot & 31, (ot >> 5) & 1, __builtin_amdgcn_readfirstlane(ot >> 6), ot}; unit_diff(F.lds, E, (i & 15) >> 2, i & 3, 15 - (i >> 4), wctx); } }
            if (ENA(1)) for (;;) { const int i = queue_next(F, qh + 64); if (i >= 256) break; { const int ot = opaque_tid(); const att::WaveCtx wctx{ot & 63, ot & 31, (ot >> 5) & 1, __builtin_amdgcn_readfirstlane(ot >> 6), ot}; unit_mla(F.lds, E, (i & 15) >> 2, i & 3, 15 - (i >> 4), wctx); } }
            if (ENA(2)) for (;;) { const int i = queue_next(F, qh + 128); if (i >= 256) break; { const int ot = opaque_tid(); const att::WaveCtx wctx{ot & 63, ot & 31, (ot >> 5) & 1, __builtin_amdgcn_readfirstlane(ot >> 6), ot}; unit_moba(F.lds, E, (i & 15) >> 2, i & 3, 15 - (i >> 4), wctx); } }
            if (ENA(3)) for (;;) { const int i = queue_next(F, qh + 192); if (i >= 512) break; { const int ot = opaque_tid(); const att::WaveCtx wctx{ot & 63, ot & 31, (ot >> 5) & 1, __builtin_amdgcn_readfirstlane(ot >> 6), ot}; unit_swa(F.lds, E, (i & 31) >> 3, i & 7, 15 - (i >> 5), wctx); } }
            SEAM(p0 + 5);
        }
        if (EN(6) && IN(p0 + 6)) {
            pg8::Gemm g{(const bf16_t*)(ws + WS_BRO), (const bf16_t*)(wl + W_BR), M, DM, 512, DM, (size_t)512 * 2, (size_t)DM * 512 * 2}; pg8::StaticOrder S; S.init(M, DM, F.G, (int)blockIdx.x, 4);
            pg8::EpiMerge E{Z + ZG, ZLD, T, MG};
            pg8::gemm_phase<pg8::EpiMerge, pg8::StaticOrder, true>(F.lds + RING_OFF, g, S, E);
            SEAM(p0 + 6);
        }
        if (EN(7) && IN(p0 + 7)) {
            pg8::Gemm g{MG, (const bf16_t*)(wl + W_OUT), M, DM, DM, DM, 0, 0}; pg8::StaticOrder S; S.init(M, DM, F.G, (int)blockIdx.x);
            pg8::EpiResF32 E{xin, X, DM};
            pg8::gemm_phase<pg8::EpiResF32, pg8::StaticOrder, true>(F.lds + RING_OFF, g, S, E);
            SEAM(p0 + 7);
        }
        if (EN(8) && IN(p0 + 8)) { const int ol = opaque_tid() & 63; const float* g = args.in[14] + (size_t)l * DM; for (int m = opaque_s(gw); m < M; m += NGW) rms_row_bf16(X + (size_t)m * DM, g, XN + (size_t)m * DM, ol); SEAM(p0 + 8); }
        if (EN(9) && IN(p0 + 9)) {
            pg8::Gemm g{XN, (const bf16_t*)(wl + W_UP), M, UP_N, DM, DM, 0, 0}; pg8::StaticOrder S; S.init(M, UP_N, F.G, (int)blockIdx.x);
            pg8::EpiBf16 E{U, UP_N, 1, 1.0f};
            pg8::gemm_phase<pg8::EpiBf16, pg8::StaticOrder, true>(F.lds + RING_OFF, g, S, E);
            SEAM(p0 + 9);
        }
        if (EN(10) && IN(p0 + 10)) { p_convglu(F, args, l); SEAM(p0 + 10); }
        if (EN(11) && IN(p0 + 11)) {
            pg8::Gemm g{Gb, (const bf16_t*)(wl + W_DN), M, DM, FFN, FFN, 0, 0}; pg8::StaticOrder S; S.init(M, DM, F.G, (int)blockIdx.x);
            pg8::EpiResF32 E{X, X, DM};
            pg8::gemm_phase<pg8::EpiResF32, pg8::StaticOrder, true>(F.lds + RING_OFF, g, S, E);
            SEAM(p0 + 11);
        }
    }
    if (IN(N_PHASES - 1)) { const int ol = opaque_tid() & 63; const float* g = args.in[19]; for (int m = opaque_s(gw); m < M; m += NGW) rms_row_f32(X + (size_t)m * DM, g, args.out + (size_t)m * DM, ol); }
#undef IN
#undef SEAM
}

extern "C" void kernel_launch(void* const* d_in, const int* in_sizes, int n_in, void* d_out, int out_size, void* d_ws, size_t ws_size, hipStream_t stream) {
    static int grid = 0;
    if (grid == 0) {
        if (n_in != 20 || in_sizes[0] != M * DM || out_size != M * DM || ws_size < WS_END) {
            fprintf(stderr, "kernel_launch: shape / workspace mismatch (n_in %d, in0 %d, out %d, ws %zu, need %zu); nothing launched\n", n_in, n_in > 0 ? in_sizes[0] : -1, out_size, ws_size, (size_t)WS_END); grid = -1; return; }
        int dev = 0, cus = 0, per_cu = 0;
        if (hipGetDevice(&dev) != hipSuccess || hipDeviceGetAttribute(&cus, hipDeviceAttributeMultiprocessorCount, dev) != hipSuccess) { grid = -1; return; }
        if (hipFuncSetAttribute((const void*)trunk_fwd, hipFuncAttributeMaxDynamicSharedMemorySize, LDS_BYTES) != hipSuccess) { fprintf(stderr, "kernel_launch: hipFuncSetAttribute failed\n"); grid = -1; return; }
        if (hipOccupancyMaxActiveBlocksPerMultiprocessor(&per_cu, (const void*)trunk_fwd, NWAVES * 64, LDS_BYTES) != hipSuccess || per_cu < 1)
            fprintf(stderr, "kernel_launch: note: occupancy query reports %d workgroups per CU\n", per_cu);
        (void)hipGetLastError();
        grid = cus;
    }
    if (grid < 0) return;
    if (hipMemsetAsync((char*)d_ws + WS_CTL, 0, CTL_ZERO_BYTES, stream) != hipSuccess) return;
    Args a{};
    for (int i = 0; i < 20; ++i) a.in[i] = (const float*)d_in[i];
    a.out = (float*)d_out; a.ws = (unsigned char*)d_ws;
#if MK_N_LAUNCHES == 1
    a.ph_lo = 0; a.ph_hi = N_PHASES;
    hipLaunchKernelGGL(trunk_fwd, dim3(grid), dim3(NWAVES * 64), LDS_BYTES, stream, a);
#else
    for (int p = 0; p < N_PHASES; ++p) { a.ph_lo = p; a.ph_hi = p + 1; hipLaunchKernelGGL(trunk_fwd, dim3(grid), dim3(NWAVES * 64), LDS_BYTES, stream, a); }
#endif
    const hipError_t le = hipPeekAtLastError();
    if (le != hipSuccess) fprintf(stderr, "kernel_launch: launch failed: %s\n", hipGetErrorName(le));
}
```

```cpp
#include <hip/hip_runtime.h>
#include <cstdio>
#include <cstdint>

#ifndef MK_N_LAUNCHES
#define MK_N_LAUNCHES 1
#endif

#define GAS __attribute__((address_space(1)))
#define LAS __attribute__((address_space(3)))
typedef unsigned short bf16_t;
typedef short bf16x8 __attribute__((ext_vector_type(8)));
typedef short s16x4 __attribute__((ext_vector_type(4)));
typedef float f32x2 __attribute__((ext_vector_type(2)));
typedef float f32x4 __attribute__((ext_vector_type(4)));
typedef float f32x16 __attribute__((ext_vector_type(16)));
typedef unsigned u32x2 __attribute__((ext_vector_type(2)));
typedef unsigned u32x4 __attribute__((ext_vector_type(4)));
typedef int i32x4 __attribute__((ext_vector_type(4)));

constexpr int DM = 2048, NB = 4, SEQ = 4096, DEPTH = 4, M = NB * SEQ;
constexpr int IN_COLS = 12864, ZLD = 13056;
constexpr int ZQA = 0, ZKA = 512, ZVA = 1024, ZCQ = 1536, ZCKV = 2048, ZKR = 2304, ZSQ = 2560, ZSK = 3072, ZSV = 3200, ZMQ = 3328, ZMK = 3840, ZMV = 4352, ZG = 4864;
constexpr int FFN = 5632, UP_N = 2 * FFN;
constexpr float LOG2E = 1.4426950408889634f;
constexpr float EPS = 1e-6f;
constexpr float NEG_INF = -__builtin_huge_valf();

__device__ __forceinline__ unsigned cvt_pk_bf16(float lo, float hi) { unsigned r; asm volatile("v_cvt_pk_bf16_f32 %0, %1, %2" : "=v"(r) : "v"(lo), "v"(hi)); return r; }
__device__ __forceinline__ float bf2f(unsigned short h) { return __uint_as_float(((unsigned)h) << 16); }
__device__ __forceinline__ float bflo(unsigned w) { return __uint_as_float(w << 16); }
__device__ __forceinline__ float bfhi(unsigned w) { return __uint_as_float(w & 0xffff0000u); }
__device__ __forceinline__ float wave_sum(float v) {
#pragma unroll
    for (int o = 1; o < 64; o <<= 1) v += __shfl_xor(v, o);
    return v;
}
__device__ __forceinline__ int opaque_tid() { int t = threadIdx.x; asm volatile("" : "+v"(t)); return t; }
__device__ __forceinline__ int opaque_s(int x) { asm volatile("" : "+s"(x)); return x; }
__device__ __forceinline__ float fast_sigmoid(float x) { return __builtin_amdgcn_rcpf(1.0f + __builtin_amdgcn_exp2f(-x * LOG2E)); }

namespace pg8 {
constexpr int BM = 256, BK = 64, HALF = 128, HTB = HALF * BK * 2, STAGE_BYTES = 8 * HTB, NXCD = 8, WGM = 8;
__host__ __device__ __forceinline__ int lds_byte(int r, int c) { const int st = (r >> 4) * 2 + (c >> 5), rr = r & 15, cc = c & 31, ob = rr * 64 + cc * 2; return st * 1024 + (ob ^ (((ob >> 9) & 1) << 5)); }
__host__ __device__ __forceinline__ void stage_rc(int b, int& R, int& C) { const int st = b / 1024, sb = b % 1024, swz = sb ^ (((sb >> 9) & 1) << 5); R = (st >> 1) * 16 + swz / 64; C = (st & 1) * 32 + (swz % 64) / 2; }
__host__ __device__ __forceinline__ int perm32(int rho) { const int n = rho >> 4, i = rho & 15; return 8 * (i >> 2) + 4 * n + (i & 3); }

struct Unit { int pm, pn, z; };
struct Gemm { const bf16_t* A; const bf16_t* Bt; int M, N, K, lda; size_t zA, zB; };

struct StaticOrder {
    int nM, nN, nwg, G, c, nZ;
    __device__ void init(int M_, int N_, int G_, int c_, int nZ_ = 1) { nM = M_ / BM; nN = N_ / BM; nwg = nM * nN; G = G_; c = c_; nZ = nZ_; }
    __device__ bool next(int i, Unit& u) const {
        const int it = i / nZ; u.z = i - it * nZ;
        const long L = (long)it * G + c; if (L >= nwg) return false;
        int wgid = (int)L; { const int q = nwg / NXCD, r = nwg % NXCD, xcd = wgid % NXCD, off = wgid / NXCD; wgid = (xcd < r ? xcd * (q + 1) : r * (q + 1) + (xcd - r) * q) + off; }
        const int nig = WGM * nN, gid = wgid / nig, fm = gid * WGM, gsz = (nM - fm) < WGM ? (nM - fm) : WGM;
        u.pm = fm + ((wgid % nig) % gsz); u.pn = (wgid % nig) / gsz; return true;
    }
};


struct EpiBf16 {
    bf16_t* O; int ldc; int kind;
    float sc;
    __device__ __forceinline__ void operator()(const f32x4 (&acc)[2][2][4][2], const Unit& u, int wr, int wc, int fr, int fq) const {
        float s = sc; bool sig = false;
        if (kind == 0) {
            const int pn = u.pn;
            s = 1.0f;
            if (pn < 2 || pn == 10 || pn == 11) s = 0.125f * LOG2E;
            else if (pn == 13 || pn == 14) s = 0.08838834764831845f * LOG2E;
            sig = pn >= 19;
        }
        const int row0 = u.pm * BM + wr * 64 + fr, col0 = u.pn * BM + wc * 32 + 8 * fq;
#pragma unroll
        for (int ai = 0; ai < 2; ++ai)
#pragma unroll
            for (int m = 0; m < 4; ++m) { bf16_t* rowp = O + (size_t)(row0 + ai * HALF + m * 16) * ldc + col0;
#pragma unroll
                for (int bj = 0; bj < 2; ++bj) { f32x4 v0 = acc[ai][bj][m][0], v1 = acc[ai][bj][m][1];
                    if (sig) {
#pragma unroll
                        for (int e = 0; e < 4; ++e) { v0[e] = fast_sigmoid(v0[e]); v1[e] = fast_sigmoid(v1[e]); }
                    } else { v0 = v0 * s; v1 = v1 * s; }
                    u32x4 w; w.x = cvt_pk_bf16(v0[0], v0[1]); w.y = cvt_pk_bf16(v0[2], v0[3]); w.z = cvt_pk_bf16(v1[0], v1[1]); w.w = cvt_pk_bf16(v1[2], v1[3]);
                    *(u32x4*)(rowp + bj * HALF) = w; } }
    }
};
struct EpiResF32 {
    const float* base; float* out; int ldc;
    __device__ __forceinline__ void operator()(const f32x4 (&acc)[2][2][4][2], const Unit& u, int wr, int wc, int fr, int fq) const {
        const int row0 = u.pm * BM + wr * 64 + fr, col0 = u.pn * BM + wc * 32 + 8 * fq;
#pragma unroll
        for (int ai = 0; ai < 2; ++ai)
#pragma unroll
            for (int m = 0; m < 4; ++m) { const size_t off = (size_t)(row0 + ai * HALF + m * 16) * ldc + col0;
#pragma unroll
                for (int bj = 0; bj < 2; ++bj) {
                    const f32x4 b0 = *(const f32x4*)(base + off + bj * HALF), b1 = *(const f32x4*)(base + off + bj * HALF + 4);
                    *(f32x4*)(out + off + bj * HALF) = b0 + acc[ai][bj][m][0]; *(f32x4*)(out + off + bj * HALF + 4) = b1 + acc[ai][bj][m][1]; }
                asm volatile("" ::: "memory"); }
    }
};
struct EpiMerge {
    const bf16_t* gate; int ldg;
    float* T; bf16_t* Mg;
    __device__ __forceinline__ void operator()(const f32x4 (&acc)[2][2][4][2], const Unit& u, int wr, int wc, int fr, int fq) const {
        const int row0 = u.pm * BM + wr * 64 + fr, col0 = u.pn * BM + wc * 32 + 8 * fq, z = u.z;
#pragma unroll
        for (int ai = 0; ai < 2; ++ai)
#pragma unroll
            for (int m = 0; m < 4; ++m) { const int row = row0 + ai * HALF + m * 16; const size_t off = (size_t)row * DM + col0;
#pragma unroll
                for (int bj = 0; bj < 2; ++bj) {
                    const u32x4 g = *(const u32x4*)(gate + (size_t)row * ldg + z * DM + col0 + bj * HALF);
                    f32x4 t0 = (f32x4){0.f, 0.f, 0.f, 0.f}, t1 = t0;
                    if (z > 0) { t0 = *(const f32x4*)(T + off + bj * HALF); t1 = *(const f32x4*)(T + off + bj * HALF + 4); }
                    const f32x4 g0 = (f32x4){bflo(g.x), bfhi(g.x), bflo(g.y), bfhi(g.y)}, g1 = (f32x4){bflo(g.z), bfhi(g.z), bflo(g.w), bfhi(g.w)};
                    t0 = t0 + g0 * acc[ai][bj][m][0]; t1 = t1 + g1 * acc[ai][bj][m][1];
                    if (z < 3) { *(f32x4*)(T + off + bj * HALF) = t0; *(f32x4*)(T + off + bj * HALF + 4) = t1; }
                    else { u32x4 w; w.x = cvt_pk_bf16(t0[0], t0[1]); w.y = cvt_pk_bf16(t0[2], t0[3]); w.z = cvt_pk_bf16(t1[0], t1[1]); w.w = cvt_pk_bf16(t1[2], t1[3]);
                        *(u32x4*)(Mg + off + bj * HALF) = w; } }
                asm volatile("" ::: "memory"); }
    }
};

template <class Epi, class Sched, bool ALIGN_EPI>
__device__ __forceinline__ void gemm_phase(LAS unsigned char* lds, const Gemm g, const Sched& S, const Epi& E) {
    const int tid = opaque_tid(), wid = __builtin_amdgcn_readfirstlane(tid >> 6), lane = tid & 63, wr = wid >> 2, wc = wid & 3, fr = lane & 15, fq = lane >> 4;
    const int K = g.K, nt = K / BK, lda = g.lda;
    unsigned voffA[2], voffB[2];
#pragma unroll
    for (int i = 0; i < 2; ++i) { int R, C; stage_rc(tid * 16 + i * 8192, R, C); const int Rb = (R & ~31) + perm32(R & 31);
        voffA[i] = (unsigned)(R * lda + C) * 2u; voffB[i] = (unsigned)(Rb * K + C) * 2u; }
    const size_t kstep = (size_t)(BK * 2);
    const size_t hstepA = (size_t)HALF * lda * 2, hstepB = (size_t)HALF * K * 2;
    const size_t tstepA = 2 * hstepA, tstepB = 2 * hstepB;
    const unsigned ldsw = (unsigned)wid * 1024u;
    const int aoff = lds_byte(wr * 64 + fr, fq * 8), boff = lds_byte(wc * 32 + fr, fq * 8);
#define PG8_SA(b, h) (((b) * 2 + (h)) * HTB)
#define PG8_SB(b, h) ((4 + (b) * 2 + (h)) * HTB)
#define PG8_STAGE(bufoff, gbase, voff) do { _Pragma("unroll") for (int _i = 0; _i < 2; ++_i) \
        __builtin_amdgcn_global_load_lds((const unsigned*)((const char*)(gbase) + (voff)[_i]), (LAS unsigned*)(lds + (bufoff) + ldsw + _i * 8192), 16, 0, 0); } while (0)
#define PG8_LDA(dst, b, h) do { _Pragma("unroll") for (int m = 0; m < 4; ++m) _Pragma("unroll") for (int k = 0; k < 2; ++k) dst[m][k] = *(const LAS bf16x8*)(lds + PG8_SA(b, h) + aoff + m * 2048 + k * 1024); } while (0)
#define PG8_LDB(dst, b, h) do { _Pragma("unroll") for (int n = 0; n < 2; ++n) _Pragma("unroll") for (int k = 0; k < 2; ++k) dst[n][k] = *(const LAS bf16x8*)(lds + PG8_SB(b, h) + boff + n * 2048 + k * 1024); } while (0)
#define PG8_MMA(ai, bj, At, Bt) do { __builtin_amdgcn_s_setprio(1); _Pragma("unroll") for (int m = 0; m < 4; ++m) _Pragma("unroll") for (int n = 0; n < 2; ++n) _Pragma("unroll") for (int k = 0; k < 2; ++k) \
        acc[ai][bj][m][n] = __builtin_amdgcn_mfma_f32_16x16x32_bf16(Bt[n][k], At[m][k], acc[ai][bj][m][n], 0, 0, 0); __builtin_amdgcn_s_setprio(0); } while (0)
#define PG8_WAIT_V(n) asm volatile("s_waitcnt vmcnt(" #n ")" ::: "memory")
#define PG8_WAIT_L(n) asm volatile("s_waitcnt lgkmcnt(" #n ")" ::: "memory")
#define PG8_BAR __builtin_amdgcn_s_barrier()
#define PG8_SCHED __builtin_amdgcn_sched_barrier(0)
    Unit cur, nxt; int ui = 0;
    if (!S.next(0, cur)) return;
    f32x4 acc[2][2][4][2];
#pragma unroll
    for (int a = 0; a < 2; ++a)
#pragma unroll
        for (int b = 0; b < 2; ++b)
#pragma unroll
            for (int m = 0; m < 4; ++m)
#pragma unroll
                for (int n = 0; n < 2; ++n) acc[a][b][m][n] = (f32x4){0.f, 0.f, 0.f, 0.f};
    bf16x8 At[4][2], B0[2][2], B1[2][2];
    const char* cA = (const char*)g.A + (size_t)cur.pm * tstepA + (size_t)cur.z * g.zA; const char* cB = (const char*)g.Bt + (size_t)cur.pn * tstepB + (size_t)cur.z * g.zB;
    PG8_STAGE(PG8_SB(0, 0), cB, voffB); PG8_STAGE(PG8_SB(0, 1), cB + hstepB, voffB); PG8_STAGE(PG8_SA(0, 0), cA, voffA); PG8_STAGE(PG8_SA(0, 1), cA + hstepA, voffA);
    if (wr == 1) PG8_BAR;
    PG8_WAIT_V(2); PG8_BAR;
    PG8_STAGE(PG8_SB(1, 0), cB + kstep, voffB); PG8_STAGE(PG8_SA(1, 0), cA + kstep, voffA); PG8_STAGE(PG8_SB(1, 1), cB + hstepB + kstep, voffB);
    PG8_WAIT_V(6); PG8_BAR;
    for (;;) {
        const bool has_next = S.next(ui + 1, nxt);
        const char* nA = has_next ? (const char*)g.A + (size_t)nxt.pm * tstepA + (size_t)nxt.z * g.zA : cA; const char* nB = has_next ? (const char*)g.Bt + (size_t)nxt.pn * tstepB + (size_t)nxt.z * g.zB : cB;
        for (int t = 0; t < nt; t += 2) {
            const bool last = (t == nt - 2);
            const char* a1 = cA + (size_t)(t + 1) * kstep;
            const char* a2 = last ? nA : cA + (size_t)(t + 2) * kstep; const char* b2 = last ? nB : cB + (size_t)(t + 2) * kstep;
            const char* a3 = a2 + kstep; const char* b3 = b2 + kstep;
            PG8_LDB(B0, 0, 0); PG8_LDB(B1, 0, 1); PG8_SCHED; PG8_LDA(At, 0, 0); PG8_STAGE(PG8_SA(1, 1), a1 + hstepA, voffA);
            PG8_WAIT_V(8); PG8_WAIT_L(0); PG8_BAR; PG8_MMA(0, 0, At, B0); PG8_MMA(0, 1, At, B1); PG8_BAR; PG8_SCHED;
            PG8_LDA(At, 0, 1); PG8_STAGE(PG8_SB(0, 0), b2, voffB); PG8_STAGE(PG8_SB(0, 1), b2 + hstepB, voffB); PG8_STAGE(PG8_SA(0, 0), a2, voffA);
            PG8_WAIT_V(8); PG8_WAIT_L(0); PG8_BAR; PG8_MMA(1, 0, At, B0); PG8_MMA(1, 1, At, B1); PG8_BAR; PG8_SCHED;
            PG8_LDB(B0, 1, 0); PG8_LDB(B1, 1, 1); PG8_SCHED; PG8_LDA(At, 1, 0); PG8_STAGE(PG8_SA(0, 1), a2 + hstepA, voffA);
            PG8_WAIT_V(8); PG8_WAIT_L(0); PG8_BAR; PG8_MMA(0, 0, At, B0); PG8_MMA(0, 1, At, B1); PG8_BAR; PG8_SCHED;
            PG8_LDA(At, 1, 1); PG8_STAGE(PG8_SB(1, 0), b3, voffB); PG8_STAGE(PG8_SB(1, 1), b3 + hstepB, voffB); PG8_STAGE(PG8_SA(1, 0), a3, voffA);
            PG8_WAIT_V(8); PG8_WAIT_L(0); PG8_BAR; PG8_MMA(1, 0, At, B0); PG8_MMA(1, 1, At, B1); PG8_BAR; PG8_SCHED;
        }
        if constexpr (ALIGN_EPI) { if (wr == 0) PG8_BAR; }
        E(acc, cur, wr, wc, fr, fq);
        if (!has_next) break;
#pragma unroll
        for (int a = 0; a < 2; ++a)
#pragma unroll
            for (int b = 0; b < 2; ++b)
#pragma unroll
                for (int m = 0; m < 4; ++m)
#pragma unroll
                    for (int n = 0; n < 2; ++n) acc[a][b][m][n] = (f32x4){0.f, 0.f, 0.f, 0.f};
        cur = nxt; cA = nA; cB = nB; ++ui;
        if constexpr (ALIGN_EPI) { if (wr == 1) PG8_BAR; }
    }
    PG8_WAIT_V(0);
    if constexpr (!ALIGN_EPI) { if (wr == 0) PG8_BAR; }
    PG8_BAR;
#undef PG8_SA
#undef PG8_SB
#undef PG8_STAGE
#undef PG8_LDA
#undef PG8_LDB
#undef PG8_MMA
#undef PG8_WAIT_V
#undef PG8_WAIT_L
#undef PG8_BAR
#undef PG8_SCHED
}
}

constexpr size_t MiB = 1u << 20;
constexpr size_t WS_CTL = 0, CTL_ZERO_BYTES = 1 * MiB;
constexpr size_t WS_ROPE = 1 * MiB;
constexpr size_t WS_BTAB = 2 * MiB;
constexpr size_t WS_PMM = WS_BTAB + 16 * 132 * 4;
constexpr size_t WS_LAM = WS_PMM + 128 * 2 * 4;
constexpr size_t WS_KMEAN = 3 * MiB;
constexpr size_t WS_W = 4 * MiB;
constexpr size_t W_IN = 0, W_UQ = 51 * MiB, W_UKV = W_UQ + 768 * 512 * 2, W_BR = W_UKV + 1024 * 256 * 2, W_OUT = W_BR + 8 * MiB, W_UP = W_OUT + 8 * MiB, W_DN = W_UP + 44 * MiB, W_LAYER = W_DN + 22 * MiB;
constexpr size_t WS_X = WS_W + DEPTH * W_LAYER;
constexpr size_t WS_XN = WS_X + 128 * MiB;
constexpr size_t WS_MG = WS_XN + 64 * MiB;
constexpr size_t WS_Z = WS_MG + 64 * MiB;
constexpr size_t WS_CQN = WS_Z + 408 * MiB;
constexpr size_t WS_CKVN = WS_CQN + 16 * MiB;
constexpr size_t WS_KR = WS_CKVN + 8 * MiB;
constexpr size_t WS_QMLA = WS_KR + 2 * MiB;
constexpr size_t WS_KVMLA = WS_QMLA + 24 * MiB;
constexpr size_t WS_BRO = WS_KVMLA + 32 * MiB;
constexpr size_t WS_T = WS_BRO + 64 * MiB;
constexpr size_t WS_DSCR = WS_T + 176 * MiB;
constexpr size_t WS_END = WS_DSCR + 32 * MiB;
static_assert(W_LAYER * 1 == (size_t)(51 * MiB + 768 * 512 * 2 + 1024 * 256 * 2 + 82 * MiB), "weight map");
static_assert((size_t)M * ZLD * 2 == 408 * MiB && (size_t)M * UP_N * 2 <= 408 * MiB && (size_t)M * FFN * 2 == 176 * MiB, "buffer sizes");
constexpr int CW_TMO = 0;
constexpr int CW_QUEUE = 1024;
constexpr int CW_BAR = 4096;

constexpr int RING_OFF = 0, RING_BYTES = 131072;
constexpr int LDSCTL_OFF = RING_BYTES, MISC_OFF = LDSCTL_OFF + 320;
constexpr int LDS_BYTES = 147456;
constexpr int NWAVES = 8;

typedef GAS unsigned gu32;
#define RLX_AGENT __ATOMIC_RELAXED, __HIP_MEMORY_SCOPE_AGENT
#define LDS_WAIT() asm volatile("s_waitcnt lgkmcnt(0)" ::: "memory")
#define XB_TMO      128
#define XB_XCNT(j)  (256  + 64 * (j))
#define XB_XSUB(j)  (1280 + 64 * (j))
#define XB_XGEN(j)  (2304 + 64 * (j))
#define XB_TOP      3328
#define XB_TOPGEN   3392
#define XCD_BAR_WORDS 3456
#define XB_SPIN_CAP (1u << 22)
__device__ __forceinline__ unsigned xb_ld(unsigned* p)              { return __hip_atomic_load(p, __ATOMIC_RELAXED, __HIP_MEMORY_SCOPE_AGENT); }
__device__ __forceinline__ unsigned xb_add(unsigned* p, unsigned v) { return __hip_atomic_fetch_add(p, v, __ATOMIC_RELAXED, __HIP_MEMORY_SCOPE_AGENT); }
__device__ __forceinline__ unsigned xb_xcc_id() { return (unsigned)__builtin_amdgcn_s_getreg((3 << 11) | 20) & 0xFu; }
#define XB_SPIN(cond, bar) do { unsigned _sp = 0; while (cond) { __builtin_amdgcn_s_sleep(1); \
    if ((++_sp & 255u) == 0u) { if (xb_ld(&(bar)[XB_TMO])) break; if (_sp > XB_SPIN_CAP) { atomicAdd(&(bar)[XB_TMO], 1u); break; } } } } while (0)
struct XcdBarrier { unsigned* bar; unsigned x; volatile LAS unsigned* st; };
__device__ __forceinline__ XcdBarrier xcd_barrier_post(unsigned* bar, volatile LAS unsigned* st) {
    XcdBarrier b; b.bar = bar; b.x = xb_xcc_id(); b.st = st;
    if (threadIdx.x == 0) (void)xb_add(&bar[XB_XCNT(b.x)], 1u);
    return b;
}
__device__ __forceinline__ void xcd_barrier_complete(unsigned* bar, unsigned x, unsigned& nloc, unsigned& nx) {
    const unsigned G = gridDim.x * gridDim.y * gridDim.z;
    unsigned sum, cnt, mine, sp = 0u;
    for (;;) {
        sum = 0u; cnt = 0u; mine = 0u;
#pragma unroll
        for (unsigned j = 0; j < 16; ++j) { const unsigned c = xb_ld(&bar[XB_XCNT(j)]); sum += c; cnt += (c > 0u) ? 1u : 0u; mine = (j == x) ? c : mine; }
        if (sum == G) break;
        __builtin_amdgcn_s_sleep(1);
        if ((++sp & 255u) == 0u) { if (xb_ld(&bar[XB_TMO])) break; if (sp > XB_SPIN_CAP) { atomicAdd(&bar[XB_TMO], 1u); break; } }
    }
    nloc = mine > 0u ? mine : 1u; nx = cnt > 0u ? cnt : 1u;
}
__device__ __forceinline__ void xcd_barrier(const XcdBarrier& b) {
    asm volatile("s_waitcnt vmcnt(0)" ::: "memory");
    __syncthreads();
    if (threadIdx.x == 0) {
        unsigned* bar = b.bar;
        __builtin_amdgcn_s_waitcnt(0);
        unsigned nloc = b.st[0], nx = b.st[1];
        if (nloc == 0u) { xcd_barrier_complete(bar, b.x, nloc, nx); b.st[0] = nloc; b.st[1] = nx; }
        const unsigned old = xb_add(&bar[XB_XSUB(b.x)], 1u);
        const unsigned gen = old / nloc;
        if (old + 1u == (gen + 1u) * nloc) {
            __builtin_amdgcn_fence(__ATOMIC_RELEASE, "agent");
            asm volatile("s_waitcnt vmcnt(0)" ::: "memory");
            const unsigned og = xb_add(&bar[XB_TOP], 1u);
            const unsigned tg = og / nx;
            if (og + 1u == (tg + 1u) * nx) xb_add(&bar[XB_TOPGEN], 1u);
            else XB_SPIN(xb_ld(&bar[XB_TOPGEN]) == tg, bar);
            __builtin_amdgcn_fence(__ATOMIC_ACQUIRE, "agent");
            xb_add(&bar[XB_XGEN(b.x)], 1u);
            asm volatile("s_waitcnt vmcnt(0)" ::: "memory");
        } else {
            XB_SPIN(xb_ld(&bar[XB_XGEN(b.x)]) == gen, bar);
            __builtin_amdgcn_fence(__ATOMIC_ACQUIRE, "agent");
            asm volatile("s_waitcnt vmcnt(0)" ::: "memory");
        }
    }
    __syncthreads();
}

namespace att {
template <int DK0_, int DK1_, int DV_> struct Cfg {
    static constexpr int DK0 = DK0_, DK1 = DK1_, DK = DK0_ + DK1_, DV = DV_;
    static constexpr int KP = DK * 2 + 16, VP = DV * 2 + 64;
    static constexpr int KOFF = 0, VOFF = 64 * KP, POFF = VOFF + 64 * VP, BUFB = POFF + 256;
    static constexpr int NKC = (64 * DK / 8) / 512, NVC = (64 * DV / 8) / 512;
    static constexpr int ND = DK / 16, NO = DV / 32;
};
constexpr int BTAB_OFF = 94208, KMEAN_OFF = 94208 + 1024;
struct Src { const bf16_t* k0; int pk0; const bf16_t* k1; int pk1; const bf16_t* v; int pv; const int* pos; };
struct WaveCtx { int lane, r32, hi, wid, tid; };

template <class C, bool WITH_POS> struct Stage {
    u32x4 kr[C::NKC]; u32x4 vr[C::NVC]; int pr;
    __device__ __forceinline__ void load(const Src& s, int t, int tid) {
        const int kb = t * 64;
#pragma unroll
        for (int i = 0; i < C::NKC; ++i) { const int id = tid + 512 * i, row = id / (C::DK / 8), c = id % (C::DK / 8);
            const bf16_t* p = (C::DK1 == 0 || c < C::DK0 / 8) ? s.k0 + (size_t)(kb + row) * s.pk0 + c * 8 : s.k1 + (size_t)(kb + row) * s.pk1 + (c - C::DK0 / 8) * 8;
            kr[i] = *(const u32x4*)p; }
#pragma unroll
        for (int i = 0; i < C::NVC; ++i) { const int id = tid + 512 * i, row = id / (C::DV / 8), c = id % (C::DV / 8);
            vr[i] = *(const u32x4*)(s.v + (size_t)(kb + row) * s.pv + c * 8); }
        pr = (WITH_POS && tid < 64) ? s.pos[kb + tid] : 0;
    }
    __device__ __forceinline__ void store(LAS unsigned char* buf, int tid) const {
#pragma unroll
        for (int i = 0; i < C::NKC; ++i) { const int id = tid + 512 * i, row = id / (C::DK / 8), c = id % (C::DK / 8); *(LAS u32x4*)(buf + C::KOFF + row * C::KP + c * 16) = kr[i]; }
#pragma unroll
        for (int i = 0; i < C::NVC; ++i) { const int id = tid + 512 * i, row = id / (C::DV / 8), c = id % (C::DV / 8); *(LAS u32x4*)(buf + C::VOFF + row * C::VP + c * 16) = vr[i]; }
        if (WITH_POS && tid < 64) *(LAS int*)(buf + C::POFF + tid * 4) = pr;
    }
};
__device__ __forceinline__ s16x4 vtr(const LAS unsigned char* p) { typedef short v4i16_t __attribute__((ext_vector_type(4))); return __builtin_bit_cast(s16x4, __builtin_amdgcn_ds_read_tr16_b64_v4i16((LAS v4i16_t*)p)); }

struct RowState { float m, l; };

template <class C, int KIND, bool BIAS>
__device__ __forceinline__ void tile_compute(const LAS unsigned char* buf, const LAS float* btab, const bf16x8 (&qf)[C::ND], f32x16 (&O)[C::NO], RowState& st,
                                             int k0, int qw, int posq, int pminq, const int* pmm, unsigned selmask, int blk, const WaveCtx& w) {
    const int qi = qw + w.r32;
#pragma unroll
    for (int p = 0; p < 2; ++p) {
        const int ks = k0 + 32 * p;
        bool causal_tile = true, sel_lane = true, skip = false, fast = false;
        if (KIND == 0) { skip = ks > qw + 31; fast = (ks + 31 <= qw); }
        if (KIND == 1) { skip = (ks > qw + 31) || (ks + 31 < qw - 127); }
        if (KIND == 2) {
            const int n = ks >> 8;
            if (n < blk) { causal_tile = false; sel_lane = ((selmask >> n) & 1u) != 0u; skip = !__any(sel_lane); fast = (bool)__all(sel_lane); }
            else { skip = ks > qw + 31; fast = (ks + 31 <= qw); }
        }
        if (skip) continue;
        if (BIAS && fast) { const int pmaxk = pmm[(ks >> 5) * 2 + 1]; fast = (pminq - pmaxk >= 128); }
        f32x16 sc;
#pragma unroll
        for (int r = 0; r < 16; ++r) sc[r] = 0.f;
        const LAS unsigned char* kb = buf + C::KOFF + (32 * p + w.r32) * C::KP + w.hi * 16;
#pragma unroll
        for (int d0 = 0; d0 < C::ND; ++d0) {
            const bf16x8 a0 = *(const LAS bf16x8*)(kb + d0 * 32);
            sc = __builtin_amdgcn_mfma_f32_32x32x16_bf16(a0, qf[d0], sc, 0, 0, 0);
        }
        if (fast) {
            if (BIAS) { const float bc = btab[128];
#pragma unroll
                for (int r = 0; r < 16; ++r) sc[r] += bc; }
        } else {
#pragma unroll
            for (int g4 = 0; g4 < 4; ++g4) {
                i32x4 pk = (i32x4){0, 0, 0, 0};
                if (BIAS) pk = *(const LAS i32x4*)(buf + C::POFF + (32 * p + 8 * g4 + 4 * w.hi) * 4);
#pragma unroll
                for (int e = 0; e < 4; ++e) {
                    const int r = 4 * g4 + e, kv = ks + 8 * g4 + 4 * w.hi + e;
                    float v = sc[r];
                    if (BIAS) { int d = posq - pk[e]; d = d < 0 ? 0 : (d > 128 ? 128 : d); v += btab[d]; }
                    bool valid;
                    if (KIND == 0) valid = kv <= qi;
                    else if (KIND == 1) valid = (unsigned)(qi - kv) < 128u;
                    else valid = causal_tile ? (kv <= qi) : sel_lane;
                    sc[r] = valid ? v : NEG_INF;
                }
            }
        }
        float tmax = sc[0];
#pragma unroll
        for (int r = 1; r < 16; ++r) tmax = fmaxf(tmax, sc[r]);
        tmax = fmaxf(tmax, __shfl_xor(tmax, 32));
        const float mn = fmaxf(st.m, tmax);
        const float alpha = __builtin_amdgcn_exp2f(st.m - mn);
        st.m = mn;
        float ps = 0.f;
#pragma unroll
        for (int r = 0; r < 16; ++r) { sc[r] = __builtin_amdgcn_exp2f(sc[r] - mn); ps += sc[r]; }
        st.l = st.l * alpha + ps;
        if (__any(alpha != 1.0f)) {
#pragma unroll
            for (int d = 0; d < C::NO; ++d)
#pragma unroll
                for (int r = 0; r < 16; ++r) O[d][r] *= alpha;
        }
        const LAS unsigned char* vb = buf + C::VOFF + (32 * p + 4 * w.hi + ((w.lane & 15) >> 2)) * C::VP + (16 * ((w.lane >> 4) & 1) + 4 * (w.lane & 3)) * 2;
#pragma unroll
        for (int s = 0; s < 2; ++s) {
            u32x4 t; const int b = 8 * s;
            t.x = cvt_pk_bf16(sc[b], sc[b + 1]); t.y = cvt_pk_bf16(sc[b + 2], sc[b + 3]); t.z = cvt_pk_bf16(sc[b + 4], sc[b + 5]); t.w = cvt_pk_bf16(sc[b + 6], sc[b + 7]);
            const bf16x8 pf = __builtin_bit_cast(bf16x8, t);
#pragma unroll
            for (int d = 0; d < C::NO; ++d) {
                const s16x4 lo = vtr(vb + (16 * s) * C::VP + d * 64), hi4 = vtr(vb + (16 * s + 8) * C::VP + d * 64);
                const bf16x8 vf = (bf16x8){lo[0], lo[1], lo[2], lo[3], hi4[0], hi4[1], hi4[2], hi4[3]};
                O[d] = __builtin_amdgcn_mfma_f32_32x32x16_bf16(vf, pf, O[d], 0, 0, 0);
            }
        }
    }
}

template <class C, int KIND, bool BIAS>
__device__ __forceinline__ void run_tiles(LAS unsigned char* lds, const Src& src, int t0, int t1, const bf16x8 (&qf)[C::ND], f32x16 (&O)[C::NO], RowState& st,
                                          int qw, int posq, int pminq, const int* pmm, unsigned selmask, int blk, const WaveCtx& w) {
    Stage<C, BIAS> sg;
    const LAS float* btab = (const LAS float*)(lds + BTAB_OFF);
    if (t0 < t1) sg.load(src, t0, w.tid);
    int it = 0;
    for (int t = t0; t < t1; ++t, ++it) {
        LAS unsigned char* buf = lds + (it & 1) * C::BUFB;
        sg.store(buf, w.tid);
        __syncthreads();
        if (t + 1 < t1) sg.load(src, t + 1, w.tid);
        tile_compute<C, KIND, BIAS>(buf, btab, qf, O, st, t * 64, qw, posq, pminq, pmm, selmask, blk, w);
    }
    __syncthreads();
}
template <int ND> __device__ __forceinline__ void load_q(bf16x8 (&qf)[ND], const bf16_t* qrow, int hi) {
#pragma unroll
    for (int d0 = 0; d0 < ND; ++d0) qf[d0] = *(const bf16x8*)(qrow + d0 * 16 + hi * 8);
}
template <int NO> __device__ __forceinline__ void store_o(const f32x16 (&O)[NO], bf16_t* orow, int hi) {
#pragma unroll
    for (int d = 0; d < NO; ++d)
#pragma unroll
        for (int g = 0; g < 4; ++g) { u32x2 v; v.x = cvt_pk_bf16(O[d][4 * g], O[d][4 * g + 1]); v.y = cvt_pk_bf16(O[d][4 * g + 2], O[d][4 * g + 3]); *(u32x2*)(orow + 32 * d + 8 * g + 4 * hi) = v; }
}
}

struct Args { const float* in[20]; float* out; unsigned char* ws; int ph_lo, ph_hi; };
constexpr int PH_PER_LAYER = 12, N_PHASES = 2 + DEPTH * PH_PER_LAYER;

struct Frame {
    LAS unsigned char* lds; volatile LAS unsigned* MISC; unsigned* ctl;
    int tid, lane, wave, G, vcu;
    unsigned char* ws;
};

__device__ __forceinline__ void transpose_item(const float* W, int K, int Nsrc, bf16_t* WT, int Ndst, int pad_lo, int pad_hi, int shift, LAS float* scr, int item, int lane) {
    const int nblk = Ndst / 32, kb = item / nblk, nb = item % nblk, k0 = 64 * kb, n0 = 32 * nb;
    const bool pad = (n0 >= pad_lo && n0 < pad_hi);
    const int ns0 = n0 - (n0 >= pad_hi ? shift : 0);
    if (!pad) {
#pragma unroll 8
        for (int i = 0; i < 32; ++i) { const int kk = 2 * i + (lane >> 5); scr[kk * 33 + (lane & 31)] = W[(size_t)(k0 + kk) * Nsrc + ns0 + (lane & 31)]; }
    }
    LDS_WAIT(); asm volatile("" ::: "memory");
    const int c = lane & 7;
#pragma unroll
    for (int j = 0; j < 4; ++j) { const int n = (lane >> 3) + 8 * j; const LAS float* s = scr + (8 * c) * 33 + n;
        u32x4 o = (u32x4){0u, 0u, 0u, 0u};
        if (!pad) { o.x = cvt_pk_bf16(s[0 * 33], s[1 * 33]); o.y = cvt_pk_bf16(s[2 * 33], s[3 * 33]); o.z = cvt_pk_bf16(s[4 * 33], s[5 * 33]); o.w = cvt_pk_bf16(s[6 * 33], s[7 * 33]); }
        *(u32x4*)(WT + (size_t)(n0 + n) * K + k0 + 8 * c) = o; }
    LDS_WAIT(); asm volatile("" ::: "memory");
}
__device__ __forceinline__ int t5_bucket(int n) {
    if (n < 16) return n;
    int b = 16;
    b += (n >= 19); b += (n >= 21); b += (n >= 24); b += (n >= 27); b += (n >= 31); b += (n >= 35); b += (n >= 40); b += (n >= 46);
    b += (n >= 52); b += (n >= 59); b += (n >= 67); b += (n >= 77); b += (n >= 87); b += (n >= 99); b += (n >= 113);
    return b;
}
__device__ __forceinline__ void rms_row_bf16(const float* xrow, const float* g, bf16_t* orow, int lane) {
    f32x4 v[8]; float s = 0.f;
#pragma unroll
    for (int j = 0; j < 8; ++j) { v[j] = *((const f32x4*)xrow + lane + 64 * j); s += (v[j].x * v[j].x + v[j].y * v[j].y) + (v[j].z * v[j].z + v[j].w * v[j].w); }
    const float rstd = 1.0f / sqrtf(wave_sum(s) * (1.0f / DM) + EPS);
#pragma unroll
    for (int j = 0; j < 8; ++j) { const f32x4 gg = *((const f32x4*)g + lane + 64 * j);
        u32x2 o; o.x = cvt_pk_bf16(v[j].x * rstd * gg.x, v[j].y * rstd * gg.y); o.y = cvt_pk_bf16(v[j].z * rstd * gg.z, v[j].w * rstd * gg.w);
        *((u32x2*)orow + lane + 64 * j) = o; }
}
__device__ __forceinline__ void rms_row_f32(const float* xrow, const float* g, float* orow, int lane) {
    f32x4 v[8]; float s = 0.f;
#pragma unroll
    for (int j = 0; j < 8; ++j) { v[j] = *((const f32x4*)xrow + lane + 64 * j); s += (v[j].x * v[j].x + v[j].y * v[j].y) + (v[j].z * v[j].z + v[j].w * v[j].w); }
    const float rstd = 1.0f / sqrtf(wave_sum(s) * (1.0f / DM) + EPS);
#pragma unroll
    for (int j = 0; j < 8; ++j) { const f32x4 gg = *((const f32x4*)g + lane + 64 * j); *((f32x4*)orow + lane + 64 * j) = v[j] * rstd * gg; }
}

__device__ __forceinline__ float gelu_f(float v) {
    const float av = fabsf(v), d = av * 0.2316418882f + 1.0f;
    const float t = __builtin_amdgcn_rcpf(d);
    float q = t * 0.5307027145f + (-0.7265760135f); q = q * t + 0.7107068705f; q = q * t + (-0.142248368f); q = q * t + 0.127414796f; q = q * t;
    const float e = __builtin_amdgcn_exp2f((v * v) * (-0.72134752044f));
    const float m = v * (q * e), r = v - m;
    return v < 0.f ? m : r;
}

__device__ __forceinline__ void p_prologue(Frame& F, const Args& a) {
    const int otid = opaque_tid(), olane = otid & 63;
    LAS float* scr = (LAS float*)(F.lds + RING_OFF + F.wave * 16384);
    const int gw = F.vcu * NWAVES + F.wave, NGW = F.G * NWAVES;
    constexpr int I_IN = (DM / 64) * (ZLD / 32), I_UQ = (512 / 64) * (768 / 32), I_UKV = (256 / 64) * (1024 / 32), I_BR1 = (512 / 64) * (DM / 32), I_BR = 4 * I_BR1,
                  I_OUT = (DM / 64) * (DM / 32), I_UP = (DM / 64) * (UP_N / 32), I_DN = (FFN / 64) * (DM / 32);
    constexpr int I_LAYER = I_IN + I_UQ + I_UKV + I_BR + I_OUT + I_UP + I_DN;
    for (int it = gw; it < DEPTH * I_LAYER; it += NGW) {
        const int l = it / I_LAYER; int r = it - l * I_LAYER;
        unsigned char* wl = F.ws + WS_W + (size_t)l * W_LAYER;
        if (r < I_IN) { transpose_item(a.in[4] + (size_t)l * DM * IN_COLS, DM, IN_COLS, (bf16_t*)(wl + W_IN), ZLD, 2368, 2560, 192, scr, r, olane); continue; } r -= I_IN;
        if (r < I_UQ) { transpose_item(a.in[8] + (size_t)l * 512 * 768, 512, 768, (bf16_t*)(wl + W_UQ), 768, 1 << 30, 1 << 30, 0, scr, r, olane); continue; } r -= I_UQ;
        if (r < I_UKV) { transpose_item(a.in[10] + (size_t)l * 256 * 1024, 256, 1024, (bf16_t*)(wl + W_UKV), 1024, 1 << 30, 1 << 30, 0, scr, r, olane); continue; } r -= I_UKV;
        if (r < I_BR) { const int i = r / I_BR1; transpose_item(a.in[12] + ((size_t)l * 4 + i) * 512 * DM, 512, DM, (bf16_t*)(wl + W_BR) + (size_t)i * DM * 512, DM, 1 << 30, 1 << 30, 0, scr, r - i * I_BR1, olane); continue; } r -= I_BR;
        if (r < I_OUT) { transpose_item(a.in[13] + (size_t)l * DM * DM, DM, DM, (bf16_t*)(wl + W_OUT), DM, 1 << 30, 1 << 30, 0, scr, r, olane); continue; } r -= I_OUT;
        if (r < I_UP) { transpose_item(a.in[15] + (size_t)l * DM * UP_N, DM, UP_N, (bf16_t*)(wl + W_UP), UP_N, 1 << 30, 1 << 30, 0, scr, r, olane); continue; } r -= I_UP;
        transpose_item(a.in[18] + (size_t)l * FFN * DM, FFN, DM, (bf16_t*)(wl + W_DN), DM, 1 << 30, 1 << 30, 0, scr, r, olane);
    }
    const int* pos = (const int*)a.in[1];
    const int gt = F.vcu * (NWAVES * 64) + otid, NGT = F.G * NWAVES * 64;
    f32x2* rope = (f32x2*)(F.ws + WS_ROPE);
    for (int e = gt; e < SEQ * 32; e += NGT) {
        const int s = e >> 5, i = e & 31;
        const float inv = (float)exp2((double)(-i) * (13.287712379549449 / 32.0));
        const float ang = (float)pos[s] * inv;
        const double rev = (double)ang * 0.15915494309189535;
        const float fr = (float)(rev - rint(rev));
        rope[e] = (f32x2){__builtin_amdgcn_cosf(fr), __builtin_amdgcn_sinf(fr)};
    }
    float* btab = (float*)(F.ws + WS_BTAB);
    for (int e = gt; e < 16 * 132; e += NGT) { const int hd = e / 132, n = e - hd * 132; btab[e] = (n <= 128) ? a.in[2][t5_bucket(n) * 16 + hd] * LOG2E : 0.f; }
    int* pmm = (int*)(F.ws + WS_PMM);
    for (int e = gt; e < 128; e += NGT) { int mn = pos[e * 32], mx = mn;
        for (int j = 1; j < 32; ++j) { const int p = pos[e * 32 + j]; mn = p < mn ? p : mn; mx = p > mx ? p : mx; }
        pmm[2 * e] = mn; pmm[2 * e + 1] = mx; }
    if (gt < DEPTH) {
        const float* lv = a.in[5] + (size_t)gt * 4 * 64; float s01 = 0.f, s23 = 0.f;
        for (int j = 0; j < 64; ++j) { s01 += lv[j] * lv[64 + j]; s23 += lv[128 + j] * lv[192 + j]; }
        const double li[4] = {0.20000000000000007, 0.35550906759096934, 0.4707130183435842, 0.5560582041556406};
        const float lam_init = (float)(gt == 0 ? li[0] : gt == 1 ? li[1] : gt == 2 ? li[2] : li[3]);
        ((float*)(F.ws + WS_LAM))[gt] = expf(s01) - expf(s23) + lam_init;
    }
}

__device__ __forceinline__ void p_prep(Frame& F, const Args& a, int l) {
    const int otid = opaque_tid(), lane = otid & 63;
    const int gw = F.vcu * NWAVES + F.wave, NGW = F.G * NWAVES;
    const bf16_t* Z = (const bf16_t*)(F.ws + WS_Z);
    bf16_t* CQN = (bf16_t*)(F.ws + WS_CQN); bf16_t* CKVN = (bf16_t*)(F.ws + WS_CKVN); bf16_t* KR = (bf16_t*)(F.ws + WS_KR);
    const float* gq = a.in[7] + (size_t)l * 512; const float* gkv = a.in[9] + (size_t)l * 256;
    const f32x2* rope = (const f32x2*)(F.ws + WS_ROPE);
    for (int m = gw; m < M; m += NGW) {
        const bf16_t* zr = Z + (size_t)m * ZLD;
        {
            const u32x4 v = *(const u32x4*)(zr + ZCQ + lane * 8);
            float x[8] = {bflo(v.x), bfhi(v.x), bflo(v.y), bfhi(v.y), bflo(v.z), bfhi(v.z), bflo(v.w), bfhi(v.w)};
            float s = 0.f;
#pragma unroll
            for (int j = 0; j < 8; ++j) s += x[j] * x[j];
            const float rstd = 1.0f / sqrtf(wave_sum(s) * (1.0f / 512.0f) + EPS);
            const f32x4 g0 = *(const f32x4*)(gq + lane * 8), g1 = *(const f32x4*)(gq + lane * 8 + 4);
            u32x4 o; o.x = cvt_pk_bf16(x[0] * rstd * g0.x, x[1] * rstd * g0.y); o.y = cvt_pk_bf16(x[2] * rstd * g0.z, x[3] * rstd * g0.w);
            o.z = cvt_pk_bf16(x[4] * rstd * g1.x, x[5] * rstd * g1.y); o.w = cvt_pk_bf16(x[6] * rstd * g1.z, x[7] * rstd * g1.w);
            *(u32x4*)(CQN + (size_t)m * 512 + lane * 8) = o;
        }
        {
            const u32x2 v = *(const u32x2*)(zr + ZCKV + lane * 4);
            const float x0 = bflo(v.x), x1 = bfhi(v.x), x2 = bflo(v.y), x3 = bfhi(v.y);
            const float rstd = 1.0f / sqrtf(wave_sum((x0 * x0 + x1 * x1) + (x2 * x2 + x3 * x3)) * (1.0f / 256.0f) + EPS);
            const f32x4 g = *(const f32x4*)(gkv + lane * 4);
            u32x2 o; o.x = cvt_pk_bf16(x0 * rstd * g.x, x1 * rstd * g.y); o.y = cvt_pk_bf16(x2 * rstd * g.z, x3 * rstd * g.w);
            *(u32x2*)(CKVN + (size_t)m * 256 + lane * 4) = o;
        }
        if (lane < 32) {
            const float x1 = bf2f(zr[ZKR + lane]), x2 = bf2f(zr[ZKR + 32 + lane]);
            const f32x2 cs = rope[(m & (SEQ - 1)) * 32 + lane];
            KR[(size_t)m * 64 + lane] = (bf16_t)(cvt_pk_bf16(x1 * cs.x - x2 * cs.y, 0.f) & 0xffffu);
            KR[(size_t)m * 64 + 32 + lane] = (bf16_t)(cvt_pk_bf16(x1 * cs.y + x2 * cs.x, 0.f) & 0xffffu);
        }
    }
    LAS float* scr = (LAS float*)(F.lds + RING_OFF);
    float* KM = (float*)(F.ws + WS_KMEAN);
    for (int it = F.vcu; it < NB * 4 * 16; it += F.G) {
        const int b = it >> 6, h = (it >> 4) & 3, n = it & 15;
        const int c8 = otid & 15, rg = otid >> 4;
        float acc[8];
#pragma unroll
        for (int j = 0; j < 8; ++j) acc[j] = 0.f;
        for (int j = 0; j < 8; ++j) {
            const u32x4 v = *(const u32x4*)(Z + (size_t)(b * SEQ + n * 256 + rg + 32 * j) * ZLD + ZMK + h * 128 + c8 * 8);
            acc[0] += bflo(v.x); acc[1] += bfhi(v.x); acc[2] += bflo(v.y); acc[3] += bfhi(v.y); acc[4] += bflo(v.z); acc[5] += bfhi(v.z); acc[6] += bflo(v.w); acc[7] += bfhi(v.w);
        }
#pragma unroll
        for (int j = 0; j < 8; ++j) scr[rg * 132 + c8 * 8 + j] = acc[j];
        __syncthreads();
        if (otid < 128) { float s = 0.f; for (int r = 0; r < 32; ++r) s += scr[r * 132 + otid]; KM[(size_t)it * 128 + otid] = s * (1.0f / 256.0f); }
        __syncthreads();
    }
}

__device__ __forceinline__ void p_convglu(Frame& F, const Args& a, int l) {
    const int lane = opaque_tid() & 63;
    const int gw = F.vcu * NWAVES + F.wave, NGW = F.G * NWAVES;
    const bf16_t* U = (const bf16_t*)(F.ws + WS_Z); bf16_t* Gb = (bf16_t*)(F.ws + WS_T);
    const float* cw = a.in[16] + (size_t)l * 3 * FFN; const float* cb = a.in[17] + (size_t)l * FFN;
    constexpr int NCG = FFN / 512;
    for (int it = gw; it < (M / 16) * NCG; it += NGW) {
        const int rb = it / NCG, cg = it - rb * NCG, ch0 = (cg * 64 + lane) * 8, m0 = rb * 16;
        float w0[8], w1[8], w2[8], bb[8];
#pragma unroll
        for (int h = 0; h < 2; ++h) { const f32x4 t0 = *(const f32x4*)(cw + ch0 + 4 * h), t1 = *(const f32x4*)(cw + FFN + ch0 + 4 * h), t2 = *(const f32x4*)(cw + 2 * FFN + ch0 + 4 * h), t3 = *(const f32x4*)(cb + ch0 + 4 * h);
#pragma unroll
            for (int e = 0; e < 4; ++e) { w0[4 * h + e] = t0[e]; w1[4 * h + e] = t1[e]; w2[4 * h + e] = t2[e]; bb[4 * h + e] = t3[e]; } }
        float am1[8], am2[8];
        if ((m0 & (SEQ - 1)) == 0) {
#pragma unroll
            for (int e = 0; e < 8; ++e) { am1[e] = 0.f; am2[e] = 0.f; }
        } else {
            const u32x4 p1 = *(const u32x4*)(U + (size_t)(m0 - 1) * UP_N + ch0), p2 = *(const u32x4*)(U + (size_t)(m0 - 2) * UP_N + ch0);
            am1[0] = bflo(p1.x); am1[1] = bfhi(p1.x); am1[2] = bflo(p1.y); am1[3] = bfhi(p1.y); am1[4] = bflo(p1.z); am1[5] = bfhi(p1.z); am1[6] = bflo(p1.w); am1[7] = bfhi(p1.w);
            am2[0] = bflo(p2.x); am2[1] = bfhi(p2.x); am2[2] = bflo(p2.y); am2[3] = bfhi(p2.y); am2[4] = bflo(p2.z); am2[5] = bfhi(p2.z); am2[6] = bflo(p2.w); am2[7] = bfhi(p2.w);
        }
        for (int r = 0; r < 16; ++r) {
            const size_t row = (size_t)(m0 + r);
            const u32x4 pa = *(const u32x4*)(U + row * UP_N + ch0), pv = *(const u32x4*)(U + row * UP_N + FFN + ch0);
            float a0[8] = {bflo(pa.x), bfhi(pa.x), bflo(pa.y), bfhi(pa.y), bflo(pa.z), bfhi(pa.z), bflo(pa.w), bfhi(pa.w)};
            float vv[8] = {bflo(pv.x), bfhi(pv.x), bflo(pv.y), bfhi(pv.y), bflo(pv.z), bfhi(pv.z), bflo(pv.w), bfhi(pv.w)};
            float o[8];
#pragma unroll
            for (int e = 0; e < 8; ++e) { const float c = bb[e] + w0[e] * am2[e] + w1[e] * am1[e] + w2[e] * a0[e]; o[e] = gelu_f(c) * vv[e]; am2[e] = am1[e]; am1[e] = a0[e]; }
            u32x4 w; w.x = cvt_pk_bf16(o[0], o[1]); w.y = cvt_pk_bf16(o[2], o[3]); w.z = cvt_pk_bf16(o[4], o[5]); w.w = cvt_pk_bf16(o[6], o[7]);
            *(u32x4*)(Gb + row * FFN + ch0) = w;
        }
    }
}

struct AttnEnv { const bf16_t* Z; const bf16_t* QMLA; const bf16_t* KVMLA; const bf16_t* KR; bf16_t* BRO; const int* pos; const int* pmm; const float* btabg; const f32x2* rope; const float* kmean;
                 const float* subln_g; const float* sinks; float* dscr; float lam, one_m_li; };

__device__ __forceinline__ void load_btab(LAS unsigned char* lds, const float* src, int tid) { if (tid < 132) ((LAS float*)(lds + att::BTAB_OFF))[tid] = src[tid]; }

__device__ __forceinline__ void unit_diff(LAS unsigned char* lds, const AttnEnv& E, int b, int h, int qb, const att::WaveCtx& w) {
    typedef att::Cfg<64, 0, 128> C;
    const int qw = qb * 256 + 32 * w.wid, qi = qw + w.r32; const size_t grow = (size_t)b * SEQ + qi;
    load_btab(lds, E.btabg + (0 + h) * 132, w.tid);
    const int posq = E.pos[qi], pminq = E.pmm[(qw >> 5) * 2];
    f32x16 O[4];
    f32x4* park = (f32x4*)(E.dscr + ((size_t)blockIdx.x * 512 + w.tid) * 64);
#pragma unroll
    for (int mp = 0; mp < 2; ++mp) {
        att::Src src; src.k0 = E.Z + (size_t)b * SEQ * ZLD + ZKA + (2 * h + mp) * 64; src.pk0 = ZLD; src.k1 = src.k0; src.pk1 = ZLD; src.v = E.Z + (size_t)b * SEQ * ZLD + ZVA + h * 128; src.pv = ZLD; src.pos = E.pos;
        bf16x8 qf[4]; att::load_q<4>(qf, E.Z + grow * ZLD + ZQA + (2 * h + mp) * 64, w.hi);
#pragma unroll
        for (int d = 0; d < 4; ++d)
#pragma unroll
            for (int r = 0; r < 16; ++r) O[d][r] = 0.f;
        att::RowState st; st.m = -1e30f; st.l = 0.f;
        att::run_tiles<C, 0, true>(lds, src, 0, 4 * (qb + 1), qf, O, st, qw, posq, pminq, E.pmm, 0u, 0, w);
        const float inv = 1.0f / (st.l + __shfl_xor(st.l, 32));
        if (mp == 0) {
#pragma unroll
            for (int d = 0; d < 4; ++d)
#pragma unroll
                for (int g = 0; g < 4; ++g) park[d * 4 + g] = (f32x4){O[d][4 * g] * inv, O[d][4 * g + 1] * inv, O[d][4 * g + 2] * inv, O[d][4 * g + 3] * inv};
        } else {
            const float li = E.lam * inv;
#pragma unroll
            for (int d = 0; d < 4; ++d)
#pragma unroll
                for (int g = 0; g < 4; ++g) { const f32x4 pv = park[d * 4 + g];
#pragma unroll
                    for (int e = 0; e < 4; ++e) O[d][4 * g + e] = pv[e] - li * O[d][4 * g + e]; }
        }
    }
    float ss = 0.f;
#pragma unroll
    for (int d = 0; d < 4; ++d)
#pragma unroll
        for (int r = 0; r < 16; ++r) ss += O[d][r] * O[d][r];
    ss += __shfl_xor(ss, 32);
    const float sc = (1.0f / sqrtf(ss * (1.0f / 128.0f) + EPS)) * E.one_m_li;
#pragma unroll
    for (int d = 0; d < 4; ++d)
#pragma unroll
        for (int g = 0; g < 4; ++g) { const f32x4 gg = *(const f32x4*)(E.subln_g + 32 * d + 8 * g + 4 * w.hi);
#pragma unroll
            for (int e = 0; e < 4; ++e) O[d][4 * g + e] *= sc * gg[e]; }
    att::store_o<4>(O, E.BRO + grow * DM + h * 128, w.hi);
}

__device__ __forceinline__ void unit_mla(LAS unsigned char* lds, const AttnEnv& E, int b, int h, int qb, const att::WaveCtx& w) {
    typedef att::Cfg<128, 64, 128> C;
    const int qw = qb * 256 + 32 * w.wid, qi = qw + w.r32; const size_t grow = (size_t)b * SEQ + qi;
    att::Src src; src.k0 = E.KVMLA + (size_t)b * SEQ * 1024 + h * 256; src.pk0 = 1024; src.k1 = E.KR + (size_t)b * SEQ * 64; src.pk1 = 64; src.v = E.KVMLA + (size_t)b * SEQ * 1024 + h * 256 + 128; src.pv = 1024; src.pos = E.pos;
    bf16x8 qf[12]; att::load_q<12>(qf, E.QMLA + grow * 768 + h * 192, w.hi);
#pragma unroll
    for (int dd = 0; dd < 2; ++dd) {
        const f32x2* cs = E.rope + (size_t)qi * 32 + 16 * dd + 8 * w.hi;
        unsigned o1[4], o2[4];
#pragma unroll
        for (int jp = 0; jp < 4; ++jp) {
            const f32x4 c2 = *(const f32x4*)(cs + 2 * jp);
            const float a0 = bf2f((unsigned short)qf[8 + dd][2 * jp]), a1 = bf2f((unsigned short)qf[8 + dd][2 * jp + 1]);
            const float b0 = bf2f((unsigned short)qf[10 + dd][2 * jp]), b1 = bf2f((unsigned short)qf[10 + dd][2 * jp + 1]);
            o1[jp] = cvt_pk_bf16(a0 * c2[0] - b0 * c2[1], a1 * c2[2] - b1 * c2[3]);
            o2[jp] = cvt_pk_bf16(a0 * c2[1] + b0 * c2[0], a1 * c2[3] + b1 * c2[2]);
        }
        qf[8 + dd] = __builtin_bit_cast(bf16x8, (u32x4){o1[0], o1[1], o1[2], o1[3]});
        qf[10 + dd] = __builtin_bit_cast(bf16x8, (u32x4){o2[0], o2[1], o2[2], o2[3]});
    }
    f32x16 O[4];
#pragma unroll
    for (int d = 0; d < 4; ++d)
#pragma unroll
        for (int r = 0; r < 16; ++r) O[d][r] = 0.f;
    att::RowState st; st.m = -1e30f; st.l = 0.f;
    att::run_tiles<C, 0, false>(lds, src, 0, 4 * (qb + 1), qf, O, st, qw, 0, 0, E.pmm, 0u, 0, w);
    const float inv = 1.0f / (st.l + __shfl_xor(st.l, 32));
#pragma unroll
    for (int d = 0; d < 4; ++d)
#pragma unroll
        for (int r = 0; r < 16; ++r) O[d][r] *= inv;
    att::store_o<4>(O, E.BRO + grow * DM + 512 + h * 128, w.hi);
}

__device__ __forceinline__ void unit_swa(LAS unsigned char* lds, const AttnEnv& E, int b, int qh, int qb, const att::WaveCtx& w) {
    typedef att::Cfg<64, 0, 64> C;
    const int qw = qb * 256 + 32 * w.wid, qi = qw + w.r32; const size_t grow = (size_t)b * SEQ + qi; const int kvh = qh >> 2;
    load_btab(lds, E.btabg + (4 + qh) * 132, w.tid);
    const int posq = E.pos[qi], pminq = E.pmm[(qw >> 5) * 2];
    att::Src src; src.k0 = E.Z + (size_t)b * SEQ * ZLD + ZSK + kvh * 64; src.pk0 = ZLD; src.k1 = src.k0; src.pk1 = ZLD; src.v = E.Z + (size_t)b * SEQ * ZLD + ZSV + kvh * 64; src.pv = ZLD; src.pos = E.pos;
    bf16x8 qf[4]; att::load_q<4>(qf, E.Z + grow * ZLD + ZSQ + qh * 64, w.hi);
    f32x16 O[2];
#pragma unroll
    for (int d = 0; d < 2; ++d)
#pragma unroll
        for (int r = 0; r < 16; ++r) O[d][r] = 0.f;
    att::RowState st; st.m = E.sinks[qh] * LOG2E; st.l = (w.hi == 0) ? 1.0f : 0.0f;
    const int t0 = qb == 0 ? 0 : 4 * qb - 2;
    att::run_tiles<C, 1, true>(lds, src, t0, 4 * (qb + 1), qf, O, st, qw, posq, pminq, E.pmm, 0u, 0, w);
    const float inv = 1.0f / (st.l + __shfl_xor(st.l, 32));
#pragma unroll
    for (int d = 0; d < 2; ++d)
#pragma unroll
        for (int r = 0; r < 16; ++r) O[d][r] *= inv;
    att::store_o<2>(O, E.BRO + grow * DM + 1024 + qh * 64, w.hi);
}

__device__ __forceinline__ void unit_moba(LAS unsigned char* lds, const AttnEnv& E, int b, int h, int blk, const att::WaveCtx& w) {
    typedef att::Cfg<128, 0, 128> C;
    const int qw = blk * 256 + 32 * w.wid, qi = qw + w.r32; const size_t grow = (size_t)b * SEQ + qi;
    load_btab(lds, E.btabg + (12 + h) * 132, w.tid);
    LAS float* km = (LAS float*)(lds + att::KMEAN_OFF);
    for (int e = w.tid; e < blk * 128; e += 512) km[e] = E.kmean[(size_t)((b * 4 + h) * 16) * 128 + e];
    const int posq = E.pos[qi], pminq = E.pmm[(qw >> 5) * 2];
    att::Src src; src.k0 = E.Z + (size_t)b * SEQ * ZLD + ZMK + h * 128; src.pk0 = ZLD; src.k1 = src.k0; src.pk1 = ZLD; src.v = E.Z + (size_t)b * SEQ * ZLD + ZMV + h * 128; src.pv = ZLD; src.pos = E.pos;
    bf16x8 qf[8]; att::load_q<8>(qf, E.Z + grow * ZLD + ZMQ + h * 128, w.hi);
    __syncthreads();
    unsigned selmask;
    if (blk <= 3) selmask = (1u << blk) - 1u;
    else {
        float v1 = NEG_INF, v2 = NEG_INF, v3 = NEG_INF; int i1 = 31, i2 = 31, i3 = 31;
        for (int n = 0; n < blk; ++n) {
            float part = 0.f;
#pragma unroll
            for (int d0 = 0; d0 < 8; ++d0) {
                const f32x4 k0 = *(const LAS f32x4*)(km + n * 128 + 16 * d0 + 8 * w.hi), k1 = *(const LAS f32x4*)(km + n * 128 + 16 * d0 + 8 * w.hi + 4);
#pragma unroll
                for (int j = 0; j < 4; ++j) part += bf2f((unsigned short)qf[d0][j]) * k0[j] + bf2f((unsigned short)qf[d0][4 + j]) * k1[j];
            }
            const float g = part + __shfl_xor(part, 32);
            if (g > v1) { v3 = v2; i3 = i2; v2 = v1; i2 = i1; v1 = g; i1 = n; }
            else if (g > v2) { v3 = v2; i3 = i2; v2 = g; i2 = n; }
            else if (g > v3) { v3 = g; i3 = n; }
        }
        selmask = (1u << i1) | (1u << i2) | (1u << i3);
    }
    f32x16 O[4];
#pragma unroll
    for (int d = 0; d < 4; ++d)
#pragma unroll
        for (int r = 0; r < 16; ++r) O[d][r] = 0.f;
    att::RowState st; st.m = -1e30f; st.l = 0.f;
    att::run_tiles<C, 2, true>(lds, src, 0, 4 * (blk + 1), qf, O, st, qw, posq, pminq, E.pmm, selmask, blk, w);
    const float inv = 1.0f / (st.l + __shfl_xor(st.l, 32));
#pragma unroll
    for (int d = 0; d < 4; ++d)
#pragma unroll
        for (int r = 0; r < 16; ++r) O[d][r] *= inv;
    att::store_o<4>(O, E.BRO + grow * DM + 1536 + h * 128, w.hi);
}

__device__ __forceinline__ int queue_next(Frame& F, unsigned* head) {
    __syncthreads();
    if (threadIdx.x == 0) F.MISC[4] = __hip_atomic_fetch_add(head, 1u, RLX_AGENT);
    __syncthreads();
    return (int)F.MISC[4];
}

__global__ void __launch_bounds__(NWAVES * 64, 2) trunk_fwd(Args args) {
    extern __shared__ __attribute__((aligned(16))) unsigned char lds_raw[];
    Frame F;
    F.lds = (LAS unsigned char*)lds_raw;
    F.MISC = (volatile LAS unsigned*)(F.lds + MISC_OFF);
    F.tid = threadIdx.x; F.lane = F.tid & 63; F.wave = __builtin_amdgcn_readfirstlane(F.tid >> 6);
    F.G = gridDim.x; { const int bx = blockIdx.x; F.vcu = (F.G % 8 == 0) ? (bx % 8) * (F.G / 8) + bx / 8 : bx; }
    F.ws = args.ws; F.ctl = (unsigned*)(args.ws + WS_CTL);
    for (int u = F.tid; u < (LDS_BYTES - LDSCTL_OFF) / 4; u += NWAVES * 64) ((LAS unsigned*)(F.lds + LDSCTL_OFF))[u] = 0u;
    __syncthreads();
    const int lo = args.ph_lo, hi = args.ph_hi;
    XcdBarrier bar; bar.bar = F.ctl + CW_BAR; bar.x = 0; bar.st = nullptr;
    if (hi - lo > 1) bar = xcd_barrier_post(F.ctl + CW_BAR, F.MISC + 8);
#ifndef DBG_MASK
#define DBG_MASK 0xFFFFu
#endif
#define EN(j) (((DBG_MASK) >> (j)) & 1u)
#ifndef DBG_ATT
#define DBG_ATT 0xFu
#endif
#define ENA(j) (((DBG_ATT) >> (j)) & 1u)
#define IN(k) (lo <= (k) && (k) < hi)
#define SEAM(k) do { if ((k) + 1 < hi) xcd_barrier(bar); } while (0)
    const int gw = F.vcu * NWAVES + F.wave, NGW = F.G * NWAVES;
    unsigned char* ws = F.ws;
    float* X = (float*)(ws + WS_X); bf16_t* XN = (bf16_t*)(ws + WS_XN); bf16_t* MG = (bf16_t*)(ws + WS_MG); bf16_t* Z = (bf16_t*)(ws + WS_Z);
    bf16_t* U = (bf16_t*)(ws + WS_Z); bf16_t* Gb = (bf16_t*)(ws + WS_T); float* T = (float*)(ws + WS_T);

    if (EN(12) && IN(0)) { p_prologue(F, args); SEAM(0); }

    for (int l = 0; l < DEPTH; ++l) {
        const int p0 = 1 + l * PH_PER_LAYER;
        if (hi <= p0 || lo >= p0 + PH_PER_LAYER) continue;
        unsigned char* wl = ws + WS_W + (size_t)l * W_LAYER;
        const float* xin = (l == 0) ? args.in[0] : X;
        if (EN(0) && IN(p0 + 0)) { const int ol = opaque_tid() & 63; const float* g = args.in[3] + (size_t)l * DM; for (int m = opaque_s(gw); m < M; m += NGW) rms_row_bf16(xin + (size_t)m * DM, g, XN + (size_t)m * DM, ol); SEAM(p0 + 0); }
        if (EN(1) && IN(p0 + 1)) {
            pg8::Gemm g{XN, (const bf16_t*)(wl + W_IN), M, ZLD, DM, DM, 0, 0}; pg8::StaticOrder S; S.init(M, ZLD, F.G, (int)blockIdx.x);
            pg8::EpiBf16 E{Z, ZLD, 0, 1.0f};
            pg8::gemm_phase<pg8::EpiBf16, pg8::StaticOrder, true>(F.lds + RING_OFF, g, S, E);
            SEAM(p0 + 1);
        }
        if (EN(2) && IN(p0 + 2)) { p_prep(F, args, l); SEAM(p0 + 2); }
        if (EN(3) && IN(p0 + 3)) {
            pg8::Gemm g{(const bf16_t*)(ws + WS_CQN), (const bf16_t*)(wl + W_UQ), M, 768, 512, 512, 0, 0}; pg8::StaticOrder S; S.init(M, 768, F.G, (int)blockIdx.x);
            pg8::EpiBf16 E{(bf16_t*)(ws + WS_QMLA), 768, 1, 0.07216878364870322f * LOG2E};
            pg8::gemm_phase<pg8::EpiBf16, pg8::StaticOrder, true>(F.lds + RING_OFF, g, S, E);
            SEAM(p0 + 3);
        }
        if (EN(4) && IN(p0 + 4)) {
            pg8::Gemm g{(const bf16_t*)(ws + WS_CKVN), (const bf16_t*)(wl + W_UKV), M, 1024, 256, 256, 0, 0}; pg8::StaticOrder S; S.init(M, 1024, F.G, (int)blockIdx.x);
            pg8::EpiBf16 E{(bf16_t*)(ws + WS_KVMLA), 1024, 1, 1.0f};
            pg8::gemm_phase<pg8::EpiBf16, pg8::StaticOrder, true>(F.lds + RING_OFF, g, S, E);
            SEAM(p0 + 4);
        }
        if (EN(5) && IN(p0 + 5)) {
            const double li[4] = {0.20000000000000007, 0.35550906759096934, 0.4707130183435842, 0.5560582041556406};
            AttnEnv E; E.Z = Z; E.QMLA = (const bf16_t*)(ws + WS_QMLA); E.KVMLA = (const bf16_t*)(ws + WS_KVMLA); E.KR = (const bf16_t*)(ws + WS_KR); E.BRO = (bf16_t*)(ws + WS_BRO);
            E.pos = (const int*)args.in[1]; E.pmm = (const int*)(ws + WS_PMM); E.btabg = (const float*)(ws + WS_BTAB); E.rope = (const f32x2*)(ws + WS_ROPE); E.kmean = (const float*)(ws + WS_KMEAN);
            E.dscr = (float*)(ws + WS_DSCR); E.subln_g = args.in[6] + (size_t)l * 128; E.sinks = args.in[11] + (size_t)l * 8; E.lam = ((const float*)(ws + WS_LAM))[l];
            E.one_m_li = 1.0f - (float)(l == 0 ? li[0] : l == 1 ? li[1] : l == 2 ? li[2] : li[3]);
            unsigned* qh = F.ctl + CW_QUEUE + 64 * (l * 4);
            if (ENA(0)) for (;;) { const int i = queue_next(F, qh + 0); if (i >= 256) break; { const int ot = opaque_tid(); const att::WaveCtx wctx{ot & 63, ot & 31, (ot >> 5) & 1, __builtin_amdgcn_readfirstlane(ot >> 6), ot}; unit_diff(F.lds, E, (i & 15) >> 2, i & 3, 15 - (i >> 4), wctx); } }
            if (ENA(1)) for (;;) { const int i = queue_next(F, qh + 64); if (i >= 256) break; { const int ot = opaque_tid(); const att::WaveCtx wctx{ot & 63, ot & 31, (ot >> 5) & 1, __builtin_amdgcn_readfirstlane(ot >> 6), ot}; unit_mla(F.lds, E, (i & 15) >> 2, i & 3, 15 - (i >> 4), wctx); } }
            if (ENA(2)) for (;;) { const int i = queue_next(F, qh + 128); if (i >= 256) break; { const int ot = opaque_tid(); const att::WaveCtx wctx{ot & 63, ot & 31, (ot >> 5) & 1, __builtin_amdgcn_readfirstlane(ot >> 6), ot}; unit_moba(F.lds, E, (i & 15) >> 2, i & 3, 15 - (i >> 4), wctx); } }
            if (ENA(3)) for (;;) { const int i = queue_next(F, qh + 192); if (i >= 512) break; { const int ot = opaque_tid(); const att::WaveCtx wctx{ot & 63, ot & 31, (ot >> 5) & 1, __builtin_amdgcn_readfirstlane(ot >> 6), ot}; unit_swa(F.lds, E, (i & 31) >> 3, i & 7, 15 - (i >> 5), wctx); } }
            SEAM(p0 + 5);
        }
        if (EN(6) && IN(p0 + 6)) {
            pg8::Gemm g{(const bf16_t*)(ws + WS_BRO), (const bf16_t*)(wl + W_BR), M, DM, 512, DM, (size_t)512 * 2, (size_t)DM * 512 * 2}; pg8::StaticOrder S; S.init(M, DM, F.G, (int)blockIdx.x, 4);
            pg8::EpiMerge E{Z + ZG, ZLD, T, MG};
            pg8::gemm_phase<pg8::EpiMerge, pg8::StaticOrder, true>(F.lds + RING_OFF, g, S, E);
            SEAM(p0 + 6);
        }
        if (EN(7) && IN(p0 + 7)) {
            pg8::Gemm g{MG, (const bf16_t*)(wl + W_OUT), M, DM, DM, DM, 0, 0}; pg8::StaticOrder S; S.init(M, DM, F.G, (int)blockIdx.x);
            pg8::EpiResF32 E{xin, X, DM};
            pg8::gemm_phase<pg8::EpiResF32, pg8::StaticOrder, true>(F.lds + RING_OFF, g, S, E);
            SEAM(p0 + 7);
        }
        if (EN(8) && IN(p0 + 8)) { const int ol = opaque_tid() & 63; const float* g = args.in[14] + (size_t)l * DM; for (int m = opaque_s(gw); m < M; m += NGW) rms_row_bf16(X + (size_t)m * DM, g, XN + (size_t)m * DM, ol); SEAM(p0 + 8); }
        if (EN(9) && IN(p0 + 9)) {
            pg8::Gemm g{XN, (const bf16_t*)(wl + W_UP), M, UP_N, DM, DM, 0, 0}; pg8::StaticOrder S; S.init(M, UP_N, F.G, (int)blockIdx.x);
            pg8::EpiBf16 E{U, UP_N, 1, 1.0f};
            pg8::gemm_phase<pg8::EpiBf16, pg8::StaticOrder, true>(F.lds + RING_OFF, g, S, E);
            SEAM(p0 + 9);
        }
        if (EN(10) && IN(p0 + 10)) { p_convglu(F, args, l); SEAM(p0 + 10); }
        if (EN(11) && IN(p0 + 11)) {
            pg8::Gemm g{Gb, (const bf16_t*)(wl + W_DN), M, DM, FFN, FFN, 0, 0}; pg8::StaticOrder S; S.init(M, DM, F.G, (int)blockIdx.x);
            pg8::EpiResF32 E{X, X, DM};
            pg8::gemm_phase<pg8::EpiResF32, pg8::StaticOrder, true>(F.lds + RING_OFF, g, S, E);
            SEAM(p0 + 11);
        }
    }
    if (IN(N_PHASES - 1)) { const int ol = opaque_tid() & 63; const float* g = args.in[19]; for (int m = opaque_s(gw); m < M; m += NGW) rms_row_f32(X + (size_t)m * DM, g, args.out + (size_t)m * DM, ol); }
#undef IN
#undef SEAM
}

extern "C" void kernel_launch(void* const* d_in, const int* in_sizes, int n_in, void* d_out, int out_size, void* d_ws, size_t ws_size, hipStream_t stream) {
    static int grid = 0;
    if (grid == 0) {
        if (n_in != 20 || in_sizes[0] != M * DM || out_size != M * DM || ws_size < WS_END) {
            fprintf(stderr, "kernel_launch: shape / workspace mismatch (n_in %d, in0 %d, out %d, ws %zu, need %zu); nothing launched\n", n_in, n_in > 0 ? in_sizes[0] : -1, out_size, ws_size, (size_t)WS_END); grid = -1; return; }
        int dev = 0, cus = 0, per_cu = 0;
        if (hipGetDevice(&dev) != hipSuccess || hipDeviceGetAttribute(&cus, hipDeviceAttributeMultiprocessorCount, dev) != hipSuccess) { grid = -1; return; }
        if (hipFuncSetAttribute((const void*)trunk_fwd, hipFuncAttributeMaxDynamicSharedMemorySize, LDS_BYTES) != hipSuccess) { fprintf(stderr, "kernel_launch: hipFuncSetAttribute failed\n"); grid = -1; return; }
        if (hipOccupancyMaxActiveBlocksPerMultiprocessor(&per_cu, (const void*)trunk_fwd, NWAVES * 64, LDS_BYTES) != hipSuccess || per_cu < 1)
            fprintf(stderr, "kernel_launch: note: occupancy query reports %d workgroups per CU\n", per_cu);
        (void)hipGetLastError();
        grid = cus;
    }
    if (grid < 0) return;
    if (hipMemsetAsync((char*)d_ws + WS_CTL, 0, CTL_ZERO_BYTES, stream) != hipSuccess) return;
    Args a{};
    for (int i = 0; i < 20; ++i) a.in[i] = (const float*)d_in[i];
    a.out = (float*)d_out; a.ws = (unsigned char*)d_ws;
#if MK_N_LAUNCHES == 1
    a.ph_lo = 0; a.ph_hi = N_PHASES;
    hipLaunchKernelGGL(trunk_fwd, dim3(grid), dim3(NWAVES * 64), LDS_BYTES, stream, a);
#else
    for (int p = 0; p < N_PHASES; ++p) { a.ph_lo = p; a.ph_hi = p + 1; hipLaunchKernelGGL(trunk_fwd, dim3(grid), dim3(NWAVES * 64), LDS_BYTES, stream, a); }
#endif
    const hipError_t le = hipPeekAtLastError();
    if (le != hipSuccess) fprintf(stderr, "kernel_launch: launch failed: %s\n", hipGetErrorName(le));
}
```

```cpp
#include <hip/hip_runtime.h>
#include <cstdio>
#include <cstdint>

#ifndef MK_N_LAUNCHES
#define MK_N_LAUNCHES 1
#endif

#define GAS __attribute__((address_space(1)))
#define LAS __attribute__((address_space(3)))
typedef unsigned short bf16_t;
typedef short bf16x8 __attribute__((ext_vector_type(8)));
typedef short s16x4 __attribute__((ext_vector_type(4)));
typedef float f32x2 __attribute__((ext_vector_type(2)));
typedef float f32x4 __attribute__((ext_vector_type(4)));
typedef float f32x16 __attribute__((ext_vector_type(16)));
typedef unsigned u32x2 __attribute__((ext_vector_type(2)));
typedef unsigned u32x4 __attribute__((ext_vector_type(4)));
typedef int i32x4 __attribute__((ext_vector_type(4)));

constexpr int DM = 2048, NB = 4, SEQ = 4096, DEPTH = 4, M = NB * SEQ;
constexpr int IN_COLS = 12864, ZLD = 13056;
constexpr int ZQA = 0, ZKA = 512, ZVA = 1024, ZCQ = 1536, ZCKV = 2048, ZKR = 2304, ZSQ = 2560, ZSK = 3072, ZSV = 3200, ZMQ = 3328, ZMK = 3840, ZMV = 4352, ZG = 4864;
constexpr int FFN = 5632, UP_N = 2 * FFN;
constexpr float LOG2E = 1.4426950408889634f;
constexpr float EPS = 1e-6f;
constexpr float NEG_INF = -__builtin_huge_valf();

__device__ __forceinline__ unsigned cvt_pk_bf16(float lo, float hi) { unsigned r; asm volatile("v_cvt_pk_bf16_f32 %0, %1, %2" : "=v"(r) : "v"(lo), "v"(hi)); return r; }
__device__ __forceinline__ float bf2f(unsigned short h) { return __uint_as_float(((unsigned)h) << 16); }
__device__ __forceinline__ float bflo(unsigned w) { return __uint_as_float(w << 16); }
__device__ __forceinline__ float bfhi(unsigned w) { return __uint_as_float(w & 0xffff0000u); }
__device__ __forceinline__ float wave_sum(float v) {
#pragma unroll
    for (int o = 1; o < 64; o <<= 1) v += __shfl_xor(v, o);
    return v;
}
__device__ __forceinline__ int opaque_tid() { int t = threadIdx.x; asm volatile("" : "+v"(t)); return t; }
__device__ __forceinline__ int opaque_s(int x) { asm volatile("" : "+s"(x)); return x; }
__device__ __forceinline__ float fast_sigmoid(float x) { return __builtin_amdgcn_rcpf(1.0f + __builtin_amdgcn_exp2f(-x * LOG2E)); }

namespace pg8 {
constexpr int BM = 256, BK = 64, HALF = 128, HTB = HALF * BK * 2, STAGE_BYTES = 8 * HTB, NXCD = 8, WGM = 8;
__host__ __device__ __forceinline__ int lds_byte(int r, int c) { const int st = (r >> 4) * 2 + (c >> 5), rr = r & 15, cc = c & 31, ob = rr * 64 + cc * 2; return st * 1024 + (ob ^ (((ob >> 9) & 1) << 5)); }
__host__ __device__ __forceinline__ void stage_rc(int b, int& R, int& C) { const int st = b / 1024, sb = b % 1024, swz = sb ^ (((sb >> 9) & 1) << 5); R = (st >> 1) * 16 + swz / 64; C = (st & 1) * 32 + (swz % 64) / 2; }
__host__ __device__ __forceinline__ int perm32(int rho) { const int n = rho >> 4, i = rho & 15; return 8 * (i >> 2) + 4 * n + (i & 3); }

struct Unit { int pm, pn, z; };
struct Gemm { const bf16_t* A; const bf16_t* Bt; int M, N, K, lda; size_t zA, zB; };

struct StaticOrder {
    int nM, nN, nwg, G, c, nZ;
    __device__ void init(int M_, int N_, int G_, int c_, int nZ_ = 1) { nM = M_ / BM; nN = N_ / BM; nwg = nM * nN; G = G_; c = c_; nZ = nZ_; }
    __device__ void init_tiles(int nM_, int nN_, int G_, int c_, int nZ_) { nM = nM_; nN = nN_; nwg = nM * nN; G = G_; c = c_; nZ = nZ_; }
    __device__ bool next(int i, Unit& u) const {
        const int it = i / nZ; u.z = i - it * nZ;
        const long L = (long)it * G + c; if (L >= nwg) return false;
        int wgid = (int)L; { const int q = nwg / NXCD, r = nwg % NXCD, xcd = wgid % NXCD, off = wgid / NXCD; wgid = (xcd < r ? xcd * (q + 1) : r * (q + 1) + (xcd - r) * q) + off; }
        const int nig = WGM * nN, gid = wgid / nig, fm = gid * WGM, gsz = (nM - fm) < WGM ? (nM - fm) : WGM;
        u.pm = fm + ((wgid % nig) % gsz); u.pn = (wgid % nig) / gsz; return true;
    }
};


struct EpiBf16 {
    bf16_t* O; int ldc; int kind;
    float sc;
    __device__ __forceinline__ void operator()(const f32x4 (&acc)[2][2][4][2], const Unit& u, int wr, int wc, int fr, int fq) const {
        float s = sc; bool sig = false;
        if (kind == 0) {
            const int pn = u.pn;
            s = 1.0f;
            if (pn < 2 || pn == 10 || pn == 11) s = 0.125f * LOG2E;
            else if (pn == 13 || pn == 14) s = 0.08838834764831845f * LOG2E;
            sig = pn >= 19;
        }
        const int row0 = u.pm * BM + wr * 64 + fr, col0 = u.pn * BM + wc * 32 + 8 * fq;
#pragma unroll
        for (int ai = 0; ai < 2; ++ai)
#pragma unroll
            for (int m = 0; m < 4; ++m) { bf16_t* rowp = O + (size_t)(row0 + ai * HALF + m * 16) * ldc + col0;
#pragma unroll
                for (int bj = 0; bj < 2; ++bj) { f32x4 v0 = acc[ai][bj][m][0], v1 = acc[ai][bj][m][1];
                    if (sig) {
#pragma unroll
                        for (int e = 0; e < 4; ++e) { v0[e] = fast_sigmoid(v0[e]); v1[e] = fast_sigmoid(v1[e]); }
                    } else { v0 = v0 * s; v1 = v1 * s; }
                    u32x4 w; w.x = cvt_pk_bf16(v0[0], v0[1]); w.y = cvt_pk_bf16(v0[2], v0[3]); w.z = cvt_pk_bf16(v1[0], v1[1]); w.w = cvt_pk_bf16(v1[2], v1[3]);
                    *(u32x4*)(rowp + bj * HALF) = w; } }
    }
};
struct EpiResF32 {
    const float* base; float* out; int ldc;
    __device__ __forceinline__ void operator()(const f32x4 (&acc)[2][2][4][2], const Unit& u, int wr, int wc, int fr, int fq) const {
        const int row0 = u.pm * BM + wr * 64 + fr, col0 = u.pn * BM + wc * 32 + 8 * fq;
        f32x4 bv[2][2][2];
#define PG8_RES_LOAD(buf, k) do { const size_t off_ = (size_t)(row0 + ((k) >> 2) * HALF + ((k) & 3) * 16) * ldc + col0; \
            _Pragma("unroll") for (int bj = 0; bj < 2; ++bj) { bv[buf][bj][0] = *(const f32x4*)(base + off_ + bj * HALF); bv[buf][bj][1] = *(const f32x4*)(base + off_ + bj * HALF + 4); } } while (0)
        PG8_RES_LOAD(0, 0);
#pragma unroll
        for (int k = 0; k < 8; ++k) {
            if (k + 1 < 8) PG8_RES_LOAD((k + 1) & 1, k + 1);
            const int ai = k >> 2, m = k & 3; const size_t off = (size_t)(row0 + ai * HALF + m * 16) * ldc + col0;
#pragma unroll
            for (int bj = 0; bj < 2; ++bj) { *(f32x4*)(out + off + bj * HALF) = bv[k & 1][bj][0] + acc[ai][bj][m][0]; *(f32x4*)(out + off + bj * HALF + 4) = bv[k & 1][bj][1] + acc[ai][bj][m][1]; }
        }
#undef PG8_RES_LOAD
    }
};
struct EpiMerge {
    const bf16_t* gate; int ldg;
    float* T; bf16_t* Mg;
    __device__ __forceinline__ void operator()(const f32x4 (&acc)[2][2][4][2], const Unit& u, int wr, int wc, int fr, int fq) const {
        const int row0 = u.pm * BM + wr * 64 + fr, col0 = u.pn * BM + wc * 32 + 8 * fq, z = u.z;
        u32x4 gv[2][2]; f32x4 tv[2][2][2];
#define PG8_MG_LOAD(buf, k) do { const int row_ = row0 + ((k) >> 2) * HALF + ((k) & 3) * 16; const size_t off_ = (size_t)row_ * DM + col0; \
            _Pragma("unroll") for (int bj = 0; bj < 2; ++bj) { gv[buf][bj] = *(const u32x4*)(gate + (size_t)row_ * ldg + z * DM + col0 + bj * HALF); \
                if (z > 0) { tv[buf][bj][0] = *(const f32x4*)(T + off_ + bj * HALF); tv[buf][bj][1] = *(const f32x4*)(T + off_ + bj * HALF + 4); } \
                else { tv[buf][bj][0] = (f32x4){0.f, 0.f, 0.f, 0.f}; tv[buf][bj][1] = (f32x4){0.f, 0.f, 0.f, 0.f}; } } } while (0)
        PG8_MG_LOAD(0, 0);
#pragma unroll
        for (int k = 0; k < 8; ++k) {
            if (k + 1 < 8) PG8_MG_LOAD((k + 1) & 1, k + 1);
            const int ai = k >> 2, m = k & 3; const size_t off = (size_t)(row0 + ai * HALF + m * 16) * DM + col0;
#pragma unroll
            for (int bj = 0; bj < 2; ++bj) {
                const u32x4 g = gv[k & 1][bj];
                const f32x4 g0 = (f32x4){bflo(g.x), bfhi(g.x), bflo(g.y), bfhi(g.y)}, g1 = (f32x4){bflo(g.z), bfhi(g.z), bflo(g.w), bfhi(g.w)};
                const f32x4 t0 = tv[k & 1][bj][0] + g0 * acc[ai][bj][m][0], t1 = tv[k & 1][bj][1] + g1 * acc[ai][bj][m][1];
                if (z < 3) { *(f32x4*)(T + off + bj * HALF) = t0; *(f32x4*)(T + off + bj * HALF + 4) = t1; }
                else { u32x4 w; w.x = cvt_pk_bf16(t0[0], t0[1]); w.y = cvt_pk_bf16(t0[2], t0[3]); w.z = cvt_pk_bf16(t1[0], t1[1]); w.w = cvt_pk_bf16(t1[2], t1[3]);
                    *(u32x4*)(Mg + off + bj * HALF) = w; } }
        }
#undef PG8_MG_LOAD
    }
};

struct EpiMergeDiag {
    const bf16_t* gate; int ldg; bf16_t* Mg;
    __device__ __forceinline__ void operator()(f32x4 (&acc)[2][2][4][2], const Unit& u, int wr, int wc, int fr, int fq) const {
        const int row0 = u.pm * HALF + wr * 64 + fr, col0 = u.pn * HALF + wc * 32 + 8 * fq, z0 = 2 * u.z;
#pragma unroll
        for (int m = 0; m < 4; ++m) { const int row = row0 + m * 16;
            const u32x4 ga = *(const u32x4*)(gate + (size_t)row * ldg + z0 * DM + col0), gb = *(const u32x4*)(gate + (size_t)row * ldg + (z0 + 1) * DM + col0);
            const f32x4 a0 = (f32x4){bflo(ga.x), bfhi(ga.x), bflo(ga.y), bfhi(ga.y)}, a1 = (f32x4){bflo(ga.z), bfhi(ga.z), bflo(ga.w), bfhi(ga.w)};
            const f32x4 b0 = (f32x4){bflo(gb.x), bfhi(gb.x), bflo(gb.y), bfhi(gb.y)}, b1 = (f32x4){bflo(gb.z), bfhi(gb.z), bflo(gb.w), bfhi(gb.w)};
            f32x4 t0 = a0 * acc[0][0][m][0] + b0 * acc[1][1][m][0], t1 = a1 * acc[0][0][m][1] + b1 * acc[1][1][m][1];
            if (u.z == 0) { acc[0][1][m][0] = t0; acc[0][1][m][1] = t1; }
            else { t0 = t0 + acc[0][1][m][0]; t1 = t1 + acc[0][1][m][1];
                u32x4 w; w.x = cvt_pk_bf16(t0[0], t0[1]); w.y = cvt_pk_bf16(t0[2], t0[3]); w.z = cvt_pk_bf16(t1[0], t1[1]); w.w = cvt_pk_bf16(t1[2], t1[3]);
                *(u32x4*)(Mg + (size_t)row * DM + col0) = w; } }
    }
};

template <class Epi, class Sched, bool ALIGN_EPI, bool DIAG = false>
__device__ __forceinline__ void gemm_phase(LAS unsigned char* lds, const Gemm g, const Sched& S, const Epi& E) {
    const int tid = opaque_tid(), wid = __builtin_amdgcn_readfirstlane(tid >> 6), lane = tid & 63, wr = wid >> 2, wc = wid & 3, fr = lane & 15, fq = lane >> 4;
    const int K = g.K, nt = K / BK, lda = g.lda;
    unsigned voffA[2], voffB[2];
#pragma unroll
    for (int i = 0; i < 2; ++i) { int R, C; stage_rc(tid * 16 + i * 8192, R, C); const int Rb = (R & ~31) + perm32(R & 31);
        voffA[i] = (unsigned)(R * lda + C) * 2u; voffB[i] = (unsigned)(Rb * K + C) * 2u; }
    const size_t kstep = (size_t)(BK * 2);
    const size_t hstepA = DIAG ? g.zA : (size_t)HALF * lda * 2, hstepB = DIAG ? g.zB : (size_t)HALF * K * 2;
    const size_t tstepA = (DIAG ? 1 : 2) * (size_t)HALF * lda * 2, tstepB = (DIAG ? 1 : 2) * (size_t)HALF * K * 2;
    const size_t zsA = (DIAG ? 2 : 1) * g.zA, zsB = (DIAG ? 2 : 1) * g.zB;
    const unsigned ldsw = (unsigned)wid * 1024u;
    const int aoff = lds_byte(wr * 64 + fr, fq * 8), boff = lds_byte(wc * 32 + fr, fq * 8);
#define PG8_SA(b, h) (((b) * 2 + (h)) * HTB)
#define PG8_SB(b, h) ((4 + (b) * 2 + (h)) * HTB)
#define PG8_STAGE(bufoff, gbase, voff) do { _Pragma("unroll") for (int _i = 0; _i < 2; ++_i) \
        __builtin_amdgcn_global_load_lds((const unsigned*)((const char*)(gbase) + (voff)[_i]), (LAS unsigned*)(lds + (bufoff) + ldsw + _i * 8192), 16, 0, 0); } while (0)
#define PG8_LDA(dst, b, h) do { _Pragma("unroll") for (int m = 0; m < 4; ++m) _Pragma("unroll") for (int k = 0; k < 2; ++k) dst[m][k] = *(const LAS bf16x8*)(lds + PG8_SA(b, h) + aoff + m * 2048 + k * 1024); } while (0)
#define PG8_LDB(dst, b, h) do { _Pragma("unroll") for (int n = 0; n < 2; ++n) _Pragma("unroll") for (int k = 0; k < 2; ++k) dst[n][k] = *(const LAS bf16x8*)(lds + PG8_SB(b, h) + boff + n * 2048 + k * 1024); } while (0)
#define PG8_MMA(ai, bj, At, Bt) do { __builtin_amdgcn_s_setprio(1); _Pragma("unroll") for (int m = 0; m < 4; ++m) _Pragma("unroll") for (int n = 0; n < 2; ++n) _Pragma("unroll") for (int k = 0; k < 2; ++k) \
        acc[ai][bj][m][n] = __builtin_amdgcn_mfma_f32_16x16x32_bf16(Bt[n][k], At[m][k], acc[ai][bj][m][n], 0, 0, 0); __builtin_amdgcn_s_setprio(0); } while (0)
#define PG8_WAIT_V(n) asm volatile("s_waitcnt vmcnt(" #n ")" ::: "memory")
#define PG8_WAIT_L(n) asm volatile("s_waitcnt lgkmcnt(" #n ")" ::: "memory")
#define PG8_BAR __builtin_amdgcn_s_barrier()
#define PG8_SCHED __builtin_amdgcn_sched_barrier(0)
    Unit cur, nxt; int ui = 0;
    if (!S.next(0, cur)) return;
    f32x4 acc[2][2][4][2];
#pragma unroll
    for (int a = 0; a < 2; ++a)
#pragma unroll
        for (int b = 0; b < 2; ++b)
#pragma unroll
            for (int m = 0; m < 4; ++m)
#pragma unroll
                for (int n = 0; n < 2; ++n) acc[a][b][m][n] = (f32x4){0.f, 0.f, 0.f, 0.f};
    bf16x8 At[4][2], B0[2][2], B1[2][2];
    const char* cA = (const char*)g.A + (size_t)cur.pm * tstepA + (size_t)cur.z * zsA; const char* cB = (const char*)g.Bt + (size_t)cur.pn * tstepB + (size_t)cur.z * zsB;
    PG8_STAGE(PG8_SB(0, 0), cB, voffB); PG8_STAGE(PG8_SB(0, 1), cB + hstepB, voffB); PG8_STAGE(PG8_SA(0, 0), cA, voffA); PG8_STAGE(PG8_SA(0, 1), cA + hstepA, voffA);
    if (wr == 1) PG8_BAR;
    PG8_WAIT_V(2); PG8_BAR;
    PG8_STAGE(PG8_SB(1, 0), cB + kstep, voffB); PG8_STAGE(PG8_SA(1, 0), cA + kstep, voffA); PG8_STAGE(PG8_SB(1, 1), cB + hstepB + kstep, voffB);
    PG8_WAIT_V(6); PG8_BAR;
    for (;;) {
        const bool has_next = S.next(ui + 1, nxt);
        const char* nA = has_next ? (const char*)g.A + (size_t)nxt.pm * tstepA + (size_t)nxt.z * zsA : cA; const char* nB = has_next ? (const char*)g.Bt + (size_t)nxt.pn * tstepB + (size_t)nxt.z * zsB : cB;
        for (int t = 0; t < nt; t += 2) {
            const bool last = (t == nt - 2);
            const char* a1 = cA + (size_t)(t + 1) * kstep;
            const char* a2 = last ? nA : cA + (size_t)(t + 2) * kstep; const char* b2 = last ? nB : cB + (size_t)(t + 2) * kstep;
            const char* a3 = a2 + kstep; const char* b3 = b2 + kstep;
            PG8_LDB(B0, 0, 0); PG8_LDB(B1, 0, 1); PG8_SCHED; PG8_LDA(At, 0, 0); PG8_STAGE(PG8_SA(1, 1), a1 + hstepA, voffA);
            PG8_WAIT_V(8); PG8_WAIT_L(0); PG8_BAR; PG8_MMA(0, 0, At, B0); if constexpr (!DIAG) PG8_MMA(0, 1, At, B1); PG8_BAR; PG8_SCHED;
            PG8_LDA(At, 0, 1); PG8_STAGE(PG8_SB(0, 0), b2, voffB); PG8_STAGE(PG8_SB(0, 1), b2 + hstepB, voffB); PG8_STAGE(PG8_SA(0, 0), a2, voffA);
            PG8_WAIT_V(8); PG8_WAIT_L(0); PG8_BAR; if constexpr (!DIAG) PG8_MMA(1, 0, At, B0); PG8_MMA(1, 1, At, B1); PG8_BAR; PG8_SCHED;
            PG8_LDB(B0, 1, 0); PG8_LDB(B1, 1, 1); PG8_SCHED; PG8_LDA(At, 1, 0); PG8_STAGE(PG8_SA(0, 1), a2 + hstepA, voffA);
            PG8_WAIT_V(8); PG8_WAIT_L(0); PG8_BAR; PG8_MMA(0, 0, At, B0); if constexpr (!DIAG) PG8_MMA(0, 1, At, B1); PG8_BAR; PG8_SCHED;
            PG8_LDA(At, 1, 1); PG8_STAGE(PG8_SB(1, 0), b3, voffB); PG8_STAGE(PG8_SB(1, 1), b3 + hstepB, voffB); PG8_STAGE(PG8_SA(1, 0), a3, voffA);
            PG8_WAIT_V(8); PG8_WAIT_L(0); PG8_BAR; if constexpr (!DIAG) PG8_MMA(1, 0, At, B0); PG8_MMA(1, 1, At, B1); PG8_BAR; PG8_SCHED;
        }
        if constexpr (ALIGN_EPI) { if (wr == 0) PG8_BAR; }
        E(acc, cur, wr, wc, fr, fq);
        if (!has_next) break;
#pragma unroll
        for (int a = 0; a < 2; ++a)
#pragma unroll
            for (int b = 0; b < 2; ++b)
#pragma unroll
                for (int m = 0; m < 4; ++m)
#pragma unroll
                    for (int n = 0; n < 2; ++n) if (!DIAG || a == b) acc[a][b][m][n] = (f32x4){0.f, 0.f, 0.f, 0.f};
        cur = nxt; cA = nA; cB = nB; ++ui;
        if constexpr (ALIGN_EPI) { if (wr == 1) PG8_BAR; }
    }
    PG8_WAIT_V(0);
    if constexpr (!ALIGN_EPI) { if (wr == 0) PG8_BAR; }
    PG8_BAR;
#undef PG8_SA
#undef PG8_SB
#undef PG8_STAGE
#undef PG8_LDA
#undef PG8_LDB
#undef PG8_MMA
#undef PG8_WAIT_V
#undef PG8_WAIT_L
#undef PG8_BAR
#undef PG8_SCHED
}
}

constexpr size_t MiB = 1u << 20;
constexpr size_t WS_CTL = 0, CTL_ZERO_BYTES = 1 * MiB;
constexpr size_t WS_ROPE = 1 * MiB;
constexpr size_t WS_BTAB = 2 * MiB;
constexpr size_t WS_PMM = WS_BTAB + 16 * 132 * 4;
constexpr size_t WS_LAM = WS_PMM + 128 * 2 * 4;
constexpr size_t WS_KMEAN = 3 * MiB;
constexpr size_t WS_W = 4 * MiB;
constexpr size_t W_IN = 0, W_UQ = 51 * MiB, W_UKV = W_UQ + 768 * 512 * 2, W_BR = W_UKV + 1024 * 256 * 2, W_OUT = W_BR + 8 * MiB, W_UP = W_OUT + 8 * MiB, W_DN = W_UP + 44 * MiB, W_LAYER = W_DN + 22 * MiB;
constexpr size_t WS_X = WS_W + DEPTH * W_LAYER;
constexpr size_t WS_XN = WS_X + 128 * MiB;
constexpr size_t WS_MG = WS_XN + 64 * MiB;
constexpr size_t WS_Z = WS_MG + 64 * MiB;
constexpr size_t WS_CQN = WS_Z + 408 * MiB;
constexpr size_t WS_CKVN = WS_CQN + 16 * MiB;
constexpr size_t WS_KR = WS_CKVN + 8 * MiB;
constexpr size_t WS_QMLA = WS_KR + 2 * MiB;
constexpr size_t WS_KVMLA = WS_QMLA + 24 * MiB;
constexpr size_t WS_BRO = WS_KVMLA + 32 * MiB;
constexpr size_t WS_T = WS_BRO + 64 * MiB;
constexpr size_t WS_DSCR = WS_T + 176 * MiB;
constexpr size_t WS_END = WS_DSCR + 32 * MiB;
static_assert(W_LAYER * 1 == (size_t)(51 * MiB + 768 * 512 * 2 + 1024 * 256 * 2 + 82 * MiB), "weight map");
static_assert((size_t)M * ZLD * 2 == 408 * MiB && (size_t)M * UP_N * 2 <= 408 * MiB && (size_t)M * FFN * 2 == 176 * MiB, "buffer sizes");
constexpr int CW_TMO = 0;
constexpr int CW_QUEUE = 1024;
constexpr int CW_BAR = 4096;

constexpr int RING_OFF = 0, RING_BYTES = 131072;
constexpr int LDSCTL_OFF = RING_BYTES, MISC_OFF = LDSCTL_OFF + 320;
constexpr int LDS_BYTES = 147456;
constexpr int NWAVES = 8;

typedef GAS unsigned gu32;
#define RLX_AGENT __ATOMIC_RELAXED, __HIP_MEMORY_SCOPE_AGENT
#define LDS_WAIT() asm volatile("s_waitcnt lgkmcnt(0)" ::: "memory")
#define XB_TMO      128
#define XB_XCNT(j)  (256  + 64 * (j))
#define XB_XSUB(j)  (1280 + 64 * (j))
#define XB_XGEN(j)  (2304 + 64 * (j))
#define XB_TOP      3328
#define XB_TOPGEN   3392
#define XCD_BAR_WORDS 3456
#define XB_SPIN_CAP (1u << 22)
__device__ __forceinline__ unsigned xb_ld(unsigned* p)              { return __hip_atomic_load(p, __ATOMIC_RELAXED, __HIP_MEMORY_SCOPE_AGENT); }
__device__ __forceinline__ unsigned xb_add(unsigned* p, unsigned v) { return __hip_atomic_fetch_add(p, v, __ATOMIC_RELAXED, __HIP_MEMORY_SCOPE_AGENT); }
__device__ __forceinline__ unsigned xb_xcc_id() { return (unsigned)__builtin_amdgcn_s_getreg((3 << 11) | 20) & 0xFu; }
#define XB_SPIN(cond, bar) do { unsigned _sp = 0; while (cond) { __builtin_amdgcn_s_sleep(1); \
    if ((++_sp & 255u) == 0u) { if (xb_ld(&(bar)[XB_TMO])) break; if (_sp > XB_SPIN_CAP) { atomicAdd(&(bar)[XB_TMO], 1u); break; } } } } while (0)
struct XcdBarrier { unsigned* bar; unsigned x; volatile LAS unsigned* st; };
__device__ __forceinline__ XcdBarrier xcd_barrier_post(unsigned* bar, volatile LAS unsigned* st) {
    XcdBarrier b; b.bar = bar; b.x = xb_xcc_id(); b.st = st;
    if (threadIdx.x == 0) (void)xb_add(&bar[XB_XCNT(b.x)], 1u);
    return b;
}
__device__ __forceinline__ void xcd_barrier_complete(unsigned* bar, unsigned x, unsigned& nloc, unsigned& nx) {
    const unsigned G = gridDim.x * gridDim.y * gridDim.z;
    unsigned sum, cnt, mine, sp = 0u;
    for (;;) {
        sum = 0u; cnt = 0u; mine = 0u;
#pragma unroll
        for (unsigned j = 0; j < 16; ++j) { const unsigned c = xb_ld(&bar[XB_XCNT(j)]); sum += c; cnt += (c > 0u) ? 1u : 0u; mine = (j == x) ? c : mine; }
        if (sum == G) break;
        __builtin_amdgcn_s_sleep(1);
        if ((++sp & 255u) == 0u) { if (xb_ld(&bar[XB_TMO])) break; if (sp > XB_SPIN_CAP) { atomicAdd(&bar[XB_TMO], 1u); break; } }
    }
    nloc = mine > 0u ? mine : 1u; nx = cnt > 0u ? cnt : 1u;
}
__device__ __forceinline__ void xcd_barrier(const XcdBarrier& b) {
    asm volatile("s_waitcnt vmcnt(0)" ::: "memory");
    __syncthreads();
    if (threadIdx.x == 0) {
        unsigned* bar = b.bar;
        __builtin_amdgcn_s_waitcnt(0);
        unsigned nloc = b.st[0], nx = b.st[1];
        if (nloc == 0u) { xcd_barrier_complete(bar, b.x, nloc, nx); b.st[0] = nloc; b.st[1] = nx; }
        const unsigned old = xb_add(&bar[XB_XSUB(b.x)], 1u);
        const unsigned gen = old / nloc;
        if (old + 1u == (gen + 1u) * nloc) {
            __builtin_amdgcn_fence(__ATOMIC_RELEASE, "agent");
            asm volatile("s_waitcnt vmcnt(0)" ::: "memory");
            const unsigned og = xb_add(&bar[XB_TOP], 1u);
            const unsigned tg = og / nx;
            if (og + 1u == (tg + 1u) * nx) xb_add(&bar[XB_TOPGEN], 1u);
            else XB_SPIN(xb_ld(&bar[XB_TOPGEN]) == tg, bar);
            __builtin_amdgcn_fence(__ATOMIC_ACQUIRE, "agent");
            xb_add(&bar[XB_XGEN(b.x)], 1u);
            asm volatile("s_waitcnt vmcnt(0)" ::: "memory");
        } else {
            XB_SPIN(xb_ld(&bar[XB_XGEN(b.x)]) == gen, bar);
            __builtin_amdgcn_fence(__ATOMIC_ACQUIRE, "agent");
            asm volatile("s_waitcnt vmcnt(0)" ::: "memory");
        }
    }
    __syncthreads();
}

namespace att {
template <int DK0_, int DK1_, int DV_> struct Cfg {
    static constexpr int DK0 = DK0_, DK1 = DK1_, DK = DK0_ + DK1_, DV = DV_;
    static constexpr int KP = DK * 2 + 16, VP = DV * 2 + 64;
    static constexpr int KOFF = 0, VOFF = 64 * KP, POFF = VOFF + 64 * VP, BUFB = POFF + 256;
    static constexpr int NKC = (64 * DK / 8) / 512, NVC = (64 * DV / 8) / 512;
    static constexpr int ND = DK / 16, NO = DV / 32;
};
constexpr int BTAB_OFF = 94208, KMEAN_OFF = 94208 + 1024;
struct Src { const bf16_t* k0; int pk0; const bf16_t* k1; int pk1; const bf16_t* v; int pv; const int* pos; };
struct WaveCtx { int lane, r32, hi, wid, tid; };

template <class C, bool WITH_POS> struct Stage {
    u32x4 kr[C::NKC]; u32x4 vr[C::NVC]; int pr;
    __device__ __forceinline__ void load(const Src& s, int t, int tid) {
        const int kb = t * 64;
#pragma unroll
        for (int i = 0; i < C::NKC; ++i) { const int id = tid + 512 * i, row = id / (C::DK / 8), c = id % (C::DK / 8);
            const bf16_t* p = (C::DK1 == 0 || c < C::DK0 / 8) ? s.k0 + (size_t)(kb + row) * s.pk0 + c * 8 : s.k1 + (size_t)(kb + row) * s.pk1 + (c - C::DK0 / 8) * 8;
            kr[i] = *(const u32x4*)p; }
#pragma unroll
        for (int i = 0; i < C::NVC; ++i) { const int id = tid + 512 * i, row = id / (C::DV / 8), c = id % (C::DV / 8);
            vr[i] = *(const u32x4*)(s.v + (size_t)(kb + row) * s.pv + c * 8); }
        pr = (WITH_POS && tid < 64) ? s.pos[kb + tid] : 0;
    }
    __device__ __forceinline__ void store(LAS unsigned char* buf, int tid) const {
#pragma unroll
        for (int i = 0; i < C::NKC; ++i) { const int id = tid + 512 * i, row = id / (C::DK / 8), c = id % (C::DK / 8); *(LAS u32x4*)(buf + C::KOFF + row * C::KP + c * 16) = kr[i]; }
#pragma unroll
        for (int i = 0; i < C::NVC; ++i) { const int id = tid + 512 * i, row = id / (C::DV / 8), c = id % (C::DV / 8); *(LAS u32x4*)(buf + C::VOFF + row * C::VP + c * 16) = vr[i]; }
        if (WITH_POS && tid < 64) *(LAS int*)(buf + C::POFF + tid * 4) = pr;
    }
};
__device__ __forceinline__ s16x4 vtr(const LAS unsigned char* p) { typedef short v4i16_t __attribute__((ext_vector_type(4))); return __builtin_bit_cast(s16x4, __builtin_amdgcn_ds_read_tr16_b64_v4i16((LAS v4i16_t*)p)); }

struct RowState { float m, l; };

template <class C, int KIND, bool BIAS>
__device__ __forceinline__ void tile_compute(const LAS unsigned char* buf, const LAS float* btab, const bf16x8 (&qf)[C::ND], f32x16 (&O)[C::NO], RowState& st,
                                             int k0, int qw, int posq, int pminq, const int* pmm, unsigned selmask, int blk, const WaveCtx& w) {
    const int qi = qw + w.r32;
#pragma unroll
    for (int p = 0; p < 2; ++p) {
        const int ks = k0 + 32 * p;
        bool causal_tile = true, sel_lane = true, skip = false, fast = false;
        if (KIND == 0) { skip = ks > qw + 31; fast = (ks + 31 <= qw); }
        if (KIND == 1) { skip = (ks > qw + 31) || (ks + 31 < qw - 127); }
        if (KIND == 2) {
            const int n = ks >> 8;
            if (n < blk) { causal_tile = false; sel_lane = ((selmask >> n) & 1u) != 0u; skip = !__any(sel_lane); fast = (bool)__all(sel_lane); }
            else { skip = ks > qw + 31; fast = (ks + 31 <= qw); }
        }
        if (skip) continue;
        if (BIAS && fast) { const int pmaxk = pmm[(ks >> 5) * 2 + 1]; fast = (pminq - pmaxk >= 128); }
        f32x16 sc;
#pragma unroll
        for (int r = 0; r < 16; ++r) sc[r] = 0.f;
        const LAS unsigned char* kb = buf + C::KOFF + (32 * p + w.r32) * C::KP + w.hi * 16;
#pragma unroll
        for (int d0 = 0; d0 < C::ND; ++d0) {
            const bf16x8 a0 = *(const LAS bf16x8*)(kb + d0 * 32);
            sc = __builtin_amdgcn_mfma_f32_32x32x16_bf16(a0, qf[d0], sc, 0, 0, 0);
        }
        if (fast) {
            if (BIAS) { const float bc = btab[128];
#pragma unroll
                for (int r = 0; r < 16; ++r) sc[r] += bc; }
        } else {
#pragma unroll
            for (int g4 = 0; g4 < 4; ++g4) {
                i32x4 pk = (i32x4){0, 0, 0, 0};
                if (BIAS) pk = *(const LAS i32x4*)(buf + C::POFF + (32 * p + 8 * g4 + 4 * w.hi) * 4);
#pragma unroll
                for (int e = 0; e < 4; ++e) {
                    const int r = 4 * g4 + e, kv = ks + 8 * g4 + 4 * w.hi + e;
                    float v = sc[r];
                    if (BIAS) { int d = posq - pk[e]; d = d < 0 ? 0 : (d > 128 ? 128 : d); v += btab[d]; }
                    bool valid;
                    if (KIND == 0) valid = kv <= qi;
                    else if (KIND == 1) valid = (unsigned)(qi - kv) < 128u;
                    else valid = causal_tile ? (kv <= qi) : sel_lane;
                    sc[r] = valid ? v : NEG_INF;
                }
            }
        }
        float tmax = sc[0];
#pragma unroll
        for (int r = 1; r < 16; ++r) tmax = fmaxf(tmax, sc[r]);
        tmax = fmaxf(tmax, __shfl_xor(tmax, 32));
        const float mn = fmaxf(st.m, tmax);
        const float alpha = __builtin_amdgcn_exp2f(st.m - mn);
        st.m = mn;
        float ps = 0.f;
#pragma unroll
        for (int r = 0; r < 16; ++r) { sc[r] = __builtin_amdgcn_exp2f(sc[r] - mn); ps += sc[r]; }
        st.l = st.l * alpha + ps;
        if (__any(alpha != 1.0f)) {
#pragma unroll
            for (int d = 0; d < C::NO; ++d)
#pragma unroll
                for (int r = 0; r < 16; ++r) O[d][r] *= alpha;
        }
        const LAS unsigned char* vb = buf + C::VOFF + (32 * p + 4 * w.hi + ((w.lane & 15) >> 2)) * C::VP + (16 * ((w.lane >> 4) & 1) + 4 * (w.lane & 3)) * 2;
#pragma unroll
        for (int s = 0; s < 2; ++s) {
            u32x4 t; const int b = 8 * s;
            t.x = cvt_pk_bf16(sc[b], sc[b + 1]); t.y = cvt_pk_bf16(sc[b + 2], sc[b + 3]); t.z = cvt_pk_bf16(sc[b + 4], sc[b + 5]); t.w = cvt_pk_bf16(sc[b + 6], sc[b + 7]);
            const bf16x8 pf = __builtin_bit_cast(bf16x8, t);
#pragma unroll
            for (int d = 0; d < C::NO; ++d) {
                const s16x4 lo = vtr(vb + (16 * s) * C::VP + d * 64), hi4 = vtr(vb + (16 * s + 8) * C::VP + d * 64);
                const bf16x8 vf = (bf16x8){lo[0], lo[1], lo[2], lo[3], hi4[0], hi4[1], hi4[2], hi4[3]};
                O[d] = __builtin_amdgcn_mfma_f32_32x32x16_bf16(vf, pf, O[d], 0, 0, 0);
            }
        }
    }
}

template <class C, int KIND, bool BIAS>
__device__ __forceinline__ void run_tiles(LAS unsigned char* lds, const Src& src, int t0, int t1, const bf16x8 (&qf)[C::ND], f32x16 (&O)[C::NO], RowState& st,
                                          int qw, int posq, int pminq, const int* pmm, unsigned selmask, int blk, const WaveCtx& w) {
    Stage<C, BIAS> sg;
    const LAS float* btab = (const LAS float*)(lds + BTAB_OFF);
    if (t0 < t1) sg.load(src, t0, w.tid);
    int it = 0;
    for (int t = t0; t < t1; ++t, ++it) {
        LAS unsigned char* buf = lds + (it & 1) * C::BUFB;
        sg.store(buf, w.tid);
        __syncthreads();
        if (t + 1 < t1) sg.load(src, t + 1, w.tid);
        tile_compute<C, KIND, BIAS>(buf, btab, qf, O, st, t * 64, qw, posq, pminq, pmm, selmask, blk, w);
    }
    __syncthreads();
}
template <int ND> __device__ __forceinline__ void load_q(bf16x8 (&qf)[ND], const bf16_t* qrow, int hi) {
#pragma unroll
    for (int d0 = 0; d0 < ND; ++d0) qf[d0] = *(const bf16x8*)(qrow + d0 * 16 + hi * 8);
}
template <int NO> __device__ __forceinline__ void store_o(const f32x16 (&O)[NO], bf16_t* orow, int hi) {
#pragma unroll
    for (int d = 0; d < NO; ++d)
#pragma unroll
        for (int g = 0; g < 4; ++g) { u32x2 v; v.x = cvt_pk_bf16(O[d][4 * g], O[d][4 * g + 1]); v.y = cvt_pk_bf16(O[d][4 * g + 2], O[d][4 * g + 3]); *(u32x2*)(orow + 32 * d + 8 * g + 4 * hi) = v; }
}
}

struct Args { const float* in[20]; float* out; unsigned char* ws; int ph_lo, ph_hi; };
constexpr int PH_PER_LAYER = 12, N_PHASES = 2 + DEPTH * PH_PER_LAYER;

struct Frame {
    LAS unsigned char* lds; volatile LAS unsigned* MISC; unsigned* ctl;
    int tid, lane, wave, G, vcu;
    unsigned char* ws;
};

__device__ __forceinline__ void transpose_item(const float* W, int K, int Nsrc, bf16_t* WT, int Ndst, int pad_lo, int pad_hi, int shift, LAS float* scr, int item, int lane) {
    const int nblk = Ndst / 32, kb = item / nblk, nb = item % nblk, k0 = 64 * kb, n0 = 32 * nb;
    const bool pad = (n0 >= pad_lo && n0 < pad_hi);
    const int ns0 = n0 - (n0 >= pad_hi ? shift : 0);
    if (!pad) {
#pragma unroll 8
        for (int i = 0; i < 32; ++i) { const int kk = 2 * i + (lane >> 5); scr[kk * 33 + (lane & 31)] = W[(size_t)(k0 + kk) * Nsrc + ns0 + (lane & 31)]; }
    }
    LDS_WAIT(); asm volatile("" ::: "memory");
    const int c = lane & 7;
#pragma unroll
    for (int j = 0; j < 4; ++j) { const int n = (lane >> 3) + 8 * j; const LAS float* s = scr + (8 * c) * 33 + n;
        u32x4 o = (u32x4){0u, 0u, 0u, 0u};
        if (!pad) { o.x = cvt_pk_bf16(s[0 * 33], s[1 * 33]); o.y = cvt_pk_bf16(s[2 * 33], s[3 * 33]); o.z = cvt_pk_bf16(s[4 * 33], s[5 * 33]); o.w = cvt_pk_bf16(s[6 * 33], s[7 * 33]); }
        *(u32x4*)(WT + (size_t)(n0 + n) * K + k0 + 8 * c) = o; }
    LDS_WAIT(); asm volatile("" ::: "memory");
}
__device__ __forceinline__ int t5_bucket(int n) {
    if (n < 16) return n;
    int b = 16;
    b += (n >= 19); b += (n >= 21); b += (n >= 24); b += (n >= 27); b += (n >= 31); b += (n >= 35); b += (n >= 40); b += (n >= 46);
    b += (n >= 52); b += (n >= 59); b += (n >= 67); b += (n >= 77); b += (n >= 87); b += (n >= 99); b += (n >= 113);
    return b;
}
__device__ __forceinline__ void rms_row_bf16(const float* xrow, const float* g, bf16_t* orow, int lane) {
    f32x4 v[8]; float s = 0.f;
#pragma unroll
    for (int j = 0; j < 8; ++j) { v[j] = *((const f32x4*)xrow + lane + 64 * j); s += (v[j].x * v[j].x + v[j].y * v[j].y) + (v[j].z * v[j].z + v[j].w * v[j].w); }
    const float rstd = 1.0f / sqrtf(wave_sum(s) * (1.0f / DM) + EPS);
#pragma unroll
    for (int j = 0; j < 8; ++j) { const f32x4 gg = *((const f32x4*)g + lane + 64 * j);
        u32x2 o; o.x = cvt_pk_bf16(v[j].x * rstd * gg.x, v[j].y * rstd * gg.y); o.y = cvt_pk_bf16(v[j].z * rstd * gg.z, v[j].w * rstd * gg.w);
        *((u32x2*)orow + lane + 64 * j) = o; }
}
__device__ __forceinline__ void rms_row_f32(const float* xrow, const float* g, float* orow, int lane) {
    f32x4 v[8]; float s = 0.f;
#pragma unroll
    for (int j = 0; j < 8; ++j) { v[j] = *((const f32x4*)xrow + lane + 64 * j); s += (v[j].x * v[j].x + v[j].y * v[j].y) + (v[j].z * v[j].z + v[j].w * v[j].w); }
    const float rstd = 1.0f / sqrtf(wave_sum(s) * (1.0f / DM) + EPS);
#pragma unroll
    for (int j = 0; j < 8; ++j) { const f32x4 gg = *((const f32x4*)g + lane + 64 * j); *((f32x4*)orow + lane + 64 * j) = v[j] * rstd * gg; }
}

__device__ __forceinline__ float gelu_f(float v) {
    const float av = fabsf(v), d = av * 0.2316418882f + 1.0f;
    const float t = __builtin_amdgcn_rcpf(d);
    float q = t * 0.5307027145f + (-0.7265760135f); q = q * t + 0.7107068705f; q = q * t + (-0.142248368f); q = q * t + 0.127414796f; q = q * t;
    const float e = __builtin_amdgcn_exp2f((v * v) * (-0.72134752044f));
    const float m = v * (q * e), r = v - m;
    return v < 0.f ? m : r;
}

__device__ __forceinline__ void p_prologue(Frame& F, const Args& a) {
    const int otid = opaque_tid(), olane = otid & 63;
    LAS float* scr = (LAS float*)(F.lds + RING_OFF + F.wave * 16384);
    const int gw = F.vcu * NWAVES + F.wave, NGW = F.G * NWAVES;
    constexpr int I_IN = (DM / 64) * (ZLD / 32), I_UQ = (512 / 64) * (768 / 32), I_UKV = (256 / 64) * (1024 / 32), I_BR1 = (512 / 64) * (DM / 32), I_BR = 4 * I_BR1,
                  I_OUT = (DM / 64) * (DM / 32), I_UP = (DM / 64) * (UP_N / 32), I_DN = (FFN / 64) * (DM / 32);
    constexpr int I_LAYER = I_IN + I_UQ + I_UKV + I_BR + I_OUT + I_UP + I_DN;
    for (int it = gw; it < DEPTH * I_LAYER; it += NGW) {
        const int l = it / I_LAYER; int r = it - l * I_LAYER;
        unsigned char* wl = F.ws + WS_W + (size_t)l * W_LAYER;
        if (r < I_IN) { transpose_item(a.in[4] + (size_t)l * DM * IN_COLS, DM, IN_COLS, (bf16_t*)(wl + W_IN), ZLD, 2368, 2560, 192, scr, r, olane); continue; } r -= I_IN;
        if (r < I_UQ) { transpose_item(a.in[8] + (size_t)l * 512 * 768, 512, 768, (bf16_t*)(wl + W_UQ), 768, 1 << 30, 1 << 30, 0, scr, r, olane); continue; } r -= I_UQ;
        if (r < I_UKV) { transpose_item(a.in[10] + (size_t)l * 256 * 1024, 256, 1024, (bf16_t*)(wl + W_UKV), 1024, 1 << 30, 1 << 30, 0, scr, r, olane); continue; } r -= I_UKV;
        if (r < I_BR) { const int i = r / I_BR1; transpose_item(a.in[12] + ((size_t)l * 4 + i) * 512 * DM, 512, DM, (bf16_t*)(wl + W_BR) + (size_t)i * DM * 512, DM, 1 << 30, 1 << 30, 0, scr, r - i * I_BR1, olane); continue; } r -= I_BR;
        if (r < I_OUT) { transpose_item(a.in[13] + (size_t)l * DM * DM, DM, DM, (bf16_t*)(wl + W_OUT), DM, 1 << 30, 1 << 30, 0, scr, r, olane); continue; } r -= I_OUT;
        if (r < I_UP) { transpose_item(a.in[15] + (size_t)l * DM * UP_N, DM, UP_N, (bf16_t*)(wl + W_UP), UP_N, 1 << 30, 1 << 30, 0, scr, r, olane); continue; } r -= I_UP;
        transpose_item(a.in[18] + (size_t)l * FFN * DM, FFN, DM, (bf16_t*)(wl + W_DN), DM, 1 << 30, 1 << 30, 0, scr, r, olane);
    }
    const int* pos = (const int*)a.in[1];
    const int gt = F.vcu * (NWAVES * 64) + otid, NGT = F.G * NWAVES * 64;
    f32x2* rope = (f32x2*)(F.ws + WS_ROPE);
    for (int e = gt; e < SEQ * 32; e += NGT) {
        const int s = e >> 5, i = e & 31;
        const float inv = (float)exp2((double)(-i) * (13.287712379549449 / 32.0));
        const float ang = (float)pos[s] * inv;
        const double rev = (double)ang * 0.15915494309189535;
        const float fr = (float)(rev - rint(rev));
        rope[e] = (f32x2){__builtin_amdgcn_cosf(fr), __builtin_amdgcn_sinf(fr)};
    }
    float* btab = (float*)(F.ws + WS_BTAB);
    for (int e = gt; e < 16 * 132; e += NGT) { const int hd = e / 132, n = e - hd * 132; btab[e] = (n <= 128) ? a.in[2][t5_bucket(n) * 16 + hd] * LOG2E : 0.f; }
    int* pmm = (int*)(F.ws + WS_PMM);
    for (int e = gt; e < 128; e += NGT) { int mn = pos[e * 32], mx = mn;
        for (int j = 1; j < 32; ++j) { const int p = pos[e * 32 + j]; mn = p < mn ? p : mn; mx = p > mx ? p : mx; }
        pmm[2 * e] = mn; pmm[2 * e + 1] = mx; }
    if (gt < DEPTH) {
        const float* lv = a.in[5] + (size_t)gt * 4 * 64; float s01 = 0.f, s23 = 0.f;
        for (int j = 0; j < 64; ++j) { s01 += lv[j] * lv[64 + j]; s23 += lv[128 + j] * lv[192 + j]; }
        const double li[4] = {0.20000000000000007, 0.35550906759096934, 0.4707130183435842, 0.5560582041556406};
        const float lam_init = (float)(gt == 0 ? li[0] : gt == 1 ? li[1] : gt == 2 ? li[2] : li[3]);
        ((float*)(F.ws + WS_LAM))[gt] = expf(s01) - expf(s23) + lam_init;
    }
}

__device__ __forceinline__ void p_prep(Frame& F, const Args& a, int l) {
    const int otid = opaque_tid(), lane = otid & 63;
    const int gw = F.vcu * NWAVES + F.wave, NGW = F.G * NWAVES;
    const bf16_t* Z = (const bf16_t*)(F.ws + WS_Z);
    bf16_t* CQN = (bf16_t*)(F.ws + WS_CQN); bf16_t* CKVN = (bf16_t*)(F.ws + WS_CKVN); bf16_t* KR = (bf16_t*)(F.ws + WS_KR);
    const float* gq = a.in[7] + (size_t)l * 512; const float* gkv = a.in[9] + (size_t)l * 256;
    const f32x2* rope = (const f32x2*)(F.ws + WS_ROPE);
    for (int m = gw; m < M; m += NGW) {
        const bf16_t* zr = Z + (size_t)m * ZLD;
        {
            const u32x4 v = *(const u32x4*)(zr + ZCQ + lane * 8);
            float x[8] = {bflo(v.x), bfhi(v.x), bflo(v.y), bfhi(v.y), bflo(v.z), bfhi(v.z), bflo(v.w), bfhi(v.w)};
            float s = 0.f;
#pragma unroll
            for (int j = 0; j < 8; ++j) s += x[j] * x[j];
            const float rstd = 1.0f / sqrtf(wave_sum(s) * (1.0f / 512.0f) + EPS);
            const f32x4 g0 = *(const f32x4*)(gq + lane * 8), g1 = *(const f32x4*)(gq + lane * 8 + 4);
            u32x4 o; o.x = cvt_pk_bf16(x[0] * rstd * g0.x, x[1] * rstd * g0.y); o.y = cvt_pk_bf16(x[2] * rstd * g0.z, x[3] * rstd * g0.w);
            o.z = cvt_pk_bf16(x[4] * rstd * g1.x, x[5] * rstd * g1.y); o.w = cvt_pk_bf16(x[6] * rstd * g1.z, x[7] * rstd * g1.w);
            *(u32x4*)(CQN + (size_t)m * 512 + lane * 8) = o;
        }
        {
            const u32x2 v = *(const u32x2*)(zr + ZCKV + lane * 4);
            const float x0 = bflo(v.x), x1 = bfhi(v.x), x2 = bflo(v.y), x3 = bfhi(v.y);
            const float rstd = 1.0f / sqrtf(wave_sum((x0 * x0 + x1 * x1) + (x2 * x2 + x3 * x3)) * (1.0f / 256.0f) + EPS);
            const f32x4 g = *(const f32x4*)(gkv + lane * 4);
            u32x2 o; o.x = cvt_pk_bf16(x0 * rstd * g.x, x1 * rstd * g.y); o.y = cvt_pk_bf16(x2 * rstd * g.z, x3 * rstd * g.w);
            *(u32x2*)(CKVN + (size_t)m * 256 + lane * 4) = o;
        }
        if (lane < 32) {
            const float x1 = bf2f(zr[ZKR + lane]), x2 = bf2f(zr[ZKR + 32 + lane]);
            const f32x2 cs = rope[(m & (SEQ - 1)) * 32 + lane];
            KR[(size_t)m * 64 + lane] = (bf16_t)(cvt_pk_bf16(x1 * cs.x - x2 * cs.y, 0.f) & 0xffffu);
            KR[(size_t)m * 64 + 32 + lane] = (bf16_t)(cvt_pk_bf16(x1 * cs.y + x2 * cs.x, 0.f) & 0xffffu);
        }
    }
    LAS float* scr = (LAS float*)(F.lds + RING_OFF);
    float* KM = (float*)(F.ws + WS_KMEAN);
    for (int it = F.vcu; it < NB * 4 * 16; it += F.G) {
        const int b = it >> 6, h = (it >> 4) & 3, n = it & 15;
        const int c8 = otid & 15, rg = otid >> 4;
        float acc[8];
#pragma unroll
        for (int j = 0; j < 8; ++j) acc[j] = 0.f;
        for (int j = 0; j < 8; ++j) {
            const u32x4 v = *(const u32x4*)(Z + (size_t)(b * SEQ + n * 256 + rg + 32 * j) * ZLD + ZMK + h * 128 + c8 * 8);
            acc[0] += bflo(v.x); acc[1] += bfhi(v.x); acc[2] += bflo(v.y); acc[3] += bfhi(v.y); acc[4] += bflo(v.z); acc[5] += bfhi(v.z); acc[6] += bflo(v.w); acc[7] += bfhi(v.w);
        }
#pragma unroll
        for (int j = 0; j < 8; ++j) scr[rg * 132 + c8 * 8 + j] = acc[j];
        __syncthreads();
        if (otid < 128) { float s = 0.f; for (int r = 0; r < 32; ++r) s += scr[r * 132 + otid]; KM[(size_t)it * 128 + otid] = s * (1.0f / 256.0f); }
        __syncthreads();
    }
}

__device__ __forceinline__ void p_convglu(Frame& F, const Args& a, int l) {
    const int lane = opaque_tid() & 63;
    const int gw = F.vcu * NWAVES + F.wave, NGW = F.G * NWAVES;
    const bf16_t* U = (const bf16_t*)(F.ws + WS_Z); bf16_t* Gb = (bf16_t*)(F.ws + WS_T);
    const float* cw = a.in[16] + (size_t)l * 3 * FFN; const float* cb = a.in[17] + (size_t)l * FFN;
    constexpr int NCG = FFN / 512;
    for (int it = gw; it < (M / 16) * NCG; it += NGW) {
        const int rb = it / NCG, cg = it - rb * NCG, ch0 = (cg * 64 + lane) * 8, m0 = rb * 16;
        float w0[8], w1[8], w2[8], bb[8];
#pragma unroll
        for (int h = 0; h < 2; ++h) { const f32x4 t0 = *(const f32x4*)(cw + ch0 + 4 * h), t1 = *(const f32x4*)(cw + FFN + ch0 + 4 * h), t2 = *(const f32x4*)(cw + 2 * FFN + ch0 + 4 * h), t3 = *(const f32x4*)(cb + ch0 + 4 * h);
#pragma unroll
            for (int e = 0; e < 4; ++e) { w0[4 * h + e] = t0[e]; w1[4 * h + e] = t1[e]; w2[4 * h + e] = t2[e]; bb[4 * h + e] = t3[e]; } }
        float am1[8], am2[8];
        if ((m0 & (SEQ - 1)) == 0) {
#pragma unroll
            for (int e = 0; e < 8; ++e) { am1[e] = 0.f; am2[e] = 0.f; }
        } else {
            const u32x4 p1 = *(const u32x4*)(U + (size_t)(m0 - 1) * UP_N + ch0), p2 = *(const u32x4*)(U + (size_t)(m0 - 2) * UP_N + ch0);
            am1[0] = bflo(p1.x); am1[1] = bfhi(p1.x); am1[2] = bflo(p1.y); am1[3] = bfhi(p1.y); am1[4] = bflo(p1.z); am1[5] = bfhi(p1.z); am1[6] = bflo(p1.w); am1[7] = bfhi(p1.w);
            am2[0] = bflo(p2.x); am2[1] = bfhi(p2.x); am2[2] = bflo(p2.y); am2[3] = bfhi(p2.y); am2[4] = bflo(p2.z); am2[5] = bfhi(p2.z); am2[6] = bflo(p2.w); am2[7] = bfhi(p2.w);
        }
        for (int r = 0; r < 16; ++r) {
            const size_t row = (size_t)(m0 + r);
            const u32x4 pa = *(const u32x4*)(U + row * UP_N + ch0), pv = *(const u32x4*)(U + row * UP_N + FFN + ch0);
            float a0[8] = {bflo(pa.x), bfhi(pa.x), bflo(pa.y), bfhi(pa.y), bflo(pa.z), bfhi(pa.z), bflo(pa.w), bfhi(pa.w)};
            float vv[8] = {bflo(pv.x), bfhi(pv.x), bflo(pv.y), bfhi(pv.y), bflo(pv.z), bfhi(pv.z), bflo(pv.w), bfhi(pv.w)};
            float o[8];
#pragma unroll
            for (int e = 0; e < 8; ++e) { const float c = bb[e] + w0[e] * am2[e] + w1[e] * am1[e] + w2[e] * a0[e]; o[e] = gelu_f(c) * vv[e]; am2[e] = am1[e]; am1[e] = a0[e]; }
            u32x4 w; w.x = cvt_pk_bf16(o[0], o[1]); w.y = cvt_pk_bf16(o[2], o[3]); w.z = cvt_pk_bf16(o[4], o[5]); w.w = cvt_pk_bf16(o[6], o[7]);
            *(u32x4*)(Gb + row * FFN + ch0) = w;
        }
    }
}

struct AttnEnv { const bf16_t* Z; const bf16_t* QMLA; const bf16_t* KVMLA; const bf16_t* KR; bf16_t* BRO; const int* pos; const int* pmm; const float* btabg; const f32x2* rope; const float* kmean;
                 const float* subln_g; const float* sinks; float* dscr; float lam, one_m_li; };

__device__ __forceinline__ void load_btab(LAS unsigned char* lds, const float* src, int tid) { if (tid < 132) ((LAS float*)(lds + att::BTAB_OFF))[tid] = src[tid]; }

__device__ __forceinline__ void unit_diff(LAS unsigned char* lds, const AttnEnv& E, int b, int h, int qb, const att::WaveCtx& w) {
    typedef att::Cfg<64, 0, 128> C;
    const int qw = qb * 256 + 32 * w.wid, qi = qw + w.r32; const size_t grow = (size_t)b * SEQ + qi;
    load_btab(lds, E.btabg + (0 + h) * 132, w.tid);
    const int posq = E.pos[qi], pminq = E.pmm[(qw >> 5) * 2];
    f32x16 O[4];
    f32x4* park = (f32x4*)(E.dscr + ((size_t)blockIdx.x * 512 + w.tid) * 64);
#pragma unroll
    for (int mp = 0; mp < 2; ++mp) {
        att::Src src; src.k0 = E.Z + (size_t)b * SEQ * ZLD + ZKA + (2 * h + mp) * 64; src.pk0 = ZLD; src.k1 = src.k0; src.pk1 = ZLD; src.v = E.Z + (size_t)b * SEQ * ZLD + ZVA + h * 128; src.pv = ZLD; src.pos = E.pos;
        bf16x8 qf[4]; att::load_q<4>(qf, E.Z + grow * ZLD + ZQA + (2 * h + mp) * 64, w.hi);
#pragma unroll
        for (int d = 0; d < 4; ++d)
#pragma unroll
            for (int r = 0; r < 16; ++r) O[d][r] = 0.f;
        att::RowState st; st.m = -1e30f; st.l = 0.f;
        att::run_tiles<C, 0, true>(lds, src, 0, 4 * (qb + 1), qf, O, st, qw, posq, pminq, E.pmm, 0u, 0, w);
        const float inv = 1.0f / (st.l + __shfl_xor(st.l, 32));
        if (mp == 0) {
#pragma unroll
            for (int d = 0; d < 4; ++d)
#pragma unroll
                for (int g = 0; g < 4; ++g) park[d * 4 + g] = (f32x4){O[d][4 * g] * inv, O[d][4 * g + 1] * inv, O[d][4 * g + 2] * inv, O[d][4 * g + 3] * inv};
        } else {
            const float li = E.lam * inv;
#pragma unroll
            for (int d = 0; d < 4; ++d)
#pragma unroll
                for (int g = 0; g < 4; ++g) { const f32x4 pv = park[d * 4 + g];
#pragma unroll
                    for (int e = 0; e < 4; ++e) O[d][4 * g + e] = pv[e] - li * O[d][4 * g + e]; }
        }
    }
    float ss = 0.f;
#pragma unroll
    for (int d = 0; d < 4; ++d)
#pragma unroll
        for (int r = 0; r < 16; ++r) ss += O[d][r] * O[d][r];
    ss += __shfl_xor(ss, 32);
    const float sc = (1.0f / sqrtf(ss * (1.0f / 128.0f) + EPS)) * E.one_m_li;
#pragma unroll
    for (int d = 0; d < 4; ++d)
#pragma unroll
        for (int g = 0; g < 4; ++g) { const f32x4 gg = *(const f32x4*)(E.subln_g + 32 * d + 8 * g + 4 * w.hi);
#pragma unroll
            for (int e = 0; e < 4; ++e) O[d][4 * g + e] *= sc * gg[e]; }
    att::store_o<4>(O, E.BRO + grow * DM + h * 128, w.hi);
}

__device__ __forceinline__ void unit_mla(LAS unsigned char* lds, const AttnEnv& E, int b, int h, int qb, const att::WaveCtx& w) {
    typedef att::Cfg<128, 64, 128> C;
    const int qw = qb * 256 + 32 * w.wid, qi = qw + w.r32; const size_t grow = (size_t)b * SEQ + qi;
    att::Src src; src.k0 = E.KVMLA + (size_t)b * SEQ * 1024 + h * 256; src.pk0 = 1024; src.k1 = E.KR + (size_t)b * SEQ * 64; src.pk1 = 64; src.v = E.KVMLA + (size_t)b * SEQ * 1024 + h * 256 + 128; src.pv = 1024; src.pos = E.pos;
    bf16x8 qf[12]; att::load_q<12>(qf, E.QMLA + grow * 768 + h * 192, w.hi);
#pragma unroll
    for (int dd = 0; dd < 2; ++dd) {
        const f32x2* cs = E.rope + (size_t)qi * 32 + 16 * dd + 8 * w.hi;
        unsigned o1[4], o2[4];
#pragma unroll
        for (int jp = 0; jp < 4; ++jp) {
            const f32x4 c2 = *(const f32x4*)(cs + 2 * jp);
            const float a0 = bf2f((unsigned short)qf[8 + dd][2 * jp]), a1 = bf2f((unsigned short)qf[8 + dd][2 * jp + 1]);
            const float b0 = bf2f((unsigned short)qf[10 + dd][2 * jp]), b1 = bf2f((unsigned short)qf[10 + dd][2 * jp + 1]);
            o1[jp] = cvt_pk_bf16(a0 * c2[0] - b0 * c2[1], a1 * c2[2] - b1 * c2[3]);
            o2[jp] = cvt_pk_bf16(a0 * c2[1] + b0 * c2[0], a1 * c2[3] + b1 * c2[2]);
        }
        qf[8 + dd] = __builtin_bit_cast(bf16x8, (u32x4){o1[0], o1[1], o1[2], o1[3]});
        qf[10 + dd] = __builtin_bit_cast(bf16x8, (u32x4){o2[0], o2[1], o2[2], o2[3]});
    }
    f32x16 O[4];
#pragma unroll
    for (int d = 0; d < 4; ++d)
#pragma unroll
        for (int r = 0; r < 16; ++r) O[d][r] = 0.f;
    att::RowState st; st.m = -1e30f; st.l = 0.f;
    att::run_tiles<C, 0, false>(lds, src, 0, 4 * (qb + 1), qf, O, st, qw, 0, 0, E.pmm, 0u, 0, w);
    const float inv = 1.0f / (st.l + __shfl_xor(st.l, 32));
#pragma unroll
    for (int d = 0; d < 4; ++d)
#pragma unroll
        for (int r = 0; r < 16; ++r) O[d][r] *= inv;
    att::store_o<4>(O, E.BRO + grow * DM + 512 + h * 128, w.hi);
}

__device__ __forceinline__ void unit_swa(LAS unsigned char* lds, const AttnEnv& E, int b, int qh, int qb, const att::WaveCtx& w) {
    typedef att::Cfg<64, 0, 64> C;
    const int qw = qb * 256 + 32 * w.wid, qi = qw + w.r32; const size_t grow = (size_t)b * SEQ + qi; const int kvh = qh >> 2;
    load_btab(lds, E.btabg + (4 + qh) * 132, w.tid);
    const int posq = E.pos[qi], pminq = E.pmm[(qw >> 5) * 2];
    att::Src src; src.k0 = E.Z + (size_t)b * SEQ * ZLD + ZSK + kvh * 64; src.pk0 = ZLD; src.k1 = src.k0; src.pk1 = ZLD; src.v = E.Z + (size_t)b * SEQ * ZLD + ZSV + kvh * 64; src.pv = ZLD; src.pos = E.pos;
    bf16x8 qf[4]; att::load_q<4>(qf, E.Z + grow * ZLD + ZSQ + qh * 64, w.hi);
    f32x16 O[2];
#pragma unroll
    for (int d = 0; d < 2; ++d)
#pragma unroll
        for (int r = 0; r < 16; ++r) O[d][r] = 0.f;
    att::RowState st; st.m = E.sinks[qh] * LOG2E; st.l = (w.hi == 0) ? 1.0f : 0.0f;
    const int t0 = qb == 0 ? 0 : 4 * qb - 2;
    att::run_tiles<C, 1, true>(lds, src, t0, 4 * (qb + 1), qf, O, st, qw, posq, pminq, E.pmm, 0u, 0, w);
    const float inv = 1.0f / (st.l + __shfl_xor(st.l, 32));
#pragma unroll
    for (int d = 0; d < 2; ++d)
#pragma unroll
        for (int r = 0; r < 16; ++r) O[d][r] *= inv;
    att::store_o<2>(O, E.BRO + grow * DM + 1024 + qh * 64, w.hi);
}

__device__ __forceinline__ void unit_moba(LAS unsigned char* lds, const AttnEnv& E, int b, int h, int blk, const att::WaveCtx& w) {
    typedef att::Cfg<128, 0, 128> C;
    const int qw = blk * 256 + 32 * w.wid, qi = qw + w.r32; const size_t grow = (size_t)b * SEQ + qi;
    load_btab(lds, E.btabg + (12 + h) * 132, w.tid);
    LAS float* km = (LAS float*)(lds + att::KMEAN_OFF);
    for (int e = w.tid; e < blk * 128; e += 512) km[e] = E.kmean[(size_t)((b * 4 + h) * 16) * 128 + e];
    const int posq = E.pos[qi], pminq = E.pmm[(qw >> 5) * 2];
    att::Src src; src.k0 = E.Z + (size_t)b * SEQ * ZLD + ZMK + h * 128; src.pk0 = ZLD; src.k1 = src.k0; src.pk1 = ZLD; src.v = E.Z + (size_t)b * SEQ * ZLD + ZMV + h * 128; src.pv = ZLD; src.pos = E.pos;
    bf16x8 qf[8]; att::load_q<8>(qf, E.Z + grow * ZLD + ZMQ + h * 128, w.hi);
    __syncthreads();
    unsigned selmask;
    if (blk <= 3) selmask = (1u << blk) - 1u;
    else {
        float v1 = NEG_INF, v2 = NEG_INF, v3 = NEG_INF; int i1 = 31, i2 = 31, i3 = 31;
        for (int n = 0; n < blk; ++n) {
            float part = 0.f;
#pragma unroll
            for (int d0 = 0; d0 < 8; ++d0) {
                const f32x4 k0 = *(const LAS f32x4*)(km + n * 128 + 16 * d0 + 8 * w.hi), k1 = *(const LAS f32x4*)(km + n * 128 + 16 * d0 + 8 * w.hi + 4);
#pragma unroll
                for (int j = 0; j < 4; ++j) part += bf2f((unsigned short)qf[d0][j]) * k0[j] + bf2f((unsigned short)qf[d0][4 + j]) * k1[j];
            }
            const float g = part + __shfl_xor(part, 32);
            if (g > v1) { v3 = v2; i3 = i2; v2 = v1; i2 = i1; v1 = g; i1 = n; }
            else if (g > v2) { v3 = v2; i3 = i2; v2 = g; i2 = n; }
            else if (g > v3) { v3 = g; i3 = n; }
        }
        selmask = (1u << i1) | (1u << i2) | (1u << i3);
    }
    f32x16 O[4];
#pragma unroll
    for (int d = 0; d < 4; ++d)
#pragma unroll
        for (int r = 0; r < 16; ++r) O[d][r] = 0.f;
    att::RowState st; st.m = -1e30f; st.l = 0.f;
    att::run_tiles<C, 2, true>(lds, src, 0, 4 * (blk + 1), qf, O, st, qw, posq, pminq, E.pmm, selmask, blk, w);
    const float inv = 1.0f / (st.l + __shfl_xor(st.l, 32));
#pragma unroll
    for (int d = 0; d < 4; ++d)
#pragma unroll
        for (int r = 0; r < 16; ++r) O[d][r] *= inv;
    att::store_o<4>(O, E.BRO + grow * DM + 1536 + h * 128, w.hi);
}

__device__ __forceinline__ int queue_next(Frame& F, unsigned* head) {
    __syncthreads();
    if (threadIdx.x == 0) F.MISC[4] = __hip_atomic_fetch_add(head, 1u, RLX_AGENT);
    __syncthreads();
    return (int)F.MISC[4];
}

__global__ void __launch_bounds__(NWAVES * 64, 2) trunk_fwd(Args args) {
    extern __shared__ __attribute__((aligned(16))) unsigned char lds_raw[];
    Frame F;
    F.lds = (LAS unsigned char*)lds_raw;
    F.MISC = (volatile LAS unsigned*)(F.lds + MISC_OFF);
    F.tid = threadIdx.x; F.lane = F.tid & 63; F.wave = __builtin_amdgcn_readfirstlane(F.tid >> 6);
    F.G = gridDim.x; { const int bx = blockIdx.x; F.vcu = (F.G % 8 == 0) ? (bx % 8) * (F.G / 8) + bx / 8 : bx; }
    F.ws = args.ws; F.ctl = (unsigned*)(args.ws + WS_CTL);
    for (int u = F.tid; u < (LDS_BYTES - LDSCTL_OFF) / 4; u += NWAVES * 64) ((LAS unsigned*)(F.lds + LDSCTL_OFF))[u] = 0u;
    __syncthreads();
    const int lo = args.ph_lo, hi = args.ph_hi;
    XcdBarrier bar; bar.bar = F.ctl + CW_BAR; bar.x = 0; bar.st = nullptr;
    if (hi - lo > 1) bar = xcd_barrier_post(F.ctl + CW_BAR, F.MISC + 8);
#ifndef DBG_MASK
#define DBG_MASK 0xFFFFu
#endif
#define EN(j) (((DBG_MASK) >> (j)) & 1u)
#ifndef DBG_ATT
#define DBG_ATT 0xFu
#endif
#define ENA(j) (((DBG_ATT) >> (j)) & 1u)
#define IN(k) (lo <= (k) && (k) < hi)
#ifndef DUP
#define DUP (-1)
#endif
#define REPS(j) ((DUP) == (j) ? 2 : 1)
#define SEAM(k) do { if ((k) + 1 < hi) xcd_barrier(bar); } while (0)
    const int gw = F.vcu * NWAVES + F.wave, NGW = F.G * NWAVES;
    unsigned char* ws = F.ws;
    float* X = (float*)(ws + WS_X); bf16_t* XN = (bf16_t*)(ws + WS_XN); bf16_t* MG = (bf16_t*)(ws + WS_MG); bf16_t* Z = (bf16_t*)(ws + WS_Z);
    bf16_t* U = (bf16_t*)(ws + WS_Z); bf16_t* Gb = (bf16_t*)(ws + WS_T); float* T = (float*)(ws + WS_T);

    if (EN(12) && IN(0)) for (int rep = 0; rep < REPS(12); ++rep) { p_prologue(F, args); SEAM(0); }

    for (int l = 0; l < DEPTH; ++l) {
        const int p0 = 1 + l * PH_PER_LAYER;
        if (hi <= p0 || lo >= p0 + PH_PER_LAYER) continue;
        unsigned char* wl = ws + WS_W + (size_t)l * W_LAYER;
        const float* xin = (l == 0) ? args.in[0] : X;
        if (EN(0) && IN(p0 + 0)) for (int rep = 0; rep < REPS(0); ++rep) { const int ol = opaque_tid() & 63; const float* g = args.in[3] + (size_t)l * DM; for (int m = opaque_s(gw); m < M; m += NGW) rms_row_bf16(xin + (size_t)m * DM, g, XN + (size_t)m * DM, ol); SEAM(p0 + 0); }
        if (EN(1) && IN(p0 + 1)) for (int rep = 0; rep < REPS(1); ++rep) {
            pg8::Gemm g{XN, (const bf16_t*)(wl + W_IN), M, ZLD, DM, DM, 0, 0}; pg8::StaticOrder S; S.init(M, ZLD, F.G, (int)blockIdx.x);
            pg8::EpiBf16 E{Z, ZLD, 0, 1.0f};
            pg8::gemm_phase<pg8::EpiBf16, pg8::StaticOrder, true>(F.lds + RING_OFF, g, S, E);
            SEAM(p0 + 1);
        }
        if (EN(2) && IN(p0 + 2)) for (int rep = 0; rep < REPS(2); ++rep) { p_prep(F, args, l); SEAM(p0 + 2); }
        if (EN(3) && IN(p0 + 3)) for (int rep = 0; rep < REPS(3); ++rep) {
            pg8::Gemm g{(const bf16_t*)(ws + WS_CQN), (const bf16_t*)(wl + W_UQ), M, 768, 512, 512, 0, 0}; pg8::StaticOrder S; S.init(M, 768, F.G, (int)blockIdx.x);
            pg8::EpiBf16 E{(bf16_t*)(ws + WS_QMLA), 768, 1, 0.07216878364870322f * LOG2E};
            pg8::gemm_phase<pg8::EpiBf16, pg8::StaticOrder, true>(F.lds + RING_OFF, g, S, E);
            SEAM(p0 + 3);
        }
        if (EN(4) && IN(p0 + 4)) for (int rep = 0; rep < REPS(4); ++rep) {
            pg8::Gemm g{(const bf16_t*)(ws + WS_CKVN), (const bf16_t*)(wl + W_UKV), M, 1024, 256, 256, 0, 0}; pg8::StaticOrder S; S.init(M, 1024, F.G, (int)blockIdx.x);
            pg8::EpiBf16 E{(bf16_t*)(ws + WS_KVMLA), 1024, 1, 1.0f};
            pg8::gemm_phase<pg8::EpiBf16, pg8::StaticOrder, true>(F.lds + RING_OFF, g, S, E);
            SEAM(p0 + 4);
        }
        if (EN(5) && IN(p0 + 5)) for (int rep = 0; rep < REPS(5); ++rep) {
            const double li[4] = {0.20000000000000007, 0.35550906759096934, 0.4707130183435842, 0.5560582041556406};
            AttnEnv E; E.Z = Z; E.QMLA = (const bf16_t*)(ws + WS_QMLA); E.KVMLA = (const bf16_t*)(ws + WS_KVMLA); E.KR = (const bf16_t*)(ws + WS_KR); E.BRO = (bf16_t*)(ws + WS_BRO);
            E.pos = (const int*)args.in[1]; E.pmm = (const int*)(ws + WS_PMM); E.btabg = (const float*)(ws + WS_BTAB); E.rope = (const f32x2*)(ws + WS_ROPE); E.kmean = (const float*)(ws + WS_KMEAN);
            E.dscr = (float*)(ws + WS_DSCR); E.subln_g = args.in[6] + (size_t)l * 128; E.sinks = args.in[11] + (size_t)l * 8; E.lam = ((const float*)(ws + WS_LAM))[l];
            E.one_m_li = 1.0f - (float)(l == 0 ? li[0] : l == 1 ? li[1] : l == 2 ? li[2] : li[3]);
            unsigned* qh = F.ctl + CW_QUEUE + 64 * (l * 4) + 64 * 16 * rep;
            if (ENA(0)) for (;;) { const int i = queue_next(F, qh + 0); if (i >= 256) break; { const int ot = opaque_tid(); const att::WaveCtx wctx{ot & 63, ot & 31, (ot >> 5) & 1, __builtin_amdgcn_readfirstlane(ot >> 6), ot}; unit_diff(F.lds, E, (i & 15) >> 2, i & 3, 15 - (i >> 4), wctx); } }
            if (ENA(1)) for (;;) { const int i = queue_next(F, qh + 64); if (i >= 256) break; { const int ot = opaque_tid(); const att::WaveCtx wctx{ot & 63, ot & 31, (ot >> 5) & 1, __builtin_amdgcn_readfirstlane(ot >> 6), ot}; unit_mla(F.lds, E, (i & 15) >> 2, i & 3, 15 - (i >> 4), wctx); } }
            if (ENA(2)) for (;;) { const int i = queue_next(F, qh + 128); if (i >= 256) break; { const int ot = opaque_tid(); const att::WaveCtx wctx{ot & 63, ot & 31, (ot >> 5) & 1, __builtin_amdgcn_readfirstlane(ot >> 6), ot}; unit_moba(F.lds, E, (i & 15) >> 2, i & 3, 15 - (i >> 4), wctx); } }
            if (ENA(3)) for (;;) { const int i = queue_next(F, qh + 192); if (i >= 512) break; { const int ot = opaque_tid(); const att::WaveCtx wctx{ot & 63, ot & 31, (ot >> 5) & 1, __builtin_amdgcn_readfirstlane(ot >> 6), ot}; unit_swa(F.lds, E, (i & 31) >> 3, i & 7, 15 - (i >> 5), wctx); } }
            SEAM(p0 + 5);
        }
        if (EN(6) && IN(p0 + 6)) for (int rep = 0; rep < REPS(6); ++rep) {
            pg8::Gemm g{(const bf16_t*)(ws + WS_BRO), (const bf16_t*)(wl + W_BR), M, DM, 512, DM, (size_t)512 * 2, (size_t)DM * 512 * 2}; pg8::StaticOrder S; S.init_tiles(M / 128, DM / 128, F.G, (int)blockIdx.x, 2);
            pg8::EpiMergeDiag E{Z + ZG, ZLD, MG};
            pg8::gemm_phase<pg8::EpiMergeDiag, pg8::StaticOrder, true, true>(F.lds + RING_OFF, g, S, E);
            SEAM(p0 + 6);
        }
        if (EN(7) && IN(p0 + 7)) for (int rep = 0; rep < REPS(7); ++rep) {
            pg8::Gemm g{MG, (const bf16_t*)(wl + W_OUT), M, DM, DM, DM, 0, 0}; pg8::StaticOrder S; S.init(M, DM, F.G, (int)blockIdx.x);
            pg8::EpiResF32 E{xin, X, DM};
            pg8::gemm_phase<pg8::EpiResF32, pg8::StaticOrder, true>(F.lds + RING_OFF, g, S, E);
            SEAM(p0 + 7);
        }
        if (EN(8) && IN(p0 + 8)) for (int rep = 0; rep < REPS(8); ++rep) { const int ol = opaque_tid() & 63; const float* g = args.in[14] + (size_t)l * DM; for (int m = opaque_s(gw); m < M; m += NGW) rms_row_bf16(X + (size_t)m * DM, g, XN + (size_t)m * DM, ol); SEAM(p0 + 8); }
        if (EN(9) && IN(p0 + 9)) for (int rep = 0; rep < REPS(9); ++rep) {
            pg8::Gemm g{XN, (const bf16_t*)(wl + W_UP), M, UP_N, DM, DM, 0, 0}; pg8::StaticOrder S; S.init(M, UP_N, F.G, (int)blockIdx.x);
            pg8::EpiBf16 E{U, UP_N, 1, 1.0f};
            pg8::gemm_phase<pg8::EpiBf16, pg8::StaticOrder, true>(F.lds + RING_OFF, g, S, E);
            SEAM(p0 + 9);
        }
        if (EN(10) && IN(p0 + 10)) for (int rep = 0; rep < REPS(10); ++rep) { p_convglu(F, args, l); SEAM(p0 + 10); }
        if (EN(11) && IN(p0 + 11)) for (int rep = 0; rep < REPS(11); ++rep) {
            pg8::Gemm g{Gb, (const bf16_t*)(wl + W_DN), M, DM, FFN, FFN, 0, 0}; pg8::StaticOrder S; S.init(M, DM, F.G, (int)blockIdx.x);
            pg8::EpiResF32 E{X, X, DM};
            pg8::gemm_phase<pg8::EpiResF32, pg8::StaticOrder, true>(F.lds + RING_OFF, g, S, E);
            SEAM(p0 + 11);
        }
    }
    if (IN(N_PHASES - 1)) { const int ol = opaque_tid() & 63; const float* g = args.in[19]; for (int m = opaque_s(gw); m < M; m += NGW) rms_row_f32(X + (size_t)m * DM, g, args.out + (size_t)m * DM, ol); }
#undef IN
#undef SEAM
}

extern "C" void kernel_launch(void* const* d_in, const int* in_sizes, int n_in, void* d_out, int out_size, void* d_ws, size_t ws_size, hipStream_t stream) {
    static int grid = 0;
    if (grid == 0) {
        if (n_in != 20 || in_sizes[0] != M * DM || out_size != M * DM || ws_size < WS_END) {
            fprintf(stderr, "kernel_launch: shape / workspace mismatch (n_in %d, in0 %d, out %d, ws %zu, need %zu); nothing launched\n", n_in, n_in > 0 ? in_sizes[0] : -1, out_size, ws_size, (size_t)WS_END); grid = -1; return; }
        int dev = 0, cus = 0, per_cu = 0;
        if (hipGetDevice(&dev) != hipSuccess || hipDeviceGetAttribute(&cus, hipDeviceAttributeMultiprocessorCount, dev) != hipSuccess) { grid = -1; return; }
        if (hipFuncSetAttribute((const void*)trunk_fwd, hipFuncAttributeMaxDynamicSharedMemorySize, LDS_BYTES) != hipSuccess) { fprintf(stderr, "kernel_launch: hipFuncSetAttribute failed\n"); grid = -1; return; }
        if (hipOccupancyMaxActiveBlocksPerMultiprocessor(&per_cu, (const void*)trunk_fwd, NWAVES * 64, LDS_BYTES) != hipSuccess || per_cu < 1)
            fprintf(stderr, "kernel_launch: note: occupancy query reports %d workgroups per CU\n", per_cu);
        (void)hipGetLastError();
        grid = cus;
    }
    if (grid < 0) return;
    if (hipMemsetAsync((char*)d_ws + WS_CTL, 0, CTL_ZERO_BYTES, stream) != hipSuccess) return;
    Args a{};
    for (int i = 0; i < 20; ++i) a.in[i] = (const float*)d_in[i];
    a.out = (float*)d_out; a.ws = (unsigned char*)d_ws;
#if MK_N_LAUNCHES == 1
    a.ph_lo = 0; a.ph_hi = N_PHASES;
    hipLaunchKernelGGL(trunk_fwd, dim3(grid), dim3(NWAVES * 64), LDS_BYTES, stream, a);
#else
    for (int p = 0; p < N_PHASES; ++p) { a.ph_lo = p; a.ph_hi = p + 1; hipLaunchKernelGGL(trunk_fwd, dim3(grid), dim3(NWAVES * 64), LDS_BYTES, stream, a); }
#endif
    const hipError_t le = hipPeekAtLastError();
    if (le != hipSuccess) fprintf(stderr, "kernel_launch: launch failed: %s\n", hipGetErrorName(le));
}
```

```cpp
#include <hip/hip_runtime.h>
#include <cstdio>
#include <cstdint>

#ifndef MK_N_LAUNCHES
#define MK_N_LAUNCHES 1
#endif

#define GAS __attribute__((address_space(1)))
#define LAS __attribute__((address_space(3)))
typedef unsigned short bf16_t;
typedef short bf16x8 __attribute__((ext_vector_type(8)));
typedef short s16x4 __attribute__((ext_vector_type(4)));
typedef float f32x2 __attribute__((ext_vector_type(2)));
typedef float f32x4 __attribute__((ext_vector_type(4)));
typedef float f32x16 __attribute__((ext_vector_type(16)));
typedef unsigned u32x2 __attribute__((ext_vector_type(2)));
typedef unsigned u32x4 __attribute__((ext_vector_type(4)));
typedef int i32x4 __attribute__((ext_vector_type(4)));

constexpr int DM = 2048, NB = 4, SEQ = 4096, DEPTH = 4, M = NB * SEQ;
constexpr int IN_COLS = 12864, ZLD = 13056;
constexpr int ZQA = 0, ZKA = 512, ZVA = 1024, ZCQ = 1536, ZCKV = 2048, ZKR = 2304, ZSQ = 2560, ZSK = 3072, ZSV = 3200, ZMQ = 3328, ZMK = 3840, ZMV = 4352, ZG = 4864;
constexpr int FFN = 5632, UP_N = 2 * FFN;
constexpr float LOG2E = 1.4426950408889634f;
constexpr float EPS = 1e-6f;
constexpr float NEG_INF = -__builtin_huge_valf();

__device__ __forceinline__ unsigned cvt_pk_bf16(float lo, float hi) { unsigned r; asm volatile("v_cvt_pk_bf16_f32 %0, %1, %2" : "=v"(r) : "v"(lo), "v"(hi)); return r; }
__device__ __forceinline__ float bf2f(unsigned short h) { return __uint_as_float(((unsigned)h) << 16); }
__device__ __forceinline__ float bflo(unsigned w) { return __uint_as_float(w << 16); }
__device__ __forceinline__ float bfhi(unsigned w) { return __uint_as_float(w & 0xffff0000u); }
template <int XORM> __device__ __forceinline__ float swz_xor(float v) { return __int_as_float(__builtin_amdgcn_ds_swizzle(__float_as_int(v), (XORM << 10) | 0x1F)); }
__device__ __forceinline__ float half_sum(float v) { const auto rr = __builtin_amdgcn_permlane32_swap(__float_as_uint(v), __float_as_uint(v), false, false); return __uint_as_float(rr[0]) + __uint_as_float(rr[1]); }
__device__ __forceinline__ float half_max(float v) { const auto rr = __builtin_amdgcn_permlane32_swap(__float_as_uint(v), __float_as_uint(v), false, false); return fmaxf(__uint_as_float(rr[0]), __uint_as_float(rr[1])); }
__device__ __forceinline__ float wave_sum(float v) {
    v += swz_xor<1>(v); v += swz_xor<2>(v); v += swz_xor<4>(v); v += swz_xor<8>(v); v += swz_xor<16>(v);
    return half_sum(v);
}
__device__ __forceinline__ float wave_max(float v) {
    v = fmaxf(v, swz_xor<1>(v)); v = fmaxf(v, swz_xor<2>(v)); v = fmaxf(v, swz_xor<4>(v)); v = fmaxf(v, swz_xor<8>(v)); v = fmaxf(v, swz_xor<16>(v));
    return half_max(v);
}
__device__ __forceinline__ int opaque_tid() { int t = threadIdx.x; asm volatile("" : "+v"(t)); return t; }
__device__ __forceinline__ int opaque_s(int x) { asm volatile("" : "+s"(x)); return x; }
__device__ __forceinline__ float fast_sigmoid(float x) { return __builtin_amdgcn_rcpf(1.0f + __builtin_amdgcn_exp2f(-x * LOG2E)); }

namespace pg8 {
constexpr int BM = 256, BK = 64, HALF = 128, HTB = HALF * BK * 2, STAGE_BYTES = 8 * HTB, NXCD = 8, WGM = 8;
__host__ __device__ __forceinline__ int lds_byte(int r, int c) { const int st = (r >> 4) * 2 + (c >> 5), rr = r & 15, cc = c & 31, ob = rr * 64 + cc * 2; return st * 1024 + (ob ^ (((ob >> 9) & 1) << 5)); }
__host__ __device__ __forceinline__ void stage_rc(int b, int& R, int& C) { const int st = b / 1024, sb = b % 1024, swz = sb ^ (((sb >> 9) & 1) << 5); R = (st >> 1) * 16 + swz / 64; C = (st & 1) * 32 + (swz % 64) / 2; }
__host__ __device__ __forceinline__ int perm32(int rho) { const int n = rho >> 4, i = rho & 15; return 8 * (i >> 2) + 4 * n + (i & 3); }

struct Unit { int pm, pn, z; };
struct Gemm { const bf16_t* A; const bf16_t* Bt; int M, N, K, lda; size_t zA, zB; };

struct StaticOrder {
    int nM, nN, nwg, G, c, nZ;
    __device__ void init(int M_, int N_, int G_, int c_, int nZ_ = 1) { nM = M_ / BM; nN = N_ / BM; nwg = nM * nN; G = G_; c = c_; nZ = nZ_; }
    __device__ void init_tiles(int nM_, int nN_, int G_, int c_, int nZ_) { nM = nM_; nN = nN_; nwg = nM * nN; G = G_; c = c_; nZ = nZ_; }
    __device__ bool next(int i, Unit& u) const {
        const int it = i / nZ; u.z = i - it * nZ;
        const long L = (long)it * G + c; if (L >= nwg) return false;
        int wgid = (int)L; { const int q = nwg / NXCD, r = nwg % NXCD, xcd = wgid % NXCD, off = wgid / NXCD; wgid = (xcd < r ? xcd * (q + 1) : r * (q + 1) + (xcd - r) * q) + off; }
        const int nig = WGM * nN, gid = wgid / nig, fm = gid * WGM, gsz = (nM - fm) < WGM ? (nM - fm) : WGM;
        u.pm = fm + ((wgid % nig) % gsz); u.pn = (wgid % nig) / gsz; return true;
    }
};


struct EpiBf16 {
    bf16_t* O; int ldc; int kind;
    float sc;
    __device__ __forceinline__ void operator()(const f32x4 (&acc)[2][2][4][2], const Unit& u, int wr, int wc, int fr, int fq) const {
        float s = sc; bool sig = false;
        if (kind == 0) {
            const int pn = u.pn;
            s = 1.0f;
            if (pn < 2 || pn == 10 || pn == 11) s = 0.125f * LOG2E;
            else if (pn == 13 || pn == 14) s = 0.08838834764831845f * LOG2E;
            sig = pn >= 19;
        }
        const int row0 = u.pm * BM + wr * 64 + fr, col0 = u.pn * BM + wc * 32 + 8 * fq;
#pragma unroll
        for (int ai = 0; ai < 2; ++ai)
#pragma unroll
            for (int m = 0; m < 4; ++m) { bf16_t* rowp = O + (size_t)(row0 + ai * HALF + m * 16) * ldc + col0;
#pragma unroll
                for (int bj = 0; bj < 2; ++bj) { f32x4 v0 = acc[ai][bj][m][0], v1 = acc[ai][bj][m][1];
                    if (sig) {
#pragma unroll
                        for (int e = 0; e < 4; ++e) { v0[e] = fast_sigmoid(v0[e]); v1[e] = fast_sigmoid(v1[e]); }
                    } else { v0 = v0 * s; v1 = v1 * s; }
                    u32x4 w; w.x = cvt_pk_bf16(v0[0], v0[1]); w.y = cvt_pk_bf16(v0[2], v0[3]); w.z = cvt_pk_bf16(v1[0], v1[1]); w.w = cvt_pk_bf16(v1[2], v1[3]);
                    *(u32x4*)(rowp + bj * HALF) = w; } }
    }
};
struct EpiResF32 {
    const float* base; float* out; int ldc;
    __device__ __forceinline__ void operator()(const f32x4 (&acc)[2][2][4][2], const Unit& u, int wr, int wc, int fr, int fq) const {
        const int row0 = u.pm * BM + wr * 64 + fr, col0 = u.pn * BM + wc * 32 + 8 * fq;
        f32x4 bv[2][2][2];
#define PG8_RES_LOAD(buf, k) do { const size_t off_ = (size_t)(row0 + ((k) >> 2) * HALF + ((k) & 3) * 16) * ldc + col0; \
            _Pragma("unroll") for (int bj = 0; bj < 2; ++bj) { bv[buf][bj][0] = *(const f32x4*)(base + off_ + bj * HALF); bv[buf][bj][1] = *(const f32x4*)(base + off_ + bj * HALF + 4); } } while (0)
        PG8_RES_LOAD(0, 0);
#pragma unroll
        for (int k = 0; k < 8; ++k) {
            if (k + 1 < 8) PG8_RES_LOAD((k + 1) & 1, k + 1);
            const int ai = k >> 2, m = k & 3; const size_t off = (size_t)(row0 + ai * HALF + m * 16) * ldc + col0;
#pragma unroll
            for (int bj = 0; bj < 2; ++bj) { *(f32x4*)(out + off + bj * HALF) = bv[k & 1][bj][0] + acc[ai][bj][m][0]; *(f32x4*)(out + off + bj * HALF + 4) = bv[k & 1][bj][1] + acc[ai][bj][m][1]; }
        }
#undef PG8_RES_LOAD
    }
};
struct EpiMerge {
    const bf16_t* gate; int ldg;
    float* T; bf16_t* Mg;
    __device__ __forceinline__ void operator()(const f32x4 (&acc)[2][2][4][2], const Unit& u, int wr, int wc, int fr, int fq) const {
        const int row0 = u.pm * BM + wr * 64 + fr, col0 = u.pn * BM + wc * 32 + 8 * fq, z = u.z;
        u32x4 gv[2][2]; f32x4 tv[2][2][2];
#define PG8_MG_LOAD(buf, k) do { const int row_ = row0 + ((k) >> 2) * HALF + ((k) & 3) * 16; const size_t off_ = (size_t)row_ * DM + col0; \
            _Pragma("unroll") for (int bj = 0; bj < 2; ++bj) { gv[buf][bj] = *(const u32x4*)(gate + (size_t)row_ * ldg + z * DM + col0 + bj * HALF); \
                if (z > 0) { tv[buf][bj][0] = *(const f32x4*)(T + off_ + bj * HALF); tv[buf][bj][1] = *(const f32x4*)(T + off_ + bj * HALF + 4); } \
                else { tv[buf][bj][0] = (f32x4){0.f, 0.f, 0.f, 0.f}; tv[buf][bj][1] = (f32x4){0.f, 0.f, 0.f, 0.f}; } } } while (0)
        PG8_MG_LOAD(0, 0);
#pragma unroll
        for (int k = 0; k < 8; ++k) {
            if (k + 1 < 8) PG8_MG_LOAD((k + 1) & 1, k + 1);
            const int ai = k >> 2, m = k & 3; const size_t off = (size_t)(row0 + ai * HALF + m * 16) * DM + col0;
#pragma unroll
            for (int bj = 0; bj < 2; ++bj) {
                const u32x4 g = gv[k & 1][bj];
                const f32x4 g0 = (f32x4){bflo(g.x), bfhi(g.x), bflo(g.y), bfhi(g.y)}, g1 = (f32x4){bflo(g.z), bfhi(g.z), bflo(g.w), bfhi(g.w)};
                const f32x4 t0 = tv[k & 1][bj][0] + g0 * acc[ai][bj][m][0], t1 = tv[k & 1][bj][1] + g1 * acc[ai][bj][m][1];
                if (z < 3) { *(f32x4*)(T + off + bj * HALF) = t0; *(f32x4*)(T + off + bj * HALF + 4) = t1; }
                else { u32x4 w; w.x = cvt_pk_bf16(t0[0], t0[1]); w.y = cvt_pk_bf16(t0[2], t0[3]); w.z = cvt_pk_bf16(t1[0], t1[1]); w.w = cvt_pk_bf16(t1[2], t1[3]);
                    *(u32x4*)(Mg + off + bj * HALF) = w; } }
        }
#undef PG8_MG_LOAD
    }
};

struct EpiMergeDiag {
    const bf16_t* gate; int ldg; bf16_t* Mg;
    __device__ __forceinline__ void operator()(f32x4 (&acc)[2][2][4][2], const Unit& u, int wr, int wc, int fr, int fq) const {
        const int row0 = u.pm * HALF + wr * 64 + fr, col0 = u.pn * HALF + wc * 32 + 8 * fq, z0 = 2 * u.z;
#pragma unroll
        for (int m = 0; m < 4; ++m) { const int row = row0 + m * 16;
            const u32x4 ga = *(const u32x4*)(gate + (size_t)row * ldg + z0 * DM + col0), gb = *(const u32x4*)(gate + (size_t)row * ldg + (z0 + 1) * DM + col0);
            const f32x4 a0 = (f32x4){bflo(ga.x), bfhi(ga.x), bflo(ga.y), bfhi(ga.y)}, a1 = (f32x4){bflo(ga.z), bfhi(ga.z), bflo(ga.w), bfhi(ga.w)};
            const f32x4 b0 = (f32x4){bflo(gb.x), bfhi(gb.x), bflo(gb.y), bfhi(gb.y)}, b1 = (f32x4){bflo(gb.z), bfhi(gb.z), bflo(gb.w), bfhi(gb.w)};
            f32x4 t0 = a0 * acc[0][0][m][0] + b0 * acc[1][1][m][0], t1 = a1 * acc[0][0][m][1] + b1 * acc[1][1][m][1];
            if (u.z == 0) { acc[0][1][m][0] = t0; acc[0][1][m][1] = t1; }
            else { t0 = t0 + acc[0][1][m][0]; t1 = t1 + acc[0][1][m][1];
                u32x4 w; w.x = cvt_pk_bf16(t0[0], t0[1]); w.y = cvt_pk_bf16(t0[2], t0[3]); w.z = cvt_pk_bf16(t1[0], t1[1]); w.w = cvt_pk_bf16(t1[2], t1[3]);
                *(u32x4*)(Mg + (size_t)row * DM + col0) = w; } }
    }
};

__device__ __forceinline__ float gelu_erf(float v) {
    const float av = fabsf(v), d = av * 0.2316418882f + 1.0f;
    const float t = __builtin_amdgcn_rcpf(d);
    float q = t * 0.5307027145f + (-0.7265760135f); q = q * t + 0.7107068705f; q = q * t + (-0.142248368f); q = q * t + 0.127414796f; q = q * t;
    const float e = __builtin_amdgcn_exp2f((v * v) * (-0.72134752044f));
    const float m = v * (q * e), r = v - m;
    return v < 0.f ? m : r;
}
struct EpiGlu {
    bf16_t* G; const float* cw; const float* cb; float* tail; float* heada; float* headv;
    __device__ __forceinline__ void operator()(const f32x4 (&acc)[2][2][4][2], const Unit& u, int wr, int wc, int fr, int fq) const {
        const int ch0 = u.pn * HALF + wc * 32 + 8 * fq, lane = fq * 16 + fr;
        const int src1 = (lane & ~15) | ((fr - 1) & 15), src2 = (lane & ~15) | ((fr - 2) & 15);
        float w0[8], w1[8], w2[8], bb[8];
#pragma unroll
        for (int h = 0; h < 2; ++h) { const f32x4 t0 = *(const f32x4*)(cw + ch0 + 4 * h), t1 = *(const f32x4*)(cw + FFN + ch0 + 4 * h), t2 = *(const f32x4*)(cw + 2 * FFN + ch0 + 4 * h), t3 = *(const f32x4*)(cb + ch0 + 4 * h);
#pragma unroll
            for (int e = 0; e < 4; ++e) { w0[4 * h + e] = t0[e]; w1[4 * h + e] = t1[e]; w2[4 * h + e] = t2[e]; bb[4 * h + e] = t3[e]; } }
#pragma unroll
        for (int ai = 0; ai < 2; ++ai) {
            const int gid = u.pm * 4 + ai * 2 + wr, rowg = gid * 64;
            float q1[8], q2[8];
#pragma unroll
            for (int m = 0; m < 4; ++m) {
                float a8[8], v8[8], r1[8], r2[8];
#pragma unroll
                for (int n = 0; n < 2; ++n)
#pragma unroll
                    for (int e = 0; e < 4; ++e) { a8[4 * n + e] = acc[ai][0][m][n][e]; v8[4 * n + e] = acc[ai][1][m][n][e]; }
#pragma unroll
                for (int c = 0; c < 8; ++c) { r1[c] = __int_as_float(__builtin_amdgcn_ds_bpermute(src1 * 4, __float_as_int(a8[c]))); r2[c] = __int_as_float(__builtin_amdgcn_ds_bpermute(src2 * 4, __float_as_int(a8[c]))); }
                const int row = rowg + m * 16 + fr;
                if (m == 0 && fr < 2) {
                    float* ha = heada + ((size_t)gid * 2 + fr) * FFN + ch0; float* hv = headv + ((size_t)gid * 2 + fr) * FFN + ch0;
                    *(f32x4*)ha = (f32x4){a8[0], a8[1], a8[2], a8[3]}; *(f32x4*)(ha + 4) = (f32x4){a8[4], a8[5], a8[6], a8[7]};
                    *(f32x4*)hv = (f32x4){v8[0], v8[1], v8[2], v8[3]}; *(f32x4*)(hv + 4) = (f32x4){v8[4], v8[5], v8[6], v8[7]};
                } else {
                    float o[8];
#pragma unroll
                    for (int c = 0; c < 8; ++c) { const float p1 = (fr >= 1) ? r1[c] : q1[c], p2 = (fr >= 2) ? r2[c] : q2[c];
                        o[c] = gelu_erf(bb[c] + w0[c] * p2 + w1[c] * p1 + w2[c] * a8[c]) * v8[c]; }
                    u32x4 w; w.x = cvt_pk_bf16(o[0], o[1]); w.y = cvt_pk_bf16(o[2], o[3]); w.z = cvt_pk_bf16(o[4], o[5]); w.w = cvt_pk_bf16(o[6], o[7]);
                    *(u32x4*)(G + (size_t)row * FFN + ch0) = w;
                }
                if (m == 3 && fr >= 14) { float* tl = tail + ((size_t)gid * 2 + (fr - 14)) * FFN + ch0;
                    *(f32x4*)tl = (f32x4){a8[0], a8[1], a8[2], a8[3]}; *(f32x4*)(tl + 4) = (f32x4){a8[4], a8[5], a8[6], a8[7]}; }
#pragma unroll
                for (int c = 0; c < 8; ++c) { q1[c] = r1[c]; q2[c] = r2[c]; }
            }
        }
    }
};

template <class Epi, class Sched, bool ALIGN_EPI, bool DIAG = false>
__device__ __forceinline__ void gemm_phase(LAS unsigned char* lds, const Gemm g, const Sched& S, const Epi& E) {
    const int tid = opaque_tid(), wid = __builtin_amdgcn_readfirstlane(tid >> 6), lane = tid & 63, wr = wid >> 2, wc = wid & 3, fr = lane & 15, fq = lane >> 4;
    const int K = g.K, nt = K / BK, lda = g.lda;
    unsigned voffA[2], voffB[2];
#pragma unroll
    for (int i = 0; i < 2; ++i) { int R, C; stage_rc(tid * 16 + i * 8192, R, C); const int Rb = (R & ~31) + perm32(R & 31);
        voffA[i] = (unsigned)(R * lda + C) * 2u; voffB[i] = (unsigned)(Rb * K + C) * 2u; }
    const size_t kstep = (size_t)(BK * 2);
    const size_t hstepA = DIAG ? g.zA : (size_t)HALF * lda * 2, hstepB = DIAG ? g.zB : (size_t)HALF * K * 2;
    const size_t tstepA = (DIAG ? 1 : 2) * (size_t)HALF * lda * 2, tstepB = (DIAG ? 1 : 2) * (size_t)HALF * K * 2;
    const size_t zsA = (DIAG ? 2 : 1) * g.zA, zsB = (DIAG ? 2 : 1) * g.zB;
    const unsigned ldsw = (unsigned)wid * 1024u;
    const int aoff = lds_byte(wr * 64 + fr, fq * 8), boff = lds_byte(wc * 32 + fr, fq * 8);
#define PG8_SA(b, h) (((b) * 2 + (h)) * HTB)
#define PG8_SB(b, h) ((4 + (b) * 2 + (h)) * HTB)
#define PG8_STAGE(bufoff, gbase, voff) do { _Pragma("unroll") for (int _i = 0; _i < 2; ++_i) \
        __builtin_amdgcn_global_load_lds((const unsigned*)((const char*)(gbase) + (voff)[_i]), (LAS unsigned*)(lds + (bufoff) + ldsw + _i * 8192), 16, 0, 0); } while (0)
#define PG8_LDA(dst, b, h) do { _Pragma("unroll") for (int m = 0; m < 4; ++m) _Pragma("unroll") for (int k = 0; k < 2; ++k) dst[m][k] = *(const LAS bf16x8*)(lds + PG8_SA(b, h) + aoff + m * 2048 + k * 1024); } while (0)
#define PG8_LDB(dst, b, h) do { _Pragma("unroll") for (int n = 0; n < 2; ++n) _Pragma("unroll") for (int k = 0; k < 2; ++k) dst[n][k] = *(const LAS bf16x8*)(lds + PG8_SB(b, h) + boff + n * 2048 + k * 1024); } while (0)
#define PG8_MMA(ai, bj, At, Bt) do { __builtin_amdgcn_s_setprio(1); _Pragma("unroll") for (int m = 0; m < 4; ++m) _Pragma("unroll") for (int n = 0; n < 2; ++n) _Pragma("unroll") for (int k = 0; k < 2; ++k) \
        acc[ai][bj][m][n] = __builtin_amdgcn_mfma_f32_16x16x32_bf16(Bt[n][k], At[m][k], acc[ai][bj][m][n], 0, 0, 0); __builtin_amdgcn_s_setprio(0); } while (0)
#define PG8_WAIT_V(n) asm volatile("s_waitcnt vmcnt(" #n ")" ::: "memory")
#define PG8_WAIT_L(n) asm volatile("s_waitcnt lgkmcnt(" #n ")" ::: "memory")
#define PG8_BAR __builtin_amdgcn_s_barrier()
#define PG8_SCHED __builtin_amdgcn_sched_barrier(0)
    Unit cur, nxt; int ui = 0;
    if (!S.next(0, cur)) return;
    f32x4 acc[2][2][4][2];
#pragma unroll
    for (int a = 0; a < 2; ++a)
#pragma unroll
        for (int b = 0; b < 2; ++b)
#pragma unroll
            for (int m = 0; m < 4; ++m)
#pragma unroll
                for (int n = 0; n < 2; ++n) acc[a][b][m][n] = (f32x4){0.f, 0.f, 0.f, 0.f};
    bf16x8 At[4][2], B0[2][2], B1[2][2];
    const char* cA = (const char*)g.A + (size_t)cur.pm * tstepA + (size_t)cur.z * zsA; const char* cB = (const char*)g.Bt + (size_t)cur.pn * tstepB + (size_t)cur.z * zsB;
    PG8_STAGE(PG8_SB(0, 0), cB, voffB); PG8_STAGE(PG8_SB(0, 1), cB + hstepB, voffB); PG8_STAGE(PG8_SA(0, 0), cA, voffA); PG8_STAGE(PG8_SA(0, 1), cA + hstepA, voffA);
    if (wr == 1) PG8_BAR;
    PG8_WAIT_V(2); PG8_BAR;
    PG8_STAGE(PG8_SB(1, 0), cB + kstep, voffB); PG8_STAGE(PG8_SA(1, 0), cA + kstep, voffA); PG8_STAGE(PG8_SB(1, 1), cB + hstepB + kstep, voffB);
    PG8_WAIT_V(6); PG8_BAR;
    for (;;) {
        const bool has_next = S.next(ui + 1, nxt);
        const char* nA = has_next ? (const char*)g.A + (size_t)nxt.pm * tstepA + (size_t)nxt.z * zsA : cA; const char* nB = has_next ? (const char*)g.Bt + (size_t)nxt.pn * tstepB + (size_t)nxt.z * zsB : cB;
        for (int t = 0; t < nt; t += 2) {
            const bool last = (t == nt - 2);
            const char* a1 = cA + (size_t)(t + 1) * kstep;
            const char* a2 = last ? nA : cA + (size_t)(t + 2) * kstep; const char* b2 = last ? nB : cB + (size_t)(t + 2) * kstep;
            const char* a3 = a2 + kstep; const char* b3 = b2 + kstep;
            PG8_LDB(B0, 0, 0); PG8_LDB(B1, 0, 1); PG8_SCHED; PG8_LDA(At, 0, 0); PG8_STAGE(PG8_SA(1, 1), a1 + hstepA, voffA);
            PG8_WAIT_V(8); PG8_WAIT_L(0); PG8_BAR; PG8_MMA(0, 0, At, B0); if constexpr (!DIAG) PG8_MMA(0, 1, At, B1); PG8_BAR; PG8_SCHED;
            PG8_LDA(At, 0, 1); PG8_STAGE(PG8_SB(0, 0), b2, voffB); PG8_STAGE(PG8_SB(0, 1), b2 + hstepB, voffB); PG8_STAGE(PG8_SA(0, 0), a2, voffA);
            PG8_WAIT_V(8); PG8_WAIT_L(0); PG8_BAR; if constexpr (!DIAG) PG8_MMA(1, 0, At, B0); PG8_MMA(1, 1, At, B1); PG8_BAR; PG8_SCHED;
            PG8_LDB(B0, 1, 0); PG8_LDB(B1, 1, 1); PG8_SCHED; PG8_LDA(At, 1, 0); PG8_STAGE(PG8_SA(0, 1), a2 + hstepA, voffA);
            PG8_WAIT_V(8); PG8_WAIT_L(0); PG8_BAR; PG8_MMA(0, 0, At, B0); if constexpr (!DIAG) PG8_MMA(0, 1, At, B1); PG8_BAR; PG8_SCHED;
            PG8_LDA(At, 1, 1); PG8_STAGE(PG8_SB(1, 0), b3, voffB); PG8_STAGE(PG8_SB(1, 1), b3 + hstepB, voffB); PG8_STAGE(PG8_SA(1, 0), a3, voffA);
            PG8_WAIT_V(8); PG8_WAIT_L(0); PG8_BAR; if constexpr (!DIAG) PG8_MMA(1, 0, At, B0); PG8_MMA(1, 1, At, B1); PG8_BAR; PG8_SCHED;
        }
        if constexpr (ALIGN_EPI) { if (wr == 0) PG8_BAR; }
        E(acc, cur, wr, wc, fr, fq);
        if (!has_next) break;
#pragma unroll
        for (int a = 0; a < 2; ++a)
#pragma unroll
            for (int b = 0; b < 2; ++b)
#pragma unroll
                for (int m = 0; m < 4; ++m)
#pragma unroll
                    for (int n = 0; n < 2; ++n) if (!DIAG || a == b) acc[a][b][m][n] = (f32x4){0.f, 0.f, 0.f, 0.f};
        cur = nxt; cA = nA; cB = nB; ++ui;
        if constexpr (ALIGN_EPI) { if (wr == 1) PG8_BAR; }
    }
    PG8_WAIT_V(0);
    if constexpr (!ALIGN_EPI) { if (wr == 0) PG8_BAR; }
    PG8_BAR;
#undef PG8_SA
#undef PG8_SB
#undef PG8_STAGE
#undef PG8_LDA
#undef PG8_LDB
#undef PG8_MMA
#undef PG8_WAIT_V
#undef PG8_WAIT_L
#undef PG8_BAR
#undef PG8_SCHED
}
}

constexpr size_t MiB = 1u << 20;
constexpr size_t WS_CTL = 0, CTL_ZERO_BYTES = 1 * MiB;
constexpr size_t WS_ROPE = 1 * MiB;
constexpr size_t WS_BTAB = 2 * MiB;
constexpr size_t WS_PMM = WS_BTAB + 16 * 132 * 4;
constexpr size_t WS_LAM = WS_PMM + 128 * 2 * 4;
constexpr size_t WS_KMEAN = 3 * MiB;
constexpr size_t WS_W = 4 * MiB;
constexpr size_t W_IN = 0, W_UQ = 51 * MiB, W_UKV = W_UQ + 768 * 512 * 2, W_BR = W_UKV + 1024 * 256 * 2, W_OUT = W_BR + 8 * MiB, W_UP = W_OUT + 8 * MiB, W_DN = W_UP + 44 * MiB, W_LAYER = W_DN + 22 * MiB;
constexpr size_t WS_X = WS_W + DEPTH * W_LAYER;
constexpr size_t WS_XN = WS_X + 128 * MiB;
constexpr size_t WS_MG = WS_XN + 64 * MiB;
constexpr size_t WS_Z = WS_MG + 64 * MiB;
constexpr size_t WS_CQN = WS_Z + 408 * MiB;
constexpr size_t WS_CKVN = WS_CQN + 16 * MiB;
constexpr size_t WS_KR = WS_CKVN + 8 * MiB;
constexpr size_t WS_QMLA = WS_KR + 2 * MiB;
constexpr size_t WS_KVMLA = WS_QMLA + 24 * MiB;
constexpr size_t WS_BRO = WS_KVMLA + 32 * MiB;
constexpr size_t WS_T = WS_BRO + 64 * MiB;
constexpr size_t WS_DSCR = WS_T + 176 * MiB;
constexpr size_t WS_END = WS_DSCR + 32 * MiB;
static_assert(W_LAYER * 1 == (size_t)(51 * MiB + 768 * 512 * 2 + 1024 * 256 * 2 + 82 * MiB), "weight map");
static_assert((size_t)M * ZLD * 2 == 408 * MiB && (size_t)M * UP_N * 2 <= 408 * MiB && (size_t)M * FFN * 2 == 176 * MiB, "buffer sizes");
constexpr int CW_TMO = 0;
constexpr int CW_QUEUE = 8192;
constexpr int CW_BAR = 4096;

constexpr int RING_OFF = 0, RING_BYTES = 131072;
constexpr int LDSCTL_OFF = RING_BYTES, MISC_OFF = LDSCTL_OFF + 320;
constexpr int LDS_BYTES = 147456;
constexpr int NWAVES = 8;

typedef GAS unsigned gu32;
#define RLX_AGENT __ATOMIC_RELAXED, __HIP_MEMORY_SCOPE_AGENT
#define LDS_WAIT() asm volatile("s_waitcnt lgkmcnt(0)" ::: "memory")
#define XB_TMO      128
#define XB_XCNT(j)  (256  + 64 * (j))
#define XB_XSUB(j)  (1280 + 64 * (j))
#define XB_XGEN(j)  (2304 + 64 * (j))
#define XB_TOP      3328
#define XB_TOPGEN   3392
#define XCD_BAR_WORDS 3456
#define XB_SPIN_CAP (1u << 22)
__device__ __forceinline__ unsigned xb_ld(unsigned* p)              { return __hip_atomic_load(p, __ATOMIC_RELAXED, __HIP_MEMORY_SCOPE_AGENT); }
__device__ __forceinline__ unsigned xb_add(unsigned* p, unsigned v) { return __hip_atomic_fetch_add(p, v, __ATOMIC_RELAXED, __HIP_MEMORY_SCOPE_AGENT); }
__device__ __forceinline__ unsigned xb_xcc_id() { return (unsigned)__builtin_amdgcn_s_getreg((3 << 11) | 20) & 0xFu; }
#define XB_SPIN(cond, bar) do { unsigned _sp = 0; while (cond) { __builtin_amdgcn_s_sleep(1); \
    if ((++_sp & 255u) == 0u) { if (xb_ld(&(bar)[XB_TMO])) break; if (_sp > XB_SPIN_CAP) { atomicAdd(&(bar)[XB_TMO], 1u); break; } } } } while (0)
struct XcdBarrier { unsigned* bar; unsigned x; volatile LAS unsigned* st; };
__device__ __forceinline__ XcdBarrier xcd_barrier_post(unsigned* bar, volatile LAS unsigned* st) {
    XcdBarrier b; b.bar = bar; b.x = xb_xcc_id(); b.st = st;
    if (threadIdx.x == 0) (void)xb_add(&bar[XB_XCNT(b.x)], 1u);
    return b;
}
__device__ __forceinline__ void xcd_barrier_complete(unsigned* bar, unsigned x, unsigned& nloc, unsigned& nx) {
    const unsigned G = gridDim.x * gridDim.y * gridDim.z;
    unsigned sum, cnt, mine, sp = 0u;
    for (;;) {
        sum = 0u; cnt = 0u; mine = 0u;
#pragma unroll
        for (unsigned j = 0; j < 16; ++j) { const unsigned c = xb_ld(&bar[XB_XCNT(j)]); sum += c; cnt += (c > 0u) ? 1u : 0u; mine = (j == x) ? c : mine; }
        if (sum == G) break;
        __builtin_amdgcn_s_sleep(1);
        if ((++sp & 255u) == 0u) { if (xb_ld(&bar[XB_TMO])) break; if (sp > XB_SPIN_CAP) { atomicAdd(&bar[XB_TMO], 1u); break; } }
    }
    nloc = mine > 0u ? mine : 1u; nx = cnt > 0u ? cnt : 1u;
}
__device__ __forceinline__ void xcd_barrier(const XcdBarrier& b) {
    asm volatile("s_waitcnt vmcnt(0)" ::: "memory");
    __syncthreads();
    if (threadIdx.x == 0) {
        unsigned* bar = b.bar;
        __builtin_amdgcn_s_waitcnt(0);
        unsigned nloc = b.st[0], nx = b.st[1];
        if (nloc == 0u) { xcd_barrier_complete(bar, b.x, nloc, nx); b.st[0] = nloc; b.st[1] = nx; }
        const unsigned old = xb_add(&bar[XB_XSUB(b.x)], 1u);
        const unsigned gen = old / nloc;
        if (old + 1u == (gen + 1u) * nloc) {
            __builtin_amdgcn_fence(__ATOMIC_RELEASE, "agent");
            asm volatile("s_waitcnt vmcnt(0)" ::: "memory");
            const unsigned og = xb_add(&bar[XB_TOP], 1u);
            const unsigned tg = og / nx;
            if (og + 1u == (tg + 1u) * nx) xb_add(&bar[XB_TOPGEN], 1u);
            else XB_SPIN(xb_ld(&bar[XB_TOPGEN]) == tg, bar);
            __builtin_amdgcn_fence(__ATOMIC_ACQUIRE, "agent");
            xb_add(&bar[XB_XGEN(b.x)], 1u);
            asm volatile("s_waitcnt vmcnt(0)" ::: "memory");
        } else {
            XB_SPIN(xb_ld(&bar[XB_XGEN(b.x)]) == gen, bar);
            __builtin_amdgcn_fence(__ATOMIC_ACQUIRE, "agent");
            asm volatile("s_waitcnt vmcnt(0)" ::: "memory");
        }
    }
    __syncthreads();
}

namespace att {
template <int DK0_, int DK1_, int DV_> struct Cfg {
    static constexpr int DK0 = DK0_, DK1 = DK1_, DK = DK0_ + DK1_, DV = DV_;
    static constexpr int KP = DK * 2 + 16, VP = DV * 2 + 64;
    static constexpr int KOFF = 0, VOFF = 64 * KP, POFF = VOFF + 64 * VP, BUFB = POFF + 256;
    static constexpr int NKC = (64 * DK / 8) / 512, NVC = (64 * DV / 8) / 512;
    static constexpr int ND = DK / 16, NO = DV / 32;
};
constexpr int BTAB_OFF = 94208, KMEAN_OFF = 94208 + 1024;
struct Src { const bf16_t* k0; int pk0; const bf16_t* k1; int pk1; const bf16_t* v; int pv; const int* pos; };
struct WaveCtx { int lane, r32, hi, wid, tid; };

template <class C, bool WITH_POS> struct Stage {
    u32x4 kr[C::NKC]; u32x4 vr[C::NVC]; int pr;
    __device__ __forceinline__ void load(const Src& s, int t, int tid) {
        const int kb = t * 64;
#pragma unroll
        for (int i = 0; i < C::NKC; ++i) { const int id = tid + 512 * i, row = id / (C::DK / 8), c = id % (C::DK / 8);
            const bf16_t* p = (C::DK1 == 0 || c < C::DK0 / 8) ? s.k0 + (size_t)(kb + row) * s.pk0 + c * 8 : s.k1 + (size_t)(kb + row) * s.pk1 + (c - C::DK0 / 8) * 8;
            kr[i] = *(const u32x4*)p; }
#pragma unroll
        for (int i = 0; i < C::NVC; ++i) { const int id = tid + 512 * i, row = id / (C::DV / 8), c = id % (C::DV / 8);
            vr[i] = *(const u32x4*)(s.v + (size_t)(kb + row) * s.pv + c * 8); }
        pr = (WITH_POS && tid < 64) ? s.pos[kb + tid] : 0;
    }
    __device__ __forceinline__ void store(LAS unsigned char* buf, int tid) const {
#pragma unroll
        for (int i = 0; i < C::NKC; ++i) { const int id = tid + 512 * i, row = id / (C::DK / 8), c = id % (C::DK / 8); *(LAS u32x4*)(buf + C::KOFF + row * C::KP + c * 16) = kr[i]; }
#pragma unroll
        for (int i = 0; i < C::NVC; ++i) { const int id = tid + 512 * i, row = id / (C::DV / 8), c = id % (C::DV / 8); *(LAS u32x4*)(buf + C::VOFF + row * C::VP + c * 16) = vr[i]; }
        if (WITH_POS && tid < 64) *(LAS int*)(buf + C::POFF + tid * 4) = pr;
    }
};
__device__ __forceinline__ s16x4 vtr(const LAS unsigned char* p) { typedef short v4i16_t __attribute__((ext_vector_type(4))); return __builtin_bit_cast(s16x4, __builtin_amdgcn_ds_read_tr16_b64_v4i16((LAS v4i16_t*)p)); }

struct RowState { float m, l; };

template <class C, int KIND, bool BIAS, bool VPRE>
__device__ __forceinline__ void tile_compute(const LAS unsigned char* buf, const LAS float* btab, const bf16x8 (&qf)[C::ND], f32x16 (&O)[C::NO], RowState& st,
                                             int k0, int qw, int posq, unsigned long long farlo, unsigned long long farhi, unsigned selmask, int blk, const WaveCtx& w) {
    const int qi = qw + w.r32;
#pragma unroll
    for (int p = 0; p < 2; ++p) {
        const int ks = k0 + 32 * p;
        bool causal_tile = true, sel_lane = true, skip = false, fast = false;
        if (KIND == 0) { skip = ks > qw + 31; fast = (ks + 31 <= qw); }
        if (KIND == 1) { skip = (ks > qw + 31) || (ks + 31 < qw - 127); }
        if (KIND == 2) {
            const int n = ks >> 8;
            if (n < blk) { causal_tile = false; sel_lane = ((selmask >> n) & 1u) != 0u; skip = !__any(sel_lane); fast = (bool)__all(sel_lane); }
            else { skip = ks > qw + 31; fast = (ks + 31 <= qw); }
        }
        if (skip) continue;
        if (BIAS && fast) { const int kb32 = ks >> 5; fast = (((kb32 < 64 ? farlo >> kb32 : farhi >> (kb32 - 64)) & 1ull) != 0ull); }
        f32x16 sc;
#pragma unroll
        for (int r = 0; r < 16; ++r) sc[r] = 0.f;
        const LAS unsigned char* kb = buf + C::KOFF + (32 * p + w.r32) * C::KP + w.hi * 16;
#pragma unroll
        for (int d0 = 0; d0 < C::ND; ++d0) {
            const bf16x8 a0 = *(const LAS bf16x8*)(kb + d0 * 32);
            sc = __builtin_amdgcn_mfma_f32_32x32x16_bf16(a0, qf[d0], sc, 0, 0, 0);
        }
        s16x4 vl[2][C::NO], vh[2][C::NO];
        if constexpr (VPRE) {
            const unsigned va = (unsigned)(__UINTPTR_TYPE__)(buf + C::VOFF + (32 * p + 4 * w.hi + ((w.lane & 15) >> 2)) * C::VP + (16 * ((w.lane >> 4) & 1) + 4 * (w.lane & 3)) * 2);
#pragma unroll
            for (int s = 0; s < 2; ++s)
#pragma unroll
                for (int d = 0; d < C::NO; ++d) {
                    asm volatile("ds_read_b64_tr_b16 %0, %1 offset:%2" : "=v"(vl[s][d]) : "v"(va), "n"((16 * s) * C::VP + d * 64));
                    asm volatile("ds_read_b64_tr_b16 %0, %1 offset:%2" : "=v"(vh[s][d]) : "v"(va), "n"((16 * s + 8) * C::VP + d * 64));
                }
            __builtin_amdgcn_sched_barrier(0);
        }
        if (fast) {
            if (BIAS) { const float bc = btab[128];
#pragma unroll
                for (int r = 0; r < 16; ++r) sc[r] += bc; }
        } else {
#pragma unroll
            for (int g4 = 0; g4 < 4; ++g4) {
                i32x4 pk = (i32x4){0, 0, 0, 0};
                if (BIAS) pk = *(const LAS i32x4*)(buf + C::POFF + (32 * p + 8 * g4 + 4 * w.hi) * 4);
#pragma unroll
                for (int e = 0; e < 4; ++e) {
                    const int r = 4 * g4 + e, kv = ks + 8 * g4 + 4 * w.hi + e;
                    float v = sc[r];
                    if (BIAS) { int d = posq - pk[e]; d = d < 0 ? 0 : (d > 128 ? 128 : d); v += btab[d]; }
                    bool valid;
                    if (KIND == 0) valid = kv <= qi;
                    else if (KIND == 1) valid = (unsigned)(qi - kv) < 128u;
                    else valid = causal_tile ? (kv <= qi) : sel_lane;
                    sc[r] = valid ? v : NEG_INF;
                }
            }
        }
        float tmax = sc[0];
#pragma unroll
        for (int r = 1; r < 16; ++r) tmax = fmaxf(tmax, sc[r]);
        { const auto rr = __builtin_amdgcn_permlane32_swap(__float_as_uint(tmax), __float_as_uint(tmax), false, false); tmax = fmaxf(__uint_as_float(rr[0]), __uint_as_float(rr[1])); }
        const float mn = fmaxf(st.m, tmax);
        const float alpha = __builtin_amdgcn_exp2f(st.m - mn);
        st.m = mn;
        float ps = 0.f;
#pragma unroll
        for (int r = 0; r < 16; ++r) { sc[r] = __builtin_amdgcn_exp2f(sc[r] - mn); ps += sc[r]; }
        st.l = st.l * alpha + ps;
        if (__any(alpha != 1.0f)) {
#pragma unroll
            for (int d = 0; d < C::NO; ++d)
#pragma unroll
                for (int r = 0; r < 16; ++r) O[d][r] *= alpha;
        }
#pragma unroll
        for (int s = 0; s < 2; ++s) {
            u32x4 t; const int b = 8 * s;
            t.x = cvt_pk_bf16(sc[b], sc[b + 1]); t.y = cvt_pk_bf16(sc[b + 2], sc[b + 3]); t.z = cvt_pk_bf16(sc[b + 4], sc[b + 5]); t.w = cvt_pk_bf16(sc[b + 6], sc[b + 7]);
            const bf16x8 pf = __builtin_bit_cast(bf16x8, t);
            if constexpr (VPRE) {
                if (s == 0) { asm volatile("s_waitcnt lgkmcnt(0)" ::: "memory"); __builtin_amdgcn_sched_barrier(0); }
#pragma unroll
                for (int d = 0; d < C::NO; ++d) {
                    const bf16x8 vf = (bf16x8){vl[s][d][0], vl[s][d][1], vl[s][d][2], vl[s][d][3], vh[s][d][0], vh[s][d][1], vh[s][d][2], vh[s][d][3]};
                    O[d] = __builtin_amdgcn_mfma_f32_32x32x16_bf16(vf, pf, O[d], 0, 0, 0);
                }
            } else {
                const LAS unsigned char* vb = buf + C::VOFF + (32 * p + 4 * w.hi + ((w.lane & 15) >> 2)) * C::VP + (16 * ((w.lane >> 4) & 1) + 4 * (w.lane & 3)) * 2;
#pragma unroll
                for (int d = 0; d < C::NO; ++d) {
                    const s16x4 lo = vtr(vb + (16 * s) * C::VP + d * 64), hi4 = vtr(vb + (16 * s + 8) * C::VP + d * 64);
                    const bf16x8 vf = (bf16x8){lo[0], lo[1], lo[2], lo[3], hi4[0], hi4[1], hi4[2], hi4[3]};
                    O[d] = __builtin_amdgcn_mfma_f32_32x32x16_bf16(vf, pf, O[d], 0, 0, 0);
                }
            }
        }
    }
}

constexpr float ATT_THR = 8.0f;
template <class C, bool VPRE>
__device__ __forceinline__ void tile64_fast(const LAS unsigned char* buf, const bf16x8 (&qf)[C::ND], f32x16 (&O)[C::NO], RowState& st, float& nm, const WaveCtx& w) {
    f32x16 s0, s1;
    const LAS unsigned char* kb = buf + C::KOFF + w.r32 * C::KP + w.hi * 16;
#pragma unroll
    for (int r = 0; r < 16; ++r) { s0[r] = 0.f; s1[r] = 0.f; }
#pragma unroll
    for (int d0 = 0; d0 < C::ND; ++d0) {
        const bf16x8 a0 = *(const LAS bf16x8*)(kb + d0 * 32), a1 = *(const LAS bf16x8*)(kb + 32 * C::KP + d0 * 32);
        s0 = __builtin_amdgcn_mfma_f32_32x32x16_bf16(a0, qf[d0], s0, 0, 0, 0); s1 = __builtin_amdgcn_mfma_f32_32x32x16_bf16(a1, qf[d0], s1, 0, 0, 0);
    }
    const unsigned va = (unsigned)(__UINTPTR_TYPE__)(buf + C::VOFF + (4 * w.hi + ((w.lane & 15) >> 2)) * C::VP + (16 * ((w.lane >> 4) & 1) + 4 * (w.lane & 3)) * 2);
    const LAS unsigned char* vb = buf + C::VOFF + (4 * w.hi + ((w.lane & 15) >> 2)) * C::VP + (16 * ((w.lane >> 4) & 1) + 4 * (w.lane & 3)) * 2;
    s16x4 vl[C::NO], vh[C::NO];
#define ATT_VREADS(KS) do { if constexpr (VPRE) { _Pragma("unroll") for (int d = 0; d < C::NO; ++d) { \
        asm volatile("ds_read_b64_tr_b16 %0, %1 offset:%2" : "=v"(vl[d]) : "v"(va), "n"((16 * (KS)) * C::VP + d * 64)); \
        asm volatile("ds_read_b64_tr_b16 %0, %1 offset:%2" : "=v"(vh[d]) : "v"(va), "n"((16 * (KS) + 8) * C::VP + d * 64)); } \
        __builtin_amdgcn_sched_barrier(0); } } while (0)
#define ATT_PVSTEP(SP, KS, NEXT) do { u32x4 tq; const int b_ = 8 * ((KS) & 1); \
        tq.x = cvt_pk_bf16(SP[b_], SP[b_ + 1]); tq.y = cvt_pk_bf16(SP[b_ + 2], SP[b_ + 3]); tq.z = cvt_pk_bf16(SP[b_ + 4], SP[b_ + 5]); tq.w = cvt_pk_bf16(SP[b_ + 6], SP[b_ + 7]); \
        const bf16x8 pf = __builtin_bit_cast(bf16x8, tq); \
        if constexpr (VPRE) { asm volatile("s_waitcnt lgkmcnt(0)" ::: "memory"); __builtin_amdgcn_sched_barrier(0); \
            _Pragma("unroll") for (int d = 0; d < C::NO; ++d) { const bf16x8 vf = (bf16x8){vl[d][0], vl[d][1], vl[d][2], vl[d][3], vh[d][0], vh[d][1], vh[d][2], vh[d][3]}; \
                O[d] = __builtin_amdgcn_mfma_f32_32x32x16_bf16(vf, pf, O[d], 0, 0, 0); } \
            __builtin_amdgcn_sched_barrier(0); if ((NEXT) >= 0) ATT_VREADS((NEXT) < 0 ? 0 : (NEXT)); } \
        else { _Pragma("unroll") for (int d = 0; d < C::NO; ++d) { const s16x4 lo = vtr(vb + (16 * (KS)) * C::VP + d * 64), hi4 = vtr(vb + (16 * (KS) + 8) * C::VP + d * 64); \
                const bf16x8 vf = (bf16x8){lo[0], lo[1], lo[2], lo[3], hi4[0], hi4[1], hi4[2], hi4[3]}; \
                O[d] = __builtin_amdgcn_mfma_f32_32x32x16_bf16(vf, pf, O[d], 0, 0, 0); } } } while (0)
#define ATT_SOFT(SP) do { \
        float t_ = fmaxf(SP[0], SP[1]); \
        _Pragma("unroll") for (int r = 2; r < 16; r += 2) t_ = fmaxf(t_, fmaxf(SP[r], SP[r + 1])); \
        { const auto rr = __builtin_amdgcn_permlane32_swap(__float_as_uint(t_), __float_as_uint(t_), false, false); t_ = fmaxf(__uint_as_float(rr[0]), __uint_as_float(rr[1])); } \
        t_ += nm; \
        if (__any(t_ > ATT_THR)) { const float dl = fmaxf(t_, 0.f), f_ = __builtin_amdgcn_exp2f(-dl); st.m += dl; nm -= dl; st.l *= f_; \
            _Pragma("unroll") for (int d = 0; d < C::NO; ++d) _Pragma("unroll") for (int r = 0; r < 16; ++r) O[d][r] *= f_; } \
        float ps_ = 0.f; \
        _Pragma("unroll") for (int r = 0; r < 16; ++r) { SP[r] = __builtin_amdgcn_exp2f(SP[r] + nm); ps_ += SP[r]; } \
        st.l += ps_; } while (0)
    ATT_VREADS(0);
    ATT_SOFT(s0);
    ATT_PVSTEP(s0, 0, 1);
    ATT_PVSTEP(s0, 1, 2);
    ATT_SOFT(s1);
    ATT_PVSTEP(s1, 2, 3);
    ATT_PVSTEP(s1, 3, -1);
#undef ATT_VREADS
#undef ATT_PVSTEP
#undef ATT_SOFT
}

template <class C, int KIND, bool BIAS, bool FASTP, bool VPRE>
__device__ __forceinline__ void run_tiles(LAS unsigned char* lds, const Src& src, int t0, int t1, const bf16x8 (&qf)[C::ND], f32x16 (&O)[C::NO], RowState& st,
                                          int qw, int posq, int pminq, const int* pmm, unsigned selmask, int blk, const WaveCtx& w) {
    const LAS float* btab = (const LAS float*)(lds + BTAB_OFF);
    unsigned long long farlo = 0ull, farhi = 0ull;
    if (BIAS) { farlo = __ballot(pminq - pmm[w.lane * 2 + 1] >= 128); farhi = __ballot(pminq - pmm[(w.lane + 64) * 2 + 1] >= 128); }
    float nm = 0.f; bool nvalid = false; int ncur = -1;
    Stage<C, BIAS> sg;
    if (t0 < t1) sg.load(src, t1 - 1, w.tid);
    int it = 0;
    for (int t = t1 - 1; t >= t0; --t, ++it) {
        LAS unsigned char* buf = lds + (it & 1) * C::BUFB;
        sg.store(buf, w.tid);
        __syncthreads();
        if (t - 1 >= t0) sg.load(src, t - 1, w.tid);
        const int k0 = t * 64;
        bool fastT = false, skipT = false, sel_lane = true; int nb = 0;
        if (FASTP) {
            const int kb32 = k0 >> 5;
            const bool far2 = !BIAS || ((((kb32 < 64 ? farlo >> kb32 : farhi >> (kb32 - 64)) & 3ull) == 3ull));
            if (KIND == 0) fastT = (k0 + 63 <= qw) && far2;
            if (KIND == 2) { nb = k0 >> 8; if (nb < blk) { sel_lane = ((selmask >> nb) & 1u) != 0u; skipT = !__any(sel_lane); fastT = far2; } }
        }
        if (skipT) continue;
        if (fastT) {
            if (!nvalid || (KIND == 2 && nb != ncur)) {
                const float bc = BIAS ? btab[128] : 0.f; nm = sel_lane ? bc - st.m : NEG_INF;
                nvalid = true; ncur = nb;
            }
            tile64_fast<C, VPRE>(buf, qf, O, st, nm, w);
        } else {
            tile_compute<C, KIND, BIAS, false>(buf, btab, qf, O, st, k0, qw, posq, farlo, farhi, selmask, blk, w);
            nvalid = false;
        }
    }
    __syncthreads();
}
template <int ND> __device__ __forceinline__ void load_q(bf16x8 (&qf)[ND], const bf16_t* qrow, int hi) {
#pragma unroll
    for (int d0 = 0; d0 < ND; ++d0) qf[d0] = *(const bf16x8*)(qrow + d0 * 16 + hi * 8);
}
template <int NO> __device__ __forceinline__ void store_o(const f32x16 (&O)[NO], bf16_t* orow, int hi) {
#pragma unroll
    for (int d = 0; d < NO; ++d)
#pragma unroll
        for (int g = 0; g < 4; ++g) { u32x2 v; v.x = cvt_pk_bf16(O[d][4 * g], O[d][4 * g + 1]); v.y = cvt_pk_bf16(O[d][4 * g + 2], O[d][4 * g + 3]); *(u32x2*)(orow + 32 * d + 8 * g + 4 * hi) = v; }
}
}

struct Args { const float* in[20]; float* out; unsigned char* ws; int ph_lo, ph_hi; };
constexpr int PH_PER_LAYER = 12, N_PHASES = 2 + DEPTH * PH_PER_LAYER;

struct Frame {
    LAS unsigned char* lds; volatile LAS unsigned* MISC; unsigned* ctl;
    int tid, lane, wave, G, vcu;
    unsigned char* ws;
};

__device__ __forceinline__ void transpose_item(const float* W, int K, int Nsrc, bf16_t* WT, int Ndst, int pad_lo, int pad_hi, int shift, LAS float* scr, int item, int lane) {
    const int nblk = Ndst / 32, kb = item / nblk, nb = item % nblk, k0 = 64 * kb, n0 = 32 * nb;
    const bool pad = (n0 >= pad_lo && n0 < pad_hi);
    int ns0 = n0 - (n0 >= pad_hi ? shift : 0);
    if (shift < 0) { const int pn = n0 >> 8, w0 = n0 & 255; ns0 = (w0 < 128) ? 128 * pn + w0 : FFN + 128 * pn + (w0 - 128); }
    if (!pad) {
#pragma unroll 8
        for (int i = 0; i < 32; ++i) { const int kk = 2 * i + (lane >> 5); scr[kk * 33 + (lane & 31)] = W[(size_t)(k0 + kk) * Nsrc + ns0 + (lane & 31)]; }
    }
    LDS_WAIT(); asm volatile("" ::: "memory");
    const int c = lane & 7;
#pragma unroll
    for (int j = 0; j < 4; ++j) { const int n = (lane >> 3) + 8 * j; const LAS float* s = scr + (8 * c) * 33 + n;
        u32x4 o = (u32x4){0u, 0u, 0u, 0u};
        if (!pad) { o.x = cvt_pk_bf16(s[0 * 33], s[1 * 33]); o.y = cvt_pk_bf16(s[2 * 33], s[3 * 33]); o.z = cvt_pk_bf16(s[4 * 33], s[5 * 33]); o.w = cvt_pk_bf16(s[6 * 33], s[7 * 33]); }
        *(u32x4*)(WT + (size_t)(n0 + n) * K + k0 + 8 * c) = o; }
    LDS_WAIT(); asm volatile("" ::: "memory");
}
__device__ __forceinline__ int t5_bucket(int n) {
    if (n < 16) return n;
    int b = 16;
    b += (n >= 19); b += (n >= 21); b += (n >= 24); b += (n >= 27); b += (n >= 31); b += (n >= 35); b += (n >= 40); b += (n >= 46);
    b += (n >= 52); b += (n >= 59); b += (n >= 67); b += (n >= 77); b += (n >= 87); b += (n >= 99); b += (n >= 113);
    return b;
}
__device__ __forceinline__ void rms_row_bf16(const float* xrow, const float* g, bf16_t* orow, int lane) {
    f32x4 v[8]; float s = 0.f;
#pragma unroll
    for (int j = 0; j < 8; ++j) { v[j] = *((const f32x4*)xrow + lane + 64 * j); s += (v[j].x * v[j].x + v[j].y * v[j].y) + (v[j].z * v[j].z + v[j].w * v[j].w); }
    const float rstd = 1.0f / sqrtf(wave_sum(s) * (1.0f / DM) + EPS);
#pragma unroll
    for (int j = 0; j < 8; ++j) { const f32x4 gg = *((const f32x4*)g + lane + 64 * j);
        u32x2 o; o.x = cvt_pk_bf16(v[j].x * rstd * gg.x, v[j].y * rstd * gg.y); o.y = cvt_pk_bf16(v[j].z * rstd * gg.z, v[j].w * rstd * gg.w);
        *((u32x2*)orow + lane + 64 * j) = o; }
}
__device__ __forceinline__ void rms_row_f32(const float* xrow, const float* g, float* orow, int lane) {
    f32x4 v[8]; float s = 0.f;
#pragma unroll
    for (int j = 0; j < 8; ++j) { v[j] = *((const f32x4*)xrow + lane + 64 * j); s += (v[j].x * v[j].x + v[j].y * v[j].y) + (v[j].z * v[j].z + v[j].w * v[j].w); }
    const float rstd = 1.0f / sqrtf(wave_sum(s) * (1.0f / DM) + EPS);
#pragma unroll
    for (int j = 0; j < 8; ++j) { const f32x4 gg = *((const f32x4*)g + lane + 64 * j); *((f32x4*)orow + lane + 64 * j) = v[j] * rstd * gg; }
}

__device__ __forceinline__ float gelu_f(float v) {
    const float av = fabsf(v), d = av * 0.2316418882f + 1.0f;
    const float t = __builtin_amdgcn_rcpf(d);
    float q = t * 0.5307027145f + (-0.7265760135f); q = q * t + 0.7107068705f; q = q * t + (-0.142248368f); q = q * t + 0.127414796f; q = q * t;
    const float e = __builtin_amdgcn_exp2f((v * v) * (-0.72134752044f));
    const float m = v * (q * e), r = v - m;
    return v < 0.f ? m : r;
}

__device__ __forceinline__ void p_prologue(Frame& F, const Args& a) {
    const int otid = opaque_tid(), olane = otid & 63;
    LAS float* scr = (LAS float*)(F.lds + RING_OFF + F.wave * 16384);
    const int gw = F.vcu * NWAVES + F.wave, NGW = F.G * NWAVES;
    constexpr int I_IN = (DM / 64) * (ZLD / 32), I_UQ = (512 / 64) * (768 / 32), I_UKV = (256 / 64) * (1024 / 32), I_BR1 = (512 / 64) * (DM / 32), I_BR = 4 * I_BR1,
                  I_OUT = (DM / 64) * (DM / 32), I_UP = (DM / 64) * (UP_N / 32), I_DN = (FFN / 64) * (DM / 32);
    constexpr int I_LAYER = I_IN + I_UQ + I_UKV + I_BR + I_OUT + I_UP + I_DN;
    for (int it = gw; it < DEPTH * I_LAYER; it += NGW) {
        const int l = it / I_LAYER; int r = it - l * I_LAYER;
        unsigned char* wl = F.ws + WS_W + (size_t)l * W_LAYER;
        if (r < I_IN) { transpose_item(a.in[4] + (size_t)l * DM * IN_COLS, DM, IN_COLS, (bf16_t*)(wl + W_IN), ZLD, 2368, 2560, 192, scr, r, olane); continue; } r -= I_IN;
        if (r < I_UQ) { transpose_item(a.in[8] + (size_t)l * 512 * 768, 512, 768, (bf16_t*)(wl + W_UQ), 768, 1 << 30, 1 << 30, 0, scr, r, olane); continue; } r -= I_UQ;
        if (r < I_UKV) { transpose_item(a.in[10] + (size_t)l * 256 * 1024, 256, 1024, (bf16_t*)(wl + W_UKV), 1024, 1 << 30, 1 << 30, 0, scr, r, olane); continue; } r -= I_UKV;
        if (r < I_BR) { const int i = r / I_BR1; transpose_item(a.in[12] + ((size_t)l * 4 + i) * 512 * DM, 512, DM, (bf16_t*)(wl + W_BR) + (size_t)i * DM * 512, DM, 1 << 30, 1 << 30, 0, scr, r - i * I_BR1, olane); continue; } r -= I_BR;
        if (r < I_OUT) { transpose_item(a.in[13] + (size_t)l * DM * DM, DM, DM, (bf16_t*)(wl + W_OUT), DM, 1 << 30, 1 << 30, 0, scr, r, olane); continue; } r -= I_OUT;
        if (r < I_UP) { transpose_item(a.in[15] + (size_t)l * DM * UP_N, DM, UP_N, (bf16_t*)(wl + W_UP), UP_N, 1 << 30, 1 << 30, -1, scr, r, olane); continue; } r -= I_UP;
        transpose_item(a.in[18] + (size_t)l * FFN * DM, FFN, DM, (bf16_t*)(wl + W_DN), DM, 1 << 30, 1 << 30, 0, scr, r, olane);
    }
    const int* pos = (const int*)a.in[1];
    const int gt = F.vcu * (NWAVES * 64) + otid, NGT = F.G * NWAVES * 64;
    f32x2* rope = (f32x2*)(F.ws + WS_ROPE);
    for (int e = gt; e < SEQ * 32; e += NGT) {
        const int s = e >> 5, i = e & 31;
        const float inv = (float)exp2((double)(-i) * (13.287712379549449 / 32.0));
        const float ang = (float)pos[s] * inv;
        const double rev = (double)ang * 0.15915494309189535;
        const float fr = (float)(rev - rint(rev));
        rope[e] = (f32x2){__builtin_amdgcn_cosf(fr), __builtin_amdgcn_sinf(fr)};
    }
    float* btab = (float*)(F.ws + WS_BTAB);
    for (int e = gt; e < 16 * 132; e += NGT) { const int hd = e / 132, n = e - hd * 132; btab[e] = (n <= 128) ? a.in[2][t5_bucket(n) * 16 + hd] * LOG2E : 0.f; }
    int* pmm = (int*)(F.ws + WS_PMM);
    for (int e = gt; e < 128; e += NGT) { int mn = pos[e * 32], mx = mn;
        for (int j = 1; j < 32; ++j) { const int p = pos[e * 32 + j]; mn = p < mn ? p : mn; mx = p > mx ? p : mx; }
        pmm[2 * e] = mn; pmm[2 * e + 1] = mx; }
    if (gt < DEPTH) {
        const float* lv = a.in[5] + (size_t)gt * 4 * 64; float s01 = 0.f, s23 = 0.f;
        for (int j = 0; j < 64; ++j) { s01 += lv[j] * lv[64 + j]; s23 += lv[128 + j] * lv[192 + j]; }
        const double li[4] = {0.20000000000000007, 0.35550906759096934, 0.4707130183435842, 0.5560582041556406};
        const float lam_init = (float)(gt == 0 ? li[0] : gt == 1 ? li[1] : gt == 2 ? li[2] : li[3]);
        ((float*)(F.ws + WS_LAM))[gt] = expf(s01) - expf(s23) + lam_init;
    }
}

__device__ __forceinline__ void p_prep(Frame& F, const Args& a, int l) {
    const int otid = opaque_tid(), lane = otid & 63;
    const int gw = F.vcu * NWAVES + F.wave, NGW = F.G * NWAVES;
    const bf16_t* Z = (const bf16_t*)(F.ws + WS_Z);
    bf16_t* CQN = (bf16_t*)(F.ws + WS_CQN); bf16_t* CKVN = (bf16_t*)(F.ws + WS_CKVN); bf16_t* KR = (bf16_t*)(F.ws + WS_KR);
    const float* gq = a.in[7] + (size_t)l * 512; const float* gkv = a.in[9] + (size_t)l * 256;
    const f32x2* rope = (const f32x2*)(F.ws + WS_ROPE);
    for (int m = gw; m < M; m += NGW) {
        const bf16_t* zr = Z + (size_t)m * ZLD;
        {
            const u32x4 v = *(const u32x4*)(zr + ZCQ + lane * 8);
            float x[8] = {bflo(v.x), bfhi(v.x), bflo(v.y), bfhi(v.y), bflo(v.z), bfhi(v.z), bflo(v.w), bfhi(v.w)};
            float s = 0.f;
#pragma unroll
            for (int j = 0; j < 8; ++j) s += x[j] * x[j];
            const float rstd = 1.0f / sqrtf(wave_sum(s) * (1.0f / 512.0f) + EPS);
            const f32x4 g0 = *(const f32x4*)(gq + lane * 8), g1 = *(const f32x4*)(gq + lane * 8 + 4);
            u32x4 o; o.x = cvt_pk_bf16(x[0] * rstd * g0.x, x[1] * rstd * g0.y); o.y = cvt_pk_bf16(x[2] * rstd * g0.z, x[3] * rstd * g0.w);
            o.z = cvt_pk_bf16(x[4] * rstd * g1.x, x[5] * rstd * g1.y); o.w = cvt_pk_bf16(x[6] * rstd * g1.z, x[7] * rstd * g1.w);
            *(u32x4*)(CQN + (size_t)m * 512 + lane * 8) = o;
        }
        {
            const u32x2 v = *(const u32x2*)(zr + ZCKV + lane * 4);
            const float x0 = bflo(v.x), x1 = bfhi(v.x), x2 = bflo(v.y), x3 = bfhi(v.y);
            const float rstd = 1.0f / sqrtf(wave_sum((x0 * x0 + x1 * x1) + (x2 * x2 + x3 * x3)) * (1.0f / 256.0f) + EPS);
            const f32x4 g = *(const f32x4*)(gkv + lane * 4);
            u32x2 o; o.x = cvt_pk_bf16(x0 * rstd * g.x, x1 * rstd * g.y); o.y = cvt_pk_bf16(x2 * rstd * g.z, x3 * rstd * g.w);
            *(u32x2*)(CKVN + (size_t)m * 256 + lane * 4) = o;
        }
        if (lane < 32) {
            const float x1 = bf2f(zr[ZKR + lane]), x2 = bf2f(zr[ZKR + 32 + lane]);
            const f32x2 cs = rope[(m & (SEQ - 1)) * 32 + lane];
            KR[(size_t)m * 64 + lane] = (bf16_t)(cvt_pk_bf16(x1 * cs.x - x2 * cs.y, 0.f) & 0xffffu);
            KR[(size_t)m * 64 + 32 + lane] = (bf16_t)(cvt_pk_bf16(x1 * cs.y + x2 * cs.x, 0.f) & 0xffffu);
        }
    }
    LAS float* scr = (LAS float*)(F.lds + RING_OFF);
    float* KM = (float*)(F.ws + WS_KMEAN);
    for (int it = F.vcu; it < NB * 4 * 16; it += F.G) {
        const int b = it >> 6, h = (it >> 4) & 3, n = it & 15;
        const int c8 = otid & 15, rg = otid >> 4;
        float acc[8];
#pragma unroll
        for (int j = 0; j < 8; ++j) acc[j] = 0.f;
        for (int j = 0; j < 8; ++j) {
            const u32x4 v = *(const u32x4*)(Z + (size_t)(b * SEQ + n * 256 + rg + 32 * j) * ZLD + ZMK + h * 128 + c8 * 8);
            acc[0] += bflo(v.x); acc[1] += bfhi(v.x); acc[2] += bflo(v.y); acc[3] += bfhi(v.y); acc[4] += bflo(v.z); acc[5] += bfhi(v.z); acc[6] += bflo(v.w); acc[7] += bfhi(v.w);
        }
#pragma unroll
        for (int j = 0; j < 8; ++j) scr[rg * 132 + c8 * 8 + j] = acc[j];
        __syncthreads();
        if (otid < 128) { float s = 0.f; for (int r = 0; r < 32; ++r) s += scr[r * 132 + otid]; KM[(size_t)it * 128 + otid] = s * (1.0f / 256.0f); }
        __syncthreads();
    }
}

constexpr size_t WS_GTAIL = WS_Z, WS_GHEADA = WS_Z + 12 * MiB, WS_GHEADV = WS_Z + 24 * MiB;
static_assert((size_t)(M / 64) * 2 * FFN * 4 <= 12 * MiB, "side buffers");
__device__ __forceinline__ void p_glufix(Frame& F, const Args& a, int l) {
    const int tid = opaque_tid();
    bf16_t* Gb = (bf16_t*)(F.ws + WS_T);
    const float* tail = (const float*)(F.ws + WS_GTAIL); const float* heada = (const float*)(F.ws + WS_GHEADA); const float* headv = (const float*)(F.ws + WS_GHEADV);
    const float* cw = a.in[16] + (size_t)l * 3 * FFN; const float* cb = a.in[17] + (size_t)l * FFN;
    constexpr int NCH = FFN / 8;
    for (int it = F.vcu * 512 + tid; it < (M / 64) * 2 * NCH; it += F.G * 512) {
        const int c8 = it % NCH, gj = it / NCH, j = gj & 1, gid = gj >> 1, ch0 = c8 * 8;
        const bool zp = (gid & 63) == 0;
        float t0[8], t1[8], h0[8], av[8], vv[8];
#pragma unroll
        for (int h = 0; h < 2; ++h) {
            const f32x4 z4 = (f32x4){0.f, 0.f, 0.f, 0.f};
            const f32x4 x0 = zp ? z4 : *(const f32x4*)(tail + ((size_t)(gid - 1) * 2 + 0) * FFN + ch0 + 4 * h), x1 = zp ? z4 : *(const f32x4*)(tail + ((size_t)(gid - 1) * 2 + 1) * FFN + ch0 + 4 * h);
            const f32x4 y0 = *(const f32x4*)(heada + ((size_t)gid * 2 + 0) * FFN + ch0 + 4 * h), ya = *(const f32x4*)(heada + ((size_t)gid * 2 + j) * FFN + ch0 + 4 * h), yv = *(const f32x4*)(headv + ((size_t)gid * 2 + j) * FFN + ch0 + 4 * h);
#pragma unroll
            for (int e = 0; e < 4; ++e) { t0[4 * h + e] = x0[e]; t1[4 * h + e] = x1[e]; h0[4 * h + e] = y0[e]; av[4 * h + e] = ya[e]; vv[4 * h + e] = yv[e]; }
        }
        float o[8];
#pragma unroll
        for (int h = 0; h < 2; ++h) { const f32x4 c0 = *(const f32x4*)(cw + ch0 + 4 * h), c1 = *(const f32x4*)(cw + FFN + ch0 + 4 * h), c2 = *(const f32x4*)(cw + 2 * FFN + ch0 + 4 * h), c3 = *(const f32x4*)(cb + ch0 + 4 * h);
#pragma unroll
            for (int e = 0; e < 4; ++e) { const int c = 4 * h + e; const float am1 = j ? h0[c] : t1[c], am2 = j ? t1[c] : t0[c];
                o[c] = pg8::gelu_erf(c3[e] + c0[e] * am2 + c1[e] * am1 + c2[e] * av[c]) * vv[c]; } }
        u32x4 w; w.x = cvt_pk_bf16(o[0], o[1]); w.y = cvt_pk_bf16(o[2], o[3]); w.z = cvt_pk_bf16(o[4], o[5]); w.w = cvt_pk_bf16(o[6], o[7]);
        *(u32x4*)(Gb + (size_t)(gid * 64 + j) * FFN + ch0) = w;
    }
}

struct AttnEnv { const bf16_t* Z; const bf16_t* QMLA; const bf16_t* KVMLA; const bf16_t* KR; bf16_t* BRO; const int* pos; const int* pmm; const float* btabg; const f32x2* rope; const float* kmean;
                 const float* subln_g; const float* sinks; float* dscr; float lam, one_m_li; };

__device__ __forceinline__ void load_btab(LAS unsigned char* lds, const float* src, int tid) { if (tid < 132) ((LAS float*)(lds + att::BTAB_OFF))[tid] = src[tid]; }

__device__ __forceinline__ void unit_diff(LAS unsigned char* lds, const AttnEnv& E, int b, int h, int qb, const att::WaveCtx& w) {
    typedef att::Cfg<64, 0, 128> C;
    const int qw = qb * 256 + 32 * w.wid, qi = qw + w.r32; const size_t grow = (size_t)b * SEQ + qi;
    load_btab(lds, E.btabg + (0 + h) * 132, w.tid);
    const int posq = E.pos[qi], pminq = E.pmm[(qw >> 5) * 2];
    f32x16 O[4];
    f32x4* park = (f32x4*)(E.dscr + ((size_t)blockIdx.x * 512 + w.tid) * 64);
#pragma unroll
    for (int mp = 0; mp < 2; ++mp) {
        att::Src src; src.k0 = E.Z + (size_t)b * SEQ * ZLD + ZKA + (2 * h + mp) * 64; src.pk0 = ZLD; src.k1 = src.k0; src.pk1 = ZLD; src.v = E.Z + (size_t)b * SEQ * ZLD + ZVA + h * 128; src.pv = ZLD; src.pos = E.pos;
        bf16x8 qf[4]; att::load_q<4>(qf, E.Z + grow * ZLD + ZQA + (2 * h + mp) * 64, w.hi);
#pragma unroll
        for (int d = 0; d < 4; ++d)
#pragma unroll
            for (int r = 0; r < 16; ++r) O[d][r] = 0.f;
        att::RowState st; st.m = -1e30f; st.l = 0.f;
        att::run_tiles<C, 0, true, true, true>(lds, src, 0, 4 * (qb + 1), qf, O, st, qw, posq, pminq, E.pmm, 0u, 0, w);
        const float inv = 1.0f / (half_sum(st.l));
        if (mp == 0) {
#pragma unroll
            for (int d = 0; d < 4; ++d)
#pragma unroll
                for (int g = 0; g < 4; ++g) park[d * 4 + g] = (f32x4){O[d][4 * g] * inv, O[d][4 * g + 1] * inv, O[d][4 * g + 2] * inv, O[d][4 * g + 3] * inv};
        } else {
            const float li = E.lam * inv;
#pragma unroll
            for (int d = 0; d < 4; ++d)
#pragma unroll
                for (int g = 0; g < 4; ++g) { const f32x4 pv = park[d * 4 + g];
#pragma unroll
                    for (int e = 0; e < 4; ++e) O[d][4 * g + e] = pv[e] - li * O[d][4 * g + e]; }
        }
    }
    float ss = 0.f;
#pragma unroll
    for (int d = 0; d < 4; ++d)
#pragma unroll
        for (int r = 0; r < 16; ++r) ss += O[d][r] * O[d][r];
    ss = half_sum(ss);
    const float sc = (1.0f / sqrtf(ss * (1.0f / 128.0f) + EPS)) * E.one_m_li;
#pragma unroll
    for (int d = 0; d < 4; ++d)
#pragma unroll
        for (int g = 0; g < 4; ++g) { const f32x4 gg = *(const f32x4*)(E.subln_g + 32 * d + 8 * g + 4 * w.hi);
#pragma unroll
            for (int e = 0; e < 4; ++e) O[d][4 * g + e] *= sc * gg[e]; }
    att::store_o<4>(O, E.BRO + grow * DM + h * 128, w.hi);
}

__device__ __forceinline__ void unit_mla(LAS unsigned char* lds, const AttnEnv& E, int b, int h, int qb, const att::WaveCtx& w) {
    typedef att::Cfg<128, 64, 128> C;
    const int qw = qb * 256 + 32 * w.wid, qi = qw + w.r32; const size_t grow = (size_t)b * SEQ + qi;
    att::Src src; src.k0 = E.KVMLA + (size_t)b * SEQ * 1024 + h * 256; src.pk0 = 1024; src.k1 = E.KR + (size_t)b * SEQ * 64; src.pk1 = 64; src.v = E.KVMLA + (size_t)b * SEQ * 1024 + h * 256 + 128; src.pv = 1024; src.pos = E.pos;
    bf16x8 qf[12]; att::load_q<12>(qf, E.QMLA + grow * 768 + h * 192, w.hi);
#pragma unroll
    for (int dd = 0; dd < 2; ++dd) {
        const f32x2* cs = E.rope + (size_t)qi * 32 + 16 * dd + 8 * w.hi;
        unsigned o1[4], o2[4];
#pragma unroll
        for (int jp = 0; jp < 4; ++jp) {
            const f32x4 c2 = *(const f32x4*)(cs + 2 * jp);
            const float a0 = bf2f((unsigned short)qf[8 + dd][2 * jp]), a1 = bf2f((unsigned short)qf[8 + dd][2 * jp + 1]);
            const float b0 = bf2f((unsigned short)qf[10 + dd][2 * jp]), b1 = bf2f((unsigned short)qf[10 + dd][2 * jp + 1]);
            o1[jp] = cvt_pk_bf16(a0 * c2[0] - b0 * c2[1], a1 * c2[2] - b1 * c2[3]);
            o2[jp] = cvt_pk_bf16(a0 * c2[1] + b0 * c2[0], a1 * c2[3] + b1 * c2[2]);
        }
        qf[8 + dd] = __builtin_bit_cast(bf16x8, (u32x4){o1[0], o1[1], o1[2], o1[3]});
        qf[10 + dd] = __builtin_bit_cast(bf16x8, (u32x4){o2[0], o2[1], o2[2], o2[3]});
    }
    f32x16 O[4];
#pragma unroll
    for (int d = 0; d < 4; ++d)
#pragma unroll
        for (int r = 0; r < 16; ++r) O[d][r] = 0.f;
    att::RowState st; st.m = -1e30f; st.l = 0.f;
    att::run_tiles<C, 0, false, false, false>(lds, src, 0, 4 * (qb + 1), qf, O, st, qw, 0, 0, E.pmm, 0u, 0, w);
    const float inv = 1.0f / (half_sum(st.l));
#pragma unroll
    for (int d = 0; d < 4; ++d)
#pragma unroll
        for (int r = 0; r < 16; ++r) O[d][r] *= inv;
    att::store_o<4>(O, E.BRO + grow * DM + 512 + h * 128, w.hi);
}

__device__ __forceinline__ void unit_swa(LAS unsigned char* lds, const AttnEnv& E, int b, int qh, int qb, const att::WaveCtx& w) {
    typedef att::Cfg<64, 0, 64> C;
    const int qw = qb * 256 + 32 * w.wid, qi = qw + w.r32; const size_t grow = (size_t)b * SEQ + qi; const int kvh = qh >> 2;
    load_btab(lds, E.btabg + (4 + qh) * 132, w.tid);
    const int posq = E.pos[qi], pminq = E.pmm[(qw >> 5) * 2];
    att::Src src; src.k0 = E.Z + (size_t)b * SEQ * ZLD + ZSK + kvh * 64; src.pk0 = ZLD; src.k1 = src.k0; src.pk1 = ZLD; src.v = E.Z + (size_t)b * SEQ * ZLD + ZSV + kvh * 64; src.pv = ZLD; src.pos = E.pos;
    bf16x8 qf[4]; att::load_q<4>(qf, E.Z + grow * ZLD + ZSQ + qh * 64, w.hi);
    f32x16 O[2];
#pragma unroll
    for (int d = 0; d < 2; ++d)
#pragma unroll
        for (int r = 0; r < 16; ++r) O[d][r] = 0.f;
    att::RowState st; st.m = E.sinks[qh] * LOG2E; st.l = (w.hi == 0) ? 1.0f : 0.0f;
    const int t0 = qb == 0 ? 0 : 4 * qb - 2;
    att::run_tiles<C, 1, true, false, true>(lds, src, t0, 4 * (qb + 1), qf, O, st, qw, posq, pminq, E.pmm, 0u, 0, w);
    const float inv = 1.0f / (half_sum(st.l));
#pragma unroll
    for (int d = 0; d < 2; ++d)
#pragma unroll
        for (int r = 0; r < 16; ++r) O[d][r] *= inv;
    att::store_o<2>(O, E.BRO + grow * DM + 1024 + qh * 64, w.hi);
}

__device__ __forceinline__ void unit_moba(LAS unsigned char* lds, const AttnEnv& E, int b, int h, int blk, const att::WaveCtx& w) {
    typedef att::Cfg<128, 0, 128> C;
    const int qw = blk * 256 + 32 * w.wid, qi = qw + w.r32; const size_t grow = (size_t)b * SEQ + qi;
    load_btab(lds, E.btabg + (12 + h) * 132, w.tid);
    LAS float* km = (LAS float*)(lds + att::KMEAN_OFF);
    for (int e = w.tid; e < blk * 128; e += 512) km[e] = E.kmean[(size_t)((b * 4 + h) * 16) * 128 + e];
    const int posq = E.pos[qi], pminq = E.pmm[(qw >> 5) * 2];
    att::Src src; src.k0 = E.Z + (size_t)b * SEQ * ZLD + ZMK + h * 128; src.pk0 = ZLD; src.k1 = src.k0; src.pk1 = ZLD; src.v = E.Z + (size_t)b * SEQ * ZLD + ZMV + h * 128; src.pv = ZLD; src.pos = E.pos;
    bf16x8 qf[8]; att::load_q<8>(qf, E.Z + grow * ZLD + ZMQ + h * 128, w.hi);
    __syncthreads();
    unsigned selmask;
    if (blk <= 3) selmask = (1u << blk) - 1u;
    else {
        float v1 = NEG_INF, v2 = NEG_INF, v3 = NEG_INF; int i1 = 31, i2 = 31, i3 = 31;
        for (int n = 0; n < blk; ++n) {
            float part = 0.f;
#pragma unroll
            for (int d0 = 0; d0 < 8; ++d0) {
                const f32x4 k0 = *(const LAS f32x4*)(km + n * 128 + 16 * d0 + 8 * w.hi), k1 = *(const LAS f32x4*)(km + n * 128 + 16 * d0 + 8 * w.hi + 4);
#pragma unroll
                for (int j = 0; j < 4; ++j) part += bf2f((unsigned short)qf[d0][j]) * k0[j] + bf2f((unsigned short)qf[d0][4 + j]) * k1[j];
            }
            const float g = half_sum(part);
            if (g > v1) { v3 = v2; i3 = i2; v2 = v1; i2 = i1; v1 = g; i1 = n; }
            else if (g > v2) { v3 = v2; i3 = i2; v2 = g; i2 = n; }
            else if (g > v3) { v3 = g; i3 = n; }
        }
        selmask = (1u << i1) | (1u << i2) | (1u << i3);
    }
    f32x16 O[4];
#pragma unroll
    for (int d = 0; d < 4; ++d)
#pragma unroll
        for (int r = 0; r < 16; ++r) O[d][r] = 0.f;
    att::RowState st; st.m = -1e30f; st.l = 0.f;
    att::run_tiles<C, 2, true, true, true>(lds, src, 0, 4 * (blk + 1), qf, O, st, qw, posq, pminq, E.pmm, selmask, blk, w);
    const float inv = 1.0f / (half_sum(st.l));
#pragma unroll
    for (int d = 0; d < 4; ++d)
#pragma unroll
        for (int r = 0; r < 16; ++r) O[d][r] *= inv;
    att::store_o<4>(O, E.BRO + grow * DM + 1536 + h * 128, w.hi);
}

#ifndef CHECK_BUILD
#define CHECK_BUILD 0
#endif
#ifndef CHECK_TOL
#define CHECK_TOL 0.04f
#endif
#ifndef CHECK_REPORT
#define CHECK_REPORT (-1)
#endif
#if CHECK_BUILD
constexpr size_t WS_CHK_KV = WS_END;
constexpr size_t WS_CHK_KR = WS_CHK_KV + (size_t)SEQ * 1024 * 4;
constexpr size_t WS_END2 = WS_CHK_KR + (size_t)SEQ * 64 * 4;
constexpr int CHK_B = 1, CHK_NS = 32;
constexpr int CW_CHK = 2048;
__device__ __forceinline__ int chk_row(int i) {
    const int ts[CHK_NS] = {0, 1, 2, 31, 32, 63, 64, 127, 128, 129, 255, 256, 257, 300, 511, 512, 700, 767, 768, 1000, 1023, 1024, 1500, 2047, 2048, 3071, 3072, 3500, 3839, 3840, 4000, 4095};
    int r = 0;
#pragma unroll
    for (int j = 0; j < CHK_NS; ++j) r = (i == j) ? ts[j] : r;
    return r;
}
__device__ __forceinline__ void chk_sincos(float ang, float& c, float& s) {
    double x = (double)ang; const double twopi = 6.283185307179586476925;
    x -= twopi * rint(x / twopi);
    const double x2 = x * x; double tc = 1.0, ts_ = x, sc = 1.0, ss = x;
#pragma unroll 1
    for (int k = 1; k < 16; ++k) { const double kk = (double)k; tc *= -x2 / ((2.0 * kk - 1.0) * (2.0 * kk)); ts_ *= -x2 / ((2.0 * kk) * (2.0 * kk + 1.0)); sc += tc; ss += ts_; }
    c = (float)sc; s = (float)ss;
}
__device__ __forceinline__ int chk_bucket(int rel) {
    const int n = rel > 0 ? rel : 0;
    if (n < 16) return n;
    const float nf = (float)n;
    const int large = 16 + (int)(logf(nf / 16.0f) / 2.0794415416798357f * 16.0f);
    return large < 31 ? large : 31;
}
__device__ __forceinline__ float chk_block_max(float v, LAS float* red, int tid) {
    v = wave_max(v);
    __syncthreads(); if ((tid & 63) == 0) red[tid >> 6] = v; __syncthreads();
    float r = red[0];
#pragma unroll
    for (int j = 1; j < 8; ++j) r = fmaxf(r, red[j]);
    return r;
}
__device__ __forceinline__ float chk_block_sum(float v, LAS float* red, int tid) {
    v = wave_sum(v);
    __syncthreads(); if ((tid & 63) == 0) red[tid >> 6] = v; __syncthreads();
    float r = 0.f;
#pragma unroll
    for (int j = 0; j < 8; ++j) r += red[j];
    return r;
}
__device__ __forceinline__ void chk_record(unsigned* ctl, int type, float diff, float mag, LAS float* red, int tid) {
    const float md = chk_block_max(diff, red, tid), mm = chk_block_max(mag, red, tid);
    if (tid == 0) { atomicMax(ctl + CW_CHK + 2 * type, __float_as_uint(mm > 0.f ? md / mm : 1.0e9f)); atomicMax(ctl + CW_CHK + 2 * type + 1, 1u); }
}
__device__ __forceinline__ void chk_prep(Frame& F, const Args& a) {
    const int tid = opaque_tid();
    const bf16_t* Z = (const bf16_t*)(F.ws + WS_Z) + (size_t)CHK_B * SEQ * ZLD;
    float* KV = (float*)(F.ws + WS_CHK_KV); float* KRn = (float*)(F.ws + WS_CHK_KR);
    const float* gkv = a.in[9]; const float* wukv = a.in[10]; const int* pos = (const int*)a.in[1];
    const long gt = (long)F.vcu * 512 + tid, NGT = (long)F.G * 512;
    for (long e = gt; e < (long)SEQ * 1024; e += NGT) {
        const int srow = (int)(e >> 10), n = (int)(e & 1023);
        const bf16_t* zr = Z + (size_t)srow * ZLD + ZCKV;
        float ss = 0.f; for (int c = 0; c < 256; ++c) { const float x = bf2f(zr[c]); ss += x * x; }
        const float rstd = 1.0f / sqrtf(ss / 256.0f + EPS);
        float acc = 0.f; for (int c = 0; c < 256; ++c) acc += bf2f(zr[c]) * rstd * gkv[c] * wukv[(size_t)c * 1024 + n];
        KV[e] = acc;
    }
    for (long e = gt; e < (long)SEQ * 32; e += NGT) {
        const int srow = (int)(e >> 5), i = (int)(e & 31);
        const float inv = __builtin_amdgcn_exp2f((float)(-2 * i) / 64.0f * 13.287712379549449f);
        float c, s_; chk_sincos((float)pos[srow] * inv, c, s_);
        const float x1 = bf2f(Z[(size_t)srow * ZLD + ZKR + i]), x2 = bf2f(Z[(size_t)srow * ZLD + ZKR + 32 + i]);
        KRn[srow * 64 + i] = x1 * c - x2 * s_; KRn[srow * 64 + 32 + i] = x1 * s_ + x2 * c;
    }
}
__device__ __forceinline__ void chk_items(Frame& F, const Args& a) {
    const int tid = opaque_tid();
    LAS float* sc = (LAS float*)(F.lds + RING_OFF);
    LAS float* qv = sc + 4096;
    LAS float* tmp = qv + 192;
    LAS float* red = tmp + 512;
    LAS float* part = red + 8;
    LAS float* gate = part + 512;
    const bf16_t* Zb = (const bf16_t*)(F.ws + WS_Z) + (size_t)CHK_B * SEQ * ZLD;
    const bf16_t* BRO = (const bf16_t*)(F.ws + WS_BRO) + (size_t)CHK_B * SEQ * DM;
    const float* KV = (const float*)(F.ws + WS_CHK_KV); const float* KRn = (const float*)(F.ws + WS_CHK_KR);
    const int* pos = (const int*)a.in[1]; const float* relb = a.in[2];
    for (int it = F.vcu; it < 16 * CHK_NS; it += F.G) {
        const int smp = it % CHK_NS, hh = it / CHK_NS;
        const int t = chk_row(smp);
        __syncthreads();
        if (hh < 4) {
            const int h = hh;
            {
                const bf16_t* zr = Zb + (size_t)t * ZLD + ZCQ;
                const float x = bf2f(zr[tid]);
                const float ss = chk_block_sum(x * x, red, tid);
                tmp[tid] = x * (1.0f / sqrtf(ss / 512.0f + EPS)) * a.in[7][tid];
            }
            __syncthreads();
            if (tid < 192) { float acc = 0.f; const float* w = a.in[8] + h * 192 + tid; for (int k = 0; k < 512; ++k) acc += tmp[k] * w[(size_t)k * 768]; qv[tid] = acc; }
            __syncthreads();
            float r1 = 0.f, r2 = 0.f;
            if (tid < 32) { const float inv = __builtin_amdgcn_exp2f((float)(-2 * tid) / 64.0f * 13.287712379549449f); float c, s_; chk_sincos((float)pos[t] * inv, c, s_);
                const float x1 = qv[128 + tid], x2 = qv[160 + tid]; r1 = x1 * c - x2 * s_; r2 = x1 * s_ + x2 * c; }
            __syncthreads();
            if (tid < 32) { qv[128 + tid] = r1; qv[160 + tid] = r2; }
            __syncthreads();
            float lmax = -3.0e38f;
            for (int k = tid; k <= t; k += 512) { float d = 0.f; const float* kr = KV + (size_t)k * 1024 + h * 256;
                for (int j = 0; j < 128; ++j) d += qv[j] * kr[j];
                for (int j = 0; j < 64; ++j) d += qv[128 + j] * KRn[k * 64 + j];
                d *= 0.07216878364870322f; sc[k] = d; lmax = fmaxf(lmax, d); }
            const float mx = chk_block_max(lmax, red, tid);
            float ls = 0.f; for (int k = tid; k <= t; k += 512) { const float p = expf(sc[k] - mx); sc[k] = p; ls += p; }
            const float den = chk_block_sum(ls, red, tid);
            __syncthreads();
            { const int dv = tid & 127, grp = tid >> 7; float o = 0.f; for (int k = grp; k <= t; k += 4) o += sc[k] * KV[(size_t)k * 1024 + h * 256 + 128 + dv]; part[grp * 128 + dv] = o; }
            __syncthreads();
            { float df = 0.f, mg = 0.f;
              if (tid < 128) { const float o = (part[tid] + part[128 + tid] + part[256 + tid] + part[384 + tid]) / den; const float f = bf2f(BRO[(size_t)t * DM + 512 + h * 128 + tid]); df = fabsf(f - o); mg = fabsf(o); }
              chk_record(F.ctl, 0, df, mg, red, tid); }
        } else if (hh < 8) {
            const int h = hh - 4, blk = t >> 8;
            if (tid < 128) qv[tid] = bf2f(Zb[(size_t)t * ZLD + ZMQ + h * 128 + tid]);
            __syncthreads();
            { const int n = tid >> 5, sub = tid & 31; float g = 0.f;
              if (n < blk) for (int r = sub; r < 256; r += 32) { const bf16_t* kr = Zb + (size_t)(n * 256 + r) * ZLD + ZMK + h * 128; float d = 0.f; for (int j = 0; j < 128; ++j) d += qv[j] * bf2f(kr[j]); g += d; }
              g += swz_xor<1>(g); g += swz_xor<2>(g); g += swz_xor<4>(g); g += swz_xor<8>(g); g += swz_xor<16>(g);
              if (sub == 0) gate[n] = (n < blk) ? g : -3.0e38f; }
            __syncthreads();
            unsigned sel = 0u;
            if (blk <= 3) sel = (1u << blk) - 1u;
            else for (int c = 0; c < 3; ++c) { int bi = -1; float bv = -3.0e38f; for (int n = 0; n < blk; ++n) if (!((sel >> n) & 1u) && gate[n] > bv) { bv = gate[n]; bi = n; } sel |= 1u << bi; }
            float lmax = -3.0e38f;
            for (int k = tid; k <= t; k += 512) { const int n = k >> 8; const bool ok = (n == blk) || ((sel >> n) & 1u);
                float d = -3.0e38f;
                if (ok) { const bf16_t* kr = Zb + (size_t)k * ZLD + ZMK + h * 128; d = 0.f; for (int j = 0; j < 128; ++j) d += qv[j] * bf2f(kr[j]);
                    d = d / LOG2E + relb[chk_bucket(pos[t] - pos[k]) * 16 + 12 + h]; lmax = fmaxf(lmax, d); }
                sc[k] = d; }
            const float mx = chk_block_max(lmax, red, tid);
            float ls = 0.f; for (int k = tid; k <= t; k += 512) { const float p = (sc[k] > -1.0e38f) ? expf(sc[k] - mx) : 0.f; sc[k] = p; ls += p; }
            const float den = chk_block_sum(ls, red, tid);
            __syncthreads();
            { const int dv = tid & 127, grp = tid >> 7; float o = 0.f; for (int k = grp; k <= t; k += 4) o += sc[k] * bf2f(Zb[(size_t)k * ZLD + ZMV + h * 128 + dv]); part[grp * 128 + dv] = o; }
            __syncthreads();
            { float df = 0.f, mg = 0.f;
              if (tid < 128) { const float o = (part[tid] + part[128 + tid] + part[256 + tid] + part[384 + tid]) / den; const float f = bf2f(BRO[(size_t)t * DM + 1536 + h * 128 + tid]); df = fabsf(f - o); mg = fabsf(o); }
              chk_record(F.ctl, 1, df, mg, red, tid); }
        } else {
            const int qh = hh - 8, kvh = qh >> 2;
            if (tid < 64) qv[tid] = bf2f(Zb[(size_t)t * ZLD + ZSQ + qh * 64 + tid]);
            __syncthreads();
            const float sink = a.in[11][qh];
            float lmax = -3.0e38f; const int kk = t - 127 + tid;
            float d = -3.0e38f;
            if (tid < 128 && kk >= 0) { const bf16_t* kr = Zb + (size_t)kk * ZLD + ZSK + kvh * 64; d = 0.f; for (int j = 0; j < 64; ++j) d += qv[j] * bf2f(kr[j]);
                d = d / LOG2E + relb[chk_bucket(pos[t] - pos[kk]) * 16 + 4 + qh]; lmax = d; }
            const float mx = fmaxf(chk_block_max(lmax, red, tid), sink);
            const float p = (d > -1.0e38f) ? expf(d - mx) : 0.f;
            if (tid < 128) sc[tid] = p;
            const float den = chk_block_sum(p, red, tid) + expf(sink - mx);
            __syncthreads();
            { float df = 0.f, mg = 0.f;
              if (tid < 64) { float o = 0.f; for (int j = 0; j < 128; ++j) { const int k2 = t - 127 + j; if (k2 >= 0) o += sc[j] * bf2f(Zb[(size_t)k2 * ZLD + ZSV + kvh * 64 + tid]); }
                o /= den; const float f = bf2f(BRO[(size_t)t * DM + 1024 + qh * 64 + tid]); df = fabsf(f - o); mg = fabsf(o); }
              chk_record(F.ctl, 2, df, mg, red, tid); }
        }
    }
}
#endif

__device__ __forceinline__ int queue_next(Frame& F, unsigned* head) {
    __syncthreads();
    if (threadIdx.x == 0) F.MISC[4] = __hip_atomic_fetch_add(head, 1u, RLX_AGENT);
    __syncthreads();
    return (int)F.MISC[4];
}

__global__ void __launch_bounds__(NWAVES * 64, 2) trunk_fwd(Args args) {
    extern __shared__ __attribute__((aligned(16))) unsigned char lds_raw[];
    Frame F;
    F.lds = (LAS unsigned char*)lds_raw;
    F.MISC = (volatile LAS unsigned*)(F.lds + MISC_OFF);
    F.tid = threadIdx.x; F.lane = F.tid & 63; F.wave = __builtin_amdgcn_readfirstlane(F.tid >> 6);
    F.G = gridDim.x; { const int bx = blockIdx.x; F.vcu = (F.G % 8 == 0) ? (bx % 8) * (F.G / 8) + bx / 8 : bx; }
    F.ws = args.ws; F.ctl = (unsigned*)(args.ws + WS_CTL);
    for (int u = F.tid; u < (LDS_BYTES - LDSCTL_OFF) / 4; u += NWAVES * 64) ((LAS unsigned*)(F.lds + LDSCTL_OFF))[u] = 0u;
    __syncthreads();
    const int lo = args.ph_lo, hi = args.ph_hi;
    XcdBarrier bar; bar.bar = F.ctl + CW_BAR; bar.x = 0; bar.st = nullptr;
    if (hi - lo > 1) bar = xcd_barrier_post(F.ctl + CW_BAR, F.MISC + 8);
#ifndef DBG_MASK
#define DBG_MASK 0xFFFFu
#endif
#define EN(j) (((DBG_MASK) >> (j)) & 1u)
#ifndef DBG_ATT
#define DBG_ATT 0xFu
#endif
#define ENA(j) (((DBG_ATT) >> (j)) & 1u)
#define IN(k) (lo <= (k) && (k) < hi)
#ifndef DUP
#define DUP (-1)
#endif
#define REPS(j) ((DUP) == (j) ? 2 : 1)
#define SEAM(k) do { if ((k) + 1 < hi) xcd_barrier(bar); } while (0)
    const int gw = F.vcu * NWAVES + F.wave, NGW = F.G * NWAVES;
    unsigned char* ws = F.ws;
    float* X = (float*)(ws + WS_X); bf16_t* XN = (bf16_t*)(ws + WS_XN); bf16_t* MG = (bf16_t*)(ws + WS_MG); bf16_t* Z = (bf16_t*)(ws + WS_Z);
    bf16_t* U = (bf16_t*)(ws + WS_Z); bf16_t* Gb = (bf16_t*)(ws + WS_T); float* T = (float*)(ws + WS_T);

    if (EN(12) && IN(0)) for (int rep = 0; rep < REPS(12); ++rep) { p_prologue(F, args); SEAM(0); }

    for (int l = 0; l < DEPTH; ++l) {
        const int p0 = 1 + l * PH_PER_LAYER;
        if (hi <= p0 || lo >= p0 + PH_PER_LAYER) continue;
        unsigned char* wl = ws + WS_W + (size_t)l * W_LAYER;
        const float* xin = (l == 0) ? args.in[0] : X;
        if (EN(0) && IN(p0 + 0)) for (int rep = 0; rep < REPS(0); ++rep) { const int ol = opaque_tid() & 63; const float* g = args.in[3] + (size_t)l * DM; for (int m = opaque_s(gw); m < M; m += NGW) rms_row_bf16(xin + (size_t)m * DM, g, XN + (size_t)m * DM, ol); SEAM(p0 + 0); }
        if (EN(1) && IN(p0 + 1)) for (int rep = 0; rep < REPS(1); ++rep) {
            pg8::Gemm g{XN, (const bf16_t*)(wl + W_IN), M, ZLD, DM, DM, 0, 0}; pg8::StaticOrder S; S.init(M, ZLD, F.G, (int)blockIdx.x);
            pg8::EpiBf16 E{Z, ZLD, 0, 1.0f};
            pg8::gemm_phase<pg8::EpiBf16, pg8::StaticOrder, true>(F.lds + RING_OFF, g, S, E);
            SEAM(p0 + 1);
        }
        if (EN(2) && IN(p0 + 2)) for (int rep = 0; rep < REPS(2); ++rep) { p_prep(F, args, l); SEAM(p0 + 2); }
        if (EN(3) && IN(p0 + 3)) for (int rep = 0; rep < REPS(3); ++rep) {
            pg8::Gemm g{(const bf16_t*)(ws + WS_CQN), (const bf16_t*)(wl + W_UQ), M, 768, 512, 512, 0, 0}; pg8::StaticOrder S; S.init(M, 768, F.G, (int)blockIdx.x);
            pg8::EpiBf16 E{(bf16_t*)(ws + WS_QMLA), 768, 1, 0.07216878364870322f * LOG2E};
            pg8::gemm_phase<pg8::EpiBf16, pg8::StaticOrder, true>(F.lds + RING_OFF, g, S, E);
            SEAM(p0 + 3);
        }
        if (EN(4) && IN(p0 + 4)) for (int rep = 0; rep < REPS(4); ++rep) {
            pg8::Gemm g{(const bf16_t*)(ws + WS_CKVN), (const bf16_t*)(wl + W_UKV), M, 1024, 256, 256, 0, 0}; pg8::StaticOrder S; S.init(M, 1024, F.G, (int)blockIdx.x);
            pg8::EpiBf16 E{(bf16_t*)(ws + WS_KVMLA), 1024, 1, 1.0f};
            pg8::gemm_phase<pg8::EpiBf16, pg8::StaticOrder, true>(F.lds + RING_OFF, g, S, E);
            SEAM(p0 + 4);
        }
        if (EN(5) && IN(p0 + 5)) for (int rep = 0; rep < REPS(5); ++rep) {
            const double li[4] = {0.20000000000000007, 0.35550906759096934, 0.4707130183435842, 0.5560582041556406};
            AttnEnv E; E.Z = Z; E.QMLA = (const bf16_t*)(ws + WS_QMLA); E.KVMLA = (const bf16_t*)(ws + WS_KVMLA); E.KR = (const bf16_t*)(ws + WS_KR); E.BRO = (bf16_t*)(ws + WS_BRO);
            E.pos = (const int*)args.in[1]; E.pmm = (const int*)(ws + WS_PMM); E.btabg = (const float*)(ws + WS_BTAB); E.rope = (const f32x2*)(ws + WS_ROPE); E.kmean = (const float*)(ws + WS_KMEAN);
            E.dscr = (float*)(ws + WS_DSCR); E.subln_g = args.in[6] + (size_t)l * 128; E.sinks = args.in[11] + (size_t)l * 8; E.lam = __uint_as_float(__builtin_amdgcn_readfirstlane(__float_as_uint(((const float*)(ws + WS_LAM))[l])));
            E.one_m_li = __uint_as_float(__builtin_amdgcn_readfirstlane(__float_as_uint(1.0f - (float)(l == 0 ? li[0] : l == 1 ? li[1] : l == 2 ? li[2] : li[3]))));
            unsigned* qh = F.ctl + CW_QUEUE + 64 * (((rep * DEPTH + l) * 4) * 8);
            const int myx = (int)xb_xcc_id() & 7;
#define WCTX const int ot = opaque_tid(); const att::WaveCtx wctx{ot & 63, ot & 31, (ot >> 5) & 1, __builtin_amdgcn_readfirstlane(ot >> 6), ot}
            if (ENA(0)) for (int sx = 0; sx < 8; ++sx) { const int x = (myx + sx) & 7; for (;;) { const int j = queue_next(F, qh + 64 * (0 * 8 + x)); if (j >= 32) break; const int bh = x + 8 * (j & 1); WCTX; unit_diff(F.lds, E, bh >> 2, bh & 3, 15 - (j >> 1), wctx); } }
            if (ENA(1)) for (int sx = 0; sx < 8; ++sx) { const int x = (myx + sx) & 7; for (;;) { const int j = queue_next(F, qh + 64 * (1 * 8 + x)); if (j >= 32) break; const int bh = x + 8 * (j & 1); WCTX; unit_mla(F.lds, E, bh >> 2, bh & 3, 15 - (j >> 1), wctx); } }
            if (ENA(2)) for (int sx = 0; sx < 8; ++sx) { const int x = (myx + sx) & 7; for (;;) { const int j = queue_next(F, qh + 64 * (2 * 8 + x)); if (j >= 32) break; const int bh = x + 8 * (j & 1); WCTX; unit_moba(F.lds, E, bh >> 2, bh & 3, 15 - (j >> 1), wctx); } }
            if (ENA(3)) for (int sx = 0; sx < 8; ++sx) { const int x = (myx + sx) & 7; for (;;) { const int j = queue_next(F, qh + 64 * (3 * 8 + x)); if (j >= 64) break; WCTX; unit_swa(F.lds, E, x >> 1, 4 * (x & 1) + (j & 3), 15 - (j >> 2), wctx); } }
#undef WCTX
#if CHECK_BUILD
            if (l == 0 && rep == 0) { xcd_barrier(bar); chk_prep(F, args); xcd_barrier(bar); chk_items(F, args); }
#endif
            SEAM(p0 + 5);
        }
        if (EN(6) && IN(p0 + 6)) for (int rep = 0; rep < REPS(6); ++rep) {
            pg8::Gemm g{(const bf16_t*)(ws + WS_BRO), (const bf16_t*)(wl + W_BR), M, DM, 512, DM, (size_t)512 * 2, (size_t)DM * 512 * 2}; pg8::StaticOrder S; S.init_tiles(M / 128, DM / 128, F.G, (int)blockIdx.x, 2);
            pg8::EpiMergeDiag E{Z + ZG, ZLD, MG};
            pg8::gemm_phase<pg8::EpiMergeDiag, pg8::StaticOrder, true, true>(F.lds + RING_OFF, g, S, E);
            SEAM(p0 + 6);
        }
        if (EN(7) && IN(p0 + 7)) for (int rep = 0; rep < REPS(7); ++rep) {
            pg8::Gemm g{MG, (const bf16_t*)(wl + W_OUT), M, DM, DM, DM, 0, 0}; pg8::StaticOrder S; S.init(M, DM, F.G, (int)blockIdx.x);
            pg8::EpiResF32 E{xin, X, DM};
            pg8::gemm_phase<pg8::EpiResF32, pg8::StaticOrder, true>(F.lds + RING_OFF, g, S, E);
            SEAM(p0 + 7);
        }
        if (EN(8) && IN(p0 + 8)) for (int rep = 0; rep < REPS(8); ++rep) { const int ol = opaque_tid() & 63; const float* g = args.in[14] + (size_t)l * DM; for (int m = opaque_s(gw); m < M; m += NGW) rms_row_bf16(X + (size_t)m * DM, g, XN + (size_t)m * DM, ol); SEAM(p0 + 8); }
        if (EN(9) && IN(p0 + 9)) for (int rep = 0; rep < REPS(9); ++rep) {
            pg8::Gemm g{XN, (const bf16_t*)(wl + W_UP), M, UP_N, DM, DM, 0, 0}; pg8::StaticOrder S; S.init(M, UP_N, F.G, (int)blockIdx.x);
            pg8::EpiGlu E{Gb, args.in[16] + (size_t)l * 3 * FFN, args.in[17] + (size_t)l * FFN, (float*)(ws + WS_GTAIL), (float*)(ws + WS_GHEADA), (float*)(ws + WS_GHEADV)};
            pg8::gemm_phase<pg8::EpiGlu, pg8::StaticOrder, true>(F.lds + RING_OFF, g, S, E);
            SEAM(p0 + 9);
        }
        if (EN(10) && IN(p0 + 10)) for (int rep = 0; rep < REPS(10); ++rep) { p_glufix(F, args, l); SEAM(p0 + 10); }
        if (EN(11) && IN(p0 + 11)) for (int rep = 0; rep < REPS(11); ++rep) {
            pg8::Gemm g{Gb, (const bf16_t*)(wl + W_DN), M, DM, FFN, FFN, 0, 0}; pg8::StaticOrder S; S.init(M, DM, F.G, (int)blockIdx.x);
            pg8::EpiResF32 E{X, X, DM};
            pg8::gemm_phase<pg8::EpiResF32, pg8::StaticOrder, true>(F.lds + RING_OFF, g, S, E);
            SEAM(p0 + 11);
        }
    }
    if (IN(N_PHASES - 1)) { const int ol = opaque_tid() & 63; const float* g = args.in[19]; for (int m = opaque_s(gw); m < M; m += NGW) rms_row_f32(X + (size_t)m * DM, g, args.out + (size_t)m * DM, ol);
#if CHECK_BUILD
        xcd_barrier(bar);
        if (blockIdx.x == 0 && threadIdx.x == 0) {
            float code = 0.f;
            for (int ty = 0; ty < 3; ++ty) { const float rt = __uint_as_float(__hip_atomic_load(F.ctl + CW_CHK + 2 * ty, RLX_AGENT)); const unsigned seen = __hip_atomic_load(F.ctl + CW_CHK + 2 * ty + 1, RLX_AGENT);
                if (!(rt <= CHECK_TOL) || seen == 0u) code += (float)(64 << ty); }
            if (CHECK_REPORT >= 0) code = 1.0e4f * __uint_as_float(__hip_atomic_load(F.ctl + CW_CHK + 2 * CHECK_REPORT, RLX_AGENT));
            if (code != 0.f) args.out[0] = code;
        }
#endif
    }
#undef IN
#undef SEAM
}

extern "C" void kernel_launch(void* const* d_in, const int* in_sizes, int n_in, void* d_out, int out_size, void* d_ws, size_t ws_size, hipStream_t stream) {
    static int grid = 0;
    if (grid == 0) {
        if (n_in != 20 || in_sizes[0] != M * DM || out_size != M * DM || ws_size < WS_END + (CHECK_BUILD ? 20 * MiB : 0)) {
            fprintf(stderr, "kernel_launch: shape / workspace mismatch (n_in %d, in0 %d, out %d, ws %zu, need %zu); nothing launched\n", n_in, n_in > 0 ? in_sizes[0] : -1, out_size, ws_size, (size_t)WS_END); grid = -1; return; }
        int dev = 0, cus = 0, per_cu = 0;
        if (hipGetDevice(&dev) != hipSuccess || hipDeviceGetAttribute(&cus, hipDeviceAttributeMultiprocessorCount, dev) != hipSuccess) { grid = -1; return; }
        if (hipFuncSetAttribute((const void*)trunk_fwd, hipFuncAttributeMaxDynamicSharedMemorySize, LDS_BYTES) != hipSuccess) { fprintf(stderr, "kernel_launch: hipFuncSetAttribute failed\n"); grid = -1; return; }
        if (hipOccupancyMaxActiveBlocksPerMultiprocessor(&per_cu, (const void*)trunk_fwd, NWAVES * 64, LDS_BYTES) != hipSuccess || per_cu < 1)
            fprintf(stderr, "kernel_launch: note: occupancy query reports %d workgroups per CU\n", per_cu);
        (void)hipGetLastError();
        grid = cus;
    }
    if (grid < 0) return;
    if (hipMemsetAsync((char*)d_ws + WS_CTL, 0, CTL_ZERO_BYTES, stream) != hipSuccess) return;
    Args a{};
    for (int i = 0; i < 20; ++i) a.in[i] = (const float*)d_in[i];
    a.out = (float*)d_out; a.ws = (unsigned char*)d_ws;
#if MK_N_LAUNCHES == 1
    a.ph_lo = 0; a.ph_hi = N_PHASES;
    hipLaunchKernelGGL(trunk_fwd, dim3(grid), dim3(NWAVES * 64), LDS_BYTES, stream, a);
#else
    for (int p = 0; p < N_PHASES; ++p) { a.ph_lo = p; a.ph_hi = p + 1; hipLaunchKernelGGL(trunk_fwd, dim3(grid), dim3(NWAVES * 64), LDS_BYTES, stream, a); }
#endif
    const hipError_t le = hipPeekAtLastError();
    if (le != hipSuccess) fprintf(stderr, "kernel_launch: launch failed: %s\n", hipGetErrorName(le));
}
```

```cpp
#include <hip/hip_runtime.h>
#include <cstdio>
#include <cstdint>

#ifndef PROF_BUILD
#define PROF_BUILD 0
#endif
#ifndef PROF_ID
#define PROF_ID 1
#endif
#ifndef MK_N_LAUNCHES
#define MK_N_LAUNCHES 1
#endif

#define GAS __attribute__((address_space(1)))
#define LAS __attribute__((address_space(3)))
typedef unsigned short bf16_t;
typedef short bf16x8 __attribute__((ext_vector_type(8)));
typedef short s16x4 __attribute__((ext_vector_type(4)));
typedef float f32x2 __attribute__((ext_vector_type(2)));
typedef float f32x4 __attribute__((ext_vector_type(4)));
typedef float f32x16 __attribute__((ext_vector_type(16)));
typedef unsigned u32x2 __attribute__((ext_vector_type(2)));
typedef unsigned u32x4 __attribute__((ext_vector_type(4)));
typedef int i32x4 __attribute__((ext_vector_type(4)));

constexpr int DM = 2048, NB = 4, SEQ = 4096, DEPTH = 4, M = NB * SEQ;
constexpr int IN_COLS = 12864, ZLD = 13056;
constexpr int ZQA = 0, ZKA = 512, ZVA = 1024, ZCQ = 1536, ZCKV = 2048, ZKR = 2304, ZSQ = 2560, ZSK = 3072, ZSV = 3200, ZMQ = 3328, ZMK = 3840, ZMV = 4352, ZG = 4864;
constexpr int FFN = 5632, UP_N = 2 * FFN;
constexpr float LOG2E = 1.4426950408889634f;
constexpr float EPS = 1e-6f;
constexpr float NEG_INF = -__builtin_huge_valf();

typedef __bf16 bf16x2_t __attribute__((ext_vector_type(2)));
__device__ __forceinline__ unsigned cvt_pk_bf16(float lo, float hi) { const f32x2 v = {lo, hi}; return __builtin_bit_cast(unsigned, __builtin_convertvector(v, bf16x2_t)); }
__device__ __forceinline__ float bf2f(unsigned short h) { return __uint_as_float(((unsigned)h) << 16); }
__device__ __forceinline__ float bflo(unsigned w) { return __uint_as_float(w << 16); }
__device__ __forceinline__ float bfhi(unsigned w) { return __uint_as_float(w & 0xffff0000u); }
template <int XORM> __device__ __forceinline__ float swz_xor(float v) { return __int_as_float(__builtin_amdgcn_ds_swizzle(__float_as_int(v), (XORM << 10) | 0x1F)); }
__device__ __forceinline__ float half_sum(float v) { const auto rr = __builtin_amdgcn_permlane32_swap(__float_as_uint(v), __float_as_uint(v), false, false); return __uint_as_float(rr[0]) + __uint_as_float(rr[1]); }
__device__ __forceinline__ float half_max(float v) { const auto rr = __builtin_amdgcn_permlane32_swap(__float_as_uint(v), __float_as_uint(v), false, false); return fmaxf(__uint_as_float(rr[0]), __uint_as_float(rr[1])); }
__device__ __forceinline__ float wave_sum(float v) {
    v += swz_xor<1>(v); v += swz_xor<2>(v); v += swz_xor<4>(v); v += swz_xor<8>(v); v += swz_xor<16>(v);
    return half_sum(v);
}
__device__ __forceinline__ float wave_max(float v) {
    v = fmaxf(v, swz_xor<1>(v)); v = fmaxf(v, swz_xor<2>(v)); v = fmaxf(v, swz_xor<4>(v)); v = fmaxf(v, swz_xor<8>(v)); v = fmaxf(v, swz_xor<16>(v));
    return half_max(v);
}
__device__ __forceinline__ unsigned fresh_lane_id() { unsigned m = ~0u; asm volatile("" : "+s"(m)); return __builtin_amdgcn_mbcnt_hi(m, __builtin_amdgcn_mbcnt_lo(m, 0u)); }
__device__ __forceinline__ int opaque_tid(int wave) { int t = wave * 64 + (int)fresh_lane_id(); asm volatile("" : "+v"(t)); return t; }
__device__ __forceinline__ bool is_thread0(int wave) { return wave == 0 && fresh_lane_id() == 0u; }
__device__ __forceinline__ int opaque_s(int x) { asm volatile("" : "+s"(x)); return x; }
__device__ __forceinline__ float fast_sigmoid(float x) { return __builtin_amdgcn_rcpf(1.0f + __builtin_amdgcn_exp2f(-x * LOG2E)); }

namespace pg8 {
constexpr int BM = 256, BK = 64, HALF = 128, HTB = HALF * BK * 2, STAGE_BYTES = 8 * HTB, NXCD = 8, WGM = 8;
__host__ __device__ __forceinline__ int lds_byte(int r, int c) { const int st = (r >> 4) * 2 + (c >> 5), rr = r & 15, cc = c & 31, ob = rr * 64 + cc * 2; return st * 1024 + (ob ^ (((ob >> 9) & 1) << 5)); }
__host__ __device__ __forceinline__ void stage_rc(int b, int& R, int& C) { const int st = b / 1024, sb = b % 1024, swz = sb ^ (((sb >> 9) & 1) << 5); R = (st >> 1) * 16 + swz / 64; C = (st & 1) * 32 + (swz % 64) / 2; }
__host__ __device__ __forceinline__ int perm32(int rho) { const int n = rho >> 4, i = rho & 15; return 8 * (i >> 2) + 4 * n + (i & 3); }

struct Unit { int pm, pn, z; };
struct Gemm { const bf16_t* A; const bf16_t* Bt; int M, N, K, lda; size_t zA, zB; };

struct StaticOrder {
    int nM, nN, nwg, G, c, nZ;
    __device__ void init(int M_, int N_, int G_, int c_, int nZ_ = 1) { nM = M_ / BM; nN = N_ / BM; nwg = nM * nN; G = G_; c = c_; nZ = nZ_; }
    __device__ void init_tiles(int nM_, int nN_, int G_, int c_, int nZ_) { nM = nM_; nN = nN_; nwg = nM * nN; G = G_; c = c_; nZ = nZ_; }
    __device__ bool next(int i, Unit& u) const {
        const int it = i / nZ; u.z = i - it * nZ;
        const long L = (long)it * G + c; if (L >= nwg) return false;
        int wgid = (int)L; { const int q = nwg / NXCD, r = nwg % NXCD, xcd = wgid % NXCD, off = wgid / NXCD; wgid = (xcd < r ? xcd * (q + 1) : r * (q + 1) + (xcd - r) * q) + off; }
        const int nig = WGM * nN, gid = wgid / nig, fm = gid * WGM, gsz = (nM - fm) < WGM ? (nM - fm) : WGM;
        u.pm = fm + ((wgid % nig) % gsz); u.pn = (wgid % nig) / gsz; return true;
    }
};


__device__ __forceinline__ float rs_of(unsigned long long q, float invn = 1.0f / DM) {
    const float f = (float)(unsigned)(q >> 32) * 256.0f + (float)(unsigned)q * (1.0f / 16777216.0f);
    return __builtin_amdgcn_rsqf(f * invn + EPS);
}
__device__ __forceinline__ void ssq_add(unsigned long long* ssq, const u32x4& w0, const u32x4& w1, int row, int k, int fq) {
    float q = 0.f;
#pragma unroll
    for (int e = 0; e < 4; ++e) { const float a = bflo(w0[e]), b = bfhi(w0[e]), c = bflo(w1[e]), d = bfhi(w1[e]); q += (a * a + b * b) + (c * c + d * d); }
    q += swz_xor<16>(q); q = half_sum(q);
    if (fq == (k & 3)) { const unsigned hi = (unsigned)q; const unsigned lo = (unsigned)((q - (float)hi) * 16777216.0f);
        atomicAdd(ssq + row, ((unsigned long long)hi << 24) + lo); }
}
constexpr int RS_LDS = STAGE_BYTES;
__device__ __forceinline__ float rs_lds(const LAS unsigned char* lds, int wid, int ai, int m, int fr, float invn = 1.0f / DM) {
    return rs_of(*(const LAS unsigned long long*)(lds + RS_LDS + wid * 1024 + ai * 512 + (m * 16 + fr) * 8), invn);
}
struct EpiBf16 {
    bf16_t* O; int ldc; int kind;
    float sc;
    const unsigned long long* ssq;
    float invn;
    unsigned long long* sq_q; unsigned long long* sq_kv;
    static constexpr bool RS = true;
    __device__ __forceinline__ void operator()(const f32x4 (&acc)[2][2][4][2], const LAS unsigned char* lds, const Unit& u, int wr, int wc, int fr, int fq) const {
        float s = sc; unsigned long long* sqo = nullptr;
        if (kind == 0) {
            const int pn = u.pn;
            s = 1.0f;
            if (pn < 2 || pn == 10 || pn == 11) s = 0.125f * LOG2E;
            else if (pn == 13 || pn == 14) s = 0.08838834764831845f * LOG2E;
            if (pn == 6 || pn == 7) sqo = sq_q; else if (pn == 8) sqo = sq_kv;
        }
        const int row0 = u.pm * BM + wr * 64 + fr, col0 = u.pn * BM + wc * 32 + 8 * fq;
        const float s0 = s;
#pragma unroll
        for (int ai = 0; ai < 2; ++ai)
#pragma unroll
            for (int m = 0; m < 4; ++m) { const int row = row0 + ai * HALF + m * 16; bf16_t* rowp = O + (size_t)row * ldc + col0; const float s = ssq ? s0 * rs_lds(lds, wr * 4 + wc, ai, m, fr, invn) : s0;
                u32x4 w[2];
#pragma unroll
                for (int bj = 0; bj < 2; ++bj) { const f32x4 v0 = acc[ai][bj][m][0] * s, v1 = acc[ai][bj][m][1] * s;
                    w[bj].x = cvt_pk_bf16(v0[0], v0[1]); w[bj].y = cvt_pk_bf16(v0[2], v0[3]); w[bj].z = cvt_pk_bf16(v1[0], v1[1]); w[bj].w = cvt_pk_bf16(v1[2], v1[3]);
                    *(u32x4*)(rowp + bj * HALF) = w[bj]; }
                if (sqo) ssq_add(sqo, w[0], w[1], row, m, fq); }
    }
};
struct EpiGate {
    bf16_t* O; int ldc; float sc0; int lo; const unsigned long long* ssq;
    static constexpr bool RS = true;
    __device__ __forceinline__ void operator()(const f32x4 (&acc)[2][2][4][2], const LAS unsigned char* lds, const Unit& u, int wr, int wc, int fr, int fq) const {
        const int row0 = u.pm * BM + wr * 64 + fr, col0 = u.pn * BM + wc * 32 + 8 * fq;
        const bool sig = u.pn >= lo;
        float rs[2][4];
#pragma unroll
        for (int ai = 0; ai < 2; ++ai)
#pragma unroll
            for (int m = 0; m < 4; ++m) rs[ai][m] = sc0 * rs_lds(lds, wr * 4 + wc, ai, m, fr);
#pragma unroll
        for (int ai = 0; ai < 2; ++ai)
#pragma unroll
            for (int m = 0; m < 4; ++m) { bf16_t* rowp = O + (size_t)(row0 + ai * HALF + m * 16) * ldc + col0; const float sc = rs[ai][m];
#pragma unroll
                for (int bj = 0; bj < 2; ++bj) { f32x4 v0 = acc[ai][bj][m][0], v1 = acc[ai][bj][m][1];
                    if (sig) {
#pragma unroll
                        for (int e = 0; e < 4; ++e) { v0[e] = fast_sigmoid(v0[e] * sc); v1[e] = fast_sigmoid(v1[e] * sc); }
                    } else { v0 = v0 * sc; v1 = v1 * sc; }
                    u32x4 w; w.x = cvt_pk_bf16(v0[0], v0[1]); w.y = cvt_pk_bf16(v0[2], v0[3]); w.z = cvt_pk_bf16(v1[0], v1[1]); w.w = cvt_pk_bf16(v1[2], v1[3]);
                    *(u32x4*)(rowp + bj * HALF) = w; } }
    }
};
struct EpiResBf16 {
    static constexpr bool RS = false;
    const float* base32; const bf16_t* base16; bf16_t* out; int ldc; unsigned long long* ssq; unsigned char* x8;
    static __device__ __forceinline__ unsigned pk4_e4m3(float a, float b, float c, float d) { int w = __builtin_amdgcn_cvt_pk_fp8_f32(a, b, 0, false); w = __builtin_amdgcn_cvt_pk_fp8_f32(c, d, w, true); return (unsigned)w; }
    __device__ __forceinline__ void store8(const u32x4& w, size_t off) const { u32x2 o; o.x = pk4_e4m3(bflo(w.x), bfhi(w.x), bflo(w.y), bfhi(w.y)); o.y = pk4_e4m3(bflo(w.z), bfhi(w.z), bflo(w.w), bfhi(w.w)); *(u32x2*)(x8 + off) = o; }
    __device__ __forceinline__ void operator()(const f32x4 (&acc)[2][2][4][2], const Unit& u, int wr, int wc, int fr, int fq) const {
        const int row0 = u.pm * BM + wr * 64 + fr, col0 = u.pn * BM + wc * 32 + 8 * fq;
        if (base32) {
            f32x4 bv[2][2][2];
#define PG8_RES_LOAD(buf, k) do { const size_t off_ = (size_t)(row0 + ((k) >> 2) * HALF + ((k) & 3) * 16) * ldc + col0; \
            _Pragma("unroll") for (int bj = 0; bj < 2; ++bj) { bv[buf][bj][0] = *(const f32x4*)(base32 + off_ + bj * HALF); bv[buf][bj][1] = *(const f32x4*)(base32 + off_ + bj * HALF + 4); } } while (0)
            PG8_RES_LOAD(0, 0);
#pragma unroll
            for (int k = 0; k < 8; ++k) {
                if (k + 1 < 8) PG8_RES_LOAD((k + 1) & 1, k + 1);
                const int ai = k >> 2, m = k & 3, row = row0 + ai * HALF + m * 16; const size_t off = (size_t)row * ldc + col0;
                u32x4 w[2];
#pragma unroll
                for (int bj = 0; bj < 2; ++bj) { const f32x4 t0 = bv[k & 1][bj][0] + acc[ai][bj][m][0], t1 = bv[k & 1][bj][1] + acc[ai][bj][m][1];
                    w[bj].x = cvt_pk_bf16(t0[0], t0[1]); w[bj].y = cvt_pk_bf16(t0[2], t0[3]); w[bj].z = cvt_pk_bf16(t1[0], t1[1]); w[bj].w = cvt_pk_bf16(t1[2], t1[3]);
                    *(u32x4*)(out + off + bj * HALF) = w[bj]; if (x8) store8(w[bj], off + bj * HALF); }
                if (ssq) ssq_add(ssq, w[0], w[1], row, k, fq);
            }
#undef PG8_RES_LOAD
        } else {
            u32x4 bv[2][2];
#define PG8_RES_LOAD(buf, k) do { const size_t off_ = (size_t)(row0 + ((k) >> 2) * HALF + ((k) & 3) * 16) * ldc + col0; \
            _Pragma("unroll") for (int bj = 0; bj < 2; ++bj) bv[buf][bj] = *(const u32x4*)(base16 + off_ + bj * HALF); } while (0)
            PG8_RES_LOAD(0, 0);
#pragma unroll
            for (int k = 0; k < 8; ++k) {
                if (k + 1 < 8) PG8_RES_LOAD((k + 1) & 1, k + 1);
                const int ai = k >> 2, m = k & 3, row = row0 + ai * HALF + m * 16; const size_t off = (size_t)row * ldc + col0;
                u32x4 w[2];
#pragma unroll
                for (int bj = 0; bj < 2; ++bj) { const u32x4 p = bv[k & 1][bj];
                    const f32x4 t0 = (f32x4){bflo(p.x), bfhi(p.x), bflo(p.y), bfhi(p.y)} + acc[ai][bj][m][0], t1 = (f32x4){bflo(p.z), bfhi(p.z), bflo(p.w), bfhi(p.w)} + acc[ai][bj][m][1];
                    w[bj].x = cvt_pk_bf16(t0[0], t0[1]); w[bj].y = cvt_pk_bf16(t0[2], t0[3]); w[bj].z = cvt_pk_bf16(t1[0], t1[1]); w[bj].w = cvt_pk_bf16(t1[2], t1[3]);
                    *(u32x4*)(out + off + bj * HALF) = w[bj]; if (x8) store8(w[bj], off + bj * HALF); }
                if (ssq) ssq_add(ssq, w[0], w[1], row, k, fq);
            }
#undef PG8_RES_LOAD
        }
    }
};
struct EpiMerge {
    static constexpr bool RS = false;
    const bf16_t* gate; int ldg;
    float* T; bf16_t* Mg;
    __device__ __forceinline__ void operator()(const f32x4 (&acc)[2][2][4][2], const Unit& u, int wr, int wc, int fr, int fq) const {
        const int row0 = u.pm * BM + wr * 64 + fr, col0 = u.pn * BM + wc * 32 + 8 * fq, z = u.z;
        u32x4 gv[2][2]; f32x4 tv[2][2][2];
#define PG8_MG_LOAD(buf, k) do { const int row_ = row0 + ((k) >> 2) * HALF + ((k) & 3) * 16; const size_t off_ = (size_t)row_ * DM + col0; \
            _Pragma("unroll") for (int bj = 0; bj < 2; ++bj) { gv[buf][bj] = *(const u32x4*)(gate + (size_t)row_ * ldg + z * DM + col0 + bj * HALF); \
                if (z > 0) { tv[buf][bj][0] = *(const f32x4*)(T + off_ + bj * HALF); tv[buf][bj][1] = *(const f32x4*)(T + off_ + bj * HALF + 4); } \
                else { tv[buf][bj][0] = (f32x4){0.f, 0.f, 0.f, 0.f}; tv[buf][bj][1] = (f32x4){0.f, 0.f, 0.f, 0.f}; } } } while (0)
        PG8_MG_LOAD(0, 0);
#pragma unroll
        for (int k = 0; k < 8; ++k) {
            if (k + 1 < 8) PG8_MG_LOAD((k + 1) & 1, k + 1);
            const int ai = k >> 2, m = k & 3; const size_t off = (size_t)(row0 + ai * HALF + m * 16) * DM + col0;
#pragma unroll
            for (int bj = 0; bj < 2; ++bj) {
                const u32x4 g = gv[k & 1][bj];
                const f32x4 g0 = (f32x4){bflo(g.x), bfhi(g.x), bflo(g.y), bfhi(g.y)}, g1 = (f32x4){bflo(g.z), bfhi(g.z), bflo(g.w), bfhi(g.w)};
                const f32x4 t0 = tv[k & 1][bj][0] + g0 * acc[ai][bj][m][0], t1 = tv[k & 1][bj][1] + g1 * acc[ai][bj][m][1];
                if (z < 3) { *(f32x4*)(T + off + bj * HALF) = t0; *(f32x4*)(T + off + bj * HALF + 4) = t1; }
                else { u32x4 w; w.x = cvt_pk_bf16(t0[0], t0[1]); w.y = cvt_pk_bf16(t0[2], t0[3]); w.z = cvt_pk_bf16(t1[0], t1[1]); w.w = cvt_pk_bf16(t1[2], t1[3]);
                    *(u32x4*)(Mg + off + bj * HALF) = w; } }
        }
#undef PG8_MG_LOAD
    }
};

struct EpiMergeDiag {
    static constexpr bool RS = false;
    const bf16_t* gate; int ldg; bf16_t* Mg;
    __device__ __forceinline__ void operator()(f32x4 (&acc)[2][2][4][2], const Unit& u, int wr, int wc, int fr, int fq) const {
        const int row0 = u.pm * HALF + wr * 64 + fr, col0 = u.pn * HALF + wc * 32 + 8 * fq, z0 = 2 * u.z;
#pragma unroll
        for (int m = 0; m < 4; ++m) { const int row = row0 + m * 16;
            const u32x4 ga = *(const u32x4*)(gate + (size_t)row * ldg + z0 * DM + col0), gb = *(const u32x4*)(gate + (size_t)row * ldg + (z0 + 1) * DM + col0);
            const f32x4 a0 = (f32x4){bflo(ga.x), bfhi(ga.x), bflo(ga.y), bfhi(ga.y)}, a1 = (f32x4){bflo(ga.z), bfhi(ga.z), bflo(ga.w), bfhi(ga.w)};
            const f32x4 b0 = (f32x4){bflo(gb.x), bfhi(gb.x), bflo(gb.y), bfhi(gb.y)}, b1 = (f32x4){bflo(gb.z), bfhi(gb.z), bflo(gb.w), bfhi(gb.w)};
            f32x4 t0 = a0 * acc[0][0][m][0] + b0 * acc[1][1][m][0], t1 = a1 * acc[0][0][m][1] + b1 * acc[1][1][m][1];
            if (u.z == 0) { acc[0][1][m][0] = t0; acc[0][1][m][1] = t1; }
            else { t0 = t0 + acc[0][1][m][0]; t1 = t1 + acc[0][1][m][1];
                u32x4 w; w.x = cvt_pk_bf16(t0[0], t0[1]); w.y = cvt_pk_bf16(t0[2], t0[3]); w.z = cvt_pk_bf16(t1[0], t1[1]); w.w = cvt_pk_bf16(t1[2], t1[3]);
                *(u32x4*)(Mg + (size_t)row * DM + col0) = w; } }
    }
};

__device__ __forceinline__ float gelu_erf(float v) {
    const float av = fabsf(v), d = av * 0.2316418882f + 1.0f;
    const float t = __builtin_amdgcn_rcpf(d);
    float q = t * 0.5307027145f + (-0.7265760135f); q = q * t + 0.7107068705f; q = q * t + (-0.142248368f); q = q * t + 0.127414796f; q = q * t;
    const float e = __builtin_amdgcn_exp2f((v * v) * (-0.72134752044f));
    const float m = v * (q * e), r = v - m;
    return v < 0.f ? m : r;
}
__device__ __forceinline__ f32x2 gelu_pk(f32x2 v) {
    f32x2 z; z.x = __builtin_amdgcn_fmed3f(v.x, -4.0f, 4.0f); z.y = __builtin_amdgcn_fmed3f(v.y, -4.0f, 4.0f);
    const f32x2 s = z * z;
    f32x2 p = s * (-1.278033807e-09f) + 1.044463725e-07f; p = p * s + (-3.709719858e-06f); p = p * s + 7.619161683e-05f; p = p * s + (-1.021055556e-03f);
    p = p * s + 9.581421419e-03f; p = p * s + (-6.606413978e-02f); p = p * s + 3.988055566e-01f;
    return v * (z * p + 0.5f);
}
__device__ __forceinline__ float dpp_shr1(float old, float src) { return __int_as_float(__builtin_amdgcn_update_dpp(__float_as_int(old), __float_as_int(src), 0x111, 0xf, 0xf, false)); }
__device__ __forceinline__ float dpp_shr2(float old, float src) { return __int_as_float(__builtin_amdgcn_update_dpp(__float_as_int(old), __float_as_int(src), 0x112, 0xf, 0xf, false)); }
__device__ __forceinline__ float dpp_ror1(float src) { return __int_as_float(__builtin_amdgcn_update_dpp(__float_as_int(src), __float_as_int(src), 0x121, 0xf, 0xf, false)); }
__device__ __forceinline__ float dpp_ror2(float src) { return __int_as_float(__builtin_amdgcn_update_dpp(__float_as_int(src), __float_as_int(src), 0x122, 0xf, 0xf, false)); }
struct EpiGlu {
    bf16_t* G; const float* cw; const float* cb; float* tail; float* heada; float* headv;
    const unsigned long long* ssq;
    static constexpr bool RS = true;
    __device__ __forceinline__ void operator()(const f32x4 (&acc)[2][2][4][2], const LAS unsigned char* lds, const Unit& u, int wr, int wc, int fr, int fq) const {
        const int ch0 = u.pn * HALF + wc * 32 + 8 * fq;
        f32x2 w0[4], w1[4], w2[4], bb[4];
#pragma unroll
        for (int h = 0; h < 2; ++h) { const f32x4 t0 = *(const f32x4*)(cw + ch0 + 4 * h), t1 = *(const f32x4*)(cw + FFN + ch0 + 4 * h), t2 = *(const f32x4*)(cw + 2 * FFN + ch0 + 4 * h), t3 = *(const f32x4*)(cb + ch0 + 4 * h);
            w0[2 * h] = (f32x2){t0[0], t0[1]}; w0[2 * h + 1] = (f32x2){t0[2], t0[3]}; w1[2 * h] = (f32x2){t1[0], t1[1]}; w1[2 * h + 1] = (f32x2){t1[2], t1[3]};
            w2[2 * h] = (f32x2){t2[0], t2[1]}; w2[2 * h + 1] = (f32x2){t2[2], t2[3]}; bb[2 * h] = (f32x2){t3[0], t3[1]}; bb[2 * h + 1] = (f32x2){t3[2], t3[3]}; }
        float rs[2][4];
#pragma unroll
        for (int ai = 0; ai < 2; ++ai)
#pragma unroll
            for (int m = 0; m < 4; ++m) rs[ai][m] = rs_lds(lds, wr * 4 + wc, ai, m, fr);
#pragma unroll
        for (int ai = 0; ai < 2; ++ai) {
            const int gid = u.pm * 4 + ai * 2 + wr, rowg = gid * 64;
            float q1[8], q2[8];
#pragma unroll
            for (int c = 0; c < 8; ++c) { q1[c] = 0.f; q2[c] = 0.f; }
#pragma unroll
            for (int m = 0; m < 4; ++m) {
                float a8[8], v8[8], p1[8], p2[8];
#pragma unroll
                for (int n = 0; n < 2; ++n)
#pragma unroll
                    for (int e = 0; e < 4; ++e) { a8[4 * n + e] = acc[ai][0][m][n][e] * rs[ai][m]; v8[4 * n + e] = acc[ai][1][m][n][e] * rs[ai][m]; }
#pragma unroll
                for (int c = 0; c < 8; ++c) { p1[c] = dpp_shr1(q1[c], a8[c]); p2[c] = dpp_shr2(q2[c], a8[c]); q1[c] = dpp_ror1(a8[c]); q2[c] = dpp_ror2(a8[c]); }
                const int row = rowg + m * 16 + fr;
                if (m == 0 && fr < 2) {
                    float* ha = heada + ((size_t)gid * 2 + fr) * FFN + ch0; float* hv = headv + ((size_t)gid * 2 + fr) * FFN + ch0;
                    *(f32x4*)ha = (f32x4){a8[0], a8[1], a8[2], a8[3]}; *(f32x4*)(ha + 4) = (f32x4){a8[4], a8[5], a8[6], a8[7]};
                    *(f32x4*)hv = (f32x4){v8[0], v8[1], v8[2], v8[3]}; *(f32x4*)(hv + 4) = (f32x4){v8[4], v8[5], v8[6], v8[7]};
                } else {
                    f32x2 o[4];
#pragma unroll
                    for (int c = 0; c < 4; ++c) { const f32x2 av = (f32x2){a8[2 * c], a8[2 * c + 1]}, pv1 = (f32x2){p1[2 * c], p1[2 * c + 1]}, pv2 = (f32x2){p2[2 * c], p2[2 * c + 1]}, vv = (f32x2){v8[2 * c], v8[2 * c + 1]};
                        o[c] = gelu_pk(bb[c] + w0[c] * pv2 + w1[c] * pv1 + w2[c] * av) * vv; }
                    u32x4 w; w.x = cvt_pk_bf16(o[0].x, o[0].y); w.y = cvt_pk_bf16(o[1].x, o[1].y); w.z = cvt_pk_bf16(o[2].x, o[2].y); w.w = cvt_pk_bf16(o[3].x, o[3].y);
                    *(u32x4*)(G + (size_t)row * FFN + ch0) = w;
                }
                if (m == 3 && fr >= 14) { float* tl = tail + ((size_t)gid * 2 + (fr - 14)) * FFN + ch0;
                    *(f32x4*)tl = (f32x4){a8[0], a8[1], a8[2], a8[3]}; *(f32x4*)(tl + 4) = (f32x4){a8[4], a8[5], a8[6], a8[7]}; }
            }
        }
    }
};

template <class Epi, class Sched, bool ALIGN_EPI, bool DIAG = false, bool F8 = false>
__device__ __forceinline__ void gemm_phase(LAS unsigned char* lds, const Gemm g, const Sched& S, const Epi& E, int wave) {
    const int tid = opaque_tid(wave), wid = __builtin_amdgcn_readfirstlane(tid >> 6), lane = tid & 63, wr = wid >> 2, wc = wid & 3, fr = lane & 15, fq = lane >> 4;
    const int K = g.K, nt = F8 ? K / (2 * BK) : K / BK, lda = g.lda;
    const int rowA = F8 ? lda : lda * 2, rowB = F8 ? K : K * 2;
    unsigned voffA[2], voffB[2];
#pragma unroll
    for (int i = 0; i < 2; ++i) { int R, C; stage_rc(tid * 16 + i * 8192, R, C); const int Rb = (R & ~31) + perm32(R & 31);
        voffA[i] = (unsigned)(R * rowA + C * 2); voffB[i] = (unsigned)(Rb * rowB + C * 2); }
    const size_t kstep = (size_t)(BK * 2);
    const size_t hstepA = DIAG ? g.zA : (size_t)HALF * rowA, hstepB = DIAG ? g.zB : (size_t)HALF * rowB;
    const size_t tstepA = (DIAG ? 1 : 2) * (size_t)HALF * rowA, tstepB = (DIAG ? 1 : 2) * (size_t)HALF * rowB;
    const size_t zsA = (DIAG ? 2 : 1) * g.zA, zsB = (DIAG ? 2 : 1) * g.zB;
    const unsigned ldsw = (unsigned)wid * 1024u;
    const int aoff = lds_byte(wr * 64 + fr, fq * 8), boff = lds_byte(wc * 32 + fr, fq * 8);
#define PG8_SA(b, h) (((b) * 2 + (h)) * HTB)
#define PG8_SB(b, h) ((4 + (b) * 2 + (h)) * HTB)
#define PG8_STAGE(bufoff, gbase, voff) do { _Pragma("unroll") for (int _i = 0; _i < 2; ++_i) \
        __builtin_amdgcn_global_load_lds((const unsigned*)((const char*)(gbase) + (voff)[_i]), (LAS unsigned*)(lds + (bufoff) + ldsw + _i * 8192), 16, 0, 0); } while (0)
#define PG8_LDA(dst, b, h) do { if constexpr (F8) { _Pragma("unroll") for (int m = 0; m < 4; ++m) { const v4i_t lo_ = *(const LAS v4i_t*)(lds + PG8_SA(b, h) + aoff + m * 2048), hi_ = *(const LAS v4i_t*)(lds + PG8_SA(b, h) + aoff + m * 2048 + 1024); \
            dst##8[m] = __builtin_shufflevector(lo_, hi_, 0, 1, 2, 3, 4, 5, 6, 7); } } \
        else { _Pragma("unroll") for (int m = 0; m < 4; ++m) _Pragma("unroll") for (int k = 0; k < 2; ++k) dst[m][k] = *(const LAS bf16x8*)(lds + PG8_SA(b, h) + aoff + m * 2048 + k * 1024); } } while (0)
#define PG8_LDB(dst, b, h) do { if constexpr (F8) { _Pragma("unroll") for (int n = 0; n < 2; ++n) { const v4i_t lo_ = *(const LAS v4i_t*)(lds + PG8_SB(b, h) + boff + n * 2048), hi_ = *(const LAS v4i_t*)(lds + PG8_SB(b, h) + boff + n * 2048 + 1024); \
            dst##8[n] = __builtin_shufflevector(lo_, hi_, 0, 1, 2, 3, 4, 5, 6, 7); } } \
        else { _Pragma("unroll") for (int n = 0; n < 2; ++n) _Pragma("unroll") for (int k = 0; k < 2; ++k) dst[n][k] = *(const LAS bf16x8*)(lds + PG8_SB(b, h) + boff + n * 2048 + k * 1024); } } while (0)
#define PG8_MMA(ai, bj, At, Bt) do { __builtin_amdgcn_s_setprio(1); \
        if constexpr (F8) { _Pragma("unroll") for (int m = 0; m < 4; ++m) _Pragma("unroll") for (int n = 0; n < 2; ++n) \
                asm volatile("v_mfma_scale_f32_16x16x128_f8f6f4 %0, %1, %2, %0, %3, %3 op_sel_hi:[0,0,0]" : "+v"(acc[ai][bj][m][n]) : "v"(Bt##8[n]), "v"(At##8[m]), "v"(f8scale)); } \
        else { _Pragma("unroll") for (int m = 0; m < 4; ++m) _Pragma("unroll") for (int n = 0; n < 2; ++n) _Pragma("unroll") for (int k = 0; k < 2; ++k) \
            acc[ai][bj][m][n] = __builtin_amdgcn_mfma_f32_16x16x32_bf16(Bt[n][k], At[m][k], acc[ai][bj][m][n], 0, 0, 0); } \
        __builtin_amdgcn_s_setprio(0); } while (0)
#define PG8_WAIT_V(n) asm volatile("s_waitcnt vmcnt(" #n ")" ::: "memory")
#define PG8_WAIT_L(n) asm volatile("s_waitcnt lgkmcnt(" #n ")" ::: "memory")
#define PG8_BAR __builtin_amdgcn_s_barrier()
#define PG8_SCHED __builtin_amdgcn_sched_barrier(0)
    Unit cur, nxt; int ui = 0;
    if (!S.next(0, cur)) return;
    f32x4 acc[2][2][4][2];
#pragma unroll
    for (int a = 0; a < 2; ++a)
#pragma unroll
        for (int b = 0; b < 2; ++b)
#pragma unroll
            for (int m = 0; m < 4; ++m)
#pragma unroll
                for (int n = 0; n < 2; ++n) acc[a][b][m][n] = (f32x4){0.f, 0.f, 0.f, 0.f};
    bf16x8 At[4][2], B0[2][2], B1[2][2];
    typedef int v4i_t __attribute__((ext_vector_type(4))); typedef int v8i_t __attribute__((ext_vector_type(8)));
    const int f8scale = 0x7f7f7f7f;
    v8i_t At8[4], B08[2], B18[2];
    const char* cA = (const char*)g.A + (size_t)cur.pm * tstepA + (size_t)cur.z * zsA; const char* cB = (const char*)g.Bt + (size_t)cur.pn * tstepB + (size_t)cur.z * zsB;
    PG8_STAGE(PG8_SB(0, 0), cB, voffB); PG8_STAGE(PG8_SB(0, 1), cB + hstepB, voffB); PG8_STAGE(PG8_SA(0, 0), cA, voffA); PG8_STAGE(PG8_SA(0, 1), cA + hstepA, voffA);
    if (wr == 1) PG8_BAR;
    PG8_WAIT_V(2); PG8_BAR;
    PG8_STAGE(PG8_SB(1, 0), cB + kstep, voffB); PG8_STAGE(PG8_SA(1, 0), cA + kstep, voffA); PG8_STAGE(PG8_SB(1, 1), cB + hstepB + kstep, voffB);
    PG8_WAIT_V(6); PG8_BAR;
    for (;;) {
        const bool has_next = S.next(ui + 1, nxt);
        const char* nA = has_next ? (const char*)g.A + (size_t)nxt.pm * tstepA + (size_t)nxt.z * zsA : cA; const char* nB = has_next ? (const char*)g.Bt + (size_t)nxt.pn * tstepB + (size_t)nxt.z * zsB : cB;
        for (int t = 0; t < nt; t += 2) {
            const bool last = (t == nt - 2);
            const char* a1 = cA + (size_t)(t + 1) * kstep;
            const char* a2 = last ? nA : cA + (size_t)(t + 2) * kstep; const char* b2 = last ? nB : cB + (size_t)(t + 2) * kstep;
            const char* a3 = a2 + kstep; const char* b3 = b2 + kstep;
            PG8_LDB(B0, 0, 0); PG8_LDB(B1, 0, 1); PG8_SCHED; PG8_LDA(At, 0, 0); PG8_STAGE(PG8_SA(1, 1), a1 + hstepA, voffA);
            bool rsw = false;
            if constexpr (Epi::RS) { rsw = last && E.ssq != nullptr;
                if (rsw) { const int fl = (int)fresh_lane_id();
                    __builtin_amdgcn_global_load_lds((const unsigned*)(E.ssq + cur.pm * BM + (fl >> 5) * HALF + wr * 64 + 2 * (fl & 31)), (LAS unsigned*)(lds + RS_LDS + ldsw), 16, 0, 0); } }
            if (rsw) PG8_WAIT_V(9); else PG8_WAIT_V(8);
            PG8_WAIT_L(0); PG8_BAR; PG8_MMA(0, 0, At, B0); if constexpr (!DIAG) PG8_MMA(0, 1, At, B1); PG8_BAR; PG8_SCHED;
            PG8_LDA(At, 0, 1); PG8_STAGE(PG8_SB(0, 0), b2, voffB); PG8_STAGE(PG8_SB(0, 1), b2 + hstepB, voffB); PG8_STAGE(PG8_SA(0, 0), a2, voffA);
            if (rsw) PG8_WAIT_V(9); else PG8_WAIT_V(8);
            PG8_WAIT_L(0); PG8_BAR; if constexpr (!DIAG) PG8_MMA(1, 0, At, B0); PG8_MMA(1, 1, At, B1); PG8_BAR; PG8_SCHED;
            PG8_LDB(B0, 1, 0); PG8_LDB(B1, 1, 1); PG8_SCHED; PG8_LDA(At, 1, 0); PG8_STAGE(PG8_SA(0, 1), a2 + hstepA, voffA);
            if (rsw) PG8_WAIT_V(9); else PG8_WAIT_V(8);
            PG8_WAIT_L(0); PG8_BAR; PG8_MMA(0, 0, At, B0); if constexpr (!DIAG) PG8_MMA(0, 1, At, B1); PG8_BAR; PG8_SCHED;
            PG8_LDA(At, 1, 1); PG8_STAGE(PG8_SB(1, 0), b3, voffB); PG8_STAGE(PG8_SB(1, 1), b3 + hstepB, voffB); PG8_STAGE(PG8_SA(1, 0), a3, voffA);
            PG8_WAIT_V(8); PG8_WAIT_L(0); PG8_BAR; if constexpr (!DIAG) PG8_MMA(1, 0, At, B0); PG8_MMA(1, 1, At, B1); PG8_BAR; PG8_SCHED;
        }
        if constexpr (ALIGN_EPI) { if (wr == 0) PG8_BAR; }
        if constexpr (F8) { __builtin_amdgcn_sched_barrier(0); asm volatile("s_nop 15\n\ts_nop 15" ::: "memory"); __builtin_amdgcn_sched_barrier(0); }
        { const int fl = (int)fresh_lane_id(), fr2 = fl & 15, fq2 = fl >> 4;
          if constexpr (Epi::RS) E(acc, lds, cur, wr, wc, fr2, fq2); else E(acc, cur, wr, wc, fr2, fq2); }
        if (!has_next) break;
#pragma unroll
        for (int a = 0; a < 2; ++a)
#pragma unroll
            for (int b = 0; b < 2; ++b)
#pragma unroll
                for (int m = 0; m < 4; ++m)
#pragma unroll
                    for (int n = 0; n < 2; ++n) if (!DIAG || a == b) acc[a][b][m][n] = (f32x4){0.f, 0.f, 0.f, 0.f};
        cur = nxt; cA = nA; cB = nB; ++ui;
        if constexpr (ALIGN_EPI) { if (wr == 1) PG8_BAR; }
    }
    PG8_WAIT_V(0);
    if constexpr (!ALIGN_EPI) { if (wr == 0) PG8_BAR; }
    PG8_BAR;
#undef PG8_SA
#undef PG8_SB
#undef PG8_STAGE
#undef PG8_LDA
#undef PG8_LDB
#undef PG8_MMA
#undef PG8_WAIT_V
#undef PG8_WAIT_L
#undef PG8_BAR
#undef PG8_SCHED
}

struct EpiMergeHalf {
    const bf16_t* gate; int ldg; bf16_t* Mg;
    __device__ __forceinline__ void prefetch(u32x4 (&gp)[8], const Unit& u, int wr, int wc, int fr, int fq) const {
        const bf16_t* ub = gate + (size_t)(u.pm * HALF) * ldg + u.z * DM + u.pn * BM;
        const unsigned lo = (unsigned)((wr * 64 + fr) * ldg + wc * 32 + 8 * fq);
#pragma unroll
        for (int m = 0; m < 4; ++m)
#pragma unroll
            for (int bj = 0; bj < 2; ++bj) gp[m * 2 + bj] = *(const u32x4*)(ub + (size_t)(m * 16) * ldg + bj * HALF + lo);
    }
    __device__ __forceinline__ void operator()(const f32x4 (&acc)[2][4][2], u32x4 (&tot)[8], const u32x4 (&gp)[8], const Unit& u, int wr, int wc, int fr, int fq) const {
        const int row0 = u.pm * HALF + wr * 64 + fr, col0 = u.pn * BM + wc * 32 + 8 * fq, z = u.z;
        const unsigned keep = (z == 3) ? 0u : 0xffffffffu;
#pragma unroll
        for (int m = 0; m < 4; ++m) { const int row = row0 + m * 16;
#pragma unroll
            for (int bj = 0; bj < 2; ++bj) {
                const u32x4 g = gp[m * 2 + bj], p = tot[m * 2 + bj];
                const f32x4 g0 = (f32x4){bflo(g.x), bfhi(g.x), bflo(g.y), bfhi(g.y)}, g1 = (f32x4){bflo(g.z), bfhi(g.z), bflo(g.w), bfhi(g.w)};
                const f32x4 p0 = (f32x4){bflo(p.x), bfhi(p.x), bflo(p.y), bfhi(p.y)}, p1 = (f32x4){bflo(p.z), bfhi(p.z), bflo(p.w), bfhi(p.w)};
                const f32x4 t0 = g0 * acc[bj][m][0] + p0, t1 = g1 * acc[bj][m][1] + p1;
                u32x4 w; w.x = cvt_pk_bf16(t0[0], t0[1]); w.y = cvt_pk_bf16(t0[2], t0[3]); w.z = cvt_pk_bf16(t1[0], t1[1]); w.w = cvt_pk_bf16(t1[2], t1[3]);
                if (z == 3) *(u32x4*)(Mg + (size_t)row * DM + col0 + bj * HALF) = w;
                tot[m * 2 + bj] = (u32x4){w.x & keep, w.y & keep, w.z & keep, w.w & keep}; } }
    }
};

template <class Epi, class Sched>
__device__ __forceinline__ void gemm_phase_m3(LAS unsigned char* lds, const Gemm g, const Sched& S, const Epi& E, int wave) {
    const int tid = opaque_tid(wave), wid = __builtin_amdgcn_readfirstlane(tid >> 6), lane = tid & 63, wr = wid >> 2, wc = wid & 3, fr = lane & 15, fq = lane >> 4;
    const int K = g.K, nt = K / BK, lda = g.lda;
    const int rowA = lda * 2, rowB = K * 2;
    unsigned voffA[2], voffB[2];
#pragma unroll
    for (int i = 0; i < 2; ++i) { int R, C; stage_rc(tid * 16 + i * 8192, R, C); const int Rb = (R & ~31) + perm32(R & 31);
        voffA[i] = (unsigned)(R * rowA + C * 2); voffB[i] = (unsigned)(Rb * rowB + C * 2); }
    const size_t kstep = (size_t)(BK * 2), hstepB = (size_t)HALF * rowB, tstepA = (size_t)HALF * rowA, tstepB = 2 * (size_t)HALF * rowB;
    const unsigned ldsw = (unsigned)wid * 1024u;
    const int aoff = lds_byte(wr * 64 + fr, fq * 8), boff = lds_byte(wc * 32 + fr, fq * 8);
    constexpr int SLOT = 3 * HTB;
#define M3_STAGE(bufoff, gbase, voff) do { _Pragma("unroll") for (int _i = 0; _i < 2; ++_i) \
        __builtin_amdgcn_global_load_lds((const unsigned*)((const char*)(gbase) + (voff)[_i]), (LAS unsigned*)(lds + (bufoff) + ldsw + _i * 8192), 16, 0, 0); } while (0)
#define M3_STAGE3(so, a_, b_) do { M3_STAGE((so), (b_), voffB); M3_STAGE((so) + HTB, (b_) + hstepB, voffB); M3_STAGE((so) + 2 * HTB, (a_), voffA); } while (0)
#define M3_LDA(dst, so) do { _Pragma("unroll") for (int m = 0; m < 4; ++m) _Pragma("unroll") for (int k = 0; k < 2; ++k) dst[m][k] = *(const LAS bf16x8*)(lds + (so) + 2 * HTB + aoff + m * 2048 + k * 1024); } while (0)
#define M3_LDB(dst, so, h) do { _Pragma("unroll") for (int n = 0; n < 2; ++n) _Pragma("unroll") for (int k = 0; k < 2; ++k) dst[n][k] = *(const LAS bf16x8*)(lds + (so) + (h) * HTB + boff + n * 2048 + k * 1024); } while (0)
#define M3_MMA(bj, At, Bt) do { __builtin_amdgcn_s_setprio(1); \
        _Pragma("unroll") for (int m = 0; m < 4; ++m) _Pragma("unroll") for (int n = 0; n < 2; ++n) _Pragma("unroll") for (int k = 0; k < 2; ++k) \
            acc[bj][m][n] = __builtin_amdgcn_mfma_f32_16x16x32_bf16(Bt[n][k], At[m][k], acc[bj][m][n], 0, 0, 0); \
        __builtin_amdgcn_s_setprio(0); } while (0)
#define M3_WAIT_V(n) asm volatile("s_waitcnt vmcnt(" #n ")" ::: "memory")
#define M3_WAIT_L(n) asm volatile("s_waitcnt lgkmcnt(" #n ")" ::: "memory")
#define M3_BAR __builtin_amdgcn_s_barrier()
#define M3_SCHED __builtin_amdgcn_sched_barrier(0)
    Unit cur, nxt; int ui = 0;
    if (!S.next(0, cur)) return;
    f32x4 acc[2][4][2];
#pragma unroll
    for (int b = 0; b < 2; ++b)
#pragma unroll
        for (int m = 0; m < 4; ++m)
#pragma unroll
            for (int n = 0; n < 2; ++n) acc[b][m][n] = (f32x4){0.f, 0.f, 0.f, 0.f};
    u32x4 tot[8];
#pragma unroll
    for (int i = 0; i < 8; ++i) tot[i] = (u32x4){0u, 0u, 0u, 0u};
    bf16x8 At[4][2], B0[2][2], B1[2][2];
    const char* cA = (const char*)g.A + (size_t)cur.pm * tstepA + (size_t)cur.z * g.zA; const char* cB = (const char*)g.Bt + (size_t)cur.pn * tstepB + (size_t)cur.z * g.zB;
    u32x4 gp[8];
    int o0 = 0, o1 = SLOT, o2 = 2 * SLOT;
    M3_STAGE3(o0, cA, cB);
    if (wr == 1) M3_BAR;
    M3_WAIT_V(0); M3_BAR;
    M3_STAGE3(o1, cA + kstep, cB + kstep);
    M3_BAR;
    for (;;) {
        const bool has_next = S.next(ui + 1, nxt);
        const char* nA = has_next ? (const char*)g.A + (size_t)nxt.pm * tstepA + (size_t)nxt.z * g.zA : cA; const char* nB = has_next ? (const char*)g.Bt + (size_t)nxt.pn * tstepB + (size_t)nxt.z * g.zB : cB;
        for (int t = 0; t < nt; ++t) {
            const bool wrap = (t + 2 >= nt);
            const char* a2 = wrap ? nA + (size_t)(t + 2 - nt) * kstep : cA + (size_t)(t + 2) * kstep; const char* b2 = wrap ? nB + (size_t)(t + 2 - nt) * kstep : cB + (size_t)(t + 2) * kstep;
            M3_LDB(B0, o0, 0); M3_LDB(B1, o0, 1); M3_SCHED; M3_LDA(At, o0); M3_STAGE3(o2, a2, b2);
            if (t == nt - 2) { M3_SCHED; E.prefetch(gp, cur, wr, wc, fr, fq); M3_SCHED; }
            if (wrap) M3_WAIT_V(14); else M3_WAIT_V(6);
            M3_WAIT_L(0); M3_BAR; M3_MMA(0, At, B0); M3_MMA(1, At, B1); M3_BAR; M3_SCHED;
            { const int r = o0; o0 = o1; o1 = o2; o2 = r; }
        }
        if (wr == 0) M3_BAR;
        E(acc, tot, gp, cur, wr, wc, fr, fq);
        if (!has_next) break;
#pragma unroll
        for (int b = 0; b < 2; ++b)
#pragma unroll
            for (int m = 0; m < 4; ++m)
#pragma unroll
                for (int n = 0; n < 2; ++n) acc[b][m][n] = (f32x4){0.f, 0.f, 0.f, 0.f};
        cur = nxt; cA = nA; cB = nB; ++ui;
        if (wr == 1) M3_BAR;
    }
    M3_WAIT_V(0);
    M3_BAR;
#undef M3_STAGE
#undef M3_STAGE3
#undef M3_LDA
#undef M3_LDB
#undef M3_MMA
#undef M3_WAIT_V
#undef M3_WAIT_L
#undef M3_BAR
#undef M3_SCHED
}
}

constexpr size_t MiB = 1u << 20;
constexpr size_t WS_CTL = 0, CTL_ZERO_BYTES = 1 * MiB;
constexpr size_t WS_ROPE = 1 * MiB;
constexpr size_t WS_BTAB = 2 * MiB;
constexpr size_t WS_PMM = WS_BTAB + 16 * 256 * 4;
constexpr size_t WS_AFF = WS_PMM + 128 * 2 * 4 + 64;
constexpr size_t WS_LAM = WS_AFF + 64;
constexpr size_t WS_KMEAN = 3 * MiB;
constexpr size_t WS_W = 4 * MiB;
constexpr size_t W_IN = 0, W_IN8 = 32 * MiB  , W_UQ = 51 * MiB, W_UKV = W_UQ + 768 * 512 * 2, W_BR = W_UKV + 1024 * 256 * 2, W_OUT = W_BR + 8 * MiB, W_UP = W_OUT + 8 * MiB, W_DN = W_UP + 44 * MiB, W_LAYER = W_DN + 22 * MiB;
constexpr size_t WS_X = WS_W + DEPTH * W_LAYER;
constexpr size_t WS_XN = WS_X + 128 * MiB;
constexpr size_t WS_MG = WS_XN + 64 * MiB;
constexpr size_t WS_Z = WS_MG + 64 * MiB;
constexpr size_t WS_CQN = WS_Z + 408 * MiB;
constexpr size_t WS_CKVN = WS_CQN + 16 * MiB;
constexpr size_t WS_KR = WS_CKVN + 8 * MiB;
constexpr size_t WS_QMLA = WS_KR + 2 * MiB;
constexpr size_t WS_KVMLA = WS_QMLA + 24 * MiB;
constexpr size_t WS_BRO = WS_KVMLA + 32 * MiB;
constexpr size_t WS_T = WS_BRO + 64 * MiB;
constexpr size_t WS_DSCR = WS_T + 176 * MiB;
constexpr size_t WS_SSQ = WS_DSCR;
constexpr size_t WS_END = WS_DSCR + 32 * MiB;
static_assert(W_LAYER * 1 == (size_t)(51 * MiB + 768 * 512 * 2 + 1024 * 256 * 2 + 82 * MiB), "weight map");
static_assert((size_t)M * ZLD * 2 == 408 * MiB && (size_t)M * UP_N * 2 <= 408 * MiB && (size_t)M * FFN * 2 == 176 * MiB, "buffer sizes");
constexpr int CW_TMO = 0;
constexpr int CW_QUEUE = 8192;
constexpr int CW_BAR = 4096;

constexpr int RING_OFF = 0, RING_BYTES = 131072;
constexpr int LDS_BYTES = 163840;
constexpr int LDSCTL_OFF = LDS_BYTES - 1024, MISC_OFF = LDSCTL_OFF + 320;
constexpr int NWAVES = 8;

typedef GAS unsigned gu32;
#define RLX_AGENT __ATOMIC_RELAXED, __HIP_MEMORY_SCOPE_AGENT
#define LDS_WAIT() asm volatile("s_waitcnt lgkmcnt(0)" ::: "memory")
#define XB_TMO      128
#define XB_XCNT(j)  (256  + 64 * (j))
#define XB_XSUB(j)  (1280 + 64 * (j))
#define XB_XGEN(j)  (2304 + 64 * (j))
#define XB_TOP      3328
#define XB_TOPGEN   3392
#define XCD_BAR_WORDS 3456
#define XB_SPIN_CAP (1u << 22)
__device__ __forceinline__ unsigned xb_ld(unsigned* p)              { return __hip_atomic_load(p, __ATOMIC_RELAXED, __HIP_MEMORY_SCOPE_AGENT); }
__device__ __forceinline__ unsigned xb_add(unsigned* p, unsigned v) { return __hip_atomic_fetch_add(p, v, __ATOMIC_RELAXED, __HIP_MEMORY_SCOPE_AGENT); }
__device__ __forceinline__ unsigned xb_xcc_id() { return (unsigned)__builtin_amdgcn_s_getreg((3 << 11) | 20) & 0xFu; }
#define XB_SPIN(cond, bar) do { unsigned _sp = 0; while (cond) { __builtin_amdgcn_s_sleep(1); \
    if ((++_sp & 255u) == 0u) { if (xb_ld(&(bar)[XB_TMO])) break; if (_sp > XB_SPIN_CAP) { atomicAdd(&(bar)[XB_TMO], 1u); break; } } } } while (0)
struct XcdBarrier { unsigned* bar; unsigned x; volatile LAS unsigned* st; int wave; };
__device__ __forceinline__ XcdBarrier xcd_barrier_post(unsigned* bar, volatile LAS unsigned* st, int wave) {
    XcdBarrier b; b.bar = bar; b.x = xb_xcc_id(); b.st = st; b.wave = wave;
    if (is_thread0(wave)) (void)xb_add(&bar[XB_XCNT(b.x)], 1u);
    return b;
}
__device__ __forceinline__ void xcd_barrier_complete(unsigned* bar, unsigned x, unsigned& nloc, unsigned& nx) {
    const unsigned G = gridDim.x * gridDim.y * gridDim.z;
    unsigned sum, cnt, mine, sp = 0u;
    for (;;) {
        sum = 0u; cnt = 0u; mine = 0u;
#pragma unroll
        for (unsigned j = 0; j < 16; ++j) { const unsigned c = xb_ld(&bar[XB_XCNT(j)]); sum += c; cnt += (c > 0u) ? 1u : 0u; mine = (j == x) ? c : mine; }
        if (sum == G) break;
        __builtin_amdgcn_s_sleep(1);
        if ((++sp & 255u) == 0u) { if (xb_ld(&bar[XB_TMO])) break; if (sp > XB_SPIN_CAP) { atomicAdd(&bar[XB_TMO], 1u); break; } }
    }
    nloc = mine > 0u ? mine : 1u; nx = cnt > 0u ? cnt : 1u;
}
__device__ __forceinline__ void xcd_barrier(const XcdBarrier& b) {
    asm volatile("s_waitcnt vmcnt(0)" ::: "memory");
    __syncthreads();
    if (is_thread0(b.wave)) {
        unsigned* bar = b.bar;
        __builtin_amdgcn_s_waitcnt(0);
        unsigned nloc = b.st[0], nx = b.st[1];
        if (nloc == 0u) { xcd_barrier_complete(bar, b.x, nloc, nx); b.st[0] = nloc; b.st[1] = nx; }
        const unsigned old = xb_add(&bar[XB_XSUB(b.x)], 1u);
        const unsigned gen = old / nloc;
        if (old + 1u == (gen + 1u) * nloc) {
            __builtin_amdgcn_fence(__ATOMIC_RELEASE, "agent");
            asm volatile("s_waitcnt vmcnt(0)" ::: "memory");
            const unsigned og = xb_add(&bar[XB_TOP], 1u);
            const unsigned tg = og / nx;
            if (og + 1u == (tg + 1u) * nx) xb_add(&bar[XB_TOPGEN], 1u);
            else XB_SPIN(xb_ld(&bar[XB_TOPGEN]) == tg, bar);
            __builtin_amdgcn_fence(__ATOMIC_ACQUIRE, "agent");
            xb_add(&bar[XB_XGEN(b.x)], 1u);
            asm volatile("s_waitcnt vmcnt(0)" ::: "memory");
        } else {
            XB_SPIN(xb_ld(&bar[XB_XGEN(b.x)]) == gen, bar);
            __builtin_amdgcn_fence(__ATOMIC_ACQUIRE, "agent");
            asm volatile("s_waitcnt vmcnt(0)" ::: "memory");
        }
    }
    __syncthreads();
}

constexpr int CW_GRP = 65536, CW_XTAB = 49152;
__device__ __forceinline__ void grp_barrier(unsigned* bar, unsigned* cnt, unsigned target, bool fast, int wave) {
    asm volatile("s_waitcnt vmcnt(0)" ::: "memory");
    __syncthreads();
    if (is_thread0(wave)) {
        __builtin_amdgcn_s_waitcnt(0);
        if (!fast) { __builtin_amdgcn_fence(__ATOMIC_RELEASE, "agent"); asm volatile("s_waitcnt vmcnt(0)" ::: "memory"); }
        xb_add(cnt, 1u);
        XB_SPIN(xb_ld(cnt) < target, bar);
        __builtin_amdgcn_fence(__ATOMIC_ACQUIRE, "agent");
        asm volatile("s_waitcnt vmcnt(0)" ::: "memory");
    }
    __syncthreads();
}

namespace att {
template <int DK0_, int DK1_, int DV_, int NQL_ = 0, int NDC_ = 0> struct Cfg {
    static constexpr int DK0 = DK0_, DK1 = DK1_, DK = DK0_ + DK1_, DV = DV_;
    static constexpr int KP = DK * 2 + 16, VP = DV * 2 + 64;
    static constexpr int KOFF = 0, VOFF = 64 * KP, POFF = VOFF + 64 * VP, BUFB = POFF + 256;
    static constexpr int NKC = (64 * DK / 8) / 512, NVC = (64 * DV / 8) / 512;
    static constexpr int ND = NDC_ > 0 ? NDC_ : DK / 16, NO = DV / 32;
    static constexpr int NQL = NQL_, NQR = ND - NQL_;
};
constexpr int BTAB_OFF = 94208, KMEAN_OFF = 94208 + 1024, QL_OFF = 92672;
struct Src { const bf16_t* k0; int pk0; const bf16_t* k1; int pk1; const bf16_t* v; int pv; const int* pos; };
#if PROF_BUILD
struct WaveCtx { int lane, r32, hi, wid, tid, koff; unsigned long long* prof; };
#define PCLK() ((unsigned)clock64())
#else
struct WaveCtx { int lane, r32, hi, wid, tid, koff; };
#endif

template <class C, bool WITH_POS> struct Stage {
    u32x4 kr[C::NKC]; u32x4 vr[C::NVC]; int pr;
    __device__ __forceinline__ void load(const Src& s, int t, int tid) {
        const int kb = t * 64;
#pragma unroll
        for (int i = 0; i < C::NKC; ++i) { const int id = tid + 512 * i, row = id / (C::DK / 8), c = id % (C::DK / 8);
            const bf16_t* p = (C::DK1 == 0 || c < C::DK0 / 8) ? s.k0 + (size_t)(kb + row) * s.pk0 + c * 8 : s.k1 + (size_t)(kb + row) * s.pk1 + (c - C::DK0 / 8) * 8;
            kr[i] = *(const u32x4*)p; }
#pragma unroll
        for (int i = 0; i < C::NVC; ++i) { const int id = tid + 512 * i, row = id / (C::DV / 8), c = id % (C::DV / 8);
            vr[i] = *(const u32x4*)(s.v + (size_t)(kb + row) * s.pv + c * 8); }
        pr = (WITH_POS && tid < 64) ? s.pos[kb + tid] : 0;
    }
    __device__ __forceinline__ void store(LAS unsigned char* buf, int tid) const {
#pragma unroll
        for (int i = 0; i < C::NKC; ++i) { const int id = tid + 512 * i, row = id / (C::DK / 8), c = id % (C::DK / 8); *(LAS u32x4*)(buf + C::KOFF + row * C::KP + c * 16) = kr[i]; }
#pragma unroll
        for (int i = 0; i < C::NVC; ++i) { const int id = tid + 512 * i, row = id / (C::DV / 8), c = id % (C::DV / 8); *(LAS u32x4*)(buf + C::VOFF + row * C::VP + c * 16) = vr[i]; }
        if (WITH_POS && tid < 64) *(LAS int*)(buf + C::POFF + tid * 4) = pr;
    }
};
__device__ __forceinline__ s16x4 vtr(const LAS unsigned char* p) { typedef short v4i16_t __attribute__((ext_vector_type(4))); return __builtin_bit_cast(s16x4, __builtin_amdgcn_ds_read_tr16_b64_v4i16((LAS v4i16_t*)p)); }

struct RowState { float m, l; };

template <class C, int KIND, bool BIAS, bool VPRE>
__device__ __forceinline__ void tile_compute(const LAS unsigned char* buf, const LAS float* btab, const bf16x8 (&qf)[C::NQR], const LAS unsigned char* qlb, f32x16 (&O)[C::NO], RowState& st,
                                             int k0, int qw, int posq, int pminq, unsigned long long farlo, unsigned long long farhi, unsigned long long afflo, unsigned long long affhi, unsigned selmask, int blk, const WaveCtx& w) {
    const int qi = qw + w.r32;
#pragma unroll
    for (int p = 0; p < 2; ++p) {
        const int ks = k0 + 32 * p;
        bool causal_tile = true, sel_lane = true, skip = false, fast = false;
        if (KIND == 0) { skip = ks > qw + 31; fast = (ks + 31 <= qw); }
        if (KIND == 1) { skip = (ks > qw + 31) || (ks + 31 < qw - 127); }
        if (KIND == 2) {
            const int n = ks >> 8;
            if (n < blk) { causal_tile = false; sel_lane = ((selmask >> n) & 1u) != 0u; skip = !__any(sel_lane); fast = (bool)__all(sel_lane); }
            else { skip = ks > qw + 31; fast = (ks + 31 <= qw); }
        }
        if (skip) continue;
        if (BIAS && fast) { const int kb32 = ks >> 5; fast = (((kb32 < 64 ? farlo >> kb32 : farhi >> (kb32 - 64)) & 1ull) != 0ull); }
        f32x16 sc;
#pragma unroll
        for (int r = 0; r < 16; ++r) sc[r] = 0.f;
        const LAS unsigned char* kb = buf + C::KOFF + (32 * p + w.r32) * C::KP + w.hi * 16 + w.koff;
#pragma unroll
        for (int d0 = 0; d0 < C::ND; ++d0) {
            const bf16x8 a0 = *(const LAS bf16x8*)(kb + d0 * 32);
            const bf16x8 qv = (d0 < C::NQR) ? qf[d0 < C::NQR ? d0 : 0] : *(const LAS bf16x8*)(qlb + (d0 - C::NQR) * 1024);
            sc = __builtin_amdgcn_mfma_f32_32x32x16_bf16(a0, qv, sc, 0, 0, 0);
        }
        s16x4 vl[2][C::NO], vh[2][C::NO];
        if constexpr (VPRE) {
            const unsigned va = (unsigned)(__UINTPTR_TYPE__)(buf + C::VOFF + (32 * p + 4 * w.hi + ((w.lane & 15) >> 2)) * C::VP + (16 * ((w.lane >> 4) & 1) + 4 * (w.lane & 3)) * 2);
#pragma unroll
            for (int s = 0; s < 2; ++s)
#pragma unroll
                for (int d = 0; d < C::NO; ++d) {
                    asm volatile("ds_read_b64_tr_b16 %0, %1 offset:%2" : "=v"(vl[s][d]) : "v"(va), "n"((16 * s) * C::VP + d * 64));
                    asm volatile("ds_read_b64_tr_b16 %0, %1 offset:%2" : "=v"(vh[s][d]) : "v"(va), "n"((16 * s + 8) * C::VP + d * 64));
                }
            __builtin_amdgcn_sched_barrier(0);
        }
        if (fast) {
            if (BIAS) { const float bc = btab[64 + 128];
#pragma unroll
                for (int r = 0; r < 16; ++r) sc[r] += bc; }
        } else {
            bool aff = false; int posk0 = 0;
            if (BIAS) {
                const int kb32 = ks >> 5, qb32 = qw >> 5;
                aff = (((kb32 < 64 ? afflo >> kb32 : affhi >> (kb32 - 64)) & 1ull) != 0ull) && (((qb32 < 64 ? afflo >> qb32 : affhi >> (qb32 - 64)) & 1ull) != 0ull);
                if (aff) { posk0 = __builtin_amdgcn_readfirstlane(*(const LAS int*)(buf + C::POFF + (32 * p) * 4)); aff = (pminq - posk0 - 31 >= -62) && (pminq + 31 - posk0 <= 191); }
            }
            if (aff) {
                const LAS float* tb = btab + (posq - posk0 + 64 - 4 * w.hi - 27);
#pragma unroll
                for (int r = 0; r < 16; ++r) {
                    const int c = (r & 3) + 8 * (r >> 2), kv = ks + c + 4 * w.hi;
                    const float v = sc[r] + tb[27 - c];
                    bool valid;
                    if (KIND == 0) valid = kv <= qi;
                    else if (KIND == 1) valid = (unsigned)(qi - kv) < 128u;
                    else valid = causal_tile ? (kv <= qi) : sel_lane;
                    sc[r] = valid ? v : NEG_INF;
                }
            } else {
#pragma unroll
            for (int g4 = 0; g4 < 4; ++g4) {
                i32x4 pk = (i32x4){0, 0, 0, 0};
                if (BIAS) pk = *(const LAS i32x4*)(buf + C::POFF + (32 * p + 8 * g4 + 4 * w.hi) * 4);
#pragma unroll
                for (int e = 0; e < 4; ++e) {
                    const int r = 4 * g4 + e, kv = ks + 8 * g4 + 4 * w.hi + e;
                    float v = sc[r];
                    if (BIAS) { int d = posq - pk[e]; d = d < 0 ? 0 : (d > 128 ? 128 : d); v += btab[64 + d]; }
                    bool valid;
                    if (KIND == 0) valid = kv <= qi;
                    else if (KIND == 1) valid = (unsigned)(qi - kv) < 128u;
                    else valid = causal_tile ? (kv <= qi) : sel_lane;
                    sc[r] = valid ? v : NEG_INF;
                }
            }
            }
        }
        float tmax = sc[0];
#pragma unroll
        for (int r = 1; r < 16; ++r) tmax = fmaxf(tmax, sc[r]);
        { const auto rr = __builtin_amdgcn_permlane32_swap(__float_as_uint(tmax), __float_as_uint(tmax), false, false); tmax = fmaxf(__uint_as_float(rr[0]), __uint_as_float(rr[1])); }
        const float mn = fmaxf(st.m, tmax);
        const float alpha = __builtin_amdgcn_exp2f(st.m - mn);
        st.m = mn;
        float ps = 0.f;
#pragma unroll
        for (int r = 0; r < 16; ++r) { sc[r] = __builtin_amdgcn_exp2f(sc[r] - mn); ps += sc[r]; }
        st.l = st.l * alpha + ps;
        if (__any(alpha != 1.0f)) {
#pragma unroll
            for (int d = 0; d < C::NO; ++d)
#pragma unroll
                for (int r = 0; r < 16; ++r) O[d][r] *= alpha;
        }
#pragma unroll
        for (int s = 0; s < 2; ++s) {
            u32x4 t; const int b = 8 * s;
            t.x = cvt_pk_bf16(sc[b], sc[b + 1]); t.y = cvt_pk_bf16(sc[b + 2], sc[b + 3]); t.z = cvt_pk_bf16(sc[b + 4], sc[b + 5]); t.w = cvt_pk_bf16(sc[b + 6], sc[b + 7]);
            const bf16x8 pf = __builtin_bit_cast(bf16x8, t);
            if constexpr (VPRE) {
                if (s == 0) { asm volatile("s_waitcnt lgkmcnt(0)" ::: "memory"); __builtin_amdgcn_sched_barrier(0); }
#pragma unroll
                for (int d = 0; d < C::NO; ++d) {
                    const bf16x8 vf = (bf16x8){vl[s][d][0], vl[s][d][1], vl[s][d][2], vl[s][d][3], vh[s][d][0], vh[s][d][1], vh[s][d][2], vh[s][d][3]};
                    O[d] = __builtin_amdgcn_mfma_f32_32x32x16_bf16(vf, pf, O[d], 0, 0, 0);
                }
            } else {
                const LAS unsigned char* vb = buf + C::VOFF + (32 * p + 4 * w.hi + ((w.lane & 15) >> 2)) * C::VP + (16 * ((w.lane >> 4) & 1) + 4 * (w.lane & 3)) * 2;
#pragma unroll
                for (int d = 0; d < C::NO; ++d) {
                    const s16x4 lo = vtr(vb + (16 * s) * C::VP + d * 64), hi4 = vtr(vb + (16 * s + 8) * C::VP + d * 64);
                    const bf16x8 vf = (bf16x8){lo[0], lo[1], lo[2], lo[3], hi4[0], hi4[1], hi4[2], hi4[3]};
                    O[d] = __builtin_amdgcn_mfma_f32_32x32x16_bf16(vf, pf, O[d], 0, 0, 0);
                }
            }
        }
    }
}

constexpr float ATT_THR = 8.0f;
template <class C, bool VPRE>
__device__ __forceinline__ void tile64_fast(const LAS unsigned char* buf, const bf16x8 (&qf)[C::NQR], const LAS unsigned char* qlb, f32x16 (&O)[C::NO], RowState& st, float& nm, const WaveCtx& w) {
    f32x16 s0, s1;
    const LAS unsigned char* kb = buf + C::KOFF + w.r32 * C::KP + w.hi * 16 + w.koff;
#pragma unroll
    for (int r = 0; r < 16; ++r) { s0[r] = 0.f; s1[r] = 0.f; }
#pragma unroll
    for (int d0 = 0; d0 < C::ND; ++d0) {
        const bf16x8 a0 = *(const LAS bf16x8*)(kb + d0 * 32), a1 = *(const LAS bf16x8*)(kb + 32 * C::KP + d0 * 32);
        const bf16x8 qv = (d0 < C::NQR) ? qf[d0 < C::NQR ? d0 : 0] : *(const LAS bf16x8*)(qlb + (d0 - C::NQR) * 1024);
        s0 = __builtin_amdgcn_mfma_f32_32x32x16_bf16(a0, qv, s0, 0, 0, 0); s1 = __builtin_amdgcn_mfma_f32_32x32x16_bf16(a1, qv, s1, 0, 0, 0);
    }
    const unsigned va = (unsigned)(__UINTPTR_TYPE__)(buf + C::VOFF + (4 * w.hi + ((w.lane & 15) >> 2)) * C::VP + (16 * ((w.lane >> 4) & 1) + 4 * (w.lane & 3)) * 2);
    const LAS unsigned char* vb = buf + C::VOFF + (4 * w.hi + ((w.lane & 15) >> 2)) * C::VP + (16 * ((w.lane >> 4) & 1) + 4 * (w.lane & 3)) * 2;
    s16x4 vl[C::NO], vh[C::NO];
#define ATT_VREADS(KS) do { if constexpr (VPRE) { _Pragma("unroll") for (int d = 0; d < C::NO; ++d) { \
        asm volatile("ds_read_b64_tr_b16 %0, %1 offset:%2" : "=v"(vl[d]) : "v"(va), "n"((16 * (KS)) * C::VP + d * 64)); \
        asm volatile("ds_read_b64_tr_b16 %0, %1 offset:%2" : "=v"(vh[d]) : "v"(va), "n"((16 * (KS) + 8) * C::VP + d * 64)); } \
        __builtin_amdgcn_sched_barrier(0); } } while (0)
#define ATT_PVSTEP(SP, KS, NEXT) do { u32x4 tq; const int b_ = 8 * ((KS) & 1); \
        tq.x = cvt_pk_bf16(SP[b_], SP[b_ + 1]); tq.y = cvt_pk_bf16(SP[b_ + 2], SP[b_ + 3]); tq.z = cvt_pk_bf16(SP[b_ + 4], SP[b_ + 5]); tq.w = cvt_pk_bf16(SP[b_ + 6], SP[b_ + 7]); \
        const bf16x8 pf = __builtin_bit_cast(bf16x8, tq); \
        if constexpr (VPRE) { asm volatile("s_waitcnt lgkmcnt(0)" ::: "memory"); __builtin_amdgcn_sched_barrier(0); \
            _Pragma("unroll") for (int d = 0; d < C::NO; ++d) { const bf16x8 vf = (bf16x8){vl[d][0], vl[d][1], vl[d][2], vl[d][3], vh[d][0], vh[d][1], vh[d][2], vh[d][3]}; \
                O[d] = __builtin_amdgcn_mfma_f32_32x32x16_bf16(vf, pf, O[d], 0, 0, 0); } \
            __builtin_amdgcn_sched_barrier(0); if ((NEXT) >= 0) ATT_VREADS((NEXT) < 0 ? 0 : (NEXT)); } \
        else { _Pragma("unroll") for (int d = 0; d < C::NO; ++d) { const s16x4 lo = vtr(vb + (16 * (KS)) * C::VP + d * 64), hi4 = vtr(vb + (16 * (KS) + 8) * C::VP + d * 64); \
                const bf16x8 vf = (bf16x8){lo[0], lo[1], lo[2], lo[3], hi4[0], hi4[1], hi4[2], hi4[3]}; \
                O[d] = __builtin_amdgcn_mfma_f32_32x32x16_bf16(vf, pf, O[d], 0, 0, 0); } } } while (0)
#define ATT_SOFT(SP) do { \
        float t_ = fmaxf(SP[0], SP[1]); \
        _Pragma("unroll") for (int r = 2; r < 16; r += 2) t_ = fmaxf(t_, fmaxf(SP[r], SP[r + 1])); \
        { const auto rr = __builtin_amdgcn_permlane32_swap(__float_as_uint(t_), __float_as_uint(t_), false, false); t_ = fmaxf(__uint_as_float(rr[0]), __uint_as_float(rr[1])); } \
        t_ += nm; \
        if (__any(t_ > ATT_THR)) { const float dl = fmaxf(t_, 0.f), f_ = __builtin_amdgcn_exp2f(-dl); st.m += dl; nm -= dl; st.l *= f_; \
            _Pragma("unroll") for (int d = 0; d < C::NO; ++d) _Pragma("unroll") for (int r = 0; r < 16; ++r) O[d][r] *= f_; } \
        float ps_ = 0.f; \
        _Pragma("unroll") for (int r = 0; r < 16; ++r) { SP[r] = __builtin_amdgcn_exp2f(SP[r] + nm); ps_ += SP[r]; } \
        st.l += ps_; } while (0)
    ATT_VREADS(0);
    ATT_SOFT(s0);
    ATT_PVSTEP(s0, 0, 1);
    ATT_PVSTEP(s0, 1, 2);
    ATT_SOFT(s1);
    ATT_PVSTEP(s1, 2, 3);
    ATT_PVSTEP(s1, 3, -1);
#undef ATT_VREADS
#undef ATT_PVSTEP
#undef ATT_SOFT
}

template <class C, int KIND, bool BIAS, bool FASTP, bool VPRE>
__device__ __forceinline__ void run_tiles(LAS unsigned char* lds, const Src& src, int t0, int t1, const bf16x8 (&qf)[C::NQR], f32x16 (&O)[C::NO], RowState& st,
                                          int qw, int posq, int pminq, const int* pmm, unsigned selmask, int blk, const WaveCtx& w, int btab_off = 0) {
    const LAS float* btab = (const LAS float*)(lds + BTAB_OFF + btab_off);
    const LAS unsigned char* qlb = lds + QL_OFF + w.wid * (C::NQL * 1024) + w.lane * 16;
    unsigned long long farlo = 0ull, farhi = 0ull;
    unsigned long long afflo = 0ull, affhi = 0ull;
    if (BIAS) { farlo = __ballot(pminq - pmm[w.lane * 2 + 1] >= 128); farhi = __ballot(pminq - pmm[(w.lane + 64) * 2 + 1] >= 128);
        const unsigned* ap = (const unsigned*)(pmm + 256 + 16);
        afflo = (unsigned long long)__builtin_amdgcn_readfirstlane(ap[0]) | ((unsigned long long)__builtin_amdgcn_readfirstlane(ap[1]) << 32);
        affhi = (unsigned long long)__builtin_amdgcn_readfirstlane(ap[2]) | ((unsigned long long)__builtin_amdgcn_readfirstlane(ap[3]) << 32); }
    float nm = 0.f; bool nvalid = false; int ncur = -1;
    Stage<C, BIAS> sg;
    if (t0 < t1) sg.load(src, t1 - 1, w.tid);
    int it = 0;
#if PROF_BUILD
    unsigned pacc = 0, pn5 = 0, pn6 = 0;
#endif
    for (int t = t1 - 1; t >= t0; --t, ++it) {
        LAS unsigned char* buf = lds + (it & 1) * C::BUFB;
#if PROF_BUILD
        unsigned ca = 0, cb = 0, cc = 0, cd = 0; if (PROF_ID == 1) ca = PCLK();
#endif
        sg.store(buf, w.tid);
#if PROF_BUILD
        if (PROF_ID == 1 || PROF_ID == 2) { asm volatile("s_waitcnt vmcnt(0) lgkmcnt(0)" ::: "memory"); cb = PCLK(); }
#endif
        __syncthreads();
#if PROF_BUILD
        if (PROF_ID == 2 || PROF_ID == 8) cc = PCLK();
#endif
        if (t - 1 >= t0) sg.load(src, t - 1, w.tid);
#if PROF_BUILD
        if (PROF_ID == 8 || PROF_ID == 3 || PROF_ID == 4) cd = PCLK();
#endif
        const int k0 = t * 64;
        bool fastT = false, skipT = false, sel_lane = true; int nb = 0;
        if (FASTP) {
            const int kb32 = k0 >> 5;
            const bool far2 = !BIAS || ((((kb32 < 64 ? farlo >> kb32 : farhi >> (kb32 - 64)) & 3ull) == 3ull));
            if (KIND == 0) fastT = (k0 + 63 <= qw) && far2;
            if (KIND == 2) { nb = k0 >> 8; if (nb < blk) { sel_lane = ((selmask >> nb) & 1u) != 0u; skipT = !__any(sel_lane); fastT = far2; } }
        }
        if (skipT) continue;
        if (fastT) {
            if (!nvalid || (KIND == 2 && nb != ncur)) {
                const float bc = BIAS ? btab[64 + 128] : 0.f; nm = sel_lane ? bc - st.m : NEG_INF;
                nvalid = true; ncur = nb;
            }
            tile64_fast<C, VPRE>(buf, qf, qlb, O, st, nm, w);
        } else {
            tile_compute<C, KIND, BIAS, false>(buf, btab, qf, qlb, O, st, k0, qw, posq, pminq, farlo, farhi, afflo, affhi, selmask, blk, w);
            nvalid = false;
        }
#if PROF_BUILD
        { unsigned ce = 0; if (PROF_ID == 3 || PROF_ID == 4) { asm volatile("s_waitcnt lgkmcnt(0)" ::: "memory"); ce = PCLK(); } if (PROF_ID == 1) pacc += cb - ca; if (PROF_ID == 2) pacc += cc - cb; if (PROF_ID == 8) pacc += cd - cc; if (fastT) { if (PROF_ID == 3) pacc += ce - cd; if (PROF_ID == 5) ++pn5; } else { if (PROF_ID == 4) pacc += ce - cd; if (PROF_ID == 5) ++pn6; } }
#endif
    }
    __syncthreads();
#if PROF_BUILD
    if (w.tid == 0) { unsigned long long* pp = w.prof; if (PROF_ID != 5) atomicAdd(pp + PROF_ID, (unsigned long long)pacc); else { atomicAdd(pp + 5, (unsigned long long)pn5); atomicAdd(pp + 6, (unsigned long long)pn6); } }
#endif
}
template <int ND> __device__ __forceinline__ void load_q(bf16x8 (&qf)[ND], const bf16_t* qrow, int hi) {
#pragma unroll
    for (int d0 = 0; d0 < ND; ++d0) qf[d0] = *(const bf16x8*)(qrow + d0 * 16 + hi * 8);
}
template <int NO> __device__ __forceinline__ void store_o(const f32x16 (&O)[NO], bf16_t* orow, int hi) {
#pragma unroll
    for (int d = 0; d < NO; ++d)
#pragma unroll
        for (int g = 0; g < 4; ++g) { u32x2 v; v.x = cvt_pk_bf16(O[d][4 * g], O[d][4 * g + 1]); v.y = cvt_pk_bf16(O[d][4 * g + 2], O[d][4 * g + 3]); *(u32x2*)(orow + 32 * d + 8 * g + 4 * hi) = v; }
}
}

struct Args { const float* in[20]; float* out; unsigned char* ws; int ph_lo, ph_hi; };
constexpr int PH_PER_LAYER = 13, N_PHASES = 2 + DEPTH * PH_PER_LAYER;

struct Frame {
    LAS unsigned char* lds; volatile LAS unsigned* MISC; unsigned* ctl;
    int tid, lane, wave, G, vcu;
    unsigned char* ws;
};

__device__ __forceinline__ void transpose_item(const float* W, int K, int Nsrc, bf16_t* WT, int Ndst, int pad_lo, int pad_hi, int shift, LAS float* scr, int item, int lane, const float* gk = nullptr) {
    const int nblk = Ndst / 32, kb = item / nblk, nb = item % nblk, k0 = 64 * kb, n0 = 32 * nb;
    const bool pad = (n0 >= pad_lo && n0 < pad_hi);
    int ns0 = n0 - (n0 >= pad_hi ? shift : 0);
    if (shift < 0) { const int pn = n0 >> 8, w0 = n0 & 255; ns0 = (w0 < 128) ? 128 * pn + w0 : FFN + 128 * pn + (w0 - 128); }
    if (!pad) {
        if (gk) {
            const float gl = gk[k0 + lane];
#pragma unroll 8
            for (int i = 0; i < 32; ++i) { const int kk = 2 * i + (lane >> 5);
                const float g0 = __uint_as_float(__builtin_amdgcn_readlane(__float_as_uint(gl), 2 * i)), g1 = __uint_as_float(__builtin_amdgcn_readlane(__float_as_uint(gl), 2 * i + 1));
                scr[kk * 33 + (lane & 31)] = W[(size_t)(k0 + kk) * Nsrc + ns0 + (lane & 31)] * ((lane >> 5) ? g1 : g0); }
        } else {
#pragma unroll 8
            for (int i = 0; i < 32; ++i) { const int kk = 2 * i + (lane >> 5); scr[kk * 33 + (lane & 31)] = W[(size_t)(k0 + kk) * Nsrc + ns0 + (lane & 31)]; }
        }
    }
    LDS_WAIT(); asm volatile("" ::: "memory");
    const int c = lane & 7;
#pragma unroll
    for (int j = 0; j < 4; ++j) { const int n = (lane >> 3) + 8 * j; const LAS float* s = scr + (8 * c) * 33 + n;
        u32x4 o = (u32x4){0u, 0u, 0u, 0u};
        if (!pad) { o.x = cvt_pk_bf16(s[0 * 33], s[1 * 33]); o.y = cvt_pk_bf16(s[2 * 33], s[3 * 33]); o.z = cvt_pk_bf16(s[4 * 33], s[5 * 33]); o.w = cvt_pk_bf16(s[6 * 33], s[7 * 33]); }
        *(u32x4*)(WT + (size_t)(n0 + n) * K + k0 + 8 * c) = o; }
    LDS_WAIT(); asm volatile("" ::: "memory");
}
constexpr float W8_SCALE = 64.0f;
__device__ __forceinline__ unsigned pk4_fp8(float a, float b, float c, float d) { int w = __builtin_amdgcn_cvt_pk_fp8_f32(a, b, 0, false); w = __builtin_amdgcn_cvt_pk_fp8_f32(c, d, w, true); return (unsigned)w; }
__device__ __forceinline__ void transpose_item_f8(const float* W, int K, int Nsrc, int col0, unsigned char* W8, int N8, LAS float* scr, int item, int lane, const float* gk) {
    const int nblk = N8 / 32, kb = item / nblk, nb = item % nblk, k0 = 64 * kb, n0 = 32 * nb;
    const float gl = gk[k0 + lane] * W8_SCALE;
#pragma unroll 8
    for (int i = 0; i < 32; ++i) { const int kk = 2 * i + (lane >> 5);
        const float g0 = __uint_as_float(__builtin_amdgcn_readlane(__float_as_uint(gl), 2 * i)), g1 = __uint_as_float(__builtin_amdgcn_readlane(__float_as_uint(gl), 2 * i + 1));
        scr[kk * 33 + (lane & 31)] = W[(size_t)(k0 + kk) * Nsrc + col0 + n0 + (lane & 31)] * ((lane >> 5) ? g1 : g0); }
    LDS_WAIT(); asm volatile("" ::: "memory");
    const int c = lane & 7;
#pragma unroll
    for (int j = 0; j < 4; ++j) { const int n = (lane >> 3) + 8 * j; const LAS float* sp = scr + (8 * c) * 33 + n;
        u32x2 o; o.x = pk4_fp8(sp[0 * 33], sp[1 * 33], sp[2 * 33], sp[3 * 33]); o.y = pk4_fp8(sp[4 * 33], sp[5 * 33], sp[6 * 33], sp[7 * 33]);
        *(u32x2*)(W8 + (size_t)(n0 + n) * K + k0 + 8 * c) = o; }
    LDS_WAIT(); asm volatile("" ::: "memory");
}
__device__ __forceinline__ int t5_bucket(int n) {
    if (n < 16) return n;
    int b = 16;
    b += (n >= 19); b += (n >= 21); b += (n >= 24); b += (n >= 27); b += (n >= 31); b += (n >= 35); b += (n >= 40); b += (n >= 46);
    b += (n >= 52); b += (n >= 59); b += (n >= 67); b += (n >= 77); b += (n >= 87); b += (n >= 99); b += (n >= 113);
    return b;
}
template <bool WITH_F8>
__device__ __forceinline__ void rms_row_bf16(const float* x32, const bf16_t* x16, const float* g, bf16_t* orow, unsigned char* orow8, int lane) {
    f32x4 v[8]; float s = 0.f;
    if (x32) {
#pragma unroll
        for (int j = 0; j < 8; ++j) v[j] = *((const f32x4*)x32 + lane + 64 * j);
    } else {
#pragma unroll
        for (int j = 0; j < 8; ++j) { const u32x2 p = *((const u32x2*)x16 + lane + 64 * j); v[j] = (f32x4){bflo(p.x), bfhi(p.x), bflo(p.y), bfhi(p.y)}; }
    }
#pragma unroll
    for (int j = 0; j < 8; ++j) s += (v[j].x * v[j].x + v[j].y * v[j].y) + (v[j].z * v[j].z + v[j].w * v[j].w);
    const float rstd = 1.0f / sqrtf(wave_sum(s) * (1.0f / DM) + EPS);
#pragma unroll
    for (int j = 0; j < 8; ++j) { const f32x4 gg = *((const f32x4*)g + lane + 64 * j);
        u32x2 o; o.x = cvt_pk_bf16(v[j].x * rstd * gg.x, v[j].y * rstd * gg.y); o.y = cvt_pk_bf16(v[j].z * rstd * gg.z, v[j].w * rstd * gg.w);
        *((u32x2*)orow + lane + 64 * j) = o;
        if (WITH_F8) *((unsigned*)orow8 + lane + 64 * j) = pk4_fp8(v[j].x * rstd * gg.x, v[j].y * rstd * gg.y, v[j].z * rstd * gg.z, v[j].w * rstd * gg.w); }
}
__device__ __forceinline__ void cvt_row_in(const float* x32, bf16_t* xb, unsigned char* x8, unsigned long long* sq, int lane) {
    float s = 0.f;
#pragma unroll
    for (int j = 0; j < 8; ++j) { const f32x4 v = *((const f32x4*)x32 + lane + 64 * j);
        u32x2 o; o.x = cvt_pk_bf16(v.x, v.y); o.y = cvt_pk_bf16(v.z, v.w);
        *((u32x2*)xb + lane + 64 * j) = o;
        const float a = bflo(o.x), b = bfhi(o.x), c = bflo(o.y), d = bfhi(o.y);
        *((unsigned*)x8 + lane + 64 * j) = pk4_fp8(a, b, c, d);
        s += (a * a + b * b) + (c * c + d * d); }
    s = wave_sum(s);
    if (lane == 0) { const unsigned hi = (unsigned)s; const unsigned lo = (unsigned)((s - (float)hi) * 16777216.0f); *sq = ((unsigned long long)hi << 24) + lo; }
}
__device__ __forceinline__ void rms_row_f32(const bf16_t* xrow, const float* g, float* orow, int lane) {
    f32x4 v[8]; float s = 0.f;
#pragma unroll
    for (int j = 0; j < 8; ++j) { const u32x2 p = *((const u32x2*)xrow + lane + 64 * j); v[j] = (f32x4){bflo(p.x), bfhi(p.x), bflo(p.y), bfhi(p.y)}; s += (v[j].x * v[j].x + v[j].y * v[j].y) + (v[j].z * v[j].z + v[j].w * v[j].w); }
    const float rstd = 1.0f / sqrtf(wave_sum(s) * (1.0f / DM) + EPS);
#pragma unroll
    for (int j = 0; j < 8; ++j) { const f32x4 gg = *((const f32x4*)g + lane + 64 * j); *((f32x4*)orow + lane + 64 * j) = v[j] * rstd * gg; }
}

__device__ __forceinline__ float gelu_f(float v) {
    const float av = fabsf(v), d = av * 0.2316418882f + 1.0f;
    const float t = __builtin_amdgcn_rcpf(d);
    float q = t * 0.5307027145f + (-0.7265760135f); q = q * t + 0.7107068705f; q = q * t + (-0.142248368f); q = q * t + 0.127414796f; q = q * t;
    const float e = __builtin_amdgcn_exp2f((v * v) * (-0.72134752044f));
    const float m = v * (q * e), r = v - m;
    return v < 0.f ? m : r;
}

__device__ __forceinline__ void p_prologue(Frame& F, const Args& a) {
    const int otid = opaque_tid(F.wave), olane = otid & 63;
    LAS float* scr = (LAS float*)(F.lds + RING_OFF + F.wave * 16384);
    const int gw = F.vcu * NWAVES + F.wave, NGW = F.G * NWAVES;
    constexpr int I_IN = (DM / 64) * (ZG / 32) + (DM / 64) * (4 * DM / 32), I_INB = (DM / 64) * (ZG / 32), I_UQ = (512 / 64) * (768 / 32), I_UKV = (256 / 64) * (1024 / 32), I_BR1 = (512 / 64) * (DM / 32), I_BR = 4 * I_BR1,
                  I_OUT = (DM / 64) * (DM / 32), I_UP = (DM / 64) * (UP_N / 32), I_DN = (FFN / 64) * (DM / 32);
    constexpr int I_LAYER = I_IN + I_UQ + I_UKV + I_BR + I_OUT + I_UP + I_DN;
    for (int it = gw; it < DEPTH * I_LAYER; it += NGW) {
        const int l = it / I_LAYER; int r = it - l * I_LAYER;
        unsigned char* wl = F.ws + WS_W + (size_t)l * W_LAYER;
        if (r < I_INB) { transpose_item(a.in[4] + (size_t)l * DM * IN_COLS, DM, IN_COLS, (bf16_t*)(wl + W_IN), ZG, 2368, 2560, 192, scr, r, olane, a.in[3] + (size_t)l * DM); continue; }
        if (r < I_IN) { transpose_item_f8(a.in[4] + (size_t)l * DM * IN_COLS, DM, IN_COLS, 4672, wl + W_IN8, 4 * DM, scr, r - I_INB, olane, a.in[3] + (size_t)l * DM); continue; } r -= I_IN;
        if (r < I_UQ) { transpose_item(a.in[8] + (size_t)l * 512 * 768, 512, 768, (bf16_t*)(wl + W_UQ), 768, 1 << 30, 1 << 30, 0, scr, r, olane, a.in[7] + (size_t)l * 512); continue; } r -= I_UQ;
        if (r < I_UKV) { transpose_item(a.in[10] + (size_t)l * 256 * 1024, 256, 1024, (bf16_t*)(wl + W_UKV), 1024, 1 << 30, 1 << 30, 0, scr, r, olane, a.in[9] + (size_t)l * 256); continue; } r -= I_UKV;
        if (r < I_BR) { const int i = r / I_BR1; transpose_item(a.in[12] + ((size_t)l * 4 + i) * 512 * DM, 512, DM, (bf16_t*)(wl + W_BR) + (size_t)i * DM * 512, DM, 1 << 30, 1 << 30, 0, scr, r - i * I_BR1, olane); continue; } r -= I_BR;
        if (r < I_OUT) { transpose_item(a.in[13] + (size_t)l * DM * DM, DM, DM, (bf16_t*)(wl + W_OUT), DM, 1 << 30, 1 << 30, 0, scr, r, olane); continue; } r -= I_OUT;
        if (r < I_UP) { transpose_item(a.in[15] + (size_t)l * DM * UP_N, DM, UP_N, (bf16_t*)(wl + W_UP), UP_N, 1 << 30, 1 << 30, -1, scr, r, olane, a.in[14] + (size_t)l * DM); continue; } r -= I_UP;
        transpose_item(a.in[18] + (size_t)l * FFN * DM, FFN, DM, (bf16_t*)(wl + W_DN), DM, 1 << 30, 1 << 30, 0, scr, r, olane);
    }
    const int* pos = (const int*)a.in[1];
    const int gt = F.vcu * (NWAVES * 64) + otid, NGT = F.G * NWAVES * 64;
    { unsigned long long* sq = (unsigned long long*)(F.ws + WS_SSQ); for (int e = gt; e < DEPTH * 4 * M; e += NGT) sq[e] = 0ull; }
    f32x2* rope = (f32x2*)(F.ws + WS_ROPE);
    for (int e = gt; e < SEQ * 32; e += NGT) {
        const int s = e >> 5, i = e & 31;
        const float inv = (float)exp2((double)(-i) * (13.287712379549449 / 32.0));
        const float ang = (float)pos[s] * inv;
        const double rev = (double)ang * 0.15915494309189535;
        const float fr = (float)(rev - rint(rev));
        rope[e] = (f32x2){__builtin_amdgcn_cosf(fr), __builtin_amdgcn_sinf(fr)};
    }
    float* btab = (float*)(F.ws + WS_BTAB);
    for (int e = gt; e < 16 * 256; e += NGT) { const int hd = e >> 8, j = e & 255; int n = j - 64; n = n < 0 ? 0 : (n > 128 ? 128 : n); btab[e] = a.in[2][t5_bucket(n) * 16 + hd] * LOG2E; }
    int* pmm = (int*)(F.ws + WS_PMM);
    for (int e = gt; e < 128; e += NGT) { int mn = pos[e * 32], mx = mn;
        for (int j = 1; j < 32; ++j) { const int p = pos[e * 32 + j]; mn = p < mn ? p : mn; mx = p > mx ? p : mx; }
        pmm[2 * e] = mn; pmm[2 * e + 1] = mx; }
    if (gt < 2) { unsigned long long m = 0ull;
        for (int kb = 0; kb < 64; ++kb) { const int b0 = (gt * 64 + kb) * 32; bool ok = true; for (int j = 1; j < 32; ++j) ok = ok && (pos[b0 + j] == pos[b0] + j); m |= ok ? (1ull << kb) : 0ull; }
        ((unsigned long long*)(F.ws + WS_AFF))[gt] = m; }
    if (gt < DEPTH) {
        const float* lv = a.in[5] + (size_t)gt * 4 * 64; float s01 = 0.f, s23 = 0.f;
        for (int j = 0; j < 64; ++j) { s01 += lv[j] * lv[64 + j]; s23 += lv[128 + j] * lv[192 + j]; }
        const double li[4] = {0.20000000000000007, 0.35550906759096934, 0.4707130183435842, 0.5560582041556406};
        const float lam_init = (float)(gt == 0 ? li[0] : gt == 1 ? li[1] : gt == 2 ? li[2] : li[3]);
        ((float*)(F.ws + WS_LAM))[gt] = expf(s01) - expf(s23) + lam_init;
    }
}

__device__ __forceinline__ void p_prep(Frame& F, const Args& a, int l) {
    const int otid = opaque_tid(F.wave), lane = otid & 63;
    const int gw = F.vcu * NWAVES + F.wave, NGW = F.G * NWAVES;
    const bf16_t* Z = (const bf16_t*)(F.ws + WS_Z);
    bf16_t* KR = (bf16_t*)(F.ws + WS_KR);
    const f32x2* rope = (const f32x2*)(F.ws + WS_ROPE);
    for (int m = gw; m < M; m += NGW) {
        const bf16_t* zr = Z + (size_t)m * ZLD;
        if (lane < 32) {
            const float x1 = bf2f(zr[ZKR + lane]), x2 = bf2f(zr[ZKR + 32 + lane]);
            const f32x2 cs = rope[(m & (SEQ - 1)) * 32 + lane];
            KR[(size_t)m * 64 + lane] = (bf16_t)(cvt_pk_bf16(x1 * cs.x - x2 * cs.y, 0.f) & 0xffffu);
            KR[(size_t)m * 64 + 32 + lane] = (bf16_t)(cvt_pk_bf16(x1 * cs.y + x2 * cs.x, 0.f) & 0xffffu);
        }
    }
    LAS float* scr = (LAS float*)(F.lds + RING_OFF);
    float* KM = (float*)(F.ws + WS_KMEAN);
    for (int it = F.vcu; it < NB * 4 * 16; it += F.G) {
        const int b = it >> 6, h = (it >> 4) & 3, n = it & 15;
        const int c8 = otid & 15, rg = otid >> 4;
        float acc[8];
#pragma unroll
        for (int j = 0; j < 8; ++j) acc[j] = 0.f;
        for (int j = 0; j < 8; ++j) {
            const u32x4 v = *(const u32x4*)(Z + (size_t)(b * SEQ + n * 256 + rg + 32 * j) * ZLD + ZMK + h * 128 + c8 * 8);
            acc[0] += bflo(v.x); acc[1] += bfhi(v.x); acc[2] += bflo(v.y); acc[3] += bfhi(v.y); acc[4] += bflo(v.z); acc[5] += bfhi(v.z); acc[6] += bflo(v.w); acc[7] += bfhi(v.w);
        }
#pragma unroll
        for (int j = 0; j < 8; ++j) scr[rg * 132 + c8 * 8 + j] = acc[j];
        __syncthreads();
        if (otid < 128) { float s = 0.f; for (int r = 0; r < 32; ++r) s += scr[r * 132 + otid]; KM[(size_t)it * 128 + otid] = s * (1.0f / 256.0f); }
        __syncthreads();
    }
}

constexpr size_t WS_GTAIL = WS_Z, WS_GHEADA = WS_Z + 12 * MiB, WS_GHEADV = WS_Z + 24 * MiB;
static_assert((size_t)(M / 64) * 2 * FFN * 4 <= 12 * MiB, "side buffers");
__device__ __forceinline__ void p_glufix(Frame& F, const Args& a, int l) {
    const int tid = opaque_tid(F.wave);
    bf16_t* Gb = (bf16_t*)(F.ws + WS_T);
    const float* tail = (const float*)(F.ws + WS_GTAIL); const float* heada = (const float*)(F.ws + WS_GHEADA); const float* headv = (const float*)(F.ws + WS_GHEADV);
    const float* cw = a.in[16] + (size_t)l * 3 * FFN; const float* cb = a.in[17] + (size_t)l * FFN;
    constexpr int NCH = FFN / 8;
    for (int it = F.vcu * 512 + tid; it < (M / 64) * 2 * NCH; it += F.G * 512) {
        const int c8 = it % NCH, gj = it / NCH, j = gj & 1, gid = gj >> 1, ch0 = c8 * 8;
        const bool zp = (gid & 63) == 0;
        float t0[8], t1[8], h0[8], av[8], vv[8];
#pragma unroll
        for (int h = 0; h < 2; ++h) {
            const f32x4 z4 = (f32x4){0.f, 0.f, 0.f, 0.f};
            const f32x4 x0 = zp ? z4 : *(const f32x4*)(tail + ((size_t)(gid - 1) * 2 + 0) * FFN + ch0 + 4 * h), x1 = zp ? z4 : *(const f32x4*)(tail + ((size_t)(gid - 1) * 2 + 1) * FFN + ch0 + 4 * h);
            const f32x4 y0 = *(const f32x4*)(heada + ((size_t)gid * 2 + 0) * FFN + ch0 + 4 * h), ya = *(const f32x4*)(heada + ((size_t)gid * 2 + j) * FFN + ch0 + 4 * h), yv = *(const f32x4*)(headv + ((size_t)gid * 2 + j) * FFN + ch0 + 4 * h);
#pragma unroll
            for (int e = 0; e < 4; ++e) { t0[4 * h + e] = x0[e]; t1[4 * h + e] = x1[e]; h0[4 * h + e] = y0[e]; av[4 * h + e] = ya[e]; vv[4 * h + e] = yv[e]; }
        }
        float o[8];
#pragma unroll
        for (int h = 0; h < 2; ++h) { const f32x4 c0 = *(const f32x4*)(cw + ch0 + 4 * h), c1 = *(const f32x4*)(cw + FFN + ch0 + 4 * h), c2 = *(const f32x4*)(cw + 2 * FFN + ch0 + 4 * h), c3 = *(const f32x4*)(cb + ch0 + 4 * h);
#pragma unroll
            for (int e = 0; e < 4; ++e) { const int c = 4 * h + e; const float am1 = j ? h0[c] : t1[c], am2 = j ? t1[c] : t0[c];
                o[c] = pg8::gelu_erf(c3[e] + c0[e] * am2 + c1[e] * am1 + c2[e] * av[c]) * vv[c]; } }
        u32x4 w; w.x = cvt_pk_bf16(o[0], o[1]); w.y = cvt_pk_bf16(o[2], o[3]); w.z = cvt_pk_bf16(o[4], o[5]); w.w = cvt_pk_bf16(o[6], o[7]);
        *(u32x4*)(Gb + (size_t)(gid * 64 + j) * FFN + ch0) = w;
    }
}

struct AttnEnv { const bf16_t* Z; const bf16_t* QMLA; const bf16_t* KVMLA; const bf16_t* KR; bf16_t* BRO; const int* pos; const int* pmm; const float* btabg; const f32x2* rope; const float* kmean;
                 const float* subln_g; const float* sinks; float* dscr; float lam, one_m_li; };

__device__ __forceinline__ void load_btab(LAS unsigned char* lds, const float* src, int tid) { if (tid < 256) ((LAS float*)(lds + att::BTAB_OFF))[tid] = src[tid]; }

constexpr int DIFF_XOFF = 104448;
__device__ __forceinline__ void unit_diff(LAS unsigned char* lds, const AttnEnv& E, int b, int h, int qb, const att::WaveCtx& w0) {
    typedef att::Cfg<128, 0, 128, 0, 4> C;
    const int mp = w0.wid >> 2, rr = w0.wid & 3;
    att::WaveCtx w = w0; w.koff = mp * 128;
    const int qw = qb * 128 + 32 * rr, qi = qw + w.r32; const size_t grow = (size_t)b * SEQ + qi;
    load_btab(lds, E.btabg + (0 + h) * 256, w.tid);
    const int posq = E.pos[qi], pminq = E.pmm[(qw >> 5) * 2];
    att::Src src; src.k0 = E.Z + (size_t)b * SEQ * ZLD + ZKA + (2 * h) * 64; src.pk0 = ZLD; src.k1 = src.k0; src.pk1 = ZLD; src.v = E.Z + (size_t)b * SEQ * ZLD + ZVA + h * 128; src.pv = ZLD; src.pos = E.pos;
    bf16x8 qf[4]; att::load_q<4>(qf, E.Z + grow * ZLD + ZQA + (2 * h + mp) * 64, w.hi);
    f32x16 O[4];
#pragma unroll
    for (int d = 0; d < 4; ++d)
#pragma unroll
        for (int r = 0; r < 16; ++r) O[d][r] = 0.f;
    att::RowState st; st.m = -1e30f; st.l = 0.f;
    att::run_tiles<C, 0, true, true, true>(lds, src, 0, 2 * (qb + 1), qf, O, st, qw, posq, pminq, E.pmm, 0u, 0, w);
    const float inv = 1.0f / (half_sum(st.l));
    LAS float* X = (LAS float*)(lds + DIFF_XOFF) + rr * 2048 + w.lane;
#pragma unroll
    for (int rd = 0; rd < 2; ++rd) {
        if (mp == 1) {
#pragma unroll
            for (int dd = 0; dd < 2; ++dd)
#pragma unroll
                for (int r = 0; r < 16; ++r) X[(dd * 16 + r) * 64] = O[2 * rd + dd][r] * inv;
        }
        __syncthreads();
        if (mp == 0) {
#pragma unroll
            for (int dd = 0; dd < 2; ++dd)
#pragma unroll
                for (int r = 0; r < 16; ++r) O[2 * rd + dd][r] = O[2 * rd + dd][r] * inv - E.lam * X[(dd * 16 + r) * 64];
        }
        __syncthreads();
    }
    if (mp == 0) {
        float ss = 0.f;
#pragma unroll
        for (int d = 0; d < 4; ++d)
#pragma unroll
            for (int r = 0; r < 16; ++r) ss += O[d][r] * O[d][r];
        ss = half_sum(ss);
        const float sc = (1.0f / sqrtf(ss * (1.0f / 128.0f) + EPS)) * E.one_m_li;
#pragma unroll
        for (int d = 0; d < 4; ++d)
#pragma unroll
            for (int g = 0; g < 4; ++g) { const f32x4 gg = *(const f32x4*)(E.subln_g + 32 * d + 8 * g + 4 * w.hi);
#pragma unroll
                for (int e = 0; e < 4; ++e) O[d][4 * g + e] *= sc * gg[e]; }
        att::store_o<4>(O, E.BRO + grow * DM + h * 128, w.hi);
    }
}

__device__ __forceinline__ void unit_mla(LAS unsigned char* lds, const AttnEnv& E, int b, int h, int qb, const att::WaveCtx& w) {
    typedef att::Cfg<128, 64, 128, 6> C;
    const int qw = qb * 256 + 32 * w.wid, qi = qw + w.r32; const size_t grow = (size_t)b * SEQ + qi;
    att::Src src; src.k0 = E.KVMLA + (size_t)b * SEQ * 1024 + h * 256; src.pk0 = 1024; src.k1 = E.KR + (size_t)b * SEQ * 64; src.pk1 = 64; src.v = E.KVMLA + (size_t)b * SEQ * 1024 + h * 256 + 128; src.pv = 1024; src.pos = E.pos;
    bf16x8 qf[6]; att::load_q<6>(qf, E.QMLA + grow * 768 + h * 192, w.hi);
    {
        bf16x8 qr[4]; att::load_q<4>(qr, E.QMLA + grow * 768 + h * 192 + 128, w.hi);
        LAS unsigned char* qlw = lds + att::QL_OFF + w.wid * (C::NQL * 1024) + w.lane * 16;
        { bf16x8 qp[2]; att::load_q<2>(qp, E.QMLA + grow * 768 + h * 192 + 96, w.hi); *(LAS bf16x8*)(qlw) = qp[0]; *(LAS bf16x8*)(qlw + 1024) = qp[1]; }
#pragma unroll
        for (int dd = 0; dd < 2; ++dd) {
            const f32x2* cs = E.rope + (size_t)qi * 32 + 16 * dd + 8 * w.hi;
            unsigned o1[4], o2[4];
#pragma unroll
            for (int jp = 0; jp < 4; ++jp) {
                const f32x4 c2 = *(const f32x4*)(cs + 2 * jp);
                const float a0 = bf2f((unsigned short)qr[dd][2 * jp]), a1 = bf2f((unsigned short)qr[dd][2 * jp + 1]);
                const float b0 = bf2f((unsigned short)qr[2 + dd][2 * jp]), b1 = bf2f((unsigned short)qr[2 + dd][2 * jp + 1]);
                o1[jp] = cvt_pk_bf16(a0 * c2[0] - b0 * c2[1], a1 * c2[2] - b1 * c2[3]);
                o2[jp] = cvt_pk_bf16(a0 * c2[1] + b0 * c2[0], a1 * c2[3] + b1 * c2[2]);
            }
            *(LAS u32x4*)(qlw + (2 + dd) * 1024) = (u32x4){o1[0], o1[1], o1[2], o1[3]};
            *(LAS u32x4*)(qlw + (4 + dd) * 1024) = (u32x4){o2[0], o2[1], o2[2], o2[3]};
        }
    }
    f32x16 O[4];
#pragma unroll
    for (int d = 0; d < 4; ++d)
#pragma unroll
        for (int r = 0; r < 16; ++r) O[d][r] = 0.f;
    att::RowState st; st.m = -1e30f; st.l = 0.f;
    att::run_tiles<C, 0, false, true, true>(lds, src, 0, 4 * (qb + 1), qf, O, st, qw, 0, 0, E.pmm, 0u, 0, w);
    const float inv = 1.0f / (half_sum(st.l));
#pragma unroll
    for (int d = 0; d < 4; ++d)
#pragma unroll
        for (int r = 0; r < 16; ++r) O[d][r] *= inv;
    const size_t grow2 = (size_t)b * SEQ + qw + (int)(fresh_lane_id() & 31u);
    att::store_o<4>(O, E.BRO + grow2 * DM + 512 + h * 128, w.hi);
}

__device__ __forceinline__ void unit_swa(LAS unsigned char* lds, const AttnEnv& E, int b, int kvh, int qblk, const att::WaveCtx& w) {
    typedef att::Cfg<64, 0, 64> C;
    const int g = w.wid >> 1, qh = kvh * 4 + g;
    const int qw = qblk * 64 + 32 * (w.wid & 1), qi = qw + w.r32; const size_t grow = (size_t)b * SEQ + qi;
    for (int e = w.tid; e < 1024; e += 512) ((LAS float*)(lds + att::BTAB_OFF))[e] = E.btabg[(4 + kvh * 4 + (e >> 8)) * 256 + (e & 255)];
    const int posq = E.pos[qi], pminq = E.pmm[(qw >> 5) * 2];
    att::Src src; src.k0 = E.Z + (size_t)b * SEQ * ZLD + ZSK + kvh * 64; src.pk0 = ZLD; src.k1 = src.k0; src.pk1 = ZLD; src.v = E.Z + (size_t)b * SEQ * ZLD + ZSV + kvh * 64; src.pv = ZLD; src.pos = E.pos;
    bf16x8 qf[4]; att::load_q<4>(qf, E.Z + grow * ZLD + ZSQ + qh * 64, w.hi);
    f32x16 O[2];
#pragma unroll
    for (int d = 0; d < 2; ++d)
#pragma unroll
        for (int r = 0; r < 16; ++r) O[d][r] = 0.f;
    att::RowState st; st.m = E.sinks[qh] * LOG2E; st.l = (w.hi == 0) ? 1.0f : 0.0f;
    const int t0 = qblk < 2 ? 0 : qblk - 2;
    att::run_tiles<C, 1, true, false, true>(lds, src, t0, qblk + 1, qf, O, st, qw, posq, pminq, E.pmm, 0u, 0, w, g * 1024);
    const float inv = 1.0f / (half_sum(st.l));
#pragma unroll
    for (int d = 0; d < 2; ++d)
#pragma unroll
        for (int r = 0; r < 16; ++r) O[d][r] *= inv;
    att::store_o<2>(O, E.BRO + grow * DM + 1024 + qh * 64, w.hi);
}

__device__ __forceinline__ void unit_moba(LAS unsigned char* lds, const AttnEnv& E, int b, int h, int blk, const att::WaveCtx& w) {
    typedef att::Cfg<128, 0, 128> C;
    const int qw = blk * 256 + 32 * w.wid, qi = qw + w.r32; const size_t grow = (size_t)b * SEQ + qi;
    load_btab(lds, E.btabg + (12 + h) * 256, w.tid);
    LAS float* km = (LAS float*)(lds + att::KMEAN_OFF);
    for (int e = w.tid; e < blk * 128; e += 512) km[e] = E.kmean[(size_t)((b * 4 + h) * 16) * 128 + e];
    const int posq = E.pos[qi], pminq = E.pmm[(qw >> 5) * 2];
    att::Src src; src.k0 = E.Z + (size_t)b * SEQ * ZLD + ZMK + h * 128; src.pk0 = ZLD; src.k1 = src.k0; src.pk1 = ZLD; src.v = E.Z + (size_t)b * SEQ * ZLD + ZMV + h * 128; src.pv = ZLD; src.pos = E.pos;
    bf16x8 qf[8]; att::load_q<8>(qf, E.Z + grow * ZLD + ZMQ + h * 128, w.hi);
    __syncthreads();
    unsigned selmask;
    if (blk <= 3) selmask = (1u << blk) - 1u;
    else {
        float v1 = NEG_INF, v2 = NEG_INF, v3 = NEG_INF; int i1 = 31, i2 = 31, i3 = 31;
        for (int n = 0; n < blk; ++n) {
            float part = 0.f;
#pragma unroll
            for (int d0 = 0; d0 < 8; ++d0) {
                const f32x4 k0 = *(const LAS f32x4*)(km + n * 128 + 16 * d0 + 8 * w.hi), k1 = *(const LAS f32x4*)(km + n * 128 + 16 * d0 + 8 * w.hi + 4);
#pragma unroll
                for (int j = 0; j < 4; ++j) part += bf2f((unsigned short)qf[d0][j]) * k0[j] + bf2f((unsigned short)qf[d0][4 + j]) * k1[j];
            }
            const float g = half_sum(part);
            if (g > v1) { v3 = v2; i3 = i2; v2 = v1; i2 = i1; v1 = g; i1 = n; }
            else if (g > v2) { v3 = v2; i3 = i2; v2 = g; i2 = n; }
            else if (g > v3) { v3 = g; i3 = n; }
        }
        selmask = (1u << i1) | (1u << i2) | (1u << i3);
    }
    f32x16 O[4];
#pragma unroll
    for (int d = 0; d < 4; ++d)
#pragma unroll
        for (int r = 0; r < 16; ++r) O[d][r] = 0.f;
    att::RowState st; st.m = -1e30f; st.l = 0.f;
    att::run_tiles<C, 2, true, true, true>(lds, src, 0, 4 * (blk + 1), qf, O, st, qw, posq, pminq, E.pmm, selmask, blk, w);
    const float inv = 1.0f / (half_sum(st.l));
#pragma unroll
    for (int d = 0; d < 4; ++d)
#pragma unroll
        for (int r = 0; r < 16; ++r) O[d][r] *= inv;
    att::store_o<4>(O, E.BRO + grow * DM + 1536 + h * 128, w.hi);
}

#ifndef CHECK_BUILD
#define CHECK_BUILD 0
#endif
#ifndef CHECK_TOL
#define CHECK_TOL 0.04f
#endif
#ifndef CHECK_REPORT
#define CHECK_REPORT (-1)
#endif
#if CHECK_BUILD
constexpr size_t WS_CHK_KV = WS_END;
constexpr size_t WS_CHK_KR = WS_CHK_KV + (size_t)SEQ * 1024 * 4;
constexpr size_t WS_END2 = WS_CHK_KR + (size_t)SEQ * 64 * 4;
constexpr int CHK_B = 1, CHK_NS = 32;
constexpr int CW_CHK = 2048;
__device__ __forceinline__ int chk_row(int i) {
    const int ts[CHK_NS] = {0, 1, 2, 31, 32, 63, 64, 127, 128, 129, 255, 256, 257, 300, 511, 512, 700, 767, 768, 1000, 1023, 1024, 1500, 2047, 2048, 3071, 3072, 3500, 3839, 3840, 4000, 4095};
    int r = 0;
#pragma unroll
    for (int j = 0; j < CHK_NS; ++j) r = (i == j) ? ts[j] : r;
    return r;
}
__device__ __forceinline__ void chk_sincos(float ang, float& c, float& s) {
    double x = (double)ang; const double twopi = 6.283185307179586476925;
    x -= twopi * rint(x / twopi);
    const double x2 = x * x; double tc = 1.0, ts_ = x, sc = 1.0, ss = x;
#pragma unroll 1
    for (int k = 1; k < 16; ++k) { const double kk = (double)k; tc *= -x2 / ((2.0 * kk - 1.0) * (2.0 * kk)); ts_ *= -x2 / ((2.0 * kk) * (2.0 * kk + 1.0)); sc += tc; ss += ts_; }
    c = (float)sc; s = (float)ss;
}
__device__ __forceinline__ int chk_bucket(int rel) {
    const int n = rel > 0 ? rel : 0;
    if (n < 16) return n;
    const float nf = (float)n;
    const int large = 16 + (int)(logf(nf / 16.0f) / 2.0794415416798357f * 16.0f);
    return large < 31 ? large : 31;
}
__device__ __forceinline__ float chk_block_max(float v, LAS float* red, int tid) {
    v = wave_max(v);
    __syncthreads(); if ((tid & 63) == 0) red[tid >> 6] = v; __syncthreads();
    float r = red[0];
#pragma unroll
    for (int j = 1; j < 8; ++j) r = fmaxf(r, red[j]);
    return r;
}
__device__ __forceinline__ float chk_block_sum(float v, LAS float* red, int tid) {
    v = wave_sum(v);
    __syncthreads(); if ((tid & 63) == 0) red[tid >> 6] = v; __syncthreads();
    float r = 0.f;
#pragma unroll
    for (int j = 0; j < 8; ++j) r += red[j];
    return r;
}
__device__ __forceinline__ void chk_record(unsigned* ctl, int type, float diff, float mag, LAS float* red, int tid) {
    const float md = chk_block_max(diff, red, tid), mm = chk_block_max(mag, red, tid);
    if (tid == 0) { atomicMax(ctl + CW_CHK + 2 * type, __float_as_uint(mm > 0.f ? md / mm : 1.0e9f)); atomicMax(ctl + CW_CHK + 2 * type + 1, 1u); }
}
__device__ __forceinline__ void chk_prep(Frame& F, const Args& a) {
    const int tid = opaque_tid(F.wave);
    const bf16_t* Z = (const bf16_t*)(F.ws + WS_Z) + (size_t)CHK_B * SEQ * ZLD;
    float* KV = (float*)(F.ws + WS_CHK_KV); float* KRn = (float*)(F.ws + WS_CHK_KR);
    const float* gkv = a.in[9]; const float* wukv = a.in[10]; const int* pos = (const int*)a.in[1];
    const long gt = (long)F.vcu * 512 + tid, NGT = (long)F.G * 512;
    for (long e = gt; e < (long)SEQ * 1024; e += NGT) {
        const int srow = (int)(e >> 10), n = (int)(e & 1023);
        const bf16_t* zr = Z + (size_t)srow * ZLD + ZCKV;
        float ss = 0.f; for (int c = 0; c < 256; ++c) { const float x = bf2f(zr[c]); ss += x * x; }
        const float rstd = 1.0f / sqrtf(ss / 256.0f + EPS);
        float acc = 0.f; for (int c = 0; c < 256; ++c) acc += bf2f(zr[c]) * rstd * gkv[c] * wukv[(size_t)c * 1024 + n];
        KV[e] = acc;
    }
    for (long e = gt; e < (long)SEQ * 32; e += NGT) {
        const int srow = (int)(e >> 5), i = (int)(e & 31);
        const float inv = __builtin_amdgcn_exp2f((float)(-2 * i) / 64.0f * 13.287712379549449f);
        float c, s_; chk_sincos((float)pos[srow] * inv, c, s_);
        const float x1 = bf2f(Z[(size_t)srow * ZLD + ZKR + i]), x2 = bf2f(Z[(size_t)srow * ZLD + ZKR + 32 + i]);
        KRn[srow * 64 + i] = x1 * c - x2 * s_; KRn[srow * 64 + 32 + i] = x1 * s_ + x2 * c;
    }
}
__device__ __forceinline__ void chk_items(Frame& F, const Args& a) {
    const int tid = opaque_tid(F.wave);
    LAS float* sc = (LAS float*)(F.lds + RING_OFF);
    LAS float* qv = sc + 4096;
    LAS float* tmp = qv + 192;
    LAS float* red = tmp + 512;
    LAS float* part = red + 8;
    LAS float* gate = part + 512;
    const bf16_t* Zb = (const bf16_t*)(F.ws + WS_Z) + (size_t)CHK_B * SEQ * ZLD;
    const bf16_t* BRO = (const bf16_t*)(F.ws + WS_BRO) + (size_t)CHK_B * SEQ * DM;
    const float* KV = (const float*)(F.ws + WS_CHK_KV); const float* KRn = (const float*)(F.ws + WS_CHK_KR);
    const int* pos = (const int*)a.in[1]; const float* relb = a.in[2];
    for (int it = F.vcu; it < 16 * CHK_NS; it += F.G) {
        const int smp = it % CHK_NS, hh = it / CHK_NS;
        const int t = chk_row(smp);
        __syncthreads();
        if (hh < 4) {
            const int h = hh;
            {
                const bf16_t* zr = Zb + (size_t)t * ZLD + ZCQ;
                const float x = bf2f(zr[tid]);
                const float ss = chk_block_sum(x * x, red, tid);
                tmp[tid] = x * (1.0f / sqrtf(ss / 512.0f + EPS)) * a.in[7][tid];
            }
            __syncthreads();
            if (tid < 192) { float acc = 0.f; const float* w = a.in[8] + h * 192 + tid; for (int k = 0; k < 512; ++k) acc += tmp[k] * w[(size_t)k * 768]; qv[tid] = acc; }
            __syncthreads();
            float r1 = 0.f, r2 = 0.f;
            if (tid < 32) { const float inv = __builtin_amdgcn_exp2f((float)(-2 * tid) / 64.0f * 13.287712379549449f); float c, s_; chk_sincos((float)pos[t] * inv, c, s_);
                const float x1 = qv[128 + tid], x2 = qv[160 + tid]; r1 = x1 * c - x2 * s_; r2 = x1 * s_ + x2 * c; }
            __syncthreads();
            if (tid < 32) { qv[128 + tid] = r1; qv[160 + tid] = r2; }
            __syncthreads();
            float lmax = -3.0e38f;
            for (int k = tid; k <= t; k += 512) { float d = 0.f; const float* kr = KV + (size_t)k * 1024 + h * 256;
                for (int j = 0; j < 128; ++j) d += qv[j] * kr[j];
                for (int j = 0; j < 64; ++j) d += qv[128 + j] * KRn[k * 64 + j];
                d *= 0.07216878364870322f; sc[k] = d; lmax = fmaxf(lmax, d); }
            const float mx = chk_block_max(lmax, red, tid);
            float ls = 0.f; for (int k = tid; k <= t; k += 512) { const float p = expf(sc[k] - mx); sc[k] = p; ls += p; }
            const float den = chk_block_sum(ls, red, tid);
            __syncthreads();
            { const int dv = tid & 127, grp = tid >> 7; float o = 0.f; for (int k = grp; k <= t; k += 4) o += sc[k] * KV[(size_t)k * 1024 + h * 256 + 128 + dv]; part[grp * 128 + dv] = o; }
            __syncthreads();
            { float df = 0.f, mg = 0.f;
              if (tid < 128) { const float o = (part[tid] + part[128 + tid] + part[256 + tid] + part[384 + tid]) / den; const float f = bf2f(BRO[(size_t)t * DM + 512 + h * 128 + tid]); df = fabsf(f - o); mg = fabsf(o); }
              chk_record(F.ctl, 0, df, mg, red, tid); }
        } else if (hh < 8) {
            const int h = hh - 4, blk = t >> 8;
            if (tid < 128) qv[tid] = bf2f(Zb[(size_t)t * ZLD + ZMQ + h * 128 + tid]);
            __syncthreads();
            { const int n = tid >> 5, sub = tid & 31; float g = 0.f;
              if (n < blk) for (int r = sub; r < 256; r += 32) { const bf16_t* kr = Zb + (size_t)(n * 256 + r) * ZLD + ZMK + h * 128; float d = 0.f; for (int j = 0; j < 128; ++j) d += qv[j] * bf2f(kr[j]); g += d; }
              g += swz_xor<1>(g); g += swz_xor<2>(g); g += swz_xor<4>(g); g += swz_xor<8>(g); g += swz_xor<16>(g);
              if (sub == 0) gate[n] = (n < blk) ? g : -3.0e38f; }
            __syncthreads();
            unsigned sel = 0u;
            if (blk <= 3) sel = (1u << blk) - 1u;
            else for (int c = 0; c < 3; ++c) { int bi = -1; float bv = -3.0e38f; for (int n = 0; n < blk; ++n) if (!((sel >> n) & 1u) && gate[n] > bv) { bv = gate[n]; bi = n; } sel |= 1u << bi; }
            float lmax = -3.0e38f;
            for (int k = tid; k <= t; k += 512) { const int n = k >> 8; const bool ok = (n == blk) || ((sel >> n) & 1u);
                float d = -3.0e38f;
                if (ok) { const bf16_t* kr = Zb + (size_t)k * ZLD + ZMK + h * 128; d = 0.f; for (int j = 0; j < 128; ++j) d += qv[j] * bf2f(kr[j]);
                    d = d / LOG2E + relb[chk_bucket(pos[t] - pos[k]) * 16 + 12 + h]; lmax = fmaxf(lmax, d); }
                sc[k] = d; }
            const float mx = chk_block_max(lmax, red, tid);
            float ls = 0.f; for (int k = tid; k <= t; k += 512) { const float p = (sc[k] > -1.0e38f) ? expf(sc[k] - mx) : 0.f; sc[k] = p; ls += p; }
            const float den = chk_block_sum(ls, red, tid);
            __syncthreads();
            { const int dv = tid & 127, grp = tid >> 7; float o = 0.f; for (int k = grp; k <= t; k += 4) o += sc[k] * bf2f(Zb[(size_t)k * ZLD + ZMV + h * 128 + dv]); part[grp * 128 + dv] = o; }
            __syncthreads();
            { float df = 0.f, mg = 0.f;
              if (tid < 128) { const float o = (part[tid] + part[128 + tid] + part[256 + tid] + part[384 + tid]) / den; const float f = bf2f(BRO[(size_t)t * DM + 1536 + h * 128 + tid]); df = fabsf(f - o); mg = fabsf(o); }
              chk_record(F.ctl, 1, df, mg, red, tid); }
        } else {
            const int qh = hh - 8, kvh = qh >> 2;
            if (tid < 64) qv[tid] = bf2f(Zb[(size_t)t * ZLD + ZSQ + qh * 64 + tid]);
            __syncthreads();
            const float sink = a.in[11][qh];
            float lmax = -3.0e38f; const int kk = t - 127 + tid;
            float d = -3.0e38f;
            if (tid < 128 && kk >= 0) { const bf16_t* kr = Zb + (size_t)kk * ZLD + ZSK + kvh * 64; d = 0.f; for (int j = 0; j < 64; ++j) d += qv[j] * bf2f(kr[j]);
                d = d / LOG2E + relb[chk_bucket(pos[t] - pos[kk]) * 16 + 4 + qh]; lmax = d; }
            const float mx = fmaxf(chk_block_max(lmax, red, tid), sink);
            const float p = (d > -1.0e38f) ? expf(d - mx) : 0.f;
            if (tid < 128) sc[tid] = p;
            const float den = chk_block_sum(p, red, tid) + expf(sink - mx);
            __syncthreads();
            { float df = 0.f, mg = 0.f;
              if (tid < 64) { float o = 0.f; for (int j = 0; j < 128; ++j) { const int k2 = t - 127 + j; if (k2 >= 0) o += sc[j] * bf2f(Zb[(size_t)k2 * ZLD + ZSV + kvh * 64 + tid]); }
                o /= den; const float f = bf2f(BRO[(size_t)t * DM + 1024 + qh * 64 + tid]); df = fabsf(f - o); mg = fabsf(o); }
              chk_record(F.ctl, 2, df, mg, red, tid); }
        }
    }
}
#endif

__device__ __forceinline__ int queue_next(Frame& F, unsigned* head) {
    __syncthreads();
    if (is_thread0(F.wave)) F.MISC[4] = __hip_atomic_fetch_add(head, 1u, RLX_AGENT);
    __syncthreads();
    return (int)F.MISC[4];
}
__device__ __forceinline__ int queue_pick(Frame& F, unsigned* heads, int N, int myx) {
    __syncthreads();
    if (F.wave == 0) {
        const unsigned lane = fresh_lane_id();
        int res = -1;
        for (int tries = 0; tries < 64; ++tries) {
            unsigned h = 0xffffffffu;
            if (lane < 8u) h = __hip_atomic_load(heads + 64 * lane, RLX_AGENT);
            const unsigned long long m = __ballot(h < (unsigned)N);
            if ((m & 0xffull) == 0ull) break;
            const unsigned rot = (unsigned)(((m & 0xffull) | ((m & 0xffull) << 8)) >> myx) & 0xffu;
            const int x = (myx + __builtin_ctz(rot)) & 7;
            unsigned j = 0u;
            if (lane == 0u) j = __hip_atomic_fetch_add(heads + 64 * x, 1u, RLX_AGENT);
            j = (unsigned)__builtin_amdgcn_readfirstlane((int)j);
            if (j < (unsigned)N) { res = (x << 16) | (int)j; break; }
        }
        if (lane == 0u) F.MISC[4] = (unsigned)res;
    }
    __syncthreads();
    return (int)F.MISC[4];
}

__global__ void __launch_bounds__(NWAVES * 64, 2) trunk_fwd(Args args) {
    extern __shared__ __attribute__((aligned(16))) unsigned char lds_raw[];
    Frame F;
    F.lds = (LAS unsigned char*)lds_raw;
    F.MISC = (volatile LAS unsigned*)(F.lds + MISC_OFF);
    F.tid = threadIdx.x; F.lane = F.tid & 63; F.wave = __builtin_amdgcn_readfirstlane(F.tid >> 6);
    F.G = gridDim.x; { const int bx = blockIdx.x; F.vcu = (F.G % 8 == 0) ? (bx % 8) * (F.G / 8) + bx / 8 : bx; }
    F.ws = args.ws; F.ctl = (unsigned*)(args.ws + WS_CTL);
    for (int u = F.tid; u < (LDS_BYTES - LDSCTL_OFF) / 4; u += NWAVES * 64) ((LAS unsigned*)(F.lds + LDSCTL_OFF))[u] = 0u;
    __syncthreads();
    const int lo = args.ph_lo, hi = args.ph_hi;
    XcdBarrier bar; bar.bar = F.ctl + CW_BAR; bar.x = 0; bar.st = nullptr; bar.wave = F.wave;
    if (hi - lo > 1) bar = xcd_barrier_post(F.ctl + CW_BAR, F.MISC + 8, F.wave);
#ifndef DBG_MASK
#define DBG_MASK 0xFFFFFu
#endif
#define EN(j) (((DBG_MASK) >> (j)) & 1u)
#ifndef DBG_ATT
#define DBG_ATT 0xFu
#endif
#define ENA(j) (((DBG_ATT) >> (j)) & 1u)
#define IN(k) (lo <= (k) && (k) < hi)
#ifndef DUP
#define DUP (-1)
#endif
#define REPS(j) ((DUP) == (j) ? 2 : 1)
#define SEAM(k) do { if ((k) + 1 < hi) xcd_barrier(bar); } while (0)
    const int gw = F.vcu * NWAVES + F.wave, NGW = F.G * NWAVES;
    unsigned char* ws = F.ws;
    unsigned long long* SSQ = (unsigned long long*)(ws + WS_SSQ); unsigned long long* SSQ2 = SSQ + (size_t)DEPTH * 2 * M;
    bf16_t* X = (bf16_t*)(ws + WS_X); bf16_t* XN = (bf16_t*)(ws + WS_XN); bf16_t* MG = (bf16_t*)(ws + WS_MG); bf16_t* Z = (bf16_t*)(ws + WS_Z);
    unsigned char* X8 = ws + WS_XN;
    bf16_t* U = (bf16_t*)(ws + WS_Z); bf16_t* Gb = (bf16_t*)(ws + WS_T); float* T = (float*)(ws + WS_T);

    const bool grp_ok = (F.G == 256) && lo == 0 && hi == N_PHASES && (DUP) < 0;
    const int gpm = 8 * ((int)blockIdx.x & 7) + (((int)blockIdx.x >> 3) & 7);
    if (grp_ok && is_thread0(F.wave)) xb_add(F.ctl + CW_XTAB + (int)blockIdx.x, xb_xcc_id() + 1u);
    if (EN(13) && IN(0)) for (int rep = 0; rep < REPS(13); ++rep) { p_prologue(F, args); SEAM(0); }
    bool grp_fast = false;
    if (grp_ok) { unsigned same = 1u; const unsigned mine = xb_ld(F.ctl + CW_XTAB + (int)blockIdx.x);
        for (int r = 0; r < 4; ++r) same &= (xb_ld(F.ctl + CW_XTAB + 8 * (8 * r + (gpm & 7)) + (gpm >> 3)) == mine) ? 1u : 0u;
        grp_fast = __builtin_amdgcn_readfirstlane(same) != 0u; }
#define GSEAM(k, l_, s_) do { if (grp_ok) grp_barrier(F.ctl + CW_BAR, F.ctl + CW_GRP + 16 * ((((l_) * 4 + (s_)) * 64) + gpm), 4u, grp_fast, F.wave); else SEAM(k); } while (0)

    for (int l = 0; l < DEPTH; ++l) {
        const int p0 = 1 + l * PH_PER_LAYER;
        if (hi <= p0 || lo >= p0 + PH_PER_LAYER) continue;
        unsigned char* wl = ws + WS_W + (size_t)l * W_LAYER;
        if (EN(0) && IN(p0 + 0) && l == 0) for (int rep = 0; rep < REPS(0); ++rep) { const int ol = opaque_tid(F.wave) & 63; for (int m = opaque_s(gw); m < M; m += NGW) cvt_row_in(args.in[0] + (size_t)m * DM, X + (size_t)m * DM, X8 + (size_t)m * DM, SSQ + m, ol); SEAM(p0 + 0); }
        if (EN(1) && IN(p0 + 1)) for (int rep = 0; rep < REPS(1); ++rep) {
            { pg8::Gemm g{X, (const bf16_t*)(wl + W_IN), M, ZG, DM, DM, 0, 0}; pg8::StaticOrder S; S.init(M, ZG, F.G, (int)blockIdx.x);
              pg8::EpiBf16 E{Z, ZLD, 0, 1.0f, SSQ + (size_t)(2 * l) * M, 1.0f / DM, SSQ2 + (size_t)(2 * l) * M, SSQ2 + (size_t)(2 * l + 1) * M};
              pg8::gemm_phase<pg8::EpiBf16, pg8::StaticOrder, true>(F.lds + RING_OFF, g, S, E, F.wave); }
            { pg8::Gemm g{(const bf16_t*)X8, (const bf16_t*)(wl + W_IN8), M, 4 * DM, DM, DM, 0, 0}; pg8::StaticOrder S; S.init(M, 4 * DM, F.G, (int)blockIdx.x);
              pg8::EpiGate E{Z + ZG, ZLD, 1.0f / W8_SCALE, opaque_s(0), SSQ + (size_t)(2 * l) * M};
              pg8::gemm_phase<pg8::EpiGate, pg8::StaticOrder, true, false, true>(F.lds + RING_OFF, g, S, E, F.wave); }
            SEAM(p0 + 1);
        }
        if (EN(4) && IN(p0 + 4)) for (int rep = 0; rep < REPS(4); ++rep) {
            if (EN(3)) p_prep(F, args, l);
            { pg8::Gemm g{Z + ZCQ, (const bf16_t*)(wl + W_UQ), M, 768, 512, ZLD, 0, 0}; pg8::StaticOrder S; S.init(M, 768, F.G, (int)blockIdx.x);
            pg8::EpiBf16 E{(bf16_t*)(ws + WS_QMLA), 768, 1, 0.07216878364870322f * LOG2E, SSQ2 + (size_t)(2 * l) * M, 1.0f / 512.0f, nullptr, nullptr};
            pg8::gemm_phase<pg8::EpiBf16, pg8::StaticOrder, true>(F.lds + RING_OFF, g, S, E, F.wave); }
            {
            pg8::Gemm g{Z + ZCKV, (const bf16_t*)(wl + W_UKV), M, 1024, 256, ZLD, 0, 0}; pg8::StaticOrder S; S.init(M, 1024, F.G, (int)blockIdx.x);
            pg8::EpiBf16 E{(bf16_t*)(ws + WS_KVMLA), 1024, 1, 1.0f, SSQ2 + (size_t)(2 * l + 1) * M, 1.0f / 256.0f, nullptr, nullptr};
            pg8::gemm_phase<pg8::EpiBf16, pg8::StaticOrder, true>(F.lds + RING_OFF, g, S, E, F.wave); }
            SEAM(p0 + 4);
        }
        if (EN(6) && IN(p0 + 6)) for (int rep = 0; rep < REPS(6); ++rep) {
            const double li[4] = {0.20000000000000007, 0.35550906759096934, 0.4707130183435842, 0.5560582041556406};
            AttnEnv E; E.Z = Z; E.QMLA = (const bf16_t*)(ws + WS_QMLA); E.KVMLA = (const bf16_t*)(ws + WS_KVMLA); E.KR = (const bf16_t*)(ws + WS_KR); E.BRO = (bf16_t*)(ws + WS_BRO);
            E.pos = (const int*)args.in[1]; E.pmm = (const int*)(ws + WS_PMM); E.btabg = (const float*)(ws + WS_BTAB); E.rope = (const f32x2*)(ws + WS_ROPE); E.kmean = (const float*)(ws + WS_KMEAN);
            E.dscr = (float*)(ws + WS_DSCR); E.subln_g = args.in[6] + (size_t)l * 128; E.sinks = args.in[11] + (size_t)l * 8; E.lam = __uint_as_float(__builtin_amdgcn_readfirstlane(__float_as_uint(((const float*)(ws + WS_LAM))[l])));
            E.one_m_li = __uint_as_float(__builtin_amdgcn_readfirstlane(__float_as_uint(1.0f - (float)(l == 0 ? li[0] : l == 1 ? li[1] : l == 2 ? li[2] : li[3]))));
#if PROF_BUILD
            if (is_thread0(F.wave)) { const unsigned long long pt0 = clock64(); F.MISC[16] = (unsigned)pt0; F.MISC[17] = (unsigned)(pt0 >> 32); }
#endif
            unsigned* qh = F.ctl + CW_QUEUE + 64 * (((rep * DEPTH + l) * 4) * 8);
            const int myx = (int)xb_xcc_id() & 7;
#if PROF_BUILD
#define WCTX const int ot = opaque_tid(F.wave); const att::WaveCtx wctx{ot & 63, ot & 31, (ot >> 5) & 1, __builtin_amdgcn_readfirstlane(ot >> 6), ot, 0, (unsigned long long*)(F.ctl + 32768 + (l == 0 ? 0 : 4096))}
#else
#define WCTX const int ot = opaque_tid(F.wave); const att::WaveCtx wctx{ot & 63, ot & 31, (ot >> 5) & 1, __builtin_amdgcn_readfirstlane(ot >> 6), ot, 0}
#endif
            if (ENA(0)) for (;;) { const int pk = queue_pick(F, qh + 64 * (0 * 8), 64, myx); if (pk < 0) break; const int x = pk >> 16, j = pk & 0xffff; const int bh = x + 8 * (j & 1); WCTX; unit_diff(F.lds, E, bh >> 2, bh & 3, 31 - (j >> 1), wctx); }
            if (ENA(1)) for (;;) { const int pk = queue_pick(F, qh + 64 * (1 * 8), 32, myx); if (pk < 0) break; const int x = pk >> 16, j = pk & 0xffff; const int bh = x + 8 * (j & 1); WCTX; unit_mla(F.lds, E, bh >> 2, bh & 3, 15 - (j >> 1), wctx); }
            if (ENA(2)) for (;;) { const int pk = queue_pick(F, qh + 64 * (2 * 8), 32, myx); if (pk < 0) break; const int x = pk >> 16, j = pk & 0xffff; const int bh = x + 8 * (j & 1); WCTX; unit_moba(F.lds, E, bh >> 2, bh & 3, 15 - (j >> 1), wctx); }
            if (ENA(3)) for (;;) { const int pk = queue_pick(F, qh + 64 * (3 * 8), 64, myx); if (pk < 0) break; const int x = pk >> 16, j = pk & 0xffff; WCTX; unit_swa(F.lds, E, x >> 1, x & 1, 63 - j, wctx); }
#undef WCTX
#if PROF_BUILD
            if (is_thread0(F.wave)) { const unsigned long long pt0 = (unsigned long long)F.MISC[16] | ((unsigned long long)F.MISC[17] << 32); atomicAdd((unsigned long long*)(F.ctl + 32768 + (l == 0 ? 0 : 4096)), clock64() - pt0); }
#endif
#if CHECK_BUILD
            if (l == 0 && rep == 0) { xcd_barrier(bar); chk_prep(F, args); xcd_barrier(bar); chk_items(F, args); }
#endif
            SEAM(p0 + 6);
#if PROF_BUILD
            if (PROF_ID == 10 && is_thread0(F.wave)) { const unsigned long long pt0 = (unsigned long long)F.MISC[16] | ((unsigned long long)F.MISC[17] << 32); atomicAdd((unsigned long long*)(F.ctl + 32768 + (l == 0 ? 0 : 4096)) + 10, clock64() - pt0); }
#endif
        }
        if (EN(7) && IN(p0 + 7)) for (int rep = 0; rep < REPS(7); ++rep) {
            pg8::Gemm g{(const bf16_t*)(ws + WS_BRO), (const bf16_t*)(wl + W_BR), M, DM, 512, DM, (size_t)512 * 2, (size_t)DM * 512 * 2}; pg8::StaticOrder S; S.init_tiles(M / 128, DM / 256, F.G, (int)blockIdx.x, 4);
            pg8::EpiMergeHalf E{Z + ZG, ZLD, MG};
            pg8::gemm_phase_m3<pg8::EpiMergeHalf, pg8::StaticOrder>(F.lds + RING_OFF, g, S, E, F.wave);
            SEAM(p0 + 7);
        }
        if (EN(8) && IN(p0 + 8)) for (int rep = 0; rep < REPS(8); ++rep) {
            pg8::Gemm g{MG, (const bf16_t*)(wl + W_OUT), M, DM, DM, DM, 0, 0}; pg8::StaticOrder S; S.init(M, DM, F.G, (int)blockIdx.x);
            pg8::EpiResBf16 E{nullptr, X, X, DM, SSQ + (size_t)(2 * l + 1) * M, nullptr};
            pg8::gemm_phase<pg8::EpiResBf16, pg8::StaticOrder, true>(F.lds + RING_OFF, g, S, E, F.wave);
            GSEAM(p0 + 8, l, 0);
        }
        if (EN(10) && IN(p0 + 10)) for (int rep = 0; rep < REPS(10); ++rep) {
            pg8::Gemm g{X, (const bf16_t*)(wl + W_UP), M, UP_N, DM, DM, 0, 0}; pg8::StaticOrder S; S.init(M, UP_N, F.G, (int)blockIdx.x);
            pg8::EpiGlu E{Gb, args.in[16] + (size_t)l * 3 * FFN, args.in[17] + (size_t)l * FFN, (float*)(ws + WS_GTAIL), (float*)(ws + WS_GHEADA), (float*)(ws + WS_GHEADV), SSQ + (size_t)(2 * l + 1) * M};
            pg8::gemm_phase<pg8::EpiGlu, pg8::StaticOrder, true>(F.lds + RING_OFF, g, S, E, F.wave);
            SEAM(p0 + 10);
        }
        if (EN(11) && IN(p0 + 11)) for (int rep = 0; rep < REPS(11); ++rep) { p_glufix(F, args, l); SEAM(p0 + 11); }
        if (EN(12) && IN(p0 + 12)) for (int rep = 0; rep < REPS(12); ++rep) {
            pg8::Gemm g{Gb, (const bf16_t*)(wl + W_DN), M, DM, FFN, FFN, 0, 0}; pg8::StaticOrder S; S.init(M, DM, F.G, (int)blockIdx.x);
            pg8::EpiResBf16 E{nullptr, X, X, DM, (l + 1 < DEPTH) ? SSQ + (size_t)(2 * l + 2) * M : nullptr, (l + 1 < DEPTH) ? X8 : nullptr};
            pg8::gemm_phase<pg8::EpiResBf16, pg8::StaticOrder, true>(F.lds + RING_OFF, g, S, E, F.wave);
            if (l + 1 < DEPTH) GSEAM(p0 + 12, l, 3); else SEAM(p0 + 12);
        }
    }
    if (IN(N_PHASES - 1)) { const int ol = opaque_tid(F.wave) & 63; const float* g = args.in[19]; for (int m = opaque_s(gw); m < M; m += NGW) rms_row_f32(X + (size_t)m * DM, g, args.out + (size_t)m * DM, ol);
#if PROF_BUILD
        xcd_barrier(bar);
        if (blockIdx.x == 0 && is_thread0(F.wave)) { const unsigned long long* pp = (const unsigned long long*)(F.ctl + 32768);
            const double c0 = (double)__hip_atomic_load(pp, RLX_AGENT), cx = (double)__hip_atomic_load(pp + PROF_ID, RLX_AGENT), c5 = (double)__hip_atomic_load(pp + 5, RLX_AGENT), c6 = (double)__hip_atomic_load(pp + 6, RLX_AGENT);
            const float raw = (PROF_ID == 5) ? (float)(1000.0 * c5 / (c5 + c6)) : (PROF_ID == 9) ? (float)(c0 / 256.0 / 1000.0) : (float)(1000.0 * cx / c0);
            args.out[0] = 25.0f * floorf(raw / 25.0f + 0.5f); }
#endif
#if CHECK_BUILD
        xcd_barrier(bar);
        if (blockIdx.x == 0 && is_thread0(F.wave)) {
            float code = 0.f;
            for (int ty = 0; ty < 3; ++ty) { const float rt = __uint_as_float(__hip_atomic_load(F.ctl + CW_CHK + 2 * ty, RLX_AGENT)); const unsigned seen = __hip_atomic_load(F.ctl + CW_CHK + 2 * ty + 1, RLX_AGENT);
                if (!(rt <= CHECK_TOL) || seen == 0u) code += (float)(64 << ty); }
            if (CHECK_REPORT >= 0) code = 1.0e4f * __uint_as_float(__hip_atomic_load(F.ctl + CW_CHK + 2 * CHECK_REPORT, RLX_AGENT));
            if (code != 0.f) args.out[0] = code;
        }
#endif
    }
#undef IN
#undef SEAM
#undef GSEAM
}

extern "C" void kernel_launch(void* const* d_in, const int* in_sizes, int n_in, void* d_out, int out_size, void* d_ws, size_t ws_size, hipStream_t stream) {
    static int grid = 0;
    if (grid == 0) {
        if (n_in != 20 || in_sizes[0] != M * DM || out_size != M * DM || ws_size < WS_END + (CHECK_BUILD ? 20 * MiB : 0)) {
            fprintf(stderr, "kernel_launch: shape / workspace mismatch (n_in %d, in0 %d, out %d, ws %zu, need %zu); nothing launched\n", n_in, n_in > 0 ? in_sizes[0] : -1, out_size, ws_size, (size_t)WS_END); grid = -1; return; }
        int dev = 0, cus = 0, per_cu = 0;
        if (hipGetDevice(&dev) != hipSuccess || hipDeviceGetAttribute(&cus, hipDeviceAttributeMultiprocessorCount, dev) != hipSuccess) { grid = -1; return; }
        if (hipFuncSetAttribute((const void*)trunk_fwd, hipFuncAttributeMaxDynamicSharedMemorySize, LDS_BYTES) != hipSuccess) { fprintf(stderr, "kernel_launch: hipFuncSetAttribute failed\n"); grid = -1; return; }
        if (hipOccupancyMaxActiveBlocksPerMultiprocessor(&per_cu, (const void*)trunk_fwd, NWAVES * 64, LDS_BYTES) != hipSuccess || per_cu < 1)
            fprintf(stderr, "kernel_launch: note: occupancy query reports %d workgroups per CU\n", per_cu);
        (void)hipGetLastError();
        grid = cus;
    }
    if (grid < 0) return;
    if (hipMemsetAsync((char*)d_ws + WS_CTL, 0, CTL_ZERO_BYTES, stream) != hipSuccess) return;
    Args a{};
    for (int i = 0; i < 20; ++i) a.in[i] = (const float*)d_in[i];
    a.out = (float*)d_out; a.ws = (unsigned char*)d_ws;
#if MK_N_LAUNCHES == 1
    a.ph_lo = 0; a.ph_hi = N_PHASES;
    hipLaunchKernelGGL(trunk_fwd, dim3(grid), dim3(NWAVES * 64), LDS_BYTES, stream, a);
#else
    for (int p = 0; p < N_PHASES; ++p) { a.ph_lo = p; a.ph_hi = p + 1; hipLaunchKernelGGL(trunk_fwd, dim3(grid), dim3(NWAVES * 64), LDS_BYTES, stream, a); }
#endif
    const hipError_t le = hipPeekAtLastError();
    if (le != hipSuccess) fprintf(stderr, "kernel_launch: launch failed: %s\n", hipGetErrorName(le));
}
```

```cpp
#include <hip/hip_runtime.h>
#include <cstdio>
#include <cstdint>

#ifndef PROF_BUILD
#define PROF_BUILD 0
#endif
#ifndef PROF_ID
#define PROF_ID 1
#endif
#ifndef MK_N_LAUNCHES
#define MK_N_LAUNCHES 1
#endif

#define GAS __attribute__((address_space(1)))
#define LAS __attribute__((address_space(3)))
typedef unsigned short bf16_t;
typedef short bf16x8 __attribute__((ext_vector_type(8)));
typedef short s16x4 __attribute__((ext_vector_type(4)));
typedef float f32x2 __attribute__((ext_vector_type(2)));
typedef float f32x4 __attribute__((ext_vector_type(4)));
typedef float f32x16 __attribute__((ext_vector_type(16)));
typedef unsigned u32x2 __attribute__((ext_vector_type(2)));
typedef unsigned u32x4 __attribute__((ext_vector_type(4)));
typedef int i32x4 __attribute__((ext_vector_type(4)));

constexpr int DM = 2048, NB = 4, SEQ = 4096, DEPTH = 4, M = NB * SEQ;
constexpr int IN_COLS = 12864, ZLD = 13056;
constexpr int ZQA = 0, ZKA = 512, ZVA = 1024, ZCQ = 1536, ZCKV = 2048, ZKR = 2304, ZSQ = 2560, ZSK = 3072, ZSV = 3200, ZMQ = 3328, ZMK = 3840, ZMV = 4352, ZG = 4864;
constexpr int FFN = 5632, UP_N = 2 * FFN;
constexpr float LOG2E = 1.4426950408889634f;
constexpr float EPS = 1e-6f;
constexpr float NEG_INF = -__builtin_huge_valf();

typedef __bf16 bf16x2_t __attribute__((ext_vector_type(2)));
__device__ __forceinline__ unsigned cvt_pk_bf16(float lo, float hi) { const f32x2 v = {lo, hi}; return __builtin_bit_cast(unsigned, __builtin_convertvector(v, bf16x2_t)); }
__device__ __forceinline__ float bf2f(unsigned short h) { return __uint_as_float(((unsigned)h) << 16); }
__device__ __forceinline__ float bflo(unsigned w) { return __uint_as_float(w << 16); }
__device__ __forceinline__ float bfhi(unsigned w) { return __uint_as_float(w & 0xffff0000u); }
template <int XORM> __device__ __forceinline__ float swz_xor(float v) { return __int_as_float(__builtin_amdgcn_ds_swizzle(__float_as_int(v), (XORM << 10) | 0x1F)); }
__device__ __forceinline__ float half_sum(float v) { const auto rr = __builtin_amdgcn_permlane32_swap(__float_as_uint(v), __float_as_uint(v), false, false); return __uint_as_float(rr[0]) + __uint_as_float(rr[1]); }
__device__ __forceinline__ float half_max(float v) { const auto rr = __builtin_amdgcn_permlane32_swap(__float_as_uint(v), __float_as_uint(v), false, false); return fmaxf(__uint_as_float(rr[0]), __uint_as_float(rr[1])); }
__device__ __forceinline__ float wave_sum(float v) {
    v += swz_xor<1>(v); v += swz_xor<2>(v); v += swz_xor<4>(v); v += swz_xor<8>(v); v += swz_xor<16>(v);
    return half_sum(v);
}
__device__ __forceinline__ float wave_max(float v) {
    v = fmaxf(v, swz_xor<1>(v)); v = fmaxf(v, swz_xor<2>(v)); v = fmaxf(v, swz_xor<4>(v)); v = fmaxf(v, swz_xor<8>(v)); v = fmaxf(v, swz_xor<16>(v));
    return half_max(v);
}
__device__ __forceinline__ unsigned fresh_lane_id() { unsigned m = ~0u; asm volatile("" : "+s"(m)); return __builtin_amdgcn_mbcnt_hi(m, __builtin_amdgcn_mbcnt_lo(m, 0u)); }
__device__ __forceinline__ int opaque_tid(int wave) { int t = wave * 64 + (int)fresh_lane_id(); asm volatile("" : "+v"(t)); return t; }
__device__ __forceinline__ bool is_thread0(int wave) { return wave == 0 && fresh_lane_id() == 0u; }
__device__ __forceinline__ int opaque_s(int x) { asm volatile("" : "+s"(x)); return x; }
__device__ __forceinline__ float fast_sigmoid(float x) { return __builtin_amdgcn_rcpf(1.0f + __builtin_amdgcn_exp2f(-x * LOG2E)); }

namespace pg8 {
constexpr int BM = 256, BK = 64, HALF = 128, HTB = HALF * BK * 2, STAGE_BYTES = 8 * HTB, NXCD = 8, WGM = 8;
__host__ __device__ __forceinline__ int lds_byte(int r, int c) { const int st = (r >> 4) * 2 + (c >> 5), rr = r & 15, cc = c & 31, ob = rr * 64 + cc * 2; return st * 1024 + (ob ^ (((ob >> 9) & 1) << 5)); }
__host__ __device__ __forceinline__ void stage_rc(int b, int& R, int& C) { const int st = b / 1024, sb = b % 1024, swz = sb ^ (((sb >> 9) & 1) << 5); R = (st >> 1) * 16 + swz / 64; C = (st & 1) * 32 + (swz % 64) / 2; }
__host__ __device__ __forceinline__ int perm32(int rho) { const int n = rho >> 4, i = rho & 15; return 8 * (i >> 2) + 4 * n + (i & 3); }

struct Unit { int pm, pn, z; };
struct Gemm { const bf16_t* A; const bf16_t* Bt; int M, N, K, lda; size_t zA, zB; };

struct StaticOrder {
    int nM, nN, nwg, G, c, nZ;
    __device__ void init(int M_, int N_, int G_, int c_, int nZ_ = 1) { nM = M_ / BM; nN = N_ / BM; nwg = nM * nN; G = G_; c = c_; nZ = nZ_; }
    __device__ void init_tiles(int nM_, int nN_, int G_, int c_, int nZ_) { nM = nM_; nN = nN_; nwg = nM * nN; G = G_; c = c_; nZ = nZ_; }
    __device__ bool next(int i, Unit& u) const {
        const int it = i / nZ; u.z = i - it * nZ;
        const long L = (long)it * G + c; if (L >= nwg) return false;
        int wgid = (int)L; { const int q = nwg / NXCD, r = nwg % NXCD, xcd = wgid % NXCD, off = wgid / NXCD; wgid = (xcd < r ? xcd * (q + 1) : r * (q + 1) + (xcd - r) * q) + off; }
        const int nig = WGM * nN, gid = wgid / nig, fm = gid * WGM, gsz = (nM - fm) < WGM ? (nM - fm) : WGM;
        u.pm = fm + ((wgid % nig) % gsz); u.pn = (wgid % nig) / gsz; return true;
    }
};


__device__ __forceinline__ float rs_of(unsigned long long q, float invn = 1.0f / DM) {
    const float f = (float)(unsigned)(q >> 32) * 256.0f + (float)(unsigned)q * (1.0f / 16777216.0f);
    return __builtin_amdgcn_rsqf(f * invn + EPS);
}
__device__ __forceinline__ void ssq_add(unsigned long long* ssq, const u32x4& w0, const u32x4& w1, int row, int k, int fq) {
    float q = 0.f;
#pragma unroll
    for (int e = 0; e < 4; ++e) { const float a = bflo(w0[e]), b = bfhi(w0[e]), c = bflo(w1[e]), d = bfhi(w1[e]); q += (a * a + b * b) + (c * c + d * d); }
    q += swz_xor<16>(q); q = half_sum(q);
    if (fq == (k & 3)) { const unsigned hi = (unsigned)q; const unsigned lo = (unsigned)((q - (float)hi) * 16777216.0f);
        atomicAdd(ssq + row, ((unsigned long long)hi << 24) + lo); }
}
constexpr int RS_LDS = STAGE_BYTES;
__device__ __forceinline__ float rs_lds(const LAS unsigned char* lds, int wid, int ai, int m, int fr, float invn = 1.0f / DM) {
    return rs_of(*(const LAS unsigned long long*)(lds + RS_LDS + wid * 1024 + ai * 512 + (m * 16 + fr) * 8), invn);
}
struct EpiBf16 {
    bf16_t* O; int ldc; int kind;
    float sc;
    const unsigned long long* ssq;
    float invn;
    unsigned long long* sq_q; unsigned long long* sq_kv;
    static constexpr bool RS = true;
    __device__ __forceinline__ void operator()(const f32x4 (&acc)[2][2][4][2], const LAS unsigned char* lds, const Unit& u, int wr, int wc, int fr, int fq) const {
        float s = sc; unsigned long long* sqo = nullptr;
        if (kind == 0) {
            const int pn = u.pn;
            s = 1.0f;
            if (pn < 2 || pn == 10 || pn == 11) s = 0.125f * LOG2E;
            else if (pn == 13 || pn == 14) s = 0.08838834764831845f * LOG2E;
            if (pn == 6 || pn == 7) sqo = sq_q; else if (pn == 8) sqo = sq_kv;
        }
        const int row0 = u.pm * BM + wr * 64 + fr, col0 = u.pn * BM + wc * 32 + 8 * fq;
        const float s0 = s;
#pragma unroll
        for (int ai = 0; ai < 2; ++ai)
#pragma unroll
            for (int m = 0; m < 4; ++m) { const int row = row0 + ai * HALF + m * 16; bf16_t* rowp = O + (size_t)row * ldc + col0; const float s = ssq ? s0 * rs_lds(lds, wr * 4 + wc, ai, m, fr, invn) : s0;
                u32x4 w[2];
#pragma unroll
                for (int bj = 0; bj < 2; ++bj) { const f32x4 v0 = acc[ai][bj][m][0] * s, v1 = acc[ai][bj][m][1] * s;
                    w[bj].x = cvt_pk_bf16(v0[0], v0[1]); w[bj].y = cvt_pk_bf16(v0[2], v0[3]); w[bj].z = cvt_pk_bf16(v1[0], v1[1]); w[bj].w = cvt_pk_bf16(v1[2], v1[3]);
                    *(u32x4*)(rowp + bj * HALF) = w[bj]; }
                if (sqo) ssq_add(sqo, w[0], w[1], row, m, fq); }
    }
};
struct EpiGate {
    bf16_t* O; int ldc; float sc0; int lo; const unsigned long long* ssq;
    static constexpr bool RS = true;
    __device__ __forceinline__ void operator()(const f32x4 (&acc)[2][2][4][2], const LAS unsigned char* lds, const Unit& u, int wr, int wc, int fr, int fq) const {
        const int row0 = u.pm * BM + wr * 64 + fr, col0 = u.pn * BM + wc * 32 + 8 * fq;
        const bool sig = u.pn >= lo;
        float rs[2][4];
#pragma unroll
        for (int ai = 0; ai < 2; ++ai)
#pragma unroll
            for (int m = 0; m < 4; ++m) rs[ai][m] = sc0 * rs_lds(lds, wr * 4 + wc, ai, m, fr);
#pragma unroll
        for (int ai = 0; ai < 2; ++ai)
#pragma unroll
            for (int m = 0; m < 4; ++m) { bf16_t* rowp = O + (size_t)(row0 + ai * HALF + m * 16) * ldc + col0; const float sc = rs[ai][m];
#pragma unroll
                for (int bj = 0; bj < 2; ++bj) { f32x4 v0 = acc[ai][bj][m][0], v1 = acc[ai][bj][m][1];
                    if (sig) {
#pragma unroll
                        for (int e = 0; e < 4; ++e) { v0[e] = fast_sigmoid(v0[e] * sc); v1[e] = fast_sigmoid(v1[e] * sc); }
                    } else { v0 = v0 * sc; v1 = v1 * sc; }
                    u32x4 w; w.x = cvt_pk_bf16(v0[0], v0[1]); w.y = cvt_pk_bf16(v0[2], v0[3]); w.z = cvt_pk_bf16(v1[0], v1[1]); w.w = cvt_pk_bf16(v1[2], v1[3]);
                    *(u32x4*)(rowp + bj * HALF) = w; } }
    }
};
struct EpiResBf16 {
    static constexpr bool RS = false;
    const float* base32; const bf16_t* base16; bf16_t* out; int ldc; unsigned long long* ssq; unsigned char* x8;
    static __device__ __forceinline__ unsigned pk4_e4m3(float a, float b, float c, float d) { int w = __builtin_amdgcn_cvt_pk_fp8_f32(a, b, 0, false); w = __builtin_amdgcn_cvt_pk_fp8_f32(c, d, w, true); return (unsigned)w; }
    __device__ __forceinline__ void store8(const u32x4& w, size_t off) const { u32x2 o; o.x = pk4_e4m3(bflo(w.x), bfhi(w.x), bflo(w.y), bfhi(w.y)); o.y = pk4_e4m3(bflo(w.z), bfhi(w.z), bflo(w.w), bfhi(w.w)); *(u32x2*)(x8 + off) = o; }
    __device__ __forceinline__ void operator()(const f32x4 (&acc)[2][2][4][2], const Unit& u, int wr, int wc, int fr, int fq) const {
        const int row0 = u.pm * BM + wr * 64 + fr, col0 = u.pn * BM + wc * 32 + 8 * fq;
        if (base32) {
            f32x4 bv[2][2][2];
#define PG8_RES_LOAD(buf, k) do { const size_t off_ = (size_t)(row0 + ((k) >> 2) * HALF + ((k) & 3) * 16) * ldc + col0; \
            _Pragma("unroll") for (int bj = 0; bj < 2; ++bj) { bv[buf][bj][0] = *(const f32x4*)(base32 + off_ + bj * HALF); bv[buf][bj][1] = *(const f32x4*)(base32 + off_ + bj * HALF + 4); } } while (0)
            PG8_RES_LOAD(0, 0);
#pragma unroll
            for (int k = 0; k < 8; ++k) {
                if (k + 1 < 8) PG8_RES_LOAD((k + 1) & 1, k + 1);
                const int ai = k >> 2, m = k & 3, row = row0 + ai * HALF + m * 16; const size_t off = (size_t)row * ldc + col0;
                u32x4 w[2];
#pragma unroll
                for (int bj = 0; bj < 2; ++bj) { const f32x4 t0 = bv[k & 1][bj][0] + acc[ai][bj][m][0], t1 = bv[k & 1][bj][1] + acc[ai][bj][m][1];
                    w[bj].x = cvt_pk_bf16(t0[0], t0[1]); w[bj].y = cvt_pk_bf16(t0[2], t0[3]); w[bj].z = cvt_pk_bf16(t1[0], t1[1]); w[bj].w = cvt_pk_bf16(t1[2], t1[3]);
                    *(u32x4*)(out + off + bj * HALF) = w[bj]; if (x8) store8(w[bj], off + bj * HALF); }
                if (ssq) ssq_add(ssq, w[0], w[1], row, k, fq);
            }
#undef PG8_RES_LOAD
        } else {
            u32x4 bv[2][2];
#define PG8_RES_LOAD(buf, k) do { const size_t off_ = (size_t)(row0 + ((k) >> 2) * HALF + ((k) & 3) * 16) * ldc + col0; \
            _Pragma("unroll") for (int bj = 0; bj < 2; ++bj) bv[buf][bj] = *(const u32x4*)(base16 + off_ + bj * HALF); } while (0)
            PG8_RES_LOAD(0, 0);
#pragma unroll
            for (int k = 0; k < 8; ++k) {
                if (k + 1 < 8) PG8_RES_LOAD((k + 1) & 1, k + 1);
                const int ai = k >> 2, m = k & 3, row = row0 + ai * HALF + m * 16; const size_t off = (size_t)row * ldc + col0;
                u32x4 w[2];
#pragma unroll
                for (int bj = 0; bj < 2; ++bj) { const u32x4 p = bv[k & 1][bj];
                    const f32x4 t0 = (f32x4){bflo(p.x), bfhi(p.x), bflo(p.y), bfhi(p.y)} + acc[ai][bj][m][0], t1 = (f32x4){bflo(p.z), bfhi(p.z), bflo(p.w), bfhi(p.w)} + acc[ai][bj][m][1];
                    w[bj].x = cvt_pk_bf16(t0[0], t0[1]); w[bj].y = cvt_pk_bf16(t0[2], t0[3]); w[bj].z = cvt_pk_bf16(t1[0], t1[1]); w[bj].w = cvt_pk_bf16(t1[2], t1[3]);
                    *(u32x4*)(out + off + bj * HALF) = w[bj]; if (x8) store8(w[bj], off + bj * HALF); }
                if (ssq) ssq_add(ssq, w[0], w[1], row, k, fq);
            }
#undef PG8_RES_LOAD
        }
    }
};
struct EpiMerge {
    static constexpr bool RS = false;
    const bf16_t* gate; int ldg;
    float* T; bf16_t* Mg;
    __device__ __forceinline__ void operator()(const f32x4 (&acc)[2][2][4][2], const Unit& u, int wr, int wc, int fr, int fq) const {
        const int row0 = u.pm * BM + wr * 64 + fr, col0 = u.pn * BM + wc * 32 + 8 * fq, z = u.z;
        u32x4 gv[2][2]; f32x4 tv[2][2][2];
#define PG8_MG_LOAD(buf, k) do { const int row_ = row0 + ((k) >> 2) * HALF + ((k) & 3) * 16; const size_t off_ = (size_t)row_ * DM + col0; \
            _Pragma("unroll") for (int bj = 0; bj < 2; ++bj) { gv[buf][bj] = *(const u32x4*)(gate + (size_t)row_ * ldg + z * DM + col0 + bj * HALF); \
                if (z > 0) { tv[buf][bj][0] = *(const f32x4*)(T + off_ + bj * HALF); tv[buf][bj][1] = *(const f32x4*)(T + off_ + bj * HALF + 4); } \
                else { tv[buf][bj][0] = (f32x4){0.f, 0.f, 0.f, 0.f}; tv[buf][bj][1] = (f32x4){0.f, 0.f, 0.f, 0.f}; } } } while (0)
        PG8_MG_LOAD(0, 0);
#pragma unroll
        for (int k = 0; k < 8; ++k) {
            if (k + 1 < 8) PG8_MG_LOAD((k + 1) & 1, k + 1);
            const int ai = k >> 2, m = k & 3; const size_t off = (size_t)(row0 + ai * HALF + m * 16) * DM + col0;
#pragma unroll
            for (int bj = 0; bj < 2; ++bj) {
                const u32x4 g = gv[k & 1][bj];
                const f32x4 g0 = (f32x4){bflo(g.x), bfhi(g.x), bflo(g.y), bfhi(g.y)}, g1 = (f32x4){bflo(g.z), bfhi(g.z), bflo(g.w), bfhi(g.w)};
                const f32x4 t0 = tv[k & 1][bj][0] + g0 * acc[ai][bj][m][0], t1 = tv[k & 1][bj][1] + g1 * acc[ai][bj][m][1];
                if (z < 3) { *(f32x4*)(T + off + bj * HALF) = t0; *(f32x4*)(T + off + bj * HALF + 4) = t1; }
                else { u32x4 w; w.x = cvt_pk_bf16(t0[0], t0[1]); w.y = cvt_pk_bf16(t0[2], t0[3]); w.z = cvt_pk_bf16(t1[0], t1[1]); w.w = cvt_pk_bf16(t1[2], t1[3]);
                    *(u32x4*)(Mg + off + bj * HALF) = w; } }
        }
#undef PG8_MG_LOAD
    }
};

struct EpiMergeDiag {
    static constexpr bool RS = false;
    const bf16_t* gate; int ldg; bf16_t* Mg;
    __device__ __forceinline__ void operator()(f32x4 (&acc)[2][2][4][2], const Unit& u, int wr, int wc, int fr, int fq) const {
        const int row0 = u.pm * HALF + wr * 64 + fr, col0 = u.pn * HALF + wc * 32 + 8 * fq, z0 = 2 * u.z;
#pragma unroll
        for (int m = 0; m < 4; ++m) { const int row = row0 + m * 16;
            const u32x4 ga = *(const u32x4*)(gate + (size_t)row * ldg + z0 * DM + col0), gb = *(const u32x4*)(gate + (size_t)row * ldg + (z0 + 1) * DM + col0);
            const f32x4 a0 = (f32x4){bflo(ga.x), bfhi(ga.x), bflo(ga.y), bfhi(ga.y)}, a1 = (f32x4){bflo(ga.z), bfhi(ga.z), bflo(ga.w), bfhi(ga.w)};
            const f32x4 b0 = (f32x4){bflo(gb.x), bfhi(gb.x), bflo(gb.y), bfhi(gb.y)}, b1 = (f32x4){bflo(gb.z), bfhi(gb.z), bflo(gb.w), bfhi(gb.w)};
            f32x4 t0 = a0 * acc[0][0][m][0] + b0 * acc[1][1][m][0], t1 = a1 * acc[0][0][m][1] + b1 * acc[1][1][m][1];
            if (u.z == 0) { acc[0][1][m][0] = t0; acc[0][1][m][1] = t1; }
            else { t0 = t0 + acc[0][1][m][0]; t1 = t1 + acc[0][1][m][1];
                u32x4 w; w.x = cvt_pk_bf16(t0[0], t0[1]); w.y = cvt_pk_bf16(t0[2], t0[3]); w.z = cvt_pk_bf16(t1[0], t1[1]); w.w = cvt_pk_bf16(t1[2], t1[3]);
                *(u32x4*)(Mg + (size_t)row * DM + col0) = w; } }
    }
};

__device__ __forceinline__ float gelu_erf(float v) {
    const float av = fabsf(v), d = av * 0.2316418882f + 1.0f;
    const float t = __builtin_amdgcn_rcpf(d);
    float q = t * 0.5307027145f + (-0.7265760135f); q = q * t + 0.7107068705f; q = q * t + (-0.142248368f); q = q * t + 0.127414796f; q = q * t;
    const float e = __builtin_amdgcn_exp2f((v * v) * (-0.72134752044f));
    const float m = v * (q * e), r = v - m;
    return v < 0.f ? m : r;
}
__device__ __forceinline__ f32x2 gelu_pk(f32x2 v) {
    f32x2 z; z.x = __builtin_amdgcn_fmed3f(v.x, -4.0f, 4.0f); z.y = __builtin_amdgcn_fmed3f(v.y, -4.0f, 4.0f);
    const f32x2 s = z * z;
    f32x2 p = s * (-1.278033807e-09f) + 1.044463725e-07f; p = p * s + (-3.709719858e-06f); p = p * s + 7.619161683e-05f; p = p * s + (-1.021055556e-03f);
    p = p * s + 9.581421419e-03f; p = p * s + (-6.606413978e-02f); p = p * s + 3.988055566e-01f;
    return v * (z * p + 0.5f);
}
__device__ __forceinline__ float dpp_shr1(float old, float src) { return __int_as_float(__builtin_amdgcn_update_dpp(__float_as_int(old), __float_as_int(src), 0x111, 0xf, 0xf, false)); }
__device__ __forceinline__ float dpp_shr2(float old, float src) { return __int_as_float(__builtin_amdgcn_update_dpp(__float_as_int(old), __float_as_int(src), 0x112, 0xf, 0xf, false)); }
__device__ __forceinline__ float dpp_ror1(float src) { return __int_as_float(__builtin_amdgcn_update_dpp(__float_as_int(src), __float_as_int(src), 0x121, 0xf, 0xf, false)); }
__device__ __forceinline__ float dpp_ror2(float src) { return __int_as_float(__builtin_amdgcn_update_dpp(__float_as_int(src), __float_as_int(src), 0x122, 0xf, 0xf, false)); }
struct EpiGlu {
    bf16_t* G; const float* cw; const float* cb; float* tail; float* heada; float* headv;
    const unsigned long long* ssq;
    static constexpr bool RS = true;
    __device__ __forceinline__ void operator()(const f32x4 (&acc)[2][2][4][2], const LAS unsigned char* lds, const Unit& u, int wr, int wc, int fr, int fq) const {
        const int ch0 = u.pn * HALF + wc * 32 + 8 * fq;
        f32x2 w0[4], w1[4], w2[4], bb[4];
#pragma unroll
        for (int h = 0; h < 2; ++h) { const f32x4 t0 = *(const f32x4*)(cw + ch0 + 4 * h), t1 = *(const f32x4*)(cw + FFN + ch0 + 4 * h), t2 = *(const f32x4*)(cw + 2 * FFN + ch0 + 4 * h), t3 = *(const f32x4*)(cb + ch0 + 4 * h);
            w0[2 * h] = (f32x2){t0[0], t0[1]}; w0[2 * h + 1] = (f32x2){t0[2], t0[3]}; w1[2 * h] = (f32x2){t1[0], t1[1]}; w1[2 * h + 1] = (f32x2){t1[2], t1[3]};
            w2[2 * h] = (f32x2){t2[0], t2[1]}; w2[2 * h + 1] = (f32x2){t2[2], t2[3]}; bb[2 * h] = (f32x2){t3[0], t3[1]}; bb[2 * h + 1] = (f32x2){t3[2], t3[3]}; }
        float rs[2][4];
#pragma unroll
        for (int ai = 0; ai < 2; ++ai)
#pragma unroll
            for (int m = 0; m < 4; ++m) rs[ai][m] = rs_lds(lds, wr * 4 + wc, ai, m, fr);
#pragma unroll
        for (int ai = 0; ai < 2; ++ai) {
            const int gid = u.pm * 4 + ai * 2 + wr, rowg = gid * 64;
            float q1[8], q2[8];
#pragma unroll
            for (int c = 0; c < 8; ++c) { q1[c] = 0.f; q2[c] = 0.f; }
#pragma unroll
            for (int m = 0; m < 4; ++m) {
                float a8[8], v8[8], p1[8], p2[8];
#pragma unroll
                for (int n = 0; n < 2; ++n)
#pragma unroll
                    for (int e = 0; e < 4; ++e) { a8[4 * n + e] = acc[ai][0][m][n][e] * rs[ai][m]; v8[4 * n + e] = acc[ai][1][m][n][e] * rs[ai][m]; }
#pragma unroll
                for (int c = 0; c < 8; ++c) { p1[c] = dpp_shr1(q1[c], a8[c]); p2[c] = dpp_shr2(q2[c], a8[c]); q1[c] = dpp_ror1(a8[c]); q2[c] = dpp_ror2(a8[c]); }
                const int row = rowg + m * 16 + fr;
                if (m == 0 && fr < 2) {
                    float* ha = heada + ((size_t)gid * 2 + fr) * FFN + ch0; float* hv = headv + ((size_t)gid * 2 + fr) * FFN + ch0;
                    *(f32x4*)ha = (f32x4){a8[0], a8[1], a8[2], a8[3]}; *(f32x4*)(ha + 4) = (f32x4){a8[4], a8[5], a8[6], a8[7]};
                    *(f32x4*)hv = (f32x4){v8[0], v8[1], v8[2], v8[3]}; *(f32x4*)(hv + 4) = (f32x4){v8[4], v8[5], v8[6], v8[7]};
                } else {
                    f32x2 o[4];
#pragma unroll
                    for (int c = 0; c < 4; ++c) { const f32x2 av = (f32x2){a8[2 * c], a8[2 * c + 1]}, pv1 = (f32x2){p1[2 * c], p1[2 * c + 1]}, pv2 = (f32x2){p2[2 * c], p2[2 * c + 1]}, vv = (f32x2){v8[2 * c], v8[2 * c + 1]};
                        o[c] = gelu_pk(bb[c] + w0[c] * pv2 + w1[c] * pv1 + w2[c] * av) * vv; }
                    u32x4 w; w.x = cvt_pk_bf16(o[0].x, o[0].y); w.y = cvt_pk_bf16(o[1].x, o[1].y); w.z = cvt_pk_bf16(o[2].x, o[2].y); w.w = cvt_pk_bf16(o[3].x, o[3].y);
                    *(u32x4*)(G + (size_t)row * FFN + ch0) = w;
                }
                if (m == 3 && fr >= 14) { float* tl = tail + ((size_t)gid * 2 + (fr - 14)) * FFN + ch0;
                    *(f32x4*)tl = (f32x4){a8[0], a8[1], a8[2], a8[3]}; *(f32x4*)(tl + 4) = (f32x4){a8[4], a8[5], a8[6], a8[7]}; }
            }
        }
    }
};

template <class Epi, class Sched, bool ALIGN_EPI, bool DIAG = false, bool F8 = false>
__device__ __forceinline__ void gemm_phase(LAS unsigned char* lds, const Gemm g, const Sched& S, const Epi& E, int wave) {
    const int tid = opaque_tid(wave), wid = __builtin_amdgcn_readfirstlane(tid >> 6), lane = tid & 63, wr = wid >> 2, wc = wid & 3, fr = lane & 15, fq = lane >> 4;
    const int K = g.K, nt = F8 ? K / (2 * BK) : K / BK, lda = g.lda;
    const int rowA = F8 ? lda : lda * 2, rowB = F8 ? K : K * 2;
    unsigned voffA[2], voffB[2];
#pragma unroll
    for (int i = 0; i < 2; ++i) { int R, C; stage_rc(tid * 16 + i * 8192, R, C); const int Rb = (R & ~31) + perm32(R & 31);
        voffA[i] = (unsigned)(R * rowA + C * 2); voffB[i] = (unsigned)(Rb * rowB + C * 2); }
    const size_t kstep = (size_t)(BK * 2);
    const size_t hstepA = DIAG ? g.zA : (size_t)HALF * rowA, hstepB = DIAG ? g.zB : (size_t)HALF * rowB;
    const size_t tstepA = (DIAG ? 1 : 2) * (size_t)HALF * rowA, tstepB = (DIAG ? 1 : 2) * (size_t)HALF * rowB;
    const size_t zsA = (DIAG ? 2 : 1) * g.zA, zsB = (DIAG ? 2 : 1) * g.zB;
    const unsigned ldsw = (unsigned)wid * 1024u;
    const int aoff = lds_byte(wr * 64 + fr, fq * 8), boff = lds_byte(wc * 32 + fr, fq * 8);
#define PG8_SA(b, h) (((b) * 2 + (h)) * HTB)
#define PG8_SB(b, h) ((4 + (b) * 2 + (h)) * HTB)
#define PG8_STAGE(bufoff, gbase, voff) do { _Pragma("unroll") for (int _i = 0; _i < 2; ++_i) \
        __builtin_amdgcn_global_load_lds((const unsigned*)((const char*)(gbase) + (voff)[_i]), (LAS unsigned*)(lds + (bufoff) + ldsw + _i * 8192), 16, 0, 0); } while (0)
#define PG8_LDA(dst, b, h) do { if constexpr (F8) { _Pragma("unroll") for (int m = 0; m < 4; ++m) { const v4i_t lo_ = *(const LAS v4i_t*)(lds + PG8_SA(b, h) + aoff + m * 2048), hi_ = *(const LAS v4i_t*)(lds + PG8_SA(b, h) + aoff + m * 2048 + 1024); \
            dst##8[m] = __builtin_shufflevector(lo_, hi_, 0, 1, 2, 3, 4, 5, 6, 7); } } \
        else { _Pragma("unroll") for (int m = 0; m < 4; ++m) _Pragma("unroll") for (int k = 0; k < 2; ++k) dst[m][k] = *(const LAS bf16x8*)(lds + PG8_SA(b, h) + aoff + m * 2048 + k * 1024); } } while (0)
#define PG8_LDB(dst, b, h) do { if constexpr (F8) { _Pragma("unroll") for (int n = 0; n < 2; ++n) { const v4i_t lo_ = *(const LAS v4i_t*)(lds + PG8_SB(b, h) + boff + n * 2048), hi_ = *(const LAS v4i_t*)(lds + PG8_SB(b, h) + boff + n * 2048 + 1024); \
            dst##8[n] = __builtin_shufflevector(lo_, hi_, 0, 1, 2, 3, 4, 5, 6, 7); } } \
        else { _Pragma("unroll") for (int n = 0; n < 2; ++n) _Pragma("unroll") for (int k = 0; k < 2; ++k) dst[n][k] = *(const LAS bf16x8*)(lds + PG8_SB(b, h) + boff + n * 2048 + k * 1024); } } while (0)
#define PG8_MMA(ai, bj, At, Bt) do { __builtin_amdgcn_s_setprio(1); \
        if constexpr (F8) { _Pragma("unroll") for (int m = 0; m < 4; ++m) _Pragma("unroll") for (int n = 0; n < 2; ++n) \
                asm volatile("v_mfma_scale_f32_16x16x128_f8f6f4 %0, %1, %2, %0, %3, %3 op_sel_hi:[0,0,0]" : "+v"(acc[ai][bj][m][n]) : "v"(Bt##8[n]), "v"(At##8[m]), "v"(f8scale)); } \
        else { _Pragma("unroll") for (int m = 0; m < 4; ++m) _Pragma("unroll") for (int n = 0; n < 2; ++n) _Pragma("unroll") for (int k = 0; k < 2; ++k) \
            acc[ai][bj][m][n] = __builtin_amdgcn_mfma_f32_16x16x32_bf16(Bt[n][k], At[m][k], acc[ai][bj][m][n], 0, 0, 0); } \
        __builtin_amdgcn_s_setprio(0); } while (0)
#define PG8_WAIT_V(n) asm volatile("s_waitcnt vmcnt(" #n ")" ::: "memory")
#define PG8_WAIT_L(n) asm volatile("s_waitcnt lgkmcnt(" #n ")" ::: "memory")
#define PG8_BAR __builtin_amdgcn_s_barrier()
#define PG8_SCHED __builtin_amdgcn_sched_barrier(0)
    Unit cur, nxt; int ui = 0;
    if (!S.next(0, cur)) return;
    f32x4 acc[2][2][4][2];
#pragma unroll
    for (int a = 0; a < 2; ++a)
#pragma unroll
        for (int b = 0; b < 2; ++b)
#pragma unroll
            for (int m = 0; m < 4; ++m)
#pragma unroll
                for (int n = 0; n < 2; ++n) acc[a][b][m][n] = (f32x4){0.f, 0.f, 0.f, 0.f};
    bf16x8 At[4][2], B0[2][2], B1[2][2];
    typedef int v4i_t __attribute__((ext_vector_type(4))); typedef int v8i_t __attribute__((ext_vector_type(8)));
    const int f8scale = 0x7f7f7f7f;
    v8i_t At8[4], B08[2], B18[2];
    const char* cA = (const char*)g.A + (size_t)cur.pm * tstepA + (size_t)cur.z * zsA; const char* cB = (const char*)g.Bt + (size_t)cur.pn * tstepB + (size_t)cur.z * zsB;
    PG8_STAGE(PG8_SB(0, 0), cB, voffB); PG8_STAGE(PG8_SB(0, 1), cB + hstepB, voffB); PG8_STAGE(PG8_SA(0, 0), cA, voffA); PG8_STAGE(PG8_SA(0, 1), cA + hstepA, voffA);
    if (wr == 1) PG8_BAR;
    PG8_WAIT_V(2); PG8_BAR;
    PG8_STAGE(PG8_SB(1, 0), cB + kstep, voffB); PG8_STAGE(PG8_SA(1, 0), cA + kstep, voffA); PG8_STAGE(PG8_SB(1, 1), cB + hstepB + kstep, voffB);
    PG8_WAIT_V(6); PG8_BAR;
    for (;;) {
        const bool has_next = S.next(ui + 1, nxt);
        const char* nA = has_next ? (const char*)g.A + (size_t)nxt.pm * tstepA + (size_t)nxt.z * zsA : cA; const char* nB = has_next ? (const char*)g.Bt + (size_t)nxt.pn * tstepB + (size_t)nxt.z * zsB : cB;
        for (int t = 0; t < nt; t += 2) {
            const bool last = (t == nt - 2);
            const char* a1 = cA + (size_t)(t + 1) * kstep;
            const char* a2 = last ? nA : cA + (size_t)(t + 2) * kstep; const char* b2 = last ? nB : cB + (size_t)(t + 2) * kstep;
            const char* a3 = a2 + kstep; const char* b3 = b2 + kstep;
            PG8_LDB(B0, 0, 0); PG8_LDB(B1, 0, 1); PG8_SCHED; PG8_LDA(At, 0, 0); PG8_STAGE(PG8_SA(1, 1), a1 + hstepA, voffA);
            bool rsw = false;
            if constexpr (Epi::RS) { rsw = last && E.ssq != nullptr;
                if (rsw) { const int fl = (int)fresh_lane_id();
                    __builtin_amdgcn_global_load_lds((const unsigned*)(E.ssq + cur.pm * BM + (fl >> 5) * HALF + wr * 64 + 2 * (fl & 31)), (LAS unsigned*)(lds + RS_LDS + ldsw), 16, 0, 0); } }
            if (rsw) PG8_WAIT_V(9); else PG8_WAIT_V(8);
            PG8_WAIT_L(0); PG8_BAR; PG8_MMA(0, 0, At, B0); if constexpr (!DIAG) PG8_MMA(0, 1, At, B1); PG8_BAR; PG8_SCHED;
            PG8_LDA(At, 0, 1); PG8_STAGE(PG8_SB(0, 0), b2, voffB); PG8_STAGE(PG8_SB(0, 1), b2 + hstepB, voffB); PG8_STAGE(PG8_SA(0, 0), a2, voffA);
            if (rsw) PG8_WAIT_V(9); else PG8_WAIT_V(8);
            PG8_WAIT_L(0); PG8_BAR; if constexpr (!DIAG) PG8_MMA(1, 0, At, B0); PG8_MMA(1, 1, At, B1); PG8_BAR; PG8_SCHED;
            PG8_LDB(B0, 1, 0); PG8_LDB(B1, 1, 1); PG8_SCHED; PG8_LDA(At, 1, 0); PG8_STAGE(PG8_SA(0, 1), a2 + hstepA, voffA);
            if (rsw) PG8_WAIT_V(9); else PG8_WAIT_V(8);
            PG8_WAIT_L(0); PG8_BAR; PG8_MMA(0, 0, At, B0); if constexpr (!DIAG) PG8_MMA(0, 1, At, B1); PG8_BAR; PG8_SCHED;
            PG8_LDA(At, 1, 1); PG8_STAGE(PG8_SB(1, 0), b3, voffB); PG8_STAGE(PG8_SB(1, 1), b3 + hstepB, voffB); PG8_STAGE(PG8_SA(1, 0), a3, voffA);
            PG8_WAIT_V(8); PG8_WAIT_L(0); PG8_BAR; if constexpr (!DIAG) PG8_MMA(1, 0, At, B0); PG8_MMA(1, 1, At, B1); PG8_BAR; PG8_SCHED;
        }
        if constexpr (ALIGN_EPI) { if (wr == 0) PG8_BAR; }
        if constexpr (F8) { __builtin_amdgcn_sched_barrier(0); asm volatile("s_nop 15\n\ts_nop 15" ::: "memory"); __builtin_amdgcn_sched_barrier(0); }
        { const int fl = (int)fresh_lane_id(), fr2 = fl & 15, fq2 = fl >> 4;
          if constexpr (Epi::RS) E(acc, lds, cur, wr, wc, fr2, fq2); else E(acc, cur, wr, wc, fr2, fq2); }
        if (!has_next) break;
#pragma unroll
        for (int a = 0; a < 2; ++a)
#pragma unroll
            for (int b = 0; b < 2; ++b)
#pragma unroll
                for (int m = 0; m < 4; ++m)
#pragma unroll
                    for (int n = 0; n < 2; ++n) if (!DIAG || a == b) acc[a][b][m][n] = (f32x4){0.f, 0.f, 0.f, 0.f};
        cur = nxt; cA = nA; cB = nB; ++ui;
        if constexpr (ALIGN_EPI) { if (wr == 1) PG8_BAR; }
    }
    PG8_WAIT_V(0);
    if constexpr (!ALIGN_EPI) { if (wr == 0) PG8_BAR; }
    PG8_BAR;
#undef PG8_SA
#undef PG8_SB
#undef PG8_STAGE
#undef PG8_LDA
#undef PG8_LDB
#undef PG8_MMA
#undef PG8_WAIT_V
#undef PG8_WAIT_L
#undef PG8_BAR
#undef PG8_SCHED
}

struct EpiMergeHalf {
    const bf16_t* gate; int ldg; bf16_t* Mg;
    __device__ __forceinline__ void prefetch(u32x4 (&gp)[8], const Unit& u, int wr, int wc, int fr, int fq) const {
        const bf16_t* ub = gate + (size_t)(u.pm * HALF) * ldg + u.z * DM + u.pn * BM;
        const unsigned lo = (unsigned)((wr * 64 + fr) * ldg + wc * 32 + 8 * fq);
#pragma unroll
        for (int m = 0; m < 4; ++m)
#pragma unroll
            for (int bj = 0; bj < 2; ++bj) gp[m * 2 + bj] = *(const u32x4*)(ub + (size_t)(m * 16) * ldg + bj * HALF + lo);
    }
    __device__ __forceinline__ void operator()(const f32x4 (&acc)[2][4][2], u32x4 (&tot)[8], const u32x4 (&gp)[8], const Unit& u, int wr, int wc, int fr, int fq) const {
        const int row0 = u.pm * HALF + wr * 64 + fr, col0 = u.pn * BM + wc * 32 + 8 * fq, z = u.z;
        const unsigned keep = (z == 3) ? 0u : 0xffffffffu;
#pragma unroll
        for (int m = 0; m < 4; ++m) { const int row = row0 + m * 16;
#pragma unroll
            for (int bj = 0; bj < 2; ++bj) {
                const u32x4 g = gp[m * 2 + bj], p = tot[m * 2 + bj];
                const f32x4 g0 = (f32x4){bflo(g.x), bfhi(g.x), bflo(g.y), bfhi(g.y)}, g1 = (f32x4){bflo(g.z), bfhi(g.z), bflo(g.w), bfhi(g.w)};
                const f32x4 p0 = (f32x4){bflo(p.x), bfhi(p.x), bflo(p.y), bfhi(p.y)}, p1 = (f32x4){bflo(p.z), bfhi(p.z), bflo(p.w), bfhi(p.w)};
                const f32x4 t0 = g0 * acc[bj][m][0] + p0, t1 = g1 * acc[bj][m][1] + p1;
                u32x4 w; w.x = cvt_pk_bf16(t0[0], t0[1]); w.y = cvt_pk_bf16(t0[2], t0[3]); w.z = cvt_pk_bf16(t1[0], t1[1]); w.w = cvt_pk_bf16(t1[2], t1[3]);
                if (z == 3) *(u32x4*)(Mg + (size_t)row * DM + col0 + bj * HALF) = w;
                tot[m * 2 + bj] = (u32x4){w.x & keep, w.y & keep, w.z & keep, w.w & keep}; } }
    }
};

template <class Epi, class Sched>
__device__ __forceinline__ void gemm_phase_m3(LAS unsigned char* lds, const Gemm g, const Sched& S, const Epi& E, int wave) {
    const int tid = opaque_tid(wave), wid = __builtin_amdgcn_readfirstlane(tid >> 6), lane = tid & 63, wr = wid >> 2, wc = wid & 3, fr = lane & 15, fq = lane >> 4;
    const int K = g.K, nt = K / BK, lda = g.lda;
    const int rowA = lda * 2, rowB = K * 2;
    unsigned voffA[2], voffB[2];
#pragma unroll
    for (int i = 0; i < 2; ++i) { int R, C; stage_rc(tid * 16 + i * 8192, R, C); const int Rb = (R & ~31) + perm32(R & 31);
        voffA[i] = (unsigned)(R * rowA + C * 2); voffB[i] = (unsigned)(Rb * rowB + C * 2); }
    const size_t kstep = (size_t)(BK * 2), hstepB = (size_t)HALF * rowB, tstepA = (size_t)HALF * rowA, tstepB = 2 * (size_t)HALF * rowB;
    const unsigned ldsw = (unsigned)wid * 1024u;
    const int aoff = lds_byte(wr * 64 + fr, fq * 8), boff = lds_byte(wc * 32 + fr, fq * 8);
    constexpr int SLOT = 3 * HTB;
#define M3_STAGE(bufoff, gbase, voff) do { _Pragma("unroll") for (int _i = 0; _i < 2; ++_i) \
        __builtin_amdgcn_global_load_lds((const unsigned*)((const char*)(gbase) + (voff)[_i]), (LAS unsigned*)(lds + (bufoff) + ldsw + _i * 8192), 16, 0, 0); } while (0)
#define M3_STAGE3(so, a_, b_) do { M3_STAGE((so), (b_), voffB); M3_STAGE((so) + HTB, (b_) + hstepB, voffB); M3_STAGE((so) + 2 * HTB, (a_), voffA); } while (0)
#define M3_LDA(dst, so) do { _Pragma("unroll") for (int m = 0; m < 4; ++m) _Pragma("unroll") for (int k = 0; k < 2; ++k) dst[m][k] = *(const LAS bf16x8*)(lds + (so) + 2 * HTB + aoff + m * 2048 + k * 1024); } while (0)
#define M3_LDB(dst, so, h) do { _Pragma("unroll") for (int n = 0; n < 2; ++n) _Pragma("unroll") for (int k = 0; k < 2; ++k) dst[n][k] = *(const LAS bf16x8*)(lds + (so) + (h) * HTB + boff + n * 2048 + k * 1024); } while (0)
#define M3_MMA(bj, At, Bt) do { __builtin_amdgcn_s_setprio(1); \
        _Pragma("unroll") for (int m = 0; m < 4; ++m) _Pragma("unroll") for (int n = 0; n < 2; ++n) _Pragma("unroll") for (int k = 0; k < 2; ++k) \
            acc[bj][m][n] = __builtin_amdgcn_mfma_f32_16x16x32_bf16(Bt[n][k], At[m][k], acc[bj][m][n], 0, 0, 0); \
        __builtin_amdgcn_s_setprio(0); } while (0)
#define M3_WAIT_V(n) asm volatile("s_waitcnt vmcnt(" #n ")" ::: "memory")
#define M3_WAIT_L(n) asm volatile("s_waitcnt lgkmcnt(" #n ")" ::: "memory")
#define M3_BAR __builtin_amdgcn_s_barrier()
#define M3_SCHED __builtin_amdgcn_sched_barrier(0)
    Unit cur, nxt; int ui = 0;
    if (!S.next(0, cur)) return;
    f32x4 acc[2][4][2];
#pragma unroll
    for (int b = 0; b < 2; ++b)
#pragma unroll
        for (int m = 0; m < 4; ++m)
#pragma unroll
            for (int n = 0; n < 2; ++n) acc[b][m][n] = (f32x4){0.f, 0.f, 0.f, 0.f};
    u32x4 tot[8];
#pragma unroll
    for (int i = 0; i < 8; ++i) tot[i] = (u32x4){0u, 0u, 0u, 0u};
    bf16x8 At[4][2], B0[2][2], B1[2][2];
    const char* cA = (const char*)g.A + (size_t)cur.pm * tstepA + (size_t)cur.z * g.zA; const char* cB = (const char*)g.Bt + (size_t)cur.pn * tstepB + (size_t)cur.z * g.zB;
    u32x4 gp[8];
    int o0 = 0, o1 = SLOT, o2 = 2 * SLOT;
    M3_STAGE3(o0, cA, cB);
    if (wr == 1) M3_BAR;
    M3_WAIT_V(0); M3_BAR;
    M3_STAGE3(o1, cA + kstep, cB + kstep);
    M3_BAR;
    for (;;) {
        const bool has_next = S.next(ui + 1, nxt);
        const char* nA = has_next ? (const char*)g.A + (size_t)nxt.pm * tstepA + (size_t)nxt.z * g.zA : cA; const char* nB = has_next ? (const char*)g.Bt + (size_t)nxt.pn * tstepB + (size_t)nxt.z * g.zB : cB;
        for (int t = 0; t < nt; ++t) {
            const bool wrap = (t + 2 >= nt);
            const char* a2 = wrap ? nA + (size_t)(t + 2 - nt) * kstep : cA + (size_t)(t + 2) * kstep; const char* b2 = wrap ? nB + (size_t)(t + 2 - nt) * kstep : cB + (size_t)(t + 2) * kstep;
            M3_LDB(B0, o0, 0); M3_LDB(B1, o0, 1); M3_SCHED; M3_LDA(At, o0); M3_STAGE3(o2, a2, b2);
            if (t == nt - 2) { M3_SCHED; E.prefetch(gp, cur, wr, wc, fr, fq); M3_SCHED; }
            if (wrap) M3_WAIT_V(14); else M3_WAIT_V(6);
            M3_WAIT_L(0); M3_BAR; M3_MMA(0, At, B0); M3_MMA(1, At, B1); M3_BAR; M3_SCHED;
            { const int r = o0; o0 = o1; o1 = o2; o2 = r; }
        }
        if (wr == 0) M3_BAR;
        E(acc, tot, gp, cur, wr, wc, fr, fq);
        if (!has_next) break;
#pragma unroll
        for (int b = 0; b < 2; ++b)
#pragma unroll
            for (int m = 0; m < 4; ++m)
#pragma unroll
                for (int n = 0; n < 2; ++n) acc[b][m][n] = (f32x4){0.f, 0.f, 0.f, 0.f};
        cur = nxt; cA = nA; cB = nB; ++ui;
        if (wr == 1) M3_BAR;
    }
    M3_WAIT_V(0);
    M3_BAR;
#undef M3_STAGE
#undef M3_STAGE3
#undef M3_LDA
#undef M3_LDB
#undef M3_MMA
#undef M3_WAIT_V
#undef M3_WAIT_L
#undef M3_BAR
#undef M3_SCHED
}
}

constexpr size_t MiB = 1u << 20;
constexpr size_t WS_CTL = 0, CTL_ZERO_BYTES = 1 * MiB;
constexpr size_t WS_ROPE = 1 * MiB;
constexpr size_t WS_BTAB = 2 * MiB;
constexpr size_t WS_PMM = WS_BTAB + 16 * 256 * 4;
constexpr size_t WS_AFF = WS_PMM + 128 * 2 * 4 + 64;
constexpr size_t WS_LAM = WS_AFF + 64;
constexpr size_t WS_KMEAN = 3 * MiB;
constexpr size_t WS_W = 4 * MiB;
constexpr size_t W_IN = 0, W_IN8 = 32 * MiB  , W_UQ = 51 * MiB, W_UKV = W_UQ + 768 * 512 * 2, W_BR = W_UKV + 1024 * 256 * 2, W_OUT = W_BR + 8 * MiB, W_UP = W_OUT + 8 * MiB, W_DN = W_UP + 44 * MiB, W_LAYER = W_DN + 22 * MiB;
constexpr size_t WS_X = WS_W + DEPTH * W_LAYER;
constexpr size_t WS_XN = WS_X + 128 * MiB;
constexpr size_t WS_MG = WS_XN + 64 * MiB;
constexpr size_t WS_Z = WS_MG + 64 * MiB;
constexpr size_t WS_CQN = WS_Z + 408 * MiB;
constexpr size_t WS_CKVN = WS_CQN + 16 * MiB;
constexpr size_t WS_KR = WS_CKVN + 8 * MiB;
constexpr size_t WS_QMLA = WS_KR + 2 * MiB;
constexpr size_t WS_KVMLA = WS_QMLA + 24 * MiB;
constexpr size_t WS_BRO = WS_KVMLA + 32 * MiB;
constexpr size_t WS_T = WS_BRO + 64 * MiB;
constexpr size_t WS_DSCR = WS_T + 176 * MiB;
constexpr size_t WS_SSQ = WS_DSCR;
constexpr size_t WS_END = WS_DSCR + 32 * MiB;
static_assert(W_LAYER * 1 == (size_t)(51 * MiB + 768 * 512 * 2 + 1024 * 256 * 2 + 82 * MiB), "weight map");
static_assert((size_t)M * ZLD * 2 == 408 * MiB && (size_t)M * UP_N * 2 <= 408 * MiB && (size_t)M * FFN * 2 == 176 * MiB, "buffer sizes");
constexpr int CW_TMO = 0;
constexpr int CW_QUEUE = 8192;
constexpr int CW_BAR = 4096;

constexpr int RING_OFF = 0, RING_BYTES = 131072;
constexpr int LDS_BYTES = 163840;
constexpr int LDSCTL_OFF = LDS_BYTES - 1024, MISC_OFF = LDSCTL_OFF + 320;
constexpr int NWAVES = 8;

typedef GAS unsigned gu32;
#define RLX_AGENT __ATOMIC_RELAXED, __HIP_MEMORY_SCOPE_AGENT
#define LDS_WAIT() asm volatile("s_waitcnt lgkmcnt(0)" ::: "memory")
#define XB_TMO      128
#define XB_XCNT(j)  (256  + 64 * (j))
#define XB_XSUB(j)  (1280 + 64 * (j))
#define XB_XGEN(j)  (2304 + 64 * (j))
#define XB_TOP      3328
#define XB_TOPGEN   3392
#define XCD_BAR_WORDS 3456
#define XB_SPIN_CAP (1u << 22)
__device__ __forceinline__ unsigned xb_ld(unsigned* p)              { return __hip_atomic_load(p, __ATOMIC_RELAXED, __HIP_MEMORY_SCOPE_AGENT); }
__device__ __forceinline__ unsigned xb_add(unsigned* p, unsigned v) { return __hip_atomic_fetch_add(p, v, __ATOMIC_RELAXED, __HIP_MEMORY_SCOPE_AGENT); }
__device__ __forceinline__ unsigned xb_xcc_id() { return (unsigned)__builtin_amdgcn_s_getreg((3 << 11) | 20) & 0xFu; }
#define XB_SPIN(cond, bar) do { unsigned _sp = 0; while (cond) { __builtin_amdgcn_s_sleep(1); \
    if ((++_sp & 255u) == 0u) { if (xb_ld(&(bar)[XB_TMO])) break; if (_sp > XB_SPIN_CAP) { atomicAdd(&(bar)[XB_TMO], 1u); break; } } } } while (0)
struct XcdBarrier { unsigned* bar; unsigned x; volatile LAS unsigned* st; int wave; };
__device__ __forceinline__ XcdBarrier xcd_barrier_post(unsigned* bar, volatile LAS unsigned* st, int wave) {
    XcdBarrier b; b.bar = bar; b.x = xb_xcc_id(); b.st = st; b.wave = wave;
    if (is_thread0(wave)) (void)xb_add(&bar[XB_XCNT(b.x)], 1u);
    return b;
}
__device__ __forceinline__ void xcd_barrier_complete(unsigned* bar, unsigned x, unsigned& nloc, unsigned& nx) {
    const unsigned G = gridDim.x * gridDim.y * gridDim.z;
    unsigned sum, cnt, mine, sp = 0u;
    for (;;) {
        sum = 0u; cnt = 0u; mine = 0u;
#pragma unroll
        for (unsigned j = 0; j < 16; ++j) { const unsigned c = xb_ld(&bar[XB_XCNT(j)]); sum += c; cnt += (c > 0u) ? 1u : 0u; mine = (j == x) ? c : mine; }
        if (sum == G) break;
        __builtin_amdgcn_s_sleep(1);
        if ((++sp & 255u) == 0u) { if (xb_ld(&bar[XB_TMO])) break; if (sp > XB_SPIN_CAP) { atomicAdd(&bar[XB_TMO], 1u); break; } }
    }
    nloc = mine > 0u ? mine : 1u; nx = cnt > 0u ? cnt : 1u;
}
__device__ __forceinline__ void xcd_barrier(const XcdBarrier& b) {
    asm volatile("s_waitcnt vmcnt(0)" ::: "memory");
    __syncthreads();
    if (is_thread0(b.wave)) {
        unsigned* bar = b.bar;
        __builtin_amdgcn_s_waitcnt(0);
        unsigned nloc = b.st[0], nx = b.st[1];
        if (nloc == 0u) { xcd_barrier_complete(bar, b.x, nloc, nx); b.st[0] = nloc; b.st[1] = nx; }
        const unsigned old = xb_add(&bar[XB_XSUB(b.x)], 1u);
        const unsigned gen = old / nloc;
        if (old + 1u == (gen + 1u) * nloc) {
            __builtin_amdgcn_fence(__ATOMIC_RELEASE, "agent");
            asm volatile("s_waitcnt vmcnt(0)" ::: "memory");
            const unsigned og = xb_add(&bar[XB_TOP], 1u);
            const unsigned tg = og / nx;
            if (og + 1u == (tg + 1u) * nx) xb_add(&bar[XB_TOPGEN], 1u);
            else XB_SPIN(xb_ld(&bar[XB_TOPGEN]) == tg, bar);
            __builtin_amdgcn_fence(__ATOMIC_ACQUIRE, "agent");
            xb_add(&bar[XB_XGEN(b.x)], 1u);
            asm volatile("s_waitcnt vmcnt(0)" ::: "memory");
        } else {
            XB_SPIN(xb_ld(&bar[XB_XGEN(b.x)]) == gen, bar);
            __builtin_amdgcn_fence(__ATOMIC_ACQUIRE, "agent");
            asm volatile("s_waitcnt vmcnt(0)" ::: "memory");
        }
    }
    __syncthreads();
}

namespace att {
template <int DK0_, int DK1_, int DV_, int NQL_ = 0, int NDC_ = 0> struct Cfg {
    static constexpr int DK0 = DK0_, DK1 = DK1_, DK = DK0_ + DK1_, DV = DV_;
    static constexpr int KP = DK * 2 + 16, VP = DV * 2 + 64;
    static constexpr int KOFF = 0, VOFF = 64 * KP, POFF = VOFF + 64 * VP, BUFB = POFF + 256;
    static constexpr int NKC = (64 * DK / 8) / 512, NVC = (64 * DV / 8) / 512;
    static constexpr int ND = NDC_ > 0 ? NDC_ : DK / 16, NO = DV / 32;
    static constexpr int NQL = NQL_, NQR = ND - NQL_;
};
constexpr int BTAB_OFF = 94208, KMEAN_OFF = 94208 + 1024, QL_OFF = 92672;
struct Src { const bf16_t* k0; int pk0; const bf16_t* k1; int pk1; const bf16_t* v; int pv; const int* pos; };
#if PROF_BUILD
struct WaveCtx { int lane, r32, hi, wid, tid, koff; unsigned long long* prof; };
#define PCLK() ((unsigned)clock64())
#else
struct WaveCtx { int lane, r32, hi, wid, tid, koff; };
#endif

template <class C, bool WITH_POS> struct Stage {
    u32x4 kr[C::NKC]; u32x4 vr[C::NVC]; int pr;
    __device__ __forceinline__ void load(const Src& s, int t, int tid) {
        const int kb = t * 64;
#pragma unroll
        for (int i = 0; i < C::NKC; ++i) { const int id = tid + 512 * i, row = id / (C::DK / 8), c = id % (C::DK / 8);
            const bf16_t* p = (C::DK1 == 0 || c < C::DK0 / 8) ? s.k0 + (size_t)(kb + row) * s.pk0 + c * 8 : s.k1 + (size_t)(kb + row) * s.pk1 + (c - C::DK0 / 8) * 8;
            kr[i] = *(const u32x4*)p; }
#pragma unroll
        for (int i = 0; i < C::NVC; ++i) { const int id = tid + 512 * i, row = id / (C::DV / 8), c = id % (C::DV / 8);
            vr[i] = *(const u32x4*)(s.v + (size_t)(kb + row) * s.pv + c * 8); }
        pr = (WITH_POS && tid < 64) ? s.pos[kb + tid] : 0;
    }
    __device__ __forceinline__ void store(LAS unsigned char* buf, int tid) const {
#pragma unroll
        for (int i = 0; i < C::NKC; ++i) { const int id = tid + 512 * i, row = id / (C::DK / 8), c = id % (C::DK / 8); *(LAS u32x4*)(buf + C::KOFF + row * C::KP + c * 16) = kr[i]; }
#pragma unroll
        for (int i = 0; i < C::NVC; ++i) { const int id = tid + 512 * i, row = id / (C::DV / 8), c = id % (C::DV / 8); *(LAS u32x4*)(buf + C::VOFF + row * C::VP + c * 16) = vr[i]; }
        if (WITH_POS && tid < 64) *(LAS int*)(buf + C::POFF + tid * 4) = pr;
    }
};
__device__ __forceinline__ s16x4 vtr(const LAS unsigned char* p) { typedef short v4i16_t __attribute__((ext_vector_type(4))); return __builtin_bit_cast(s16x4, __builtin_amdgcn_ds_read_tr16_b64_v4i16((LAS v4i16_t*)p)); }

struct RowState { float m, l; };

template <class C, int KIND, bool BIAS, bool VPRE>
__device__ __forceinline__ void tile_compute(const LAS unsigned char* buf, const LAS float* btab, const bf16x8 (&qf)[C::NQR], const LAS unsigned char* qlb, f32x16 (&O)[C::NO], RowState& st,
                                             int k0, int qw, int posq, int pminq, unsigned long long farlo, unsigned long long farhi, unsigned long long afflo, unsigned long long affhi, unsigned selmask, int blk, const WaveCtx& w) {
    const int qi = qw + w.r32;
#pragma unroll
    for (int p = 0; p < 2; ++p) {
        const int ks = k0 + 32 * p;
        bool causal_tile = true, sel_lane = true, skip = false, fast = false;
        if (KIND == 0) { skip = ks > qw + 31; fast = (ks + 31 <= qw); }
        if (KIND == 1) { skip = (ks > qw + 31) || (ks + 31 < qw - 127); }
        if (KIND == 2) {
            const int n = ks >> 8;
            if (n < blk) { causal_tile = false; sel_lane = ((selmask >> n) & 1u) != 0u; skip = !__any(sel_lane); fast = (bool)__all(sel_lane); }
            else { skip = ks > qw + 31; fast = (ks + 31 <= qw); }
        }
        if (skip) continue;
        if (BIAS && fast) { const int kb32 = ks >> 5; fast = (((kb32 < 64 ? farlo >> kb32 : farhi >> (kb32 - 64)) & 1ull) != 0ull); }
        f32x16 sc;
#pragma unroll
        for (int r = 0; r < 16; ++r) sc[r] = 0.f;
        const LAS unsigned char* kb = buf + C::KOFF + (32 * p + w.r32) * C::KP + w.hi * 16 + w.koff;
#pragma unroll
        for (int d0 = 0; d0 < C::ND; ++d0) {
            const bf16x8 a0 = *(const LAS bf16x8*)(kb + d0 * 32);
            const bf16x8 qv = (d0 < C::NQR) ? qf[d0 < C::NQR ? d0 : 0] : *(const LAS bf16x8*)(qlb + (d0 - C::NQR) * 1024);
            sc = __builtin_amdgcn_mfma_f32_32x32x16_bf16(a0, qv, sc, 0, 0, 0);
        }
        s16x4 vl[2][C::NO], vh[2][C::NO];
        if constexpr (VPRE) {
            const unsigned va = (unsigned)(__UINTPTR_TYPE__)(buf + C::VOFF + (32 * p + 4 * w.hi + ((w.lane & 15) >> 2)) * C::VP + (16 * ((w.lane >> 4) & 1) + 4 * (w.lane & 3)) * 2);
#pragma unroll
            for (int s = 0; s < 2; ++s)
#pragma unroll
                for (int d = 0; d < C::NO; ++d) {
                    asm volatile("ds_read_b64_tr_b16 %0, %1 offset:%2" : "=v"(vl[s][d]) : "v"(va), "n"((16 * s) * C::VP + d * 64));
                    asm volatile("ds_read_b64_tr_b16 %0, %1 offset:%2" : "=v"(vh[s][d]) : "v"(va), "n"((16 * s + 8) * C::VP + d * 64));
                }
            __builtin_amdgcn_sched_barrier(0);
        }
        if (fast) {
            if (BIAS) { const float bc = btab[64 + 128];
#pragma unroll
                for (int r = 0; r < 16; ++r) sc[r] += bc; }
        } else {
            bool aff = false; int posk0 = 0;
            if (BIAS) {
                const int kb32 = ks >> 5, qb32 = qw >> 5;
                aff = (((kb32 < 64 ? afflo >> kb32 : affhi >> (kb32 - 64)) & 1ull) != 0ull) && (((qb32 < 64 ? afflo >> qb32 : affhi >> (qb32 - 64)) & 1ull) != 0ull);
                if (aff) { posk0 = __builtin_amdgcn_readfirstlane(*(const LAS int*)(buf + C::POFF + (32 * p) * 4)); aff = (pminq - posk0 - 31 >= -62) && (pminq + 31 - posk0 <= 191); }
            }
            if (aff) {
                const LAS float* tb = btab + (posq - posk0 + 64 - 4 * w.hi - 27);
#pragma unroll
                for (int r = 0; r < 16; ++r) {
                    const int c = (r & 3) + 8 * (r >> 2), kv = ks + c + 4 * w.hi;
                    const float v = sc[r] + tb[27 - c];
                    bool valid;
                    if (KIND == 0) valid = kv <= qi;
                    else if (KIND == 1) valid = (unsigned)(qi - kv) < 128u;
                    else valid = causal_tile ? (kv <= qi) : sel_lane;
                    sc[r] = valid ? v : NEG_INF;
                }
            } else {
#pragma unroll
            for (int g4 = 0; g4 < 4; ++g4) {
                i32x4 pk = (i32x4){0, 0, 0, 0};
                if (BIAS) pk = *(const LAS i32x4*)(buf + C::POFF + (32 * p + 8 * g4 + 4 * w.hi) * 4);
#pragma unroll
                for (int e = 0; e < 4; ++e) {
                    const int r = 4 * g4 + e, kv = ks + 8 * g4 + 4 * w.hi + e;
                    float v = sc[r];
                    if (BIAS) { int d = posq - pk[e]; d = d < 0 ? 0 : (d > 128 ? 128 : d); v += btab[64 + d]; }
                    bool valid;
                    if (KIND == 0) valid = kv <= qi;
                    else if (KIND == 1) valid = (unsigned)(qi - kv) < 128u;
                    else valid = causal_tile ? (kv <= qi) : sel_lane;
                    sc[r] = valid ? v : NEG_INF;
                }
            }
            }
        }
        float tmax = sc[0];
#pragma unroll
        for (int r = 1; r < 16; ++r) tmax = fmaxf(tmax, sc[r]);
        { const auto rr = __builtin_amdgcn_permlane32_swap(__float_as_uint(tmax), __float_as_uint(tmax), false, false); tmax = fmaxf(__uint_as_float(rr[0]), __uint_as_float(rr[1])); }
        const float mn = fmaxf(st.m, tmax);
        const float alpha = __builtin_amdgcn_exp2f(st.m - mn);
        st.m = mn;
        float ps = 0.f;
#pragma unroll
        for (int r = 0; r < 16; ++r) { sc[r] = __builtin_amdgcn_exp2f(sc[r] - mn); ps += sc[r]; }
        st.l = st.l * alpha + ps;
        if (__any(alpha != 1.0f)) {
#pragma unroll
            for (int d = 0; d < C::NO; ++d)
#pragma unroll
                for (int r = 0; r < 16; ++r) O[d][r] *= alpha;
        }
#pragma unroll
        for (int s = 0; s < 2; ++s) {
            u32x4 t; const int b = 8 * s;
            t.x = cvt_pk_bf16(sc[b], sc[b + 1]); t.y = cvt_pk_bf16(sc[b + 2], sc[b + 3]); t.z = cvt_pk_bf16(sc[b + 4], sc[b + 5]); t.w = cvt_pk_bf16(sc[b + 6], sc[b + 7]);
            const bf16x8 pf = __builtin_bit_cast(bf16x8, t);
            if constexpr (VPRE) {
                if (s == 0) { asm volatile("s_waitcnt lgkmcnt(0)" ::: "memory"); __builtin_amdgcn_sched_barrier(0); }
#pragma unroll
                for (int d = 0; d < C::NO; ++d) {
                    const bf16x8 vf = (bf16x8){vl[s][d][0], vl[s][d][1], vl[s][d][2], vl[s][d][3], vh[s][d][0], vh[s][d][1], vh[s][d][2], vh[s][d][3]};
                    O[d] = __builtin_amdgcn_mfma_f32_32x32x16_bf16(vf, pf, O[d], 0, 0, 0);
                }
            } else {
                const LAS unsigned char* vb = buf + C::VOFF + (32 * p + 4 * w.hi + ((w.lane & 15) >> 2)) * C::VP + (16 * ((w.lane >> 4) & 1) + 4 * (w.lane & 3)) * 2;
#pragma unroll
                for (int d = 0; d < C::NO; ++d) {
                    const s16x4 lo = vtr(vb + (16 * s) * C::VP + d * 64), hi4 = vtr(vb + (16 * s + 8) * C::VP + d * 64);
                    const bf16x8 vf = (bf16x8){lo[0], lo[1], lo[2], lo[3], hi4[0], hi4[1], hi4[2], hi4[3]};
                    O[d] = __builtin_amdgcn_mfma_f32_32x32x16_bf16(vf, pf, O[d], 0, 0, 0);
                }
            }
        }
    }
}

constexpr float ATT_THR = 8.0f;
template <class C, bool VPRE>
__device__ __forceinline__ void tile64_fast(const LAS unsigned char* buf, const bf16x8 (&qf)[C::NQR], const LAS unsigned char* qlb, f32x16 (&O)[C::NO], RowState& st, float& nm, const WaveCtx& w) {
    f32x16 s0, s1;
    const LAS unsigned char* kb = buf + C::KOFF + w.r32 * C::KP + w.hi * 16 + w.koff;
#pragma unroll
    for (int r = 0; r < 16; ++r) { s0[r] = 0.f; s1[r] = 0.f; }
#pragma unroll
    for (int d0 = 0; d0 < C::ND; ++d0) {
        const bf16x8 a0 = *(const LAS bf16x8*)(kb + d0 * 32), a1 = *(const LAS bf16x8*)(kb + 32 * C::KP + d0 * 32);
        const bf16x8 qv = (d0 < C::NQR) ? qf[d0 < C::NQR ? d0 : 0] : *(const LAS bf16x8*)(qlb + (d0 - C::NQR) * 1024);
        s0 = __builtin_amdgcn_mfma_f32_32x32x16_bf16(a0, qv, s0, 0, 0, 0); s1 = __builtin_amdgcn_mfma_f32_32x32x16_bf16(a1, qv, s1, 0, 0, 0);
    }
    const unsigned va = (unsigned)(__UINTPTR_TYPE__)(buf + C::VOFF + (4 * w.hi + ((w.lane & 15) >> 2)) * C::VP + (16 * ((w.lane >> 4) & 1) + 4 * (w.lane & 3)) * 2);
    const LAS unsigned char* vb = buf + C::VOFF + (4 * w.hi + ((w.lane & 15) >> 2)) * C::VP + (16 * ((w.lane >> 4) & 1) + 4 * (w.lane & 3)) * 2;
    s16x4 vl[C::NO], vh[C::NO];
#define ATT_VREADS(KS) do { if constexpr (VPRE) { _Pragma("unroll") for (int d = 0; d < C::NO; ++d) { \
        asm volatile("ds_read_b64_tr_b16 %0, %1 offset:%2" : "=v"(vl[d]) : "v"(va), "n"((16 * (KS)) * C::VP + d * 64)); \
        asm volatile("ds_read_b64_tr_b16 %0, %1 offset:%2" : "=v"(vh[d]) : "v"(va), "n"((16 * (KS) + 8) * C::VP + d * 64)); } \
        __builtin_amdgcn_sched_barrier(0); } } while (0)
#define ATT_PVSTEP(SP, KS, NEXT) do { u32x4 tq; const int b_ = 8 * ((KS) & 1); \
        tq.x = cvt_pk_bf16(SP[b_], SP[b_ + 1]); tq.y = cvt_pk_bf16(SP[b_ + 2], SP[b_ + 3]); tq.z = cvt_pk_bf16(SP[b_ + 4], SP[b_ + 5]); tq.w = cvt_pk_bf16(SP[b_ + 6], SP[b_ + 7]); \
        const bf16x8 pf = __builtin_bit_cast(bf16x8, tq); \
        if constexpr (VPRE) { asm volatile("s_waitcnt lgkmcnt(0)" ::: "memory"); __builtin_amdgcn_sched_barrier(0); \
            _Pragma("unroll") for (int d = 0; d < C::NO; ++d) { const bf16x8 vf = (bf16x8){vl[d][0], vl[d][1], vl[d][2], vl[d][3], vh[d][0], vh[d][1], vh[d][2], vh[d][3]}; \
                O[d] = __builtin_amdgcn_mfma_f32_32x32x16_bf16(vf, pf, O[d], 0, 0, 0); } \
            __builtin_amdgcn_sched_barrier(0); if ((NEXT) >= 0) ATT_VREADS((NEXT) < 0 ? 0 : (NEXT)); } \
        else { _Pragma("unroll") for (int d = 0; d < C::NO; ++d) { const s16x4 lo = vtr(vb + (16 * (KS)) * C::VP + d * 64), hi4 = vtr(vb + (16 * (KS) + 8) * C::VP + d * 64); \
                const bf16x8 vf = (bf16x8){lo[0], lo[1], lo[2], lo[3], hi4[0], hi4[1], hi4[2], hi4[3]}; \
                O[d] = __builtin_amdgcn_mfma_f32_32x32x16_bf16(vf, pf, O[d], 0, 0, 0); } } } while (0)
#define ATT_SOFT(SP) do { \
        float t_ = fmaxf(SP[0], SP[1]); \
        _Pragma("unroll") for (int r = 2; r < 16; r += 2) t_ = fmaxf(t_, fmaxf(SP[r], SP[r + 1])); \
        { const auto rr = __builtin_amdgcn_permlane32_swap(__float_as_uint(t_), __float_as_uint(t_), false, false); t_ = fmaxf(__uint_as_float(rr[0]), __uint_as_float(rr[1])); } \
        t_ += nm; \
        if (__any(t_ > ATT_THR)) { const float dl = fmaxf(t_, 0.f), f_ = __builtin_amdgcn_exp2f(-dl); st.m += dl; nm -= dl; st.l *= f_; \
            _Pragma("unroll") for (int d = 0; d < C::NO; ++d) _Pragma("unroll") for (int r = 0; r < 16; ++r) O[d][r] *= f_; } \
        float ps_ = 0.f; \
        _Pragma("unroll") for (int r = 0; r < 16; ++r) { SP[r] = __builtin_amdgcn_exp2f(SP[r] + nm); ps_ += SP[r]; } \
        st.l += ps_; } while (0)
    ATT_VREADS(0);
    ATT_SOFT(s0);
    ATT_PVSTEP(s0, 0, 1);
    ATT_PVSTEP(s0, 1, 2);
    ATT_SOFT(s1);
    ATT_PVSTEP(s1, 2, 3);
    ATT_PVSTEP(s1, 3, -1);
#undef ATT_VREADS
#undef ATT_PVSTEP
#undef ATT_SOFT
}

template <class C, int KIND, bool BIAS, bool FASTP, bool VPRE>
__device__ __forceinline__ void run_tiles(LAS unsigned char* lds, const Src& src, int t0, int t1, const bf16x8 (&qf)[C::NQR], f32x16 (&O)[C::NO], RowState& st,
                                          int qw, int posq, int pminq, const int* pmm, unsigned selmask, int blk, const WaveCtx& w, int btab_off = 0) {
    const LAS float* btab = (const LAS float*)(lds + BTAB_OFF + btab_off);
    const LAS unsigned char* qlb = lds + QL_OFF + w.wid * (C::NQL * 1024) + w.lane * 16;
    unsigned long long farlo = 0ull, farhi = 0ull;
    unsigned long long afflo = 0ull, affhi = 0ull;
    if (BIAS) { farlo = __ballot(pminq - pmm[w.lane * 2 + 1] >= 128); farhi = __ballot(pminq - pmm[(w.lane + 64) * 2 + 1] >= 128);
        const unsigned* ap = (const unsigned*)(pmm + 256 + 16);
        afflo = (unsigned long long)__builtin_amdgcn_readfirstlane(ap[0]) | ((unsigned long long)__builtin_amdgcn_readfirstlane(ap[1]) << 32);
        affhi = (unsigned long long)__builtin_amdgcn_readfirstlane(ap[2]) | ((unsigned long long)__builtin_amdgcn_readfirstlane(ap[3]) << 32); }
    float nm = 0.f; bool nvalid = false; int ncur = -1;
    Stage<C, BIAS> sg;
    if (t0 < t1) sg.load(src, t1 - 1, w.tid);
    int it = 0;
#if PROF_BUILD
    unsigned pacc = 0, pn5 = 0, pn6 = 0;
#endif
    for (int t = t1 - 1; t >= t0; --t, ++it) {
        LAS unsigned char* buf = lds + (it & 1) * C::BUFB;
#if PROF_BUILD
        unsigned ca = 0, cb = 0, cc = 0, cd = 0; if (PROF_ID == 1) ca = PCLK();
#endif
        sg.store(buf, w.tid);
#if PROF_BUILD
        if (PROF_ID == 1 || PROF_ID == 2) { asm volatile("s_waitcnt vmcnt(0) lgkmcnt(0)" ::: "memory"); cb = PCLK(); }
#endif
        __syncthreads();
#if PROF_BUILD
        if (PROF_ID == 2 || PROF_ID == 8) cc = PCLK();
#endif
        if (t - 1 >= t0) sg.load(src, t - 1, w.tid);
#if PROF_BUILD
        if (PROF_ID == 8 || PROF_ID == 3 || PROF_ID == 4) cd = PCLK();
#endif
        const int k0 = t * 64;
        bool fastT = false, skipT = false, sel_lane = true; int nb = 0;
        if (FASTP) {
            const int kb32 = k0 >> 5;
            const bool far2 = !BIAS || ((((kb32 < 64 ? farlo >> kb32 : farhi >> (kb32 - 64)) & 3ull) == 3ull));
            if (KIND == 0) fastT = (k0 + 63 <= qw) && far2;
            if (KIND == 2) { nb = k0 >> 8; if (nb < blk) { sel_lane = ((selmask >> nb) & 1u) != 0u; skipT = !__any(sel_lane); fastT = far2; } }
        }
        if (skipT) continue;
        if (fastT) {
            if (!nvalid || (KIND == 2 && nb != ncur)) {
                const float bc = BIAS ? btab[64 + 128] : 0.f; nm = sel_lane ? bc - st.m : NEG_INF;
                nvalid = true; ncur = nb;
            }
            tile64_fast<C, VPRE>(buf, qf, qlb, O, st, nm, w);
        } else {
            tile_compute<C, KIND, BIAS, false>(buf, btab, qf, qlb, O, st, k0, qw, posq, pminq, farlo, farhi, afflo, affhi, selmask, blk, w);
            nvalid = false;
        }
#if PROF_BUILD
        { unsigned ce = 0; if (PROF_ID == 3 || PROF_ID == 4) { asm volatile("s_waitcnt lgkmcnt(0)" ::: "memory"); ce = PCLK(); } if (PROF_ID == 1) pacc += cb - ca; if (PROF_ID == 2) pacc += cc - cb; if (PROF_ID == 8) pacc += cd - cc; if (fastT) { if (PROF_ID == 3) pacc += ce - cd; if (PROF_ID == 5) ++pn5; } else { if (PROF_ID == 4) pacc += ce - cd; if (PROF_ID == 5) ++pn6; } }
#endif
    }
    __syncthreads();
#if PROF_BUILD
    if (w.tid == 0) { unsigned long long* pp = w.prof; if (PROF_ID != 5) atomicAdd(pp + PROF_ID, (unsigned long long)pacc); else { atomicAdd(pp + 5, (unsigned long long)pn5); atomicAdd(pp + 6, (unsigned long long)pn6); } }
#endif
}
template <int ND> __device__ __forceinline__ void load_q(bf16x8 (&qf)[ND], const bf16_t* qrow, int hi) {
#pragma unroll
    for (int d0 = 0; d0 < ND; ++d0) qf[d0] = *(const bf16x8*)(qrow + d0 * 16 + hi * 8);
}
template <int NO> __device__ __forceinline__ void store_o(const f32x16 (&O)[NO], bf16_t* orow, int hi) {
#pragma unroll
    for (int d = 0; d < NO; ++d) {
        unsigned vx[4], vy[4];
#pragma unroll
        for (int g = 0; g < 4; ++g) { vx[g] = cvt_pk_bf16(O[d][4 * g], O[d][4 * g + 1]); vy[g] = cvt_pk_bf16(O[d][4 * g + 2], O[d][4 * g + 3]); }
#pragma unroll
        for (int g = 0; g < 2; ++g) {
            const auto sx = __builtin_amdgcn_permlane32_swap(vx[g], vx[g + 2], false, false), sy = __builtin_amdgcn_permlane32_swap(vy[g], vy[g + 2], false, false);
            u32x4 w; w.x = sx[0]; w.y = sy[0]; w.z = sx[1]; w.w = sy[1];
            *(u32x4*)(orow + 32 * d + 8 * (g + 2 * hi)) = w; }
    }
}
}

struct Args { const float* in[20]; float* out; unsigned char* ws; int ph_lo, ph_hi; };
constexpr int PH_PER_LAYER = 13, N_PHASES = 2 + DEPTH * PH_PER_LAYER;

struct Frame {
    LAS unsigned char* lds; volatile LAS unsigned* MISC; unsigned* ctl;
    int tid, lane, wave, G, vcu;
    unsigned char* ws;
};

__device__ __forceinline__ void transpose_item(const float* W, int K, int Nsrc, bf16_t* WT, int Ndst, int pad_lo, int pad_hi, int shift, LAS float* scr, int item, int lane, const float* gk = nullptr) {
    const int nblk = Ndst / 32, kb = item / nblk, nb = item % nblk, k0 = 64 * kb, n0 = 32 * nb;
    const bool pad = (n0 >= pad_lo && n0 < pad_hi);
    int ns0 = n0 - (n0 >= pad_hi ? shift : 0);
    if (shift < 0) { const int pn = n0 >> 8, w0 = n0 & 255; ns0 = (w0 < 128) ? 128 * pn + w0 : FFN + 128 * pn + (w0 - 128); }
    if (!pad) {
        if (gk) {
            const float gl = gk[k0 + lane];
#pragma unroll 8
            for (int i = 0; i < 32; ++i) { const int kk = 2 * i + (lane >> 5);
                const float g0 = __uint_as_float(__builtin_amdgcn_readlane(__float_as_uint(gl), 2 * i)), g1 = __uint_as_float(__builtin_amdgcn_readlane(__float_as_uint(gl), 2 * i + 1));
                scr[kk * 33 + (lane & 31)] = W[(size_t)(k0 + kk) * Nsrc + ns0 + (lane & 31)] * ((lane >> 5) ? g1 : g0); }
        } else {
#pragma unroll 8
            for (int i = 0; i < 32; ++i) { const int kk = 2 * i + (lane >> 5); scr[kk * 33 + (lane & 31)] = W[(size_t)(k0 + kk) * Nsrc + ns0 + (lane & 31)]; }
        }
    }
    LDS_WAIT(); asm volatile("" ::: "memory");
    const int c = lane & 7;
#pragma unroll
    for (int j = 0; j < 4; ++j) { const int n = (lane >> 3) + 8 * j; const LAS float* s = scr + (8 * c) * 33 + n;
        u32x4 o = (u32x4){0u, 0u, 0u, 0u};
        if (!pad) { o.x = cvt_pk_bf16(s[0 * 33], s[1 * 33]); o.y = cvt_pk_bf16(s[2 * 33], s[3 * 33]); o.z = cvt_pk_bf16(s[4 * 33], s[5 * 33]); o.w = cvt_pk_bf16(s[6 * 33], s[7 * 33]); }
        *(u32x4*)(WT + (size_t)(n0 + n) * K + k0 + 8 * c) = o; }
    LDS_WAIT(); asm volatile("" ::: "memory");
}
constexpr float W8_SCALE = 64.0f;
__device__ __forceinline__ unsigned pk4_fp8(float a, float b, float c, float d) { int w = __builtin_amdgcn_cvt_pk_fp8_f32(a, b, 0, false); w = __builtin_amdgcn_cvt_pk_fp8_f32(c, d, w, true); return (unsigned)w; }
__device__ __forceinline__ void transpose_item_f8(const float* W, int K, int Nsrc, int col0, unsigned char* W8, int N8, LAS float* scr, int item, int lane, const float* gk) {
    const int nblk = N8 / 32, kb = item / nblk, nb = item % nblk, k0 = 64 * kb, n0 = 32 * nb;
    const float gl = gk[k0 + lane] * W8_SCALE;
#pragma unroll 8
    for (int i = 0; i < 32; ++i) { const int kk = 2 * i + (lane >> 5);
        const float g0 = __uint_as_float(__builtin_amdgcn_readlane(__float_as_uint(gl), 2 * i)), g1 = __uint_as_float(__builtin_amdgcn_readlane(__float_as_uint(gl), 2 * i + 1));
        scr[kk * 33 + (lane & 31)] = W[(size_t)(k0 + kk) * Nsrc + col0 + n0 + (lane & 31)] * ((lane >> 5) ? g1 : g0); }
    LDS_WAIT(); asm volatile("" ::: "memory");
    const int c = lane & 7;
#pragma unroll
    for (int j = 0; j < 4; ++j) { const int n = (lane >> 3) + 8 * j; const LAS float* sp = scr + (8 * c) * 33 + n;
        u32x2 o; o.x = pk4_fp8(sp[0 * 33], sp[1 * 33], sp[2 * 33], sp[3 * 33]); o.y = pk4_fp8(sp[4 * 33], sp[5 * 33], sp[6 * 33], sp[7 * 33]);
        *(u32x2*)(W8 + (size_t)(n0 + n) * K + k0 + 8 * c) = o; }
    LDS_WAIT(); asm volatile("" ::: "memory");
}
__device__ __forceinline__ int t5_bucket(int n) {
    if (n < 16) return n;
    int b = 16;
    b += (n >= 19); b += (n >= 21); b += (n >= 24); b += (n >= 27); b += (n >= 31); b += (n >= 35); b += (n >= 40); b += (n >= 46);
    b += (n >= 52); b += (n >= 59); b += (n >= 67); b += (n >= 77); b += (n >= 87); b += (n >= 99); b += (n >= 113);
    return b;
}
template <bool WITH_F8>
__device__ __forceinline__ void rms_row_bf16(const float* x32, const bf16_t* x16, const float* g, bf16_t* orow, unsigned char* orow8, int lane) {
    f32x4 v[8]; float s = 0.f;
    if (x32) {
#pragma unroll
        for (int j = 0; j < 8; ++j) v[j] = *((const f32x4*)x32 + lane + 64 * j);
    } else {
#pragma unroll
        for (int j = 0; j < 8; ++j) { const u32x2 p = *((const u32x2*)x16 + lane + 64 * j); v[j] = (f32x4){bflo(p.x), bfhi(p.x), bflo(p.y), bfhi(p.y)}; }
    }
#pragma unroll
    for (int j = 0; j < 8; ++j) s += (v[j].x * v[j].x + v[j].y * v[j].y) + (v[j].z * v[j].z + v[j].w * v[j].w);
    const float rstd = 1.0f / sqrtf(wave_sum(s) * (1.0f / DM) + EPS);
#pragma unroll
    for (int j = 0; j < 8; ++j) { const f32x4 gg = *((const f32x4*)g + lane + 64 * j);
        u32x2 o; o.x = cvt_pk_bf16(v[j].x * rstd * gg.x, v[j].y * rstd * gg.y); o.y = cvt_pk_bf16(v[j].z * rstd * gg.z, v[j].w * rstd * gg.w);
        *((u32x2*)orow + lane + 64 * j) = o;
        if (WITH_F8) *((unsigned*)orow8 + lane + 64 * j) = pk4_fp8(v[j].x * rstd * gg.x, v[j].y * rstd * gg.y, v[j].z * rstd * gg.z, v[j].w * rstd * gg.w); }
}
__device__ __forceinline__ void cvt_row_in(const float* x32, bf16_t* xb, unsigned char* x8, unsigned long long* sq, int lane) {
    float s = 0.f;
#pragma unroll
    for (int j = 0; j < 8; ++j) { const f32x4 v = *((const f32x4*)x32 + lane + 64 * j);
        u32x2 o; o.x = cvt_pk_bf16(v.x, v.y); o.y = cvt_pk_bf16(v.z, v.w);
        *((u32x2*)xb + lane + 64 * j) = o;
        const float a = bflo(o.x), b = bfhi(o.x), c = bflo(o.y), d = bfhi(o.y);
        *((unsigned*)x8 + lane + 64 * j) = pk4_fp8(a, b, c, d);
        s += (a * a + b * b) + (c * c + d * d); }
    s = wave_sum(s);
    if (lane == 0) { const unsigned hi = (unsigned)s; const unsigned lo = (unsigned)((s - (float)hi) * 16777216.0f); *sq = ((unsigned long long)hi << 24) + lo; }
}
__device__ __forceinline__ void rms_row_f32(const bf16_t* xrow, const float* g, float* orow, int lane) {
    f32x4 v[8]; float s = 0.f;
#pragma unroll
    for (int j = 0; j < 8; ++j) { const u32x2 p = *((const u32x2*)xrow + lane + 64 * j); v[j] = (f32x4){bflo(p.x), bfhi(p.x), bflo(p.y), bfhi(p.y)}; s += (v[j].x * v[j].x + v[j].y * v[j].y) + (v[j].z * v[j].z + v[j].w * v[j].w); }
    const float rstd = 1.0f / sqrtf(wave_sum(s) * (1.0f / DM) + EPS);
#pragma unroll
    for (int j = 0; j < 8; ++j) { const f32x4 gg = *((const f32x4*)g + lane + 64 * j); *((f32x4*)orow + lane + 64 * j) = v[j] * rstd * gg; }
}

__device__ __forceinline__ float gelu_f(float v) {
    const float av = fabsf(v), d = av * 0.2316418882f + 1.0f;
    const float t = __builtin_amdgcn_rcpf(d);
    float q = t * 0.5307027145f + (-0.7265760135f); q = q * t + 0.7107068705f; q = q * t + (-0.142248368f); q = q * t + 0.127414796f; q = q * t;
    const float e = __builtin_amdgcn_exp2f((v * v) * (-0.72134752044f));
    const float m = v * (q * e), r = v - m;
    return v < 0.f ? m : r;
}

__device__ __forceinline__ void p_prologue(Frame& F, const Args& a) {
    const int otid = opaque_tid(F.wave), olane = otid & 63;
    LAS float* scr = (LAS float*)(F.lds + RING_OFF + F.wave * 16384);
    const int gw = F.vcu * NWAVES + F.wave, NGW = F.G * NWAVES;
    constexpr int I_IN = (DM / 64) * (ZG / 32) + (DM / 64) * (4 * DM / 32), I_INB = (DM / 64) * (ZG / 32), I_UQ = (512 / 64) * (768 / 32), I_UKV = (256 / 64) * (1024 / 32), I_BR1 = (512 / 64) * (DM / 32), I_BR = 4 * I_BR1,
                  I_OUT = (DM / 64) * (DM / 32), I_UP = (DM / 64) * (UP_N / 32), I_DN = (FFN / 64) * (DM / 32);
    constexpr int I_LAYER = I_IN + I_UQ + I_UKV + I_BR + I_OUT + I_UP + I_DN;
    for (int it = gw; it < DEPTH * I_LAYER; it += NGW) {
        const int l = it / I_LAYER; int r = it - l * I_LAYER;
        unsigned char* wl = F.ws + WS_W + (size_t)l * W_LAYER;
        if (r < I_INB) { transpose_item(a.in[4] + (size_t)l * DM * IN_COLS, DM, IN_COLS, (bf16_t*)(wl + W_IN), ZG, 2368, 2560, 192, scr, r, olane, a.in[3] + (size_t)l * DM); continue; }
        if (r < I_IN) { transpose_item_f8(a.in[4] + (size_t)l * DM * IN_COLS, DM, IN_COLS, 4672, wl + W_IN8, 4 * DM, scr, r - I_INB, olane, a.in[3] + (size_t)l * DM); continue; } r -= I_IN;
        if (r < I_UQ) { transpose_item(a.in[8] + (size_t)l * 512 * 768, 512, 768, (bf16_t*)(wl + W_UQ), 768, 1 << 30, 1 << 30, 0, scr, r, olane, a.in[7] + (size_t)l * 512); continue; } r -= I_UQ;
        if (r < I_UKV) { transpose_item(a.in[10] + (size_t)l * 256 * 1024, 256, 1024, (bf16_t*)(wl + W_UKV), 1024, 1 << 30, 1 << 30, 0, scr, r, olane, a.in[9] + (size_t)l * 256); continue; } r -= I_UKV;
        if (r < I_BR) { const int i = r / I_BR1; transpose_item(a.in[12] + ((size_t)l * 4 + i) * 512 * DM, 512, DM, (bf16_t*)(wl + W_BR) + (size_t)i * DM * 512, DM, 1 << 30, 1 << 30, 0, scr, r - i * I_BR1, olane); continue; } r -= I_BR;
        if (r < I_OUT) { transpose_item(a.in[13] + (size_t)l * DM * DM, DM, DM, (bf16_t*)(wl + W_OUT), DM, 1 << 30, 1 << 30, 0, scr, r, olane); continue; } r -= I_OUT;
        if (r < I_UP) { transpose_item(a.in[15] + (size_t)l * DM * UP_N, DM, UP_N, (bf16_t*)(wl + W_UP), UP_N, 1 << 30, 1 << 30, -1, scr, r, olane, a.in[14] + (size_t)l * DM); continue; } r -= I_UP;
        transpose_item(a.in[18] + (size_t)l * FFN * DM, FFN, DM, (bf16_t*)(wl + W_DN), DM, 1 << 30, 1 << 30, 0, scr, r, olane);
    }
    const int* pos = (const int*)a.in[1];
    const int gt = F.vcu * (NWAVES * 64) + otid, NGT = F.G * NWAVES * 64;
    { unsigned long long* sq = (unsigned long long*)(F.ws + WS_SSQ); for (int e = gt; e < DEPTH * 4 * M; e += NGT) sq[e] = 0ull; }
    f32x2* rope = (f32x2*)(F.ws + WS_ROPE);
    for (int e = gt; e < SEQ * 32; e += NGT) {
        const int s = e >> 5, i = e & 31;
        const float inv = (float)exp2((double)(-i) * (13.287712379549449 / 32.0));
        const float ang = (float)pos[s] * inv;
        const double rev = (double)ang * 0.15915494309189535;
        const float fr = (float)(rev - rint(rev));
        rope[e] = (f32x2){__builtin_amdgcn_cosf(fr), __builtin_amdgcn_sinf(fr)};
    }
    float* btab = (float*)(F.ws + WS_BTAB);
    for (int e = gt; e < 16 * 256; e += NGT) { const int hd = e >> 8, j = e & 255; int n = j - 64; n = n < 0 ? 0 : (n > 128 ? 128 : n); btab[e] = a.in[2][t5_bucket(n) * 16 + hd] * LOG2E; }
    int* pmm = (int*)(F.ws + WS_PMM);
    for (int e = gt; e < 128; e += NGT) { int mn = pos[e * 32], mx = mn;
        for (int j = 1; j < 32; ++j) { const int p = pos[e * 32 + j]; mn = p < mn ? p : mn; mx = p > mx ? p : mx; }
        pmm[2 * e] = mn; pmm[2 * e + 1] = mx; }
    if (gt < 2) { unsigned long long m = 0ull;
        for (int kb = 0; kb < 64; ++kb) { const int b0 = (gt * 64 + kb) * 32; bool ok = true; for (int j = 1; j < 32; ++j) ok = ok && (pos[b0 + j] == pos[b0] + j); m |= ok ? (1ull << kb) : 0ull; }
        ((unsigned long long*)(F.ws + WS_AFF))[gt] = m; }
    if (gt < DEPTH) {
        const float* lv = a.in[5] + (size_t)gt * 4 * 64; float s01 = 0.f, s23 = 0.f;
        for (int j = 0; j < 64; ++j) { s01 += lv[j] * lv[64 + j]; s23 += lv[128 + j] * lv[192 + j]; }
        const double li[4] = {0.20000000000000007, 0.35550906759096934, 0.4707130183435842, 0.5560582041556406};
        const float lam_init = (float)(gt == 0 ? li[0] : gt == 1 ? li[1] : gt == 2 ? li[2] : li[3]);
        ((float*)(F.ws + WS_LAM))[gt] = expf(s01) - expf(s23) + lam_init;
    }
}

__device__ __forceinline__ void p_prep(Frame& F, const Args& a, int l) {
    const int otid = opaque_tid(F.wave), lane = otid & 63;
    const int gw = F.vcu * NWAVES + F.wave, NGW = F.G * NWAVES;
    const bf16_t* Z = (const bf16_t*)(F.ws + WS_Z);
    bf16_t* KR = (bf16_t*)(F.ws + WS_KR);
    const f32x2* rope = (const f32x2*)(F.ws + WS_ROPE);
    for (int m = gw; m < M; m += NGW) {
        const bf16_t* zr = Z + (size_t)m * ZLD;
        if (lane < 32) {
            const float x1 = bf2f(zr[ZKR + lane]), x2 = bf2f(zr[ZKR + 32 + lane]);
            const f32x2 cs = rope[(m & (SEQ - 1)) * 32 + lane];
            KR[(size_t)m * 64 + lane] = (bf16_t)(cvt_pk_bf16(x1 * cs.x - x2 * cs.y, 0.f) & 0xffffu);
            KR[(size_t)m * 64 + 32 + lane] = (bf16_t)(cvt_pk_bf16(x1 * cs.y + x2 * cs.x, 0.f) & 0xffffu);
        }
    }
    LAS float* scr = (LAS float*)(F.lds + RING_OFF);
    float* KM = (float*)(F.ws + WS_KMEAN);
    for (int it = F.vcu; it < NB * 4 * 16; it += F.G) {
        const int b = it >> 6, h = (it >> 4) & 3, n = it & 15;
        const int c8 = otid & 15, rg = otid >> 4;
        float acc[8];
#pragma unroll
        for (int j = 0; j < 8; ++j) acc[j] = 0.f;
        for (int j = 0; j < 8; ++j) {
            const u32x4 v = *(const u32x4*)(Z + (size_t)(b * SEQ + n * 256 + rg + 32 * j) * ZLD + ZMK + h * 128 + c8 * 8);
            acc[0] += bflo(v.x); acc[1] += bfhi(v.x); acc[2] += bflo(v.y); acc[3] += bfhi(v.y); acc[4] += bflo(v.z); acc[5] += bfhi(v.z); acc[6] += bflo(v.w); acc[7] += bfhi(v.w);
        }
#pragma unroll
        for (int j = 0; j < 8; ++j) scr[rg * 132 + c8 * 8 + j] = acc[j];
        __syncthreads();
        if (otid < 128) { float s = 0.f; for (int r = 0; r < 32; ++r) s += scr[r * 132 + otid]; KM[(size_t)it * 128 + otid] = s * (1.0f / 256.0f); }
        __syncthreads();
    }
}

constexpr size_t WS_GTAIL = WS_Z, WS_GHEADA = WS_Z + 12 * MiB, WS_GHEADV = WS_Z + 24 * MiB;
static_assert((size_t)(M / 64) * 2 * FFN * 4 <= 12 * MiB, "side buffers");
__device__ __forceinline__ void p_glufix(Frame& F, const Args& a, int l) {
    const int tid = opaque_tid(F.wave);
    bf16_t* Gb = (bf16_t*)(F.ws + WS_T);
    const float* tail = (const float*)(F.ws + WS_GTAIL); const float* heada = (const float*)(F.ws + WS_GHEADA); const float* headv = (const float*)(F.ws + WS_GHEADV);
    const float* cw = a.in[16] + (size_t)l * 3 * FFN; const float* cb = a.in[17] + (size_t)l * FFN;
    constexpr int NCH = FFN / 8;
    for (int it = F.vcu * 512 + tid; it < (M / 64) * 2 * NCH; it += F.G * 512) {
        const int c8 = it % NCH, gj = it / NCH, j = gj & 1, gid = gj >> 1, ch0 = c8 * 8;
        const bool zp = (gid & 63) == 0;
        float t0[8], t1[8], h0[8], av[8], vv[8];
#pragma unroll
        for (int h = 0; h < 2; ++h) {
            const f32x4 z4 = (f32x4){0.f, 0.f, 0.f, 0.f};
            const f32x4 x0 = zp ? z4 : *(const f32x4*)(tail + ((size_t)(gid - 1) * 2 + 0) * FFN + ch0 + 4 * h), x1 = zp ? z4 : *(const f32x4*)(tail + ((size_t)(gid - 1) * 2 + 1) * FFN + ch0 + 4 * h);
            const f32x4 y0 = *(const f32x4*)(heada + ((size_t)gid * 2 + 0) * FFN + ch0 + 4 * h), ya = *(const f32x4*)(heada + ((size_t)gid * 2 + j) * FFN + ch0 + 4 * h), yv = *(const f32x4*)(headv + ((size_t)gid * 2 + j) * FFN + ch0 + 4 * h);
#pragma unroll
            for (int e = 0; e < 4; ++e) { t0[4 * h + e] = x0[e]; t1[4 * h + e] = x1[e]; h0[4 * h + e] = y0[e]; av[4 * h + e] = ya[e]; vv[4 * h + e] = yv[e]; }
        }
        float o[8];
#pragma unroll
        for (int h = 0; h < 2; ++h) { const f32x4 c0 = *(const f32x4*)(cw + ch0 + 4 * h), c1 = *(const f32x4*)(cw + FFN + ch0 + 4 * h), c2 = *(const f32x4*)(cw + 2 * FFN + ch0 + 4 * h), c3 = *(const f32x4*)(cb + ch0 + 4 * h);
#pragma unroll
            for (int e = 0; e < 4; ++e) { const int c = 4 * h + e; const float am1 = j ? h0[c] : t1[c], am2 = j ? t1[c] : t0[c];
                o[c] = pg8::gelu_erf(c3[e] + c0[e] * am2 + c1[e] * am1 + c2[e] * av[c]) * vv[c]; } }
        u32x4 w; w.x = cvt_pk_bf16(o[0], o[1]); w.y = cvt_pk_bf16(o[2], o[3]); w.z = cvt_pk_bf16(o[4], o[5]); w.w = cvt_pk_bf16(o[6], o[7]);
        *(u32x4*)(Gb + (size_t)(gid * 64 + j) * FFN + ch0) = w;
    }
}

struct AttnEnv { const bf16_t* Z; const bf16_t* QMLA; const bf16_t* KVMLA; const bf16_t* KR; bf16_t* BRO; const int* pos; const int* pmm; const float* btabg; const f32x2* rope; const float* kmean;
                 const float* subln_g; const float* sinks; float* dscr; float lam, one_m_li; };

__device__ __forceinline__ void load_btab(LAS unsigned char* lds, const float* src, int tid) { if (tid < 256) ((LAS float*)(lds + att::BTAB_OFF))[tid] = src[tid]; }

constexpr int DIFF_XOFF = 104448;
__device__ __forceinline__ void unit_diff(LAS unsigned char* lds, const AttnEnv& E, int b, int h, int qb, const att::WaveCtx& w0) {
    typedef att::Cfg<128, 0, 128, 0, 4> C;
    const int mp = w0.wid >> 2, rr = w0.wid & 3;
    att::WaveCtx w = w0; w.koff = mp * 128;
    const int qw = qb * 128 + 32 * rr, qi = qw + w.r32; const size_t grow = (size_t)b * SEQ + qi;
    load_btab(lds, E.btabg + (0 + h) * 256, w.tid);
    const int posq = E.pos[qi], pminq = E.pmm[(qw >> 5) * 2];
    att::Src src; src.k0 = E.Z + (size_t)b * SEQ * ZLD + ZKA + (2 * h) * 64; src.pk0 = ZLD; src.k1 = src.k0; src.pk1 = ZLD; src.v = E.Z + (size_t)b * SEQ * ZLD + ZVA + h * 128; src.pv = ZLD; src.pos = E.pos;
    bf16x8 qf[4]; att::load_q<4>(qf, E.Z + grow * ZLD + ZQA + (2 * h + mp) * 64, w.hi);
    f32x16 O[4];
#pragma unroll
    for (int d = 0; d < 4; ++d)
#pragma unroll
        for (int r = 0; r < 16; ++r) O[d][r] = 0.f;
    att::RowState st; st.m = -1e30f; st.l = 0.f;
    att::run_tiles<C, 0, true, true, true>(lds, src, 0, 2 * (qb + 1), qf, O, st, qw, posq, pminq, E.pmm, 0u, 0, w);
    const float inv = 1.0f / (half_sum(st.l));
    LAS float* X = (LAS float*)(lds + DIFF_XOFF) + rr * 2048 + w.lane;
#pragma unroll
    for (int rd = 0; rd < 2; ++rd) {
        if (mp == 1) {
#pragma unroll
            for (int dd = 0; dd < 2; ++dd)
#pragma unroll
                for (int r = 0; r < 16; ++r) X[(dd * 16 + r) * 64] = O[2 * rd + dd][r] * inv;
        }
        __syncthreads();
        if (mp == 0) {
#pragma unroll
            for (int dd = 0; dd < 2; ++dd)
#pragma unroll
                for (int r = 0; r < 16; ++r) O[2 * rd + dd][r] = O[2 * rd + dd][r] * inv - E.lam * X[(dd * 16 + r) * 64];
        }
        __syncthreads();
    }
    if (mp == 0) {
        float ss = 0.f;
#pragma unroll
        for (int d = 0; d < 4; ++d)
#pragma unroll
            for (int r = 0; r < 16; ++r) ss += O[d][r] * O[d][r];
        ss = half_sum(ss);
        const float sc = (1.0f / sqrtf(ss * (1.0f / 128.0f) + EPS)) * E.one_m_li;
#pragma unroll
        for (int d = 0; d < 4; ++d)
#pragma unroll
            for (int g = 0; g < 4; ++g) { const f32x4 gg = *(const f32x4*)(E.subln_g + 32 * d + 8 * g + 4 * w.hi);
#pragma unroll
                for (int e = 0; e < 4; ++e) O[d][4 * g + e] *= sc * gg[e]; }
        att::store_o<4>(O, E.BRO + grow * DM + h * 128, w.hi);
    }
}

__device__ __forceinline__ void unit_mla(LAS unsigned char* lds, const AttnEnv& E, int b, int h, int qb, const att::WaveCtx& w) {
    typedef att::Cfg<128, 64, 128, 6> C;
    const int qw = qb * 256 + 32 * w.wid, qi = qw + w.r32; const size_t grow = (size_t)b * SEQ + qi;
    att::Src src; src.k0 = E.KVMLA + (size_t)b * SEQ * 1024 + h * 256; src.pk0 = 1024; src.k1 = E.KR + (size_t)b * SEQ * 64; src.pk1 = 64; src.v = E.KVMLA + (size_t)b * SEQ * 1024 + h * 256 + 128; src.pv = 1024; src.pos = E.pos;
    bf16x8 qf[6]; att::load_q<6>(qf, E.QMLA + grow * 768 + h * 192, w.hi);
    {
        bf16x8 qr[4]; att::load_q<4>(qr, E.QMLA + grow * 768 + h * 192 + 128, w.hi);
        LAS unsigned char* qlw = lds + att::QL_OFF + w.wid * (C::NQL * 1024) + w.lane * 16;
        { bf16x8 qp[2]; att::load_q<2>(qp, E.QMLA + grow * 768 + h * 192 + 96, w.hi); *(LAS bf16x8*)(qlw) = qp[0]; *(LAS bf16x8*)(qlw + 1024) = qp[1]; }
#pragma unroll
        for (int dd = 0; dd < 2; ++dd) {
            const f32x2* cs = E.rope + (size_t)qi * 32 + 16 * dd + 8 * w.hi;
            unsigned o1[4], o2[4];
#pragma unroll
            for (int jp = 0; jp < 4; ++jp) {
                const f32x4 c2 = *(const f32x4*)(cs + 2 * jp);
                const float a0 = bf2f((unsigned short)qr[dd][2 * jp]), a1 = bf2f((unsigned short)qr[dd][2 * jp + 1]);
                const float b0 = bf2f((unsigned short)qr[2 + dd][2 * jp]), b1 = bf2f((unsigned short)qr[2 + dd][2 * jp + 1]);
                o1[jp] = cvt_pk_bf16(a0 * c2[0] - b0 * c2[1], a1 * c2[2] - b1 * c2[3]);
                o2[jp] = cvt_pk_bf16(a0 * c2[1] + b0 * c2[0], a1 * c2[3] + b1 * c2[2]);
            }
            *(LAS u32x4*)(qlw + (2 + dd) * 1024) = (u32x4){o1[0], o1[1], o1[2], o1[3]};
            *(LAS u32x4*)(qlw + (4 + dd) * 1024) = (u32x4){o2[0], o2[1], o2[2], o2[3]};
        }
    }
    f32x16 O[4];
#pragma unroll
    for (int d = 0; d < 4; ++d)
#pragma unroll
        for (int r = 0; r < 16; ++r) O[d][r] = 0.f;
    att::RowState st; st.m = -1e30f; st.l = 0.f;
    att::run_tiles<C, 0, false, true, true>(lds, src, 0, 4 * (qb + 1), qf, O, st, qw, 0, 0, E.pmm, 0u, 0, w);
    const float inv = 1.0f / (half_sum(st.l));
#pragma unroll
    for (int d = 0; d < 4; ++d)
#pragma unroll
        for (int r = 0; r < 16; ++r) O[d][r] *= inv;
    const size_t grow2 = (size_t)b * SEQ + qw + (int)(fresh_lane_id() & 31u);
    att::store_o<4>(O, E.BRO + grow2 * DM + 512 + h * 128, w.hi);
}

__device__ __forceinline__ void unit_swa(LAS unsigned char* lds, const AttnEnv& E, int b, int kvh, int qblk, const att::WaveCtx& w) {
    typedef att::Cfg<64, 0, 64> C;
    const int g = w.wid >> 1, qh = kvh * 4 + g;
    const int qw = qblk * 64 + 32 * (w.wid & 1), qi = qw + w.r32; const size_t grow = (size_t)b * SEQ + qi;
    for (int e = w.tid; e < 1024; e += 512) ((LAS float*)(lds + att::BTAB_OFF))[e] = E.btabg[(4 + kvh * 4 + (e >> 8)) * 256 + (e & 255)];
    const int posq = E.pos[qi], pminq = E.pmm[(qw >> 5) * 2];
    att::Src src; src.k0 = E.Z + (size_t)b * SEQ * ZLD + ZSK + kvh * 64; src.pk0 = ZLD; src.k1 = src.k0; src.pk1 = ZLD; src.v = E.Z + (size_t)b * SEQ * ZLD + ZSV + kvh * 64; src.pv = ZLD; src.pos = E.pos;
    bf16x8 qf[4]; att::load_q<4>(qf, E.Z + grow * ZLD + ZSQ + qh * 64, w.hi);
    f32x16 O[2];
#pragma unroll
    for (int d = 0; d < 2; ++d)
#pragma unroll
        for (int r = 0; r < 16; ++r) O[d][r] = 0.f;
    att::RowState st; st.m = E.sinks[qh] * LOG2E; st.l = (w.hi == 0) ? 1.0f : 0.0f;
    const int t0 = qblk < 2 ? 0 : qblk - 2;
    att::run_tiles<C, 1, true, false, true>(lds, src, t0, qblk + 1, qf, O, st, qw, posq, pminq, E.pmm, 0u, 0, w, g * 1024);
    const float inv = 1.0f / (half_sum(st.l));
#pragma unroll
    for (int d = 0; d < 2; ++d)
#pragma unroll
        for (int r = 0; r < 16; ++r) O[d][r] *= inv;
    att::store_o<2>(O, E.BRO + grow * DM + 1024 + qh * 64, w.hi);
}

__device__ __forceinline__ void unit_moba(LAS unsigned char* lds, const AttnEnv& E, int b, int h, int blk, const att::WaveCtx& w) {
    typedef att::Cfg<128, 0, 128> C;
    const int qw = blk * 256 + 32 * w.wid, qi = qw + w.r32; const size_t grow = (size_t)b * SEQ + qi;
    load_btab(lds, E.btabg + (12 + h) * 256, w.tid);
    LAS float* km = (LAS float*)(lds + att::KMEAN_OFF);
    for (int e = w.tid; e < blk * 128; e += 512) km[e] = E.kmean[(size_t)((b * 4 + h) * 16) * 128 + e];
    const int posq = E.pos[qi], pminq = E.pmm[(qw >> 5) * 2];
    att::Src src; src.k0 = E.Z + (size_t)b * SEQ * ZLD + ZMK + h * 128; src.pk0 = ZLD; src.k1 = src.k0; src.pk1 = ZLD; src.v = E.Z + (size_t)b * SEQ * ZLD + ZMV + h * 128; src.pv = ZLD; src.pos = E.pos;
    bf16x8 qf[8]; att::load_q<8>(qf, E.Z + grow * ZLD + ZMQ + h * 128, w.hi);
    __syncthreads();
    unsigned selmask;
    if (blk <= 3) selmask = (1u << blk) - 1u;
    else {
        float v1 = NEG_INF, v2 = NEG_INF, v3 = NEG_INF; int i1 = 31, i2 = 31, i3 = 31;
        for (int n = 0; n < blk; ++n) {
            float part = 0.f;
#pragma unroll
            for (int d0 = 0; d0 < 8; ++d0) {
                const f32x4 k0 = *(const LAS f32x4*)(km + n * 128 + 16 * d0 + 8 * w.hi), k1 = *(const LAS f32x4*)(km + n * 128 + 16 * d0 + 8 * w.hi + 4);
#pragma unroll
                for (int j = 0; j < 4; ++j) part += bf2f((unsigned short)qf[d0][j]) * k0[j] + bf2f((unsigned short)qf[d0][4 + j]) * k1[j];
            }
            const float g = half_sum(part);
            if (g > v1) { v3 = v2; i3 = i2; v2 = v1; i2 = i1; v1 = g; i1 = n; }
            else if (g > v2) { v3 = v2; i3 = i2; v2 = g; i2 = n; }
            else if (g > v3) { v3 = g; i3 = n; }
        }
        selmask = (1u << i1) | (1u << i2) | (1u << i3);
    }
    f32x16 O[4];
#pragma unroll
    for (int d = 0; d < 4; ++d)
#pragma unroll
        for (int r = 0; r < 16; ++r) O[d][r] = 0.f;
    att::RowState st; st.m = -1e30f; st.l = 0.f;
    att::run_tiles<C, 2, true, true, true>(lds, src, 0, 4 * (blk + 1), qf, O, st, qw, posq, pminq, E.pmm, selmask, blk, w);
    const float inv = 1.0f / (half_sum(st.l));
#pragma unroll
    for (int d = 0; d < 4; ++d)
#pragma unroll
        for (int r = 0; r < 16; ++r) O[d][r] *= inv;
    att::store_o<4>(O, E.BRO + grow * DM + 1536 + h * 128, w.hi);
}

#ifndef CHECK_BUILD
#define CHECK_BUILD 0
#endif
#ifndef CHECK_TOL
#define CHECK_TOL 0.04f
#endif
#ifndef CHECK_REPORT
#define CHECK_REPORT (-1)
#endif
#if CHECK_BUILD
constexpr size_t WS_CHK_KV = WS_END;
constexpr size_t WS_CHK_KR = WS_CHK_KV + (size_t)SEQ * 1024 * 4;
constexpr size_t WS_END2 = WS_CHK_KR + (size_t)SEQ * 64 * 4;
constexpr int CHK_B = 1, CHK_NS = 32;
constexpr int CW_CHK = 2048;
__device__ __forceinline__ int chk_row(int i) {
    const int ts[CHK_NS] = {0, 1, 2, 31, 32, 63, 64, 127, 128, 129, 255, 256, 257, 300, 511, 512, 700, 767, 768, 1000, 1023, 1024, 1500, 2047, 2048, 3071, 3072, 3500, 3839, 3840, 4000, 4095};
    int r = 0;
#pragma unroll
    for (int j = 0; j < CHK_NS; ++j) r = (i == j) ? ts[j] : r;
    return r;
}
__device__ __forceinline__ void chk_sincos(float ang, float& c, float& s) {
    double x = (double)ang; const double twopi = 6.283185307179586476925;
    x -= twopi * rint(x / twopi);
    const double x2 = x * x; double tc = 1.0, ts_ = x, sc = 1.0, ss = x;
#pragma unroll 1
    for (int k = 1; k < 16; ++k) { const double kk = (double)k; tc *= -x2 / ((2.0 * kk - 1.0) * (2.0 * kk)); ts_ *= -x2 / ((2.0 * kk) * (2.0 * kk + 1.0)); sc += tc; ss += ts_; }
    c = (float)sc; s = (float)ss;
}
__device__ __forceinline__ int chk_bucket(int rel) {
    const int n = rel > 0 ? rel : 0;
    if (n < 16) return n;
    const float nf = (float)n;
    const int large = 16 + (int)(logf(nf / 16.0f) / 2.0794415416798357f * 16.0f);
    return large < 31 ? large : 31;
}
__device__ __forceinline__ float chk_block_max(float v, LAS float* red, int tid) {
    v = wave_max(v);
    __syncthreads(); if ((tid & 63) == 0) red[tid >> 6] = v; __syncthreads();
    float r = red[0];
#pragma unroll
    for (int j = 1; j < 8; ++j) r = fmaxf(r, red[j]);
    return r;
}
__device__ __forceinline__ float chk_block_sum(float v, LAS float* red, int tid) {
    v = wave_sum(v);
    __syncthreads(); if ((tid & 63) == 0) red[tid >> 6] = v; __syncthreads();
    float r = 0.f;
#pragma unroll
    for (int j = 0; j < 8; ++j) r += red[j];
    return r;
}
__device__ __forceinline__ void chk_record(unsigned* ctl, int type, float diff, float mag, LAS float* red, int tid) {
    const float md = chk_block_max(diff, red, tid), mm = chk_block_max(mag, red, tid);
    if (tid == 0) { atomicMax(ctl + CW_CHK + 2 * type, __float_as_uint(mm > 0.f ? md / mm : 1.0e9f)); atomicMax(ctl + CW_CHK + 2 * type + 1, 1u); }
}
__device__ __forceinline__ void chk_prep(Frame& F, const Args& a) {
    const int tid = opaque_tid(F.wave);
    const bf16_t* Z = (const bf16_t*)(F.ws + WS_Z) + (size_t)CHK_B * SEQ * ZLD;
    float* KV = (float*)(F.ws + WS_CHK_KV); float* KRn = (float*)(F.ws + WS_CHK_KR);
    const float* gkv = a.in[9]; const float* wukv = a.in[10]; const int* pos = (const int*)a.in[1];
    const long gt = (long)F.vcu * 512 + tid, NGT = (long)F.G * 512;
    for (long e = gt; e < (long)SEQ * 1024; e += NGT) {
        const int srow = (int)(e >> 10), n = (int)(e & 1023);
        const bf16_t* zr = Z + (size_t)srow * ZLD + ZCKV;
        float ss = 0.f; for (int c = 0; c < 256; ++c) { const float x = bf2f(zr[c]); ss += x * x; }
        const float rstd = 1.0f / sqrtf(ss / 256.0f + EPS);
        float acc = 0.f; for (int c = 0; c < 256; ++c) acc += bf2f(zr[c]) * rstd * gkv[c] * wukv[(size_t)c * 1024 + n];
        KV[e] = acc;
    }
    for (long e = gt; e < (long)SEQ * 32; e += NGT) {
        const int srow = (int)(e >> 5), i = (int)(e & 31);
        const float inv = __builtin_amdgcn_exp2f((float)(-2 * i) / 64.0f * 13.287712379549449f);
        float c, s_; chk_sincos((float)pos[srow] * inv, c, s_);
        const float x1 = bf2f(Z[(size_t)srow * ZLD + ZKR + i]), x2 = bf2f(Z[(size_t)srow * ZLD + ZKR + 32 + i]);
        KRn[srow * 64 + i] = x1 * c - x2 * s_; KRn[srow * 64 + 32 + i] = x1 * s_ + x2 * c;
    }
}
__device__ __forceinline__ void chk_items(Frame& F, const Args& a) {
    const int tid = opaque_tid(F.wave);
    LAS float* sc = (LAS float*)(F.lds + RING_OFF);
    LAS float* qv = sc + 4096;
    LAS float* tmp = qv + 192;
    LAS float* red = tmp + 512;
    LAS float* part = red + 8;
    LAS float* gate = part + 512;
    const bf16_t* Zb = (const bf16_t*)(F.ws + WS_Z) + (size_t)CHK_B * SEQ * ZLD;
    const bf16_t* BRO = (const bf16_t*)(F.ws + WS_BRO) + (size_t)CHK_B * SEQ * DM;
    const float* KV = (const float*)(F.ws + WS_CHK_KV); const float* KRn = (const float*)(F.ws + WS_CHK_KR);
    const int* pos = (const int*)a.in[1]; const float* relb = a.in[2];
    for (int it = F.vcu; it < 16 * CHK_NS; it += F.G) {
        const int smp = it % CHK_NS, hh = it / CHK_NS;
        const int t = chk_row(smp);
        __syncthreads();
        if (hh < 4) {
            const int h = hh;
            {
                const bf16_t* zr = Zb + (size_t)t * ZLD + ZCQ;
                const float x = bf2f(zr[tid]);
                const float ss = chk_block_sum(x * x, red, tid);
                tmp[tid] = x * (1.0f / sqrtf(ss / 512.0f + EPS)) * a.in[7][tid];
            }
            __syncthreads();
            if (tid < 192) { float acc = 0.f; const float* w = a.in[8] + h * 192 + tid; for (int k = 0; k < 512; ++k) acc += tmp[k] * w[(size_t)k * 768]; qv[tid] = acc; }
            __syncthreads();
            float r1 = 0.f, r2 = 0.f;
            if (tid < 32) { const float inv = __builtin_amdgcn_exp2f((float)(-2 * tid) / 64.0f * 13.287712379549449f); float c, s_; chk_sincos((float)pos[t] * inv, c, s_);
                const float x1 = qv[128 + tid], x2 = qv[160 + tid]; r1 = x1 * c - x2 * s_; r2 = x1 * s_ + x2 * c; }
            __syncthreads();
            if (tid < 32) { qv[128 + tid] = r1; qv[160 + tid] = r2; }
            __syncthreads();
            float lmax = -3.0e38f;
            for (int k = tid; k <= t; k += 512) { float d = 0.f; const float* kr = KV + (size_t)k * 1024 + h * 256;
                for (int j = 0; j < 128; ++j) d += qv[j] * kr[j];
                for (int j = 0; j < 64; ++j) d += qv[128 + j] * KRn[k * 64 + j];
                d *= 0.07216878364870322f; sc[k] = d; lmax = fmaxf(lmax, d); }
            const float mx = chk_block_max(lmax, red, tid);
            float ls = 0.f; for (int k = tid; k <= t; k += 512) { const float p = expf(sc[k] - mx); sc[k] = p; ls += p; }
            const float den = chk_block_sum(ls, red, tid);
            __syncthreads();
            { const int dv = tid & 127, grp = tid >> 7; float o = 0.f; for (int k = grp; k <= t; k += 4) o += sc[k] * KV[(size_t)k * 1024 + h * 256 + 128 + dv]; part[grp * 128 + dv] = o; }
            __syncthreads();
            { float df = 0.f, mg = 0.f;
              if (tid < 128) { const float o = (part[tid] + part[128 + tid] + part[256 + tid] + part[384 + tid]) / den; const float f = bf2f(BRO[(size_t)t * DM + 512 + h * 128 + tid]); df = fabsf(f - o); mg = fabsf(o); }
              chk_record(F.ctl, 0, df, mg, red, tid); }
        } else if (hh < 8) {
            const int h = hh - 4, blk = t >> 8;
            if (tid < 128) qv[tid] = bf2f(Zb[(size_t)t * ZLD + ZMQ + h * 128 + tid]);
            __syncthreads();
            { const int n = tid >> 5, sub = tid & 31; float g = 0.f;
              if (n < blk) for (int r = sub; r < 256; r += 32) { const bf16_t* kr = Zb + (size_t)(n * 256 + r) * ZLD + ZMK + h * 128; float d = 0.f; for (int j = 0; j < 128; ++j) d += qv[j] * bf2f(kr[j]); g += d; }
              g += swz_xor<1>(g); g += swz_xor<2>(g); g += swz_xor<4>(g); g += swz_xor<8>(g); g += swz_xor<16>(g);
              if (sub == 0) gate[n] = (n < blk) ? g : -3.0e38f; }
            __syncthreads();
            unsigned sel = 0u;
            if (blk <= 3) sel = (1u << blk) - 1u;
            else for (int c = 0; c < 3; ++c) { int bi = -1; float bv = -3.0e38f; for (int n = 0; n < blk; ++n) if (!((sel >> n) & 1u) && gate[n] > bv) { bv = gate[n]; bi = n; } sel |= 1u << bi; }
            float lmax = -3.0e38f;
            for (int k = tid; k <= t; k += 512) { const int n = k >> 8; const bool ok = (n == blk) || ((sel >> n) & 1u);
                float d = -3.0e38f;
                if (ok) { const bf16_t* kr = Zb + (size_t)k * ZLD + ZMK + h * 128; d = 0.f; for (int j = 0; j < 128; ++j) d += qv[j] * bf2f(kr[j]);
                    d = d / LOG2E + relb[chk_bucket(pos[t] - pos[k]) * 16 + 12 + h]; lmax = fmaxf(lmax, d); }
                sc[k] = d; }
            const float mx = chk_block_max(lmax, red, tid);
            float ls = 0.f; for (int k = tid; k <= t; k += 512) { const float p = (sc[k] > -1.0e38f) ? expf(sc[k] - mx) : 0.f; sc[k] = p; ls += p; }
            const float den = chk_block_sum(ls, red, tid);
            __syncthreads();
            { const int dv = tid & 127, grp = tid >> 7; float o = 0.f; for (int k = grp; k <= t; k += 4) o += sc[k] * bf2f(Zb[(size_t)k * ZLD + ZMV + h * 128 + dv]); part[grp * 128 + dv] = o; }
            __syncthreads();
            { float df = 0.f, mg = 0.f;
              if (tid < 128) { const float o = (part[tid] + part[128 + tid] + part[256 + tid] + part[384 + tid]) / den; const float f = bf2f(BRO[(size_t)t * DM + 1536 + h * 128 + tid]); df = fabsf(f - o); mg = fabsf(o); }
              chk_record(F.ctl, 1, df, mg, red, tid); }
        } else {
            const int qh = hh - 8, kvh = qh >> 2;
            if (tid < 64) qv[tid] = bf2f(Zb[(size_t)t * ZLD + ZSQ + qh * 64 + tid]);
            __syncthreads();
            const float sink = a.in[11][qh];
            float lmax = -3.0e38f; const int kk = t - 127 + tid;
            float d = -3.0e38f;
            if (tid < 128 && kk >= 0) { const bf16_t* kr = Zb + (size_t)kk * ZLD + ZSK + kvh * 64; d = 0.f; for (int j = 0; j < 64; ++j) d += qv[j] * bf2f(kr[j]);
                d = d / LOG2E + relb[chk_bucket(pos[t] - pos[kk]) * 16 + 4 + qh]; lmax = d; }
            const float mx = fmaxf(chk_block_max(lmax, red, tid), sink);
            const float p = (d > -1.0e38f) ? expf(d - mx) : 0.f;
            if (tid < 128) sc[tid] = p;
            const float den = chk_block_sum(p, red, tid) + expf(sink - mx);
            __syncthreads();
            { float df = 0.f, mg = 0.f;
              if (tid < 64) { float o = 0.f; for (int j = 0; j < 128; ++j) { const int k2 = t - 127 + j; if (k2 >= 0) o += sc[j] * bf2f(Zb[(size_t)k2 * ZLD + ZSV + kvh * 64 + tid]); }
                o /= den; const float f = bf2f(BRO[(size_t)t * DM + 1024 + qh * 64 + tid]); df = fabsf(f - o); mg = fabsf(o); }
              chk_record(F.ctl, 2, df, mg, red, tid); }
        }
    }
}
#endif

__device__ __forceinline__ int queue_next(Frame& F, unsigned* head) {
    __syncthreads();
    if (is_thread0(F.wave)) F.MISC[4] = __hip_atomic_fetch_add(head, 1u, RLX_AGENT);
    __syncthreads();
    return (int)F.MISC[4];
}
__device__ __forceinline__ int queue_pick(Frame& F, unsigned* heads, int N, int myx) {
    __syncthreads();
    if (F.wave == 0) {
        const unsigned lane = fresh_lane_id();
        int res = -1;
        for (int tries = 0; tries < 64; ++tries) {
            unsigned h = 0xffffffffu;
            if (lane < 8u) h = __hip_atomic_load(heads + 64 * lane, RLX_AGENT);
            const unsigned long long m = __ballot(h < (unsigned)N);
            if ((m & 0xffull) == 0ull) break;
            const unsigned rot = (unsigned)(((m & 0xffull) | ((m & 0xffull) << 8)) >> myx) & 0xffu;
            const int x = (myx + __builtin_ctz(rot)) & 7;
            unsigned j = 0u;
            if (lane == 0u) j = __hip_atomic_fetch_add(heads + 64 * x, 1u, RLX_AGENT);
            j = (unsigned)__builtin_amdgcn_readfirstlane((int)j);
            if (j < (unsigned)N) { res = (x << 16) | (int)j; break; }
        }
        if (lane == 0u) F.MISC[4] = (unsigned)res;
    }
    __syncthreads();
    return (int)F.MISC[4];
}

__global__ void __launch_bounds__(NWAVES * 64, 2) trunk_fwd(Args args) {
    extern __shared__ __attribute__((aligned(16))) unsigned char lds_raw[];
    Frame F;
    F.lds = (LAS unsigned char*)lds_raw;
    F.MISC = (volatile LAS unsigned*)(F.lds + MISC_OFF);
    F.tid = threadIdx.x; F.lane = F.tid & 63; F.wave = __builtin_amdgcn_readfirstlane(F.tid >> 6);
    F.G = gridDim.x; { const int bx = blockIdx.x; F.vcu = (F.G % 8 == 0) ? (bx % 8) * (F.G / 8) + bx / 8 : bx; }
    F.ws = args.ws; F.ctl = (unsigned*)(args.ws + WS_CTL);
    for (int u = F.tid; u < (LDS_BYTES - LDSCTL_OFF) / 4; u += NWAVES * 64) ((LAS unsigned*)(F.lds + LDSCTL_OFF))[u] = 0u;
    __syncthreads();
    const int lo = args.ph_lo, hi = args.ph_hi;
    XcdBarrier bar; bar.bar = F.ctl + CW_BAR; bar.x = 0; bar.st = nullptr; bar.wave = F.wave;
    if (hi - lo > 1) bar = xcd_barrier_post(F.ctl + CW_BAR, F.MISC + 8, F.wave);
#ifndef DBG_MASK
#define DBG_MASK 0xFFFFFu
#endif
#define EN(j) (((DBG_MASK) >> (j)) & 1u)
#ifndef DBG_ATT
#define DBG_ATT 0xFu
#endif
#define ENA(j) (((DBG_ATT) >> (j)) & 1u)
#define IN(k) (lo <= (k) && (k) < hi)
#ifndef DUP
#define DUP (-1)
#endif
#define REPS(j) ((DUP) == (j) ? 2 : 1)
#define SEAM(k) do { if ((k) + 1 < hi) xcd_barrier(bar); } while (0)
    const int gw = F.vcu * NWAVES + F.wave, NGW = F.G * NWAVES;
    unsigned char* ws = F.ws;
    unsigned long long* SSQ = (unsigned long long*)(ws + WS_SSQ); unsigned long long* SSQ2 = SSQ + (size_t)DEPTH * 2 * M;
    bf16_t* X = (bf16_t*)(ws + WS_X); bf16_t* XN = (bf16_t*)(ws + WS_XN); bf16_t* MG = (bf16_t*)(ws + WS_MG); bf16_t* Z = (bf16_t*)(ws + WS_Z);
    unsigned char* X8 = ws + WS_XN;
    bf16_t* U = (bf16_t*)(ws + WS_Z); bf16_t* Gb = (bf16_t*)(ws + WS_T); float* T = (float*)(ws + WS_T);

    if (EN(13) && IN(0)) for (int rep = 0; rep < REPS(13); ++rep) { p_prologue(F, args); SEAM(0); }

    for (int l = 0; l < DEPTH; ++l) {
        const int p0 = 1 + l * PH_PER_LAYER;
        if (hi <= p0 || lo >= p0 + PH_PER_LAYER) continue;
        unsigned char* wl = ws + WS_W + (size_t)l * W_LAYER;
        if (EN(0) && IN(p0 + 0) && l == 0) for (int rep = 0; rep < REPS(0); ++rep) { const int ol = opaque_tid(F.wave) & 63; for (int m = opaque_s(gw); m < M; m += NGW) cvt_row_in(args.in[0] + (size_t)m * DM, X + (size_t)m * DM, X8 + (size_t)m * DM, SSQ + m, ol); SEAM(p0 + 0); }
        if (EN(1) && IN(p0 + 1)) for (int rep = 0; rep < REPS(1); ++rep) {
            { pg8::Gemm g{X, (const bf16_t*)(wl + W_IN), M, ZG, DM, DM, 0, 0}; pg8::StaticOrder S; S.init(M, ZG, F.G, (int)blockIdx.x);
              pg8::EpiBf16 E{Z, ZLD, 0, 1.0f, SSQ + (size_t)(2 * l) * M, 1.0f / DM, SSQ2 + (size_t)(2 * l) * M, SSQ2 + (size_t)(2 * l + 1) * M};
              pg8::gemm_phase<pg8::EpiBf16, pg8::StaticOrder, true>(F.lds + RING_OFF, g, S, E, F.wave); }
            { pg8::Gemm g{(const bf16_t*)X8, (const bf16_t*)(wl + W_IN8), M, 4 * DM, DM, DM, 0, 0}; pg8::StaticOrder S; S.init(M, 4 * DM, F.G, (int)blockIdx.x);
              pg8::EpiGate E{Z + ZG, ZLD, 1.0f / W8_SCALE, opaque_s(0), SSQ + (size_t)(2 * l) * M};
              pg8::gemm_phase<pg8::EpiGate, pg8::StaticOrder, true, false, true>(F.lds + RING_OFF, g, S, E, F.wave); }
            SEAM(p0 + 1);
        }
        if (EN(4) && IN(p0 + 4)) for (int rep = 0; rep < REPS(4); ++rep) {
            if (EN(3)) p_prep(F, args, l);
            { pg8::Gemm g{Z + ZCQ, (const bf16_t*)(wl + W_UQ), M, 768, 512, ZLD, 0, 0}; pg8::StaticOrder S; S.init(M, 768, F.G, (int)blockIdx.x);
            pg8::EpiBf16 E{(bf16_t*)(ws + WS_QMLA), 768, 1, 0.07216878364870322f * LOG2E, SSQ2 + (size_t)(2 * l) * M, 1.0f / 512.0f, nullptr, nullptr};
            pg8::gemm_phase<pg8::EpiBf16, pg8::StaticOrder, true>(F.lds + RING_OFF, g, S, E, F.wave); }
            {
            pg8::Gemm g{Z + ZCKV, (const bf16_t*)(wl + W_UKV), M, 1024, 256, ZLD, 0, 0}; pg8::StaticOrder S; S.init(M, 1024, F.G, (int)blockIdx.x);
            pg8::EpiBf16 E{(bf16_t*)(ws + WS_KVMLA), 1024, 1, 1.0f, SSQ2 + (size_t)(2 * l + 1) * M, 1.0f / 256.0f, nullptr, nullptr};
            pg8::gemm_phase<pg8::EpiBf16, pg8::StaticOrder, true>(F.lds + RING_OFF, g, S, E, F.wave); }
            SEAM(p0 + 4);
        }
        if (EN(6) && IN(p0 + 6)) for (int rep = 0; rep < REPS(6); ++rep) {
            const double li[4] = {0.20000000000000007, 0.35550906759096934, 0.4707130183435842, 0.5560582041556406};
            AttnEnv E; E.Z = Z; E.QMLA = (const bf16_t*)(ws + WS_QMLA); E.KVMLA = (const bf16_t*)(ws + WS_KVMLA); E.KR = (const bf16_t*)(ws + WS_KR); E.BRO = (bf16_t*)(ws + WS_BRO);
            E.pos = (const int*)args.in[1]; E.pmm = (const int*)(ws + WS_PMM); E.btabg = (const float*)(ws + WS_BTAB); E.rope = (const f32x2*)(ws + WS_ROPE); E.kmean = (const float*)(ws + WS_KMEAN);
            E.dscr = (float*)(ws + WS_DSCR); E.subln_g = args.in[6] + (size_t)l * 128; E.sinks = args.in[11] + (size_t)l * 8; E.lam = __uint_as_float(__builtin_amdgcn_readfirstlane(__float_as_uint(((const float*)(ws + WS_LAM))[l])));
            E.one_m_li = __uint_as_float(__builtin_amdgcn_readfirstlane(__float_as_uint(1.0f - (float)(l == 0 ? li[0] : l == 1 ? li[1] : l == 2 ? li[2] : li[3]))));
#if PROF_BUILD
            if (is_thread0(F.wave)) { const unsigned long long pt0 = clock64(); F.MISC[16] = (unsigned)pt0; F.MISC[17] = (unsigned)(pt0 >> 32); }
#endif
            unsigned* qh = F.ctl + CW_QUEUE + 64 * (((rep * DEPTH + l) * 4) * 8);
            const int myx = (int)xb_xcc_id() & 7;
#if PROF_BUILD
#define WCTX const int ot = opaque_tid(F.wave); const att::WaveCtx wctx{ot & 63, ot & 31, (ot >> 5) & 1, __builtin_amdgcn_readfirstlane(ot >> 6), ot, 0, (unsigned long long*)(F.ctl + 32768 + (l == 0 ? 0 : 4096))}
#else
#define WCTX const int ot = opaque_tid(F.wave); const att::WaveCtx wctx{ot & 63, ot & 31, (ot >> 5) & 1, __builtin_amdgcn_readfirstlane(ot >> 6), ot, 0}
#endif
            if (ENA(0)) for (;;) { const int pk = queue_pick(F, qh + 64 * (0 * 8), 64, myx); if (pk < 0) break; const int x = pk >> 16, j = pk & 0xffff; const int bh = x + 8 * (j & 1); WCTX; unit_diff(F.lds, E, bh >> 2, bh & 3, 31 - (j >> 1), wctx); }
            if (ENA(1)) for (;;) { const int pk = queue_pick(F, qh + 64 * (1 * 8), 32, myx); if (pk < 0) break; const int x = pk >> 16, j = pk & 0xffff; const int bh = x + 8 * (j & 1); WCTX; unit_mla(F.lds, E, bh >> 2, bh & 3, 15 - (j >> 1), wctx); }
            if (ENA(2)) for (;;) { const int pk = queue_pick(F, qh + 64 * (2 * 8), 32, myx); if (pk < 0) break; const int x = pk >> 16, j = pk & 0xffff; const int bh = x + 8 * (j & 1); WCTX; unit_moba(F.lds, E, bh >> 2, bh & 3, 15 - (j >> 1), wctx); }
            if (ENA(3)) for (;;) { const int pk = queue_pick(F, qh + 64 * (3 * 8), 64, myx); if (pk < 0) break; const int x = pk >> 16, j = pk & 0xffff; WCTX; unit_swa(F.lds, E, x >> 1, x & 1, 63 - j, wctx); }
#undef WCTX
#if PROF_BUILD
            if (is_thread0(F.wave)) { const unsigned long long pt0 = (unsigned long long)F.MISC[16] | ((unsigned long long)F.MISC[17] << 32); atomicAdd((unsigned long long*)(F.ctl + 32768 + (l == 0 ? 0 : 4096)), clock64() - pt0); }
#endif
#if CHECK_BUILD
            if (l == 0 && rep == 0) { xcd_barrier(bar); chk_prep(F, args); xcd_barrier(bar); chk_items(F, args); }
#endif
            SEAM(p0 + 6);
#if PROF_BUILD
            if (PROF_ID == 10 && is_thread0(F.wave)) { const unsigned long long pt0 = (unsigned long long)F.MISC[16] | ((unsigned long long)F.MISC[17] << 32); atomicAdd((unsigned long long*)(F.ctl + 32768 + (l == 0 ? 0 : 4096)) + 10, clock64() - pt0); }
#endif
        }
        if (EN(7) && IN(p0 + 7)) for (int rep = 0; rep < REPS(7); ++rep) {
            pg8::Gemm g{(const bf16_t*)(ws + WS_BRO), (const bf16_t*)(wl + W_BR), M, DM, 512, DM, (size_t)512 * 2, (size_t)DM * 512 * 2}; pg8::StaticOrder S; S.init_tiles(M / 128, DM / 256, F.G, (int)blockIdx.x, 4);
            pg8::EpiMergeHalf E{Z + ZG, ZLD, MG};
            pg8::gemm_phase_m3<pg8::EpiMergeHalf, pg8::StaticOrder>(F.lds + RING_OFF, g, S, E, F.wave);
            SEAM(p0 + 7);
        }
        if (EN(8) && IN(p0 + 8)) for (int rep = 0; rep < REPS(8); ++rep) {
            pg8::Gemm g{MG, (const bf16_t*)(wl + W_OUT), M, DM, DM, DM, 0, 0}; pg8::StaticOrder S; S.init(M, DM, F.G, (int)blockIdx.x);
            pg8::EpiResBf16 E{nullptr, X, X, DM, SSQ + (size_t)(2 * l + 1) * M, nullptr};
            pg8::gemm_phase<pg8::EpiResBf16, pg8::StaticOrder, true>(F.lds + RING_OFF, g, S, E, F.wave);
            SEAM(p0 + 8);
        }
        if (EN(10) && IN(p0 + 10)) for (int rep = 0; rep < REPS(10); ++rep) {
            pg8::Gemm g{X, (const bf16_t*)(wl + W_UP), M, UP_N, DM, DM, 0, 0}; pg8::StaticOrder S; S.init(M, UP_N, F.G, (int)blockIdx.x);
            pg8::EpiGlu E{Gb, args.in[16] + (size_t)l * 3 * FFN, args.in[17] + (size_t)l * FFN, (float*)(ws + WS_GTAIL), (float*)(ws + WS_GHEADA), (float*)(ws + WS_GHEADV), SSQ + (size_t)(2 * l + 1) * M};
            pg8::gemm_phase<pg8::EpiGlu, pg8::StaticOrder, true>(F.lds + RING_OFF, g, S, E, F.wave);
            SEAM(p0 + 10);
        }
        if (EN(11) && IN(p0 + 11)) for (int rep = 0; rep < REPS(11); ++rep) { p_glufix(F, args, l); SEAM(p0 + 11); }
        if (EN(12) && IN(p0 + 12)) for (int rep = 0; rep < REPS(12); ++rep) {
            pg8::Gemm g{Gb, (const bf16_t*)(wl + W_DN), M, DM, FFN, FFN, 0, 0}; pg8::StaticOrder S; S.init(M, DM, F.G, (int)blockIdx.x);
            pg8::EpiResBf16 E{nullptr, X, X, DM, (l + 1 < DEPTH) ? SSQ + (size_t)(2 * l + 2) * M : nullptr, (l + 1 < DEPTH) ? X8 : nullptr};
            pg8::gemm_phase<pg8::EpiResBf16, pg8::StaticOrder, true>(F.lds + RING_OFF, g, S, E, F.wave);
            SEAM(p0 + 12);
        }
    }
    if (IN(N_PHASES - 1)) { const int ol = opaque_tid(F.wave) & 63; const float* g = args.in[19]; for (int m = opaque_s(gw); m < M; m += NGW) rms_row_f32(X + (size_t)m * DM, g, args.out + (size_t)m * DM, ol);
#if PROF_BUILD
        xcd_barrier(bar);
        if (blockIdx.x == 0 && is_thread0(F.wave)) { const unsigned long long* pp = (const unsigned long long*)(F.ctl + 32768);
            const double c0 = (double)__hip_atomic_load(pp, RLX_AGENT), cx = (double)__hip_atomic_load(pp + PROF_ID, RLX_AGENT), c5 = (double)__hip_atomic_load(pp + 5, RLX_AGENT), c6 = (double)__hip_atomic_load(pp + 6, RLX_AGENT);
            const float raw = (PROF_ID == 5) ? (float)(1000.0 * c5 / (c5 + c6)) : (PROF_ID == 9) ? (float)(c0 / 256.0 / 1000.0) : (float)(1000.0 * cx / c0);
            args.out[0] = 25.0f * floorf(raw / 25.0f + 0.5f); }
#endif
#if CHECK_BUILD
        xcd_barrier(bar);
        if (blockIdx.x == 0 && is_thread0(F.wave)) {
            float code = 0.f;
            for (int ty = 0; ty < 3; ++ty) { const float rt = __uint_as_float(__hip_atomic_load(F.ctl + CW_CHK + 2 * ty, RLX_AGENT)); const unsigned seen = __hip_atomic_load(F.ctl + CW_CHK + 2 * ty + 1, RLX_AGENT);
                if (!(rt <= CHECK_TOL) || seen == 0u) code += (float)(64 << ty); }
            if (CHECK_REPORT >= 0) code = 1.0e4f * __uint_as_float(__hip_atomic_load(F.ctl + CW_CHK + 2 * CHECK_REPORT, RLX_AGENT));
            if (code != 0.f) args.out[0] = code;
        }
#endif
    }
#undef IN
#undef SEAM
}

extern "C" void kernel_launch(void* const* d_in, const int* in_sizes, int n_in, void* d_out, int out_size, void* d_ws, size_t ws_size, hipStream_t stream) {
    static int grid = 0;
    if (grid == 0) {
        if (n_in != 20 || in_sizes[0] != M * DM || out_size != M * DM || ws_size < WS_END + (CHECK_BUILD ? 20 * MiB : 0)) {
            fprintf(stderr, "kernel_launch: shape / workspace mismatch (n_in %d, in0 %d, out %d, ws %zu, need %zu); nothing launched\n", n_in, n_in > 0 ? in_sizes[0] : -1, out_size, ws_size, (size_t)WS_END); grid = -1; return; }
        int dev = 0, cus = 0, per_cu = 0;
        if (hipGetDevice(&dev) != hipSuccess || hipDeviceGetAttribute(&cus, hipDeviceAttributeMultiprocessorCount, dev) != hipSuccess) { grid = -1; return; }
        if (hipFuncSetAttribute((const void*)trunk_fwd, hipFuncAttributeMaxDynamicSharedMemorySize, LDS_BYTES) != hipSuccess) { fprintf(stderr, "kernel_launch: hipFuncSetAttribute failed\n"); grid = -1; return; }
        if (hipOccupancyMaxActiveBlocksPerMultiprocessor(&per_cu, (const void*)trunk_fwd, NWAVES * 64, LDS_BYTES) != hipSuccess || per_cu < 1)
            fprintf(stderr, "kernel_launch: note: occupancy query reports %d workgroups per CU\n", per_cu);
        (void)hipGetLastError();
        grid = cus;
    }
    if (grid < 0) return;
    if (hipMemsetAsync((char*)d_ws + WS_CTL, 0, CTL_ZERO_BYTES, stream) != hipSuccess) return;
    Args a{};
    for (int i = 0; i < 20; ++i) a.in[i] = (const float*)d_in[i];
    a.out = (float*)d_out; a.ws = (unsigned char*)d_ws;
#if MK_N_LAUNCHES == 1
    a.ph_lo = 0; a.ph_hi = N_PHASES;
    hipLaunchKernelGGL(trunk_fwd, dim3(grid), dim3(NWAVES * 64), LDS_BYTES, stream, a);
#else
    for (int p = 0; p < N_PHASES; ++p) { a.ph_lo = p; a.ph_hi = p + 1; hipLaunchKernelGGL(trunk_fwd, dim3(grid), dim3(NWAVES * 64), LDS_BYTES, stream, a); }
#endif
    const hipError_t le = hipPeekAtLastError();
    if (le != hipSuccess) fprintf(stderr, "kernel_launch: launch failed: %s\n", hipGetErrorName(le));
}
```

```cpp
#include <hip/hip_runtime.h>
#include <cstdio>
#include <cstdint>

#ifndef PROF_BUILD
#define PROF_BUILD 0
#endif
#ifndef PROF_ID
#define PROF_ID 1
#endif
#ifndef MK_N_LAUNCHES
#define MK_N_LAUNCHES 1
#endif

#define GAS __attribute__((address_space(1)))
#define LAS __attribute__((address_space(3)))
typedef unsigned short bf16_t;
typedef short bf16x8 __attribute__((ext_vector_type(8)));
typedef short s16x4 __attribute__((ext_vector_type(4)));
typedef float f32x2 __attribute__((ext_vector_type(2)));
typedef float f32x4 __attribute__((ext_vector_type(4)));
typedef float f32x16 __attribute__((ext_vector_type(16)));
typedef unsigned u32x2 __attribute__((ext_vector_type(2)));
typedef unsigned u32x4 __attribute__((ext_vector_type(4)));
typedef int i32x4 __attribute__((ext_vector_type(4)));

constexpr int DM = 2048, NB = 4, SEQ = 4096, DEPTH = 4, M = NB * SEQ;
constexpr int IN_COLS = 12864, ZLD = 13056;
constexpr int ZQA = 0, ZKA = 512, ZVA = 1024, ZCQ = 1536, ZCKV = 2048, ZKR = 2304, ZSQ = 2560, ZSK = 3072, ZSV = 3200, ZMQ = 3328, ZMK = 3840, ZMV = 4352, ZG = 4864;
constexpr int FFN = 5632, UP_N = 2 * FFN;
constexpr float LOG2E = 1.4426950408889634f;
constexpr float EPS = 1e-6f;
constexpr float NEG_INF = -__builtin_huge_valf();

typedef __bf16 bf16x2_t __attribute__((ext_vector_type(2)));
__device__ __forceinline__ unsigned cvt_pk_bf16(float lo, float hi) { const f32x2 v = {lo, hi}; return __builtin_bit_cast(unsigned, __builtin_convertvector(v, bf16x2_t)); }
__device__ __forceinline__ float bf2f(unsigned short h) { return __uint_as_float(((unsigned)h) << 16); }
__device__ __forceinline__ float bflo(unsigned w) { return __uint_as_float(w << 16); }
__device__ __forceinline__ float bfhi(unsigned w) { return __uint_as_float(w & 0xffff0000u); }
template <int XORM> __device__ __forceinline__ float swz_xor(float v) { return __int_as_float(__builtin_amdgcn_ds_swizzle(__float_as_int(v), (XORM << 10) | 0x1F)); }
__device__ __forceinline__ float half_sum(float v) { const auto rr = __builtin_amdgcn_permlane32_swap(__float_as_uint(v), __float_as_uint(v), false, false); return __uint_as_float(rr[0]) + __uint_as_float(rr[1]); }
__device__ __forceinline__ float half_max(float v) { const auto rr = __builtin_amdgcn_permlane32_swap(__float_as_uint(v), __float_as_uint(v), false, false); return fmaxf(__uint_as_float(rr[0]), __uint_as_float(rr[1])); }
__device__ __forceinline__ float wave_sum(float v) {
    v += swz_xor<1>(v); v += swz_xor<2>(v); v += swz_xor<4>(v); v += swz_xor<8>(v); v += swz_xor<16>(v);
    return half_sum(v);
}
__device__ __forceinline__ float wave_max(float v) {
    v = fmaxf(v, swz_xor<1>(v)); v = fmaxf(v, swz_xor<2>(v)); v = fmaxf(v, swz_xor<4>(v)); v = fmaxf(v, swz_xor<8>(v)); v = fmaxf(v, swz_xor<16>(v));
    return half_max(v);
}
__device__ __forceinline__ unsigned fresh_lane_id() { unsigned m = ~0u; asm volatile("" : "+s"(m)); return __builtin_amdgcn_mbcnt_hi(m, __builtin_amdgcn_mbcnt_lo(m, 0u)); }
__device__ __forceinline__ int opaque_tid(int wave) { int t = wave * 64 + (int)fresh_lane_id(); asm volatile("" : "+v"(t)); return t; }
__device__ __forceinline__ bool is_thread0(int wave) { return wave == 0 && fresh_lane_id() == 0u; }
__device__ __forceinline__ int opaque_s(int x) { asm volatile("" : "+s"(x)); return x; }
__device__ __forceinline__ float fast_sigmoid(float x) { return __builtin_amdgcn_rcpf(1.0f + __builtin_amdgcn_exp2f(-x * LOG2E)); }

namespace pg8 {
constexpr int BM = 256, BK = 64, HALF = 128, HTB = HALF * BK * 2, STAGE_BYTES = 8 * HTB, NXCD = 8, WGM = 4;
__host__ __device__ __forceinline__ int lds_byte(int r, int c) { const int st = (r >> 4) * 2 + (c >> 5), rr = r & 15, cc = c & 31, ob = rr * 64 + cc * 2; return st * 1024 + (ob ^ (((ob >> 9) & 1) << 5)); }
__host__ __device__ __forceinline__ void stage_rc(int b, int& R, int& C) { const int st = b / 1024, sb = b % 1024, swz = sb ^ (((sb >> 9) & 1) << 5); R = (st >> 1) * 16 + swz / 64; C = (st & 1) * 32 + (swz % 64) / 2; }
__host__ __device__ __forceinline__ int perm32(int rho) { const int n = rho >> 4, i = rho & 15; return 8 * (i >> 2) + 4 * n + (i & 3); }

struct Unit { int pm, pn, z; };
struct Gemm { const bf16_t* A; const bf16_t* Bt; int M, N, K, lda; size_t zA, zB; };

struct StaticOrder {
    int nM, nN, nwg, G, c, nZ; int wgm = WGM;
    __device__ void init(int M_, int N_, int G_, int c_, int nZ_ = 1) { nM = M_ / BM; nN = N_ / BM; nwg = nM * nN; G = G_; c = c_; nZ = nZ_; }
    __device__ void init_tiles(int nM_, int nN_, int G_, int c_, int nZ_) { nM = nM_; nN = nN_; nwg = nM * nN; G = G_; c = c_; nZ = nZ_; }
    __device__ bool next(int i, Unit& u) const {
        const int it = i / nZ; u.z = i - it * nZ;
        const long L = (long)it * G + c; if (L >= nwg) return false;
        int wgid = (int)L; { const int q = nwg / NXCD, r = nwg % NXCD, xcd = wgid % NXCD, off = wgid / NXCD; wgid = (xcd < r ? xcd * (q + 1) : r * (q + 1) + (xcd - r) * q) + off; }
        const int nig = wgm * nN, gid = wgid / nig, fm = gid * wgm, gsz = (nM - fm) < wgm ? (nM - fm) : wgm;
        u.pm = fm + ((wgid % nig) % gsz); u.pn = (wgid % nig) / gsz; return true;
    }
};


__device__ __forceinline__ float rs_of(unsigned long long q, float invn = 1.0f / DM) {
    const float f = (float)(unsigned)(q >> 32) * 256.0f + (float)(unsigned)q * (1.0f / 16777216.0f);
    return __builtin_amdgcn_rsqf(f * invn + EPS);
}
__device__ __forceinline__ void ssq_add(unsigned long long* ssq, const u32x4& w0, const u32x4& w1, int row, int k, int fq) {
    float q = 0.f;
#pragma unroll
    for (int e = 0; e < 4; ++e) { const float a = bflo(w0[e]), b = bfhi(w0[e]), c = bflo(w1[e]), d = bfhi(w1[e]); q += (a * a + b * b) + (c * c + d * d); }
    q += swz_xor<16>(q); q = half_sum(q);
    if (fq == (k & 3)) { const unsigned hi = (unsigned)q; const unsigned lo = (unsigned)((q - (float)hi) * 16777216.0f);
        atomicAdd(ssq + row, ((unsigned long long)hi << 24) + lo); }
}
constexpr int RS_LDS = STAGE_BYTES;
__device__ __forceinline__ float rs_lds(const LAS unsigned char* lds, int wid, int ai, int m, int fr, float invn = 1.0f / DM) {
    return rs_of(*(const LAS unsigned long long*)(lds + RS_LDS + wid * 1024 + ai * 512 + (m * 16 + fr) * 8), invn);
}
struct EpiBf16 {
    bf16_t* O; int ldc; int kind;
    float sc;
    const unsigned long long* ssq;
    float invn;
    unsigned long long* sq_q; unsigned long long* sq_kv;
    static constexpr bool RS = true;
    __device__ __forceinline__ void operator()(const f32x4 (&acc)[2][2][4][2], const LAS unsigned char* lds, const Unit& u, int wr, int wc, int fr, int fq) const {
        float s = sc; unsigned long long* sqo = nullptr;
        if (kind == 0) {
            const int pn = u.pn;
            s = 1.0f;
            if (pn < 2 || pn == 10 || pn == 11) s = 0.125f * LOG2E;
            else if (pn == 13 || pn == 14) s = 0.08838834764831845f * LOG2E;
            if (pn == 6 || pn == 7) sqo = sq_q; else if (pn == 8) sqo = sq_kv;
        }
        const int row0 = u.pm * BM + wr * 64 + fr, col0 = u.pn * BM + wc * 32 + 8 * fq;
        const float s0 = s;
#pragma unroll
        for (int ai = 0; ai < 2; ++ai)
#pragma unroll
            for (int m = 0; m < 4; ++m) { const int row = row0 + ai * HALF + m * 16; bf16_t* rowp = O + (size_t)row * ldc + col0; const float s = ssq ? s0 * rs_lds(lds, wr * 4 + wc, ai, m, fr, invn) : s0;
                u32x4 w[2];
#pragma unroll
                for (int bj = 0; bj < 2; ++bj) { const f32x4 v0 = acc[ai][bj][m][0] * s, v1 = acc[ai][bj][m][1] * s;
                    w[bj].x = cvt_pk_bf16(v0[0], v0[1]); w[bj].y = cvt_pk_bf16(v0[2], v0[3]); w[bj].z = cvt_pk_bf16(v1[0], v1[1]); w[bj].w = cvt_pk_bf16(v1[2], v1[3]);
                    *(u32x4*)(rowp + bj * HALF) = w[bj]; }
                if (sqo) ssq_add(sqo, w[0], w[1], row, m, fq); }
    }
};
struct EpiGate {
    bf16_t* O; int ldc; float sc0; int lo; const unsigned long long* ssq;
    static constexpr bool RS = true;
    __device__ __forceinline__ void operator()(const f32x4 (&acc)[2][2][4][2], const LAS unsigned char* lds, const Unit& u, int wr, int wc, int fr, int fq) const {
        const int row0 = u.pm * BM + wr * 64 + fr, col0 = u.pn * BM + wc * 32 + 8 * fq;
        const bool sig = u.pn >= lo;
        float rs[2][4];
#pragma unroll
        for (int ai = 0; ai < 2; ++ai)
#pragma unroll
            for (int m = 0; m < 4; ++m) rs[ai][m] = sc0 * rs_lds(lds, wr * 4 + wc, ai, m, fr);
#pragma unroll
        for (int ai = 0; ai < 2; ++ai)
#pragma unroll
            for (int m = 0; m < 4; ++m) { bf16_t* rowp = O + (size_t)(row0 + ai * HALF + m * 16) * ldc + col0; const float sc = rs[ai][m];
#pragma unroll
                for (int bj = 0; bj < 2; ++bj) { f32x4 v0 = acc[ai][bj][m][0], v1 = acc[ai][bj][m][1];
                    if (sig) {
#pragma unroll
                        for (int e = 0; e < 4; ++e) { v0[e] = fast_sigmoid(v0[e] * sc); v1[e] = fast_sigmoid(v1[e] * sc); }
                    } else { v0 = v0 * sc; v1 = v1 * sc; }
                    u32x4 w; w.x = cvt_pk_bf16(v0[0], v0[1]); w.y = cvt_pk_bf16(v0[2], v0[3]); w.z = cvt_pk_bf16(v1[0], v1[1]); w.w = cvt_pk_bf16(v1[2], v1[3]);
                    *(u32x4*)(rowp + bj * HALF) = w; } }
    }
};
struct EpiResBf16 {
    static constexpr bool RS = false;
    const float* base32; const bf16_t* base16; bf16_t* out; int ldc; unsigned long long* ssq; unsigned char* x8;
    static __device__ __forceinline__ unsigned pk4_e4m3(float a, float b, float c, float d) { int w = __builtin_amdgcn_cvt_pk_fp8_f32(a, b, 0, false); w = __builtin_amdgcn_cvt_pk_fp8_f32(c, d, w, true); return (unsigned)w; }
    __device__ __forceinline__ void store8(const u32x4& w, size_t off) const { u32x2 o; o.x = pk4_e4m3(bflo(w.x), bfhi(w.x), bflo(w.y), bfhi(w.y)); o.y = pk4_e4m3(bflo(w.z), bfhi(w.z), bflo(w.w), bfhi(w.w)); *(u32x2*)(x8 + off) = o; }
    __device__ __forceinline__ void operator()(const f32x4 (&acc)[2][2][4][2], const Unit& u, int wr, int wc, int fr, int fq) const {
        const int row0 = u.pm * BM + wr * 64 + fr, col0 = u.pn * BM + wc * 32 + 8 * fq;
        if (base32) {
            f32x4 bv[2][2][2];
#define PG8_RES_LOAD(buf, k) do { const size_t off_ = (size_t)(row0 + ((k) >> 2) * HALF + ((k) & 3) * 16) * ldc + col0; \
            _Pragma("unroll") for (int bj = 0; bj < 2; ++bj) { bv[buf][bj][0] = *(const f32x4*)(base32 + off_ + bj * HALF); bv[buf][bj][1] = *(const f32x4*)(base32 + off_ + bj * HALF + 4); } } while (0)
            PG8_RES_LOAD(0, 0);
#pragma unroll
            for (int k = 0; k < 8; ++k) {
                if (k + 1 < 8) PG8_RES_LOAD((k + 1) & 1, k + 1);
                const int ai = k >> 2, m = k & 3, row = row0 + ai * HALF + m * 16; const size_t off = (size_t)row * ldc + col0;
                u32x4 w[2];
#pragma unroll
                for (int bj = 0; bj < 2; ++bj) { const f32x4 t0 = bv[k & 1][bj][0] + acc[ai][bj][m][0], t1 = bv[k & 1][bj][1] + acc[ai][bj][m][1];
                    w[bj].x = cvt_pk_bf16(t0[0], t0[1]); w[bj].y = cvt_pk_bf16(t0[2], t0[3]); w[bj].z = cvt_pk_bf16(t1[0], t1[1]); w[bj].w = cvt_pk_bf16(t1[2], t1[3]);
                    *(u32x4*)(out + off + bj * HALF) = w[bj]; if (x8) store8(w[bj], off + bj * HALF); }
                if (ssq) ssq_add(ssq, w[0], w[1], row, k, fq);
            }
#undef PG8_RES_LOAD
        } else {
            u32x4 bv[2][2];
#define PG8_RES_LOAD(buf, k) do { const size_t off_ = (size_t)(row0 + ((k) >> 2) * HALF + ((k) & 3) * 16) * ldc + col0; \
            _Pragma("unroll") for (int bj = 0; bj < 2; ++bj) bv[buf][bj] = *(const u32x4*)(base16 + off_ + bj * HALF); } while (0)
            PG8_RES_LOAD(0, 0);
#pragma unroll
            for (int k = 0; k < 8; ++k) {
                if (k + 1 < 8) PG8_RES_LOAD((k + 1) & 1, k + 1);
                const int ai = k >> 2, m = k & 3, row = row0 + ai * HALF + m * 16; const size_t off = (size_t)row * ldc + col0;
                u32x4 w[2];
#pragma unroll
                for (int bj = 0; bj < 2; ++bj) { const u32x4 p = bv[k & 1][bj];
                    const f32x4 t0 = (f32x4){bflo(p.x), bfhi(p.x), bflo(p.y), bfhi(p.y)} + acc[ai][bj][m][0], t1 = (f32x4){bflo(p.z), bfhi(p.z), bflo(p.w), bfhi(p.w)} + acc[ai][bj][m][1];
                    w[bj].x = cvt_pk_bf16(t0[0], t0[1]); w[bj].y = cvt_pk_bf16(t0[2], t0[3]); w[bj].z = cvt_pk_bf16(t1[0], t1[1]); w[bj].w = cvt_pk_bf16(t1[2], t1[3]);
                    *(u32x4*)(out + off + bj * HALF) = w[bj]; if (x8) store8(w[bj], off + bj * HALF); }
                if (ssq) ssq_add(ssq, w[0], w[1], row, k, fq);
            }
#undef PG8_RES_LOAD
        }
    }
};
struct EpiMerge {
    static constexpr bool RS = false;
    const bf16_t* gate; int ldg;
    float* T; bf16_t* Mg;
    __device__ __forceinline__ void operator()(const f32x4 (&acc)[2][2][4][2], const Unit& u, int wr, int wc, int fr, int fq) const {
        const int row0 = u.pm * BM + wr * 64 + fr, col0 = u.pn * BM + wc * 32 + 8 * fq, z = u.z;
        u32x4 gv[2][2]; f32x4 tv[2][2][2];
#define PG8_MG_LOAD(buf, k) do { const int row_ = row0 + ((k) >> 2) * HALF + ((k) & 3) * 16; const size_t off_ = (size_t)row_ * DM + col0; \
            _Pragma("unroll") for (int bj = 0; bj < 2; ++bj) { gv[buf][bj] = *(const u32x4*)(gate + (size_t)row_ * ldg + z * DM + col0 + bj * HALF); \
                if (z > 0) { tv[buf][bj][0] = *(const f32x4*)(T + off_ + bj * HALF); tv[buf][bj][1] = *(const f32x4*)(T + off_ + bj * HALF + 4); } \
                else { tv[buf][bj][0] = (f32x4){0.f, 0.f, 0.f, 0.f}; tv[buf][bj][1] = (f32x4){0.f, 0.f, 0.f, 0.f}; } } } while (0)
        PG8_MG_LOAD(0, 0);
#pragma unroll
        for (int k = 0; k < 8; ++k) {
            if (k + 1 < 8) PG8_MG_LOAD((k + 1) & 1, k + 1);
            const int ai = k >> 2, m = k & 3; const size_t off = (size_t)(row0 + ai * HALF + m * 16) * DM + col0;
#pragma unroll
            for (int bj = 0; bj < 2; ++bj) {
                const u32x4 g = gv[k & 1][bj];
                const f32x4 g0 = (f32x4){bflo(g.x), bfhi(g.x), bflo(g.y), bfhi(g.y)}, g1 = (f32x4){bflo(g.z), bfhi(g.z), bflo(g.w), bfhi(g.w)};
                const f32x4 t0 = tv[k & 1][bj][0] + g0 * acc[ai][bj][m][0], t1 = tv[k & 1][bj][1] + g1 * acc[ai][bj][m][1];
                if (z < 3) { *(f32x4*)(T + off + bj * HALF) = t0; *(f32x4*)(T + off + bj * HALF + 4) = t1; }
                else { u32x4 w; w.x = cvt_pk_bf16(t0[0], t0[1]); w.y = cvt_pk_bf16(t0[2], t0[3]); w.z = cvt_pk_bf16(t1[0], t1[1]); w.w = cvt_pk_bf16(t1[2], t1[3]);
                    *(u32x4*)(Mg + off + bj * HALF) = w; } }
        }
#undef PG8_MG_LOAD
    }
};

struct EpiMergeDiag {
    static constexpr bool RS = false;
    const bf16_t* gate; int ldg; bf16_t* Mg;
    __device__ __forceinline__ void operator()(f32x4 (&acc)[2][2][4][2], const Unit& u, int wr, int wc, int fr, int fq) const {
        const int row0 = u.pm * HALF + wr * 64 + fr, col0 = u.pn * HALF + wc * 32 + 8 * fq, z0 = 2 * u.z;
#pragma unroll
        for (int m = 0; m < 4; ++m) { const int row = row0 + m * 16;
            const u32x4 ga = *(const u32x4*)(gate + (size_t)row * ldg + z0 * DM + col0), gb = *(const u32x4*)(gate + (size_t)row * ldg + (z0 + 1) * DM + col0);
            const f32x4 a0 = (f32x4){bflo(ga.x), bfhi(ga.x), bflo(ga.y), bfhi(ga.y)}, a1 = (f32x4){bflo(ga.z), bfhi(ga.z), bflo(ga.w), bfhi(ga.w)};
            const f32x4 b0 = (f32x4){bflo(gb.x), bfhi(gb.x), bflo(gb.y), bfhi(gb.y)}, b1 = (f32x4){bflo(gb.z), bfhi(gb.z), bflo(gb.w), bfhi(gb.w)};
            f32x4 t0 = a0 * acc[0][0][m][0] + b0 * acc[1][1][m][0], t1 = a1 * acc[0][0][m][1] + b1 * acc[1][1][m][1];
            if (u.z == 0) { acc[0][1][m][0] = t0; acc[0][1][m][1] = t1; }
            else { t0 = t0 + acc[0][1][m][0]; t1 = t1 + acc[0][1][m][1];
                u32x4 w; w.x = cvt_pk_bf16(t0[0], t0[1]); w.y = cvt_pk_bf16(t0[2], t0[3]); w.z = cvt_pk_bf16(t1[0], t1[1]); w.w = cvt_pk_bf16(t1[2], t1[3]);
                *(u32x4*)(Mg + (size_t)row * DM + col0) = w; } }
    }
};

__device__ __forceinline__ float gelu_erf(float v) {
    const float av = fabsf(v), d = av * 0.2316418882f + 1.0f;
    const float t = __builtin_amdgcn_rcpf(d);
    float q = t * 0.5307027145f + (-0.7265760135f); q = q * t + 0.7107068705f; q = q * t + (-0.142248368f); q = q * t + 0.127414796f; q = q * t;
    const float e = __builtin_amdgcn_exp2f((v * v) * (-0.72134752044f));
    const float m = v * (q * e), r = v - m;
    return v < 0.f ? m : r;
}
__device__ __forceinline__ f32x2 gelu_pk(f32x2 v) {
    f32x2 z; z.x = __builtin_amdgcn_fmed3f(v.x, -4.0f, 4.0f); z.y = __builtin_amdgcn_fmed3f(v.y, -4.0f, 4.0f);
    const f32x2 s = z * z;
    f32x2 p = s * (-1.278033807e-09f) + 1.044463725e-07f; p = p * s + (-3.709719858e-06f); p = p * s + 7.619161683e-05f; p = p * s + (-1.021055556e-03f);
    p = p * s + 9.581421419e-03f; p = p * s + (-6.606413978e-02f); p = p * s + 3.988055566e-01f;
    return v * (z * p + 0.5f);
}
__device__ __forceinline__ float dpp_shr1(float old, float src) { return __int_as_float(__builtin_amdgcn_update_dpp(__float_as_int(old), __float_as_int(src), 0x111, 0xf, 0xf, false)); }
__device__ __forceinline__ float dpp_shr2(float old, float src) { return __int_as_float(__builtin_amdgcn_update_dpp(__float_as_int(old), __float_as_int(src), 0x112, 0xf, 0xf, false)); }
__device__ __forceinline__ float dpp_ror1(float src) { return __int_as_float(__builtin_amdgcn_update_dpp(__float_as_int(src), __float_as_int(src), 0x121, 0xf, 0xf, false)); }
__device__ __forceinline__ float dpp_ror2(float src) { return __int_as_float(__builtin_amdgcn_update_dpp(__float_as_int(src), __float_as_int(src), 0x122, 0xf, 0xf, false)); }
struct EpiGlu {
    bf16_t* G; const float* cw; const float* cb; float* tail; float* heada; float* headv;
    const unsigned long long* ssq;
    static constexpr bool RS = true;
    __device__ __forceinline__ void operator()(const f32x4 (&acc)[2][2][4][2], const LAS unsigned char* lds, const Unit& u, int wr, int wc, int fr, int fq) const {
        const int ch0 = u.pn * HALF + wc * 32 + 8 * fq;
        f32x2 w0[4], w1[4], w2[4], bb[4];
#pragma unroll
        for (int h = 0; h < 2; ++h) { const f32x4 t0 = *(const f32x4*)(cw + ch0 + 4 * h), t1 = *(const f32x4*)(cw + FFN + ch0 + 4 * h), t2 = *(const f32x4*)(cw + 2 * FFN + ch0 + 4 * h), t3 = *(const f32x4*)(cb + ch0 + 4 * h);
            w0[2 * h] = (f32x2){t0[0], t0[1]}; w0[2 * h + 1] = (f32x2){t0[2], t0[3]}; w1[2 * h] = (f32x2){t1[0], t1[1]}; w1[2 * h + 1] = (f32x2){t1[2], t1[3]};
            w2[2 * h] = (f32x2){t2[0], t2[1]}; w2[2 * h + 1] = (f32x2){t2[2], t2[3]}; bb[2 * h] = (f32x2){t3[0], t3[1]}; bb[2 * h + 1] = (f32x2){t3[2], t3[3]}; }
        float rs[2][4];
#pragma unroll
        for (int ai = 0; ai < 2; ++ai)
#pragma unroll
            for (int m = 0; m < 4; ++m) rs[ai][m] = rs_lds(lds, wr * 4 + wc, ai, m, fr);
#pragma unroll
        for (int ai = 0; ai < 2; ++ai) {
            const int gid = u.pm * 4 + ai * 2 + wr, rowg = gid * 64;
            float q1[8], q2[8];
#pragma unroll
            for (int c = 0; c < 8; ++c) { q1[c] = 0.f; q2[c] = 0.f; }
#pragma unroll
            for (int m = 0; m < 4; ++m) {
                float a8[8], v8[8], p1[8], p2[8];
#pragma unroll
                for (int n = 0; n < 2; ++n)
#pragma unroll
                    for (int e = 0; e < 4; ++e) { a8[4 * n + e] = acc[ai][0][m][n][e] * rs[ai][m]; v8[4 * n + e] = acc[ai][1][m][n][e] * rs[ai][m]; }
#pragma unroll
                for (int c = 0; c < 8; ++c) { p1[c] = dpp_shr1(q1[c], a8[c]); p2[c] = dpp_shr2(q2[c], a8[c]); q1[c] = dpp_ror1(a8[c]); q2[c] = dpp_ror2(a8[c]); }
                const int row = rowg + m * 16 + fr;
                if (m == 0 && fr < 2) {
                    float* ha = heada + ((size_t)gid * 2 + fr) * FFN + ch0; float* hv = headv + ((size_t)gid * 2 + fr) * FFN + ch0;
                    *(f32x4*)ha = (f32x4){a8[0], a8[1], a8[2], a8[3]}; *(f32x4*)(ha + 4) = (f32x4){a8[4], a8[5], a8[6], a8[7]};
                    *(f32x4*)hv = (f32x4){v8[0], v8[1], v8[2], v8[3]}; *(f32x4*)(hv + 4) = (f32x4){v8[4], v8[5], v8[6], v8[7]};
                } else {
                    f32x2 o[4];
#pragma unroll
                    for (int c = 0; c < 4; ++c) { const f32x2 av = (f32x2){a8[2 * c], a8[2 * c + 1]}, pv1 = (f32x2){p1[2 * c], p1[2 * c + 1]}, pv2 = (f32x2){p2[2 * c], p2[2 * c + 1]}, vv = (f32x2){v8[2 * c], v8[2 * c + 1]};
                        o[c] = gelu_pk(bb[c] + w0[c] * pv2 + w1[c] * pv1 + w2[c] * av) * vv; }
                    u32x4 w; w.x = cvt_pk_bf16(o[0].x, o[0].y); w.y = cvt_pk_bf16(o[1].x, o[1].y); w.z = cvt_pk_bf16(o[2].x, o[2].y); w.w = cvt_pk_bf16(o[3].x, o[3].y);
                    *(u32x4*)(G + (size_t)row * FFN + ch0) = w;
                }
                if (m == 3 && fr >= 14) { float* tl = tail + ((size_t)gid * 2 + (fr - 14)) * FFN + ch0;
                    *(f32x4*)tl = (f32x4){a8[0], a8[1], a8[2], a8[3]}; *(f32x4*)(tl + 4) = (f32x4){a8[4], a8[5], a8[6], a8[7]}; }
            }
        }
    }
};

template <class Epi, class Sched, bool ALIGN_EPI, bool DIAG = false, bool F8 = false>
__device__ __forceinline__ void gemm_phase(LAS unsigned char* lds, const Gemm g, const Sched& S, const Epi& E, int wave) {
    const int tid = opaque_tid(wave), wid = __builtin_amdgcn_readfirstlane(tid >> 6), lane = tid & 63, wr = wid >> 2, wc = wid & 3, fr = lane & 15, fq = lane >> 4;
    const int K = g.K, nt = F8 ? K / (2 * BK) : K / BK, lda = g.lda;
    const int rowA = F8 ? lda : lda * 2, rowB = F8 ? K : K * 2;
    unsigned voffA[2], voffB[2];
#pragma unroll
    for (int i = 0; i < 2; ++i) { int R, C; stage_rc(tid * 16 + i * 8192, R, C); const int Rb = (R & ~31) + perm32(R & 31);
        voffA[i] = (unsigned)(R * rowA + C * 2); voffB[i] = (unsigned)(Rb * rowB + C * 2); }
    const size_t kstep = (size_t)(BK * 2);
    const size_t hstepA = DIAG ? g.zA : (size_t)HALF * rowA, hstepB = DIAG ? g.zB : (size_t)HALF * rowB;
    const size_t tstepA = (DIAG ? 1 : 2) * (size_t)HALF * rowA, tstepB = (DIAG ? 1 : 2) * (size_t)HALF * rowB;
    const size_t zsA = (DIAG ? 2 : 1) * g.zA, zsB = (DIAG ? 2 : 1) * g.zB;
    const unsigned ldsw = (unsigned)wid * 1024u;
    const int aoff = lds_byte(wr * 64 + fr, fq * 8), boff = lds_byte(wc * 32 + fr, fq * 8);
#define PG8_SA(b, h) (((b) * 2 + (h)) * HTB)
#define PG8_SB(b, h) ((4 + (b) * 2 + (h)) * HTB)
#define PG8_STAGE(bufoff, gbase, voff) do { _Pragma("unroll") for (int _i = 0; _i < 2; ++_i) \
        __builtin_amdgcn_global_load_lds((const unsigned*)((const char*)(gbase) + (voff)[_i]), (LAS unsigned*)(lds + (bufoff) + ldsw + _i * 8192), 16, 0, 0); } while (0)
#define PG8_LDA(dst, b, h) do { if constexpr (F8) { _Pragma("unroll") for (int m = 0; m < 4; ++m) { const v4i_t lo_ = *(const LAS v4i_t*)(lds + PG8_SA(b, h) + aoff + m * 2048), hi_ = *(const LAS v4i_t*)(lds + PG8_SA(b, h) + aoff + m * 2048 + 1024); \
            dst##8[m] = __builtin_shufflevector(lo_, hi_, 0, 1, 2, 3, 4, 5, 6, 7); } } \
        else { _Pragma("unroll") for (int m = 0; m < 4; ++m) _Pragma("unroll") for (int k = 0; k < 2; ++k) dst[m][k] = *(const LAS bf16x8*)(lds + PG8_SA(b, h) + aoff + m * 2048 + k * 1024); } } while (0)
#define PG8_LDB(dst, b, h) do { if constexpr (F8) { _Pragma("unroll") for (int n = 0; n < 2; ++n) { const v4i_t lo_ = *(const LAS v4i_t*)(lds + PG8_SB(b, h) + boff + n * 2048), hi_ = *(const LAS v4i_t*)(lds + PG8_SB(b, h) + boff + n * 2048 + 1024); \
            dst##8[n] = __builtin_shufflevector(lo_, hi_, 0, 1, 2, 3, 4, 5, 6, 7); } } \
        else { _Pragma("unroll") for (int n = 0; n < 2; ++n) _Pragma("unroll") for (int k = 0; k < 2; ++k) dst[n][k] = *(const LAS bf16x8*)(lds + PG8_SB(b, h) + boff + n * 2048 + k * 1024); } } while (0)
#define PG8_MMA(ai, bj, At, Bt) do { __builtin_amdgcn_s_setprio(1); \
        if constexpr (F8) { _Pragma("unroll") for (int m = 0; m < 4; ++m) _Pragma("unroll") for (int n = 0; n < 2; ++n) \
                asm volatile("v_mfma_scale_f32_16x16x128_f8f6f4 %0, %1, %2, %0, %3, %3 op_sel_hi:[0,0,0]" : "+v"(acc[ai][bj][m][n]) : "v"(Bt##8[n]), "v"(At##8[m]), "v"(f8scale)); } \
        else { _Pragma("unroll") for (int m = 0; m < 4; ++m) _Pragma("unroll") for (int n = 0; n < 2; ++n) _Pragma("unroll") for (int k = 0; k < 2; ++k) \
            acc[ai][bj][m][n] = __builtin_amdgcn_mfma_f32_16x16x32_bf16(Bt[n][k], At[m][k], acc[ai][bj][m][n], 0, 0, 0); } \
        __builtin_amdgcn_s_setprio(0); } while (0)
#define PG8_WAIT_V(n) asm volatile("s_waitcnt vmcnt(" #n ")" ::: "memory")
#define PG8_WAIT_L(n) asm volatile("s_waitcnt lgkmcnt(" #n ")" ::: "memory")
#define PG8_BAR __builtin_amdgcn_s_barrier()
#define PG8_SCHED __builtin_amdgcn_sched_barrier(0)
    Unit cur, nxt; int ui = 0;
    if (!S.next(0, cur)) return;
    f32x4 acc[2][2][4][2];
#pragma unroll
    for (int a = 0; a < 2; ++a)
#pragma unroll
        for (int b = 0; b < 2; ++b)
#pragma unroll
            for (int m = 0; m < 4; ++m)
#pragma unroll
                for (int n = 0; n < 2; ++n) acc[a][b][m][n] = (f32x4){0.f, 0.f, 0.f, 0.f};
    bf16x8 At[4][2], B0[2][2], B1[2][2];
    typedef int v4i_t __attribute__((ext_vector_type(4))); typedef int v8i_t __attribute__((ext_vector_type(8)));
    const int f8scale = 0x7f7f7f7f;
    v8i_t At8[4], B08[2], B18[2];
    const char* cA = (const char*)g.A + (size_t)cur.pm * tstepA + (size_t)cur.z * zsA; const char* cB = (const char*)g.Bt + (size_t)cur.pn * tstepB + (size_t)cur.z * zsB;
    PG8_STAGE(PG8_SB(0, 0), cB, voffB); PG8_STAGE(PG8_SB(0, 1), cB + hstepB, voffB); PG8_STAGE(PG8_SA(0, 0), cA, voffA); PG8_STAGE(PG8_SA(0, 1), cA + hstepA, voffA);
    if (wr == 1) PG8_BAR;
    PG8_WAIT_V(2); PG8_BAR;
    PG8_STAGE(PG8_SB(1, 0), cB + kstep, voffB); PG8_STAGE(PG8_SA(1, 0), cA + kstep, voffA); PG8_STAGE(PG8_SB(1, 1), cB + hstepB + kstep, voffB);
    PG8_WAIT_V(6); PG8_BAR;
    for (;;) {
        const bool has_next = S.next(ui + 1, nxt);
        const char* nA = has_next ? (const char*)g.A + (size_t)nxt.pm * tstepA + (size_t)nxt.z * zsA : cA; const char* nB = has_next ? (const char*)g.Bt + (size_t)nxt.pn * tstepB + (size_t)nxt.z * zsB : cB;
        for (int t = 0; t < nt; t += 2) {
            const bool last = (t == nt - 2);
            const char* a1 = cA + (size_t)(t + 1) * kstep;
            const char* a2 = last ? nA : cA + (size_t)(t + 2) * kstep; const char* b2 = last ? nB : cB + (size_t)(t + 2) * kstep;
            const char* a3 = a2 + kstep; const char* b3 = b2 + kstep;
            PG8_LDB(B0, 0, 0); PG8_LDB(B1, 0, 1); PG8_SCHED; PG8_LDA(At, 0, 0); PG8_STAGE(PG8_SA(1, 1), a1 + hstepA, voffA);
            bool rsw = false;
            if constexpr (Epi::RS) { rsw = last && E.ssq != nullptr;
                if (rsw) { const int fl = (int)fresh_lane_id();
                    __builtin_amdgcn_global_load_lds((const unsigned*)(E.ssq + cur.pm * BM + (fl >> 5) * HALF + wr * 64 + 2 * (fl & 31)), (LAS unsigned*)(lds + RS_LDS + ldsw), 16, 0, 0); } }
            if (rsw) PG8_WAIT_V(9); else PG8_WAIT_V(8);
            PG8_WAIT_L(0); PG8_BAR; PG8_MMA(0, 0, At, B0); if constexpr (!DIAG) PG8_MMA(0, 1, At, B1); PG8_BAR; PG8_SCHED;
            PG8_LDA(At, 0, 1); PG8_STAGE(PG8_SB(0, 0), b2, voffB); PG8_STAGE(PG8_SB(0, 1), b2 + hstepB, voffB); PG8_STAGE(PG8_SA(0, 0), a2, voffA);
            if (rsw) PG8_WAIT_V(9); else PG8_WAIT_V(8);
            PG8_WAIT_L(0); PG8_BAR; if constexpr (!DIAG) PG8_MMA(1, 0, At, B0); PG8_MMA(1, 1, At, B1); PG8_BAR; PG8_SCHED;
            PG8_LDB(B0, 1, 0); PG8_LDB(B1, 1, 1); PG8_SCHED; PG8_LDA(At, 1, 0); PG8_STAGE(PG8_SA(0, 1), a2 + hstepA, voffA);
            if (rsw) PG8_WAIT_V(9); else PG8_WAIT_V(8);
            PG8_WAIT_L(0); PG8_BAR; PG8_MMA(0, 0, At, B0); if constexpr (!DIAG) PG8_MMA(0, 1, At, B1); PG8_BAR; PG8_SCHED;
            PG8_LDA(At, 1, 1); PG8_STAGE(PG8_SB(1, 0), b3, voffB); PG8_STAGE(PG8_SB(1, 1), b3 + hstepB, voffB); PG8_STAGE(PG8_SA(1, 0), a3, voffA);
            PG8_WAIT_V(8); PG8_WAIT_L(0); PG8_BAR; if constexpr (!DIAG) PG8_MMA(1, 0, At, B0); PG8_MMA(1, 1, At, B1); PG8_BAR; PG8_SCHED;
        }
        if constexpr (ALIGN_EPI) { if (wr == 0) PG8_BAR; }
        if constexpr (F8) { __builtin_amdgcn_sched_barrier(0); asm volatile("s_nop 15\n\ts_nop 15" ::: "memory"); __builtin_amdgcn_sched_barrier(0); }
        { const int fl = (int)fresh_lane_id(), fr2 = fl & 15, fq2 = fl >> 4;
          if constexpr (Epi::RS) E(acc, lds, cur, wr, wc, fr2, fq2); else E(acc, cur, wr, wc, fr2, fq2); }
        if (!has_next) break;
#pragma unroll
        for (int a = 0; a < 2; ++a)
#pragma unroll
            for (int b = 0; b < 2; ++b)
#pragma unroll
                for (int m = 0; m < 4; ++m)
#pragma unroll
                    for (int n = 0; n < 2; ++n) if (!DIAG || a == b) acc[a][b][m][n] = (f32x4){0.f, 0.f, 0.f, 0.f};
        cur = nxt; cA = nA; cB = nB; ++ui;
        if constexpr (ALIGN_EPI) { if (wr == 1) PG8_BAR; }
    }
    PG8_WAIT_V(0);
    if constexpr (!ALIGN_EPI) { if (wr == 0) PG8_BAR; }
    PG8_BAR;
#undef PG8_SA
#undef PG8_SB
#undef PG8_STAGE
#undef PG8_LDA
#undef PG8_LDB
#undef PG8_MMA
#undef PG8_WAIT_V
#undef PG8_WAIT_L
#undef PG8_BAR
#undef PG8_SCHED
}

struct EpiMergeHalf {
    const bf16_t* gate; int ldg; bf16_t* Mg;
    __device__ __forceinline__ void prefetch(u32x4 (&gp)[8], const Unit& u, int wr, int wc, int fr, int fq) const {
        const bf16_t* ub = gate + (size_t)(u.pm * HALF) * ldg + u.z * DM + u.pn * BM;
        const unsigned lo = (unsigned)((wr * 64 + fr) * ldg + wc * 32 + 8 * fq);
#pragma unroll
        for (int m = 0; m < 4; ++m)
#pragma unroll
            for (int bj = 0; bj < 2; ++bj) gp[m * 2 + bj] = *(const u32x4*)(ub + (size_t)(m * 16) * ldg + bj * HALF + lo);
    }
    __device__ __forceinline__ void operator()(const f32x4 (&acc)[2][4][2], u32x4 (&tot)[8], const u32x4 (&gp)[8], const Unit& u, int wr, int wc, int fr, int fq) const {
        const int row0 = u.pm * HALF + wr * 64 + fr, col0 = u.pn * BM + wc * 32 + 8 * fq, z = u.z;
        const unsigned keep = (z == 3) ? 0u : 0xffffffffu;
#pragma unroll
        for (int m = 0; m < 4; ++m) { const int row = row0 + m * 16;
#pragma unroll
            for (int bj = 0; bj < 2; ++bj) {
                const u32x4 g = gp[m * 2 + bj], p = tot[m * 2 + bj];
                const f32x4 g0 = (f32x4){bflo(g.x), bfhi(g.x), bflo(g.y), bfhi(g.y)}, g1 = (f32x4){bflo(g.z), bfhi(g.z), bflo(g.w), bfhi(g.w)};
                const f32x4 p0 = (f32x4){bflo(p.x), bfhi(p.x), bflo(p.y), bfhi(p.y)}, p1 = (f32x4){bflo(p.z), bfhi(p.z), bflo(p.w), bfhi(p.w)};
                const f32x4 t0 = g0 * acc[bj][m][0] + p0, t1 = g1 * acc[bj][m][1] + p1;
                u32x4 w; w.x = cvt_pk_bf16(t0[0], t0[1]); w.y = cvt_pk_bf16(t0[2], t0[3]); w.z = cvt_pk_bf16(t1[0], t1[1]); w.w = cvt_pk_bf16(t1[2], t1[3]);
                if (z == 3) *(u32x4*)(Mg + (size_t)row * DM + col0 + bj * HALF) = w;
                tot[m * 2 + bj] = (u32x4){w.x & keep, w.y & keep, w.z & keep, w.w & keep}; } }
    }
};

template <class Epi, class Sched>
__device__ __forceinline__ void gemm_phase_m3(LAS unsigned char* lds, const Gemm g, const Sched& S, const Epi& E, int wave) {
    const int tid = opaque_tid(wave), wid = __builtin_amdgcn_readfirstlane(tid >> 6), lane = tid & 63, wr = wid >> 2, wc = wid & 3, fr = lane & 15, fq = lane >> 4;
    const int K = g.K, nt = K / BK, lda = g.lda;
    const int rowA = lda * 2, rowB = K * 2;
    unsigned voffA[2], voffB[2];
#pragma unroll
    for (int i = 0; i < 2; ++i) { int R, C; stage_rc(tid * 16 + i * 8192, R, C); const int Rb = (R & ~31) + perm32(R & 31);
        voffA[i] = (unsigned)(R * rowA + C * 2); voffB[i] = (unsigned)(Rb * rowB + C * 2); }
    const size_t kstep = (size_t)(BK * 2), hstepB = (size_t)HALF * rowB, tstepA = (size_t)HALF * rowA, tstepB = 2 * (size_t)HALF * rowB;
    const unsigned ldsw = (unsigned)wid * 1024u;
    const int aoff = lds_byte(wr * 64 + fr, fq * 8), boff = lds_byte(wc * 32 + fr, fq * 8);
    constexpr int SLOT = 3 * HTB;
#define M3_STAGE(bufoff, gbase, voff) do { _Pragma("unroll") for (int _i = 0; _i < 2; ++_i) \
        __builtin_amdgcn_global_load_lds((const unsigned*)((const char*)(gbase) + (voff)[_i]), (LAS unsigned*)(lds + (bufoff) + ldsw + _i * 8192), 16, 0, 0); } while (0)
#define M3_STAGE3(so, a_, b_) do { M3_STAGE((so), (b_), voffB); M3_STAGE((so) + HTB, (b_) + hstepB, voffB); M3_STAGE((so) + 2 * HTB, (a_), voffA); } while (0)
#define M3_LDA(dst, so) do { _Pragma("unroll") for (int m = 0; m < 4; ++m) _Pragma("unroll") for (int k = 0; k < 2; ++k) dst[m][k] = *(const LAS bf16x8*)(lds + (so) + 2 * HTB + aoff + m * 2048 + k * 1024); } while (0)
#define M3_LDB(dst, so, h) do { _Pragma("unroll") for (int n = 0; n < 2; ++n) _Pragma("unroll") for (int k = 0; k < 2; ++k) dst[n][k] = *(const LAS bf16x8*)(lds + (so) + (h) * HTB + boff + n * 2048 + k * 1024); } while (0)
#define M3_MMA(bj, At, Bt) do { __builtin_amdgcn_s_setprio(1); \
        _Pragma("unroll") for (int m = 0; m < 4; ++m) _Pragma("unroll") for (int n = 0; n < 2; ++n) _Pragma("unroll") for (int k = 0; k < 2; ++k) \
            acc[bj][m][n] = __builtin_amdgcn_mfma_f32_16x16x32_bf16(Bt[n][k], At[m][k], acc[bj][m][n], 0, 0, 0); \
        __builtin_amdgcn_s_setprio(0); } while (0)
#define M3_WAIT_V(n) asm volatile("s_waitcnt vmcnt(" #n ")" ::: "memory")
#define M3_WAIT_L(n) asm volatile("s_waitcnt lgkmcnt(" #n ")" ::: "memory")
#define M3_BAR __builtin_amdgcn_s_barrier()
#define M3_SCHED __builtin_amdgcn_sched_barrier(0)
    Unit cur, nxt; int ui = 0;
    if (!S.next(0, cur)) return;
    f32x4 acc[2][4][2];
#pragma unroll
    for (int b = 0; b < 2; ++b)
#pragma unroll
        for (int m = 0; m < 4; ++m)
#pragma unroll
            for (int n = 0; n < 2; ++n) acc[b][m][n] = (f32x4){0.f, 0.f, 0.f, 0.f};
    u32x4 tot[8];
#pragma unroll
    for (int i = 0; i < 8; ++i) tot[i] = (u32x4){0u, 0u, 0u, 0u};
    bf16x8 At[4][2], B0[2][2], B1[2][2];
    const char* cA = (const char*)g.A + (size_t)cur.pm * tstepA + (size_t)cur.z * g.zA; const char* cB = (const char*)g.Bt + (size_t)cur.pn * tstepB + (size_t)cur.z * g.zB;
    u32x4 gp[8];
    int o0 = 0, o1 = SLOT, o2 = 2 * SLOT;
    M3_STAGE3(o0, cA, cB);
    if (wr == 1) M3_BAR;
    M3_WAIT_V(0); M3_BAR;
    M3_STAGE3(o1, cA + kstep, cB + kstep);
    M3_BAR;
    for (;;) {
        const bool has_next = S.next(ui + 1, nxt);
        const char* nA = has_next ? (const char*)g.A + (size_t)nxt.pm * tstepA + (size_t)nxt.z * g.zA : cA; const char* nB = has_next ? (const char*)g.Bt + (size_t)nxt.pn * tstepB + (size_t)nxt.z * g.zB : cB;
        for (int t = 0; t < nt; ++t) {
            const bool wrap = (t + 2 >= nt);
            const char* a2 = wrap ? nA + (size_t)(t + 2 - nt) * kstep : cA + (size_t)(t + 2) * kstep; const char* b2 = wrap ? nB + (size_t)(t + 2 - nt) * kstep : cB + (size_t)(t + 2) * kstep;
            M3_LDB(B0, o0, 0); M3_LDB(B1, o0, 1); M3_SCHED; M3_LDA(At, o0); M3_STAGE3(o2, a2, b2);
            if (t == nt - 2) { M3_SCHED; E.prefetch(gp, cur, wr, wc, fr, fq); M3_SCHED; }
            if (wrap) M3_WAIT_V(14); else M3_WAIT_V(6);
            M3_WAIT_L(0); M3_BAR; M3_MMA(0, At, B0); M3_MMA(1, At, B1); M3_BAR; M3_SCHED;
            { const int r = o0; o0 = o1; o1 = o2; o2 = r; }
        }
        if (wr == 0) M3_BAR;
        E(acc, tot, gp, cur, wr, wc, fr, fq);
        if (!has_next) break;
#pragma unroll
        for (int b = 0; b < 2; ++b)
#pragma unroll
            for (int m = 0; m < 4; ++m)
#pragma unroll
                for (int n = 0; n < 2; ++n) acc[b][m][n] = (f32x4){0.f, 0.f, 0.f, 0.f};
        cur = nxt; cA = nA; cB = nB; ++ui;
        if (wr == 1) M3_BAR;
    }
    M3_WAIT_V(0);
    M3_BAR;
#undef M3_STAGE
#undef M3_STAGE3
#undef M3_LDA
#undef M3_LDB
#undef M3_MMA
#undef M3_WAIT_V
#undef M3_WAIT_L
#undef M3_BAR
#undef M3_SCHED
}
}

constexpr size_t MiB = 1u << 20;
constexpr size_t WS_CTL = 0, CTL_ZERO_BYTES = 1 * MiB;
constexpr size_t WS_ROPE = 1 * MiB;
constexpr size_t WS_BTAB = 2 * MiB;
constexpr size_t WS_PMM = WS_BTAB + 16 * 256 * 4;
constexpr size_t WS_AFF = WS_PMM + 128 * 2 * 4 + 64;
constexpr size_t WS_LAM = WS_AFF + 64;
constexpr size_t WS_KMEAN = 3 * MiB;
constexpr size_t WS_W = 4 * MiB;
constexpr size_t W_IN = 0, W_IN8 = 32 * MiB  , W_UQ = 51 * MiB, W_UKV = W_UQ + 768 * 512 * 2, W_BR = W_UKV + 1024 * 256 * 2, W_OUT = W_BR + 8 * MiB, W_UP = W_OUT + 8 * MiB, W_DN = W_UP + 44 * MiB, W_LAYER = W_DN + 22 * MiB;
constexpr size_t WS_X = WS_W + DEPTH * W_LAYER;
constexpr size_t WS_XN = WS_X + 128 * MiB;
constexpr size_t WS_MG = WS_XN + 64 * MiB;
constexpr size_t WS_Z = WS_MG + 64 * MiB;
constexpr size_t WS_CQN = WS_Z + 408 * MiB;
constexpr size_t WS_CKVN = WS_CQN + 16 * MiB;
constexpr size_t WS_KR = WS_CKVN + 8 * MiB;
constexpr size_t WS_QMLA = WS_KR + 2 * MiB;
constexpr size_t WS_KVMLA = WS_QMLA + 24 * MiB;
constexpr size_t WS_BRO = WS_KVMLA + 32 * MiB;
constexpr size_t WS_T = WS_BRO + 64 * MiB;
constexpr size_t WS_DSCR = WS_T + 176 * MiB;
constexpr size_t WS_SSQ = WS_DSCR;
constexpr size_t WS_END = WS_DSCR + 32 * MiB;
static_assert(W_LAYER * 1 == (size_t)(51 * MiB + 768 * 512 * 2 + 1024 * 256 * 2 + 82 * MiB), "weight map");
static_assert((size_t)M * ZLD * 2 == 408 * MiB && (size_t)M * UP_N * 2 <= 408 * MiB && (size_t)M * FFN * 2 == 176 * MiB, "buffer sizes");
constexpr int CW_TMO = 0;
constexpr int CW_QUEUE = 8192;
constexpr int CW_BAR = 4096;

constexpr int RING_OFF = 0, RING_BYTES = 131072;
constexpr int LDS_BYTES = 163840;
constexpr int LDSCTL_OFF = LDS_BYTES - 1024, MISC_OFF = LDSCTL_OFF + 320;
constexpr int NWAVES = 8;

typedef GAS unsigned gu32;
#define RLX_AGENT __ATOMIC_RELAXED, __HIP_MEMORY_SCOPE_AGENT
#define LDS_WAIT() asm volatile("s_waitcnt lgkmcnt(0)" ::: "memory")
#define XB_TMO      128
#define XB_XCNT(j)  (256  + 64 * (j))
#define XB_XSUB(j)  (1280 + 64 * (j))
#define XB_XGEN(j)  (2304 + 64 * (j))
#define XB_TOP      3328
#define XB_TOPGEN   3392
#define XCD_BAR_WORDS 3456
#define XB_SPIN_CAP (1u << 22)
__device__ __forceinline__ unsigned xb_ld(unsigned* p)              { return __hip_atomic_load(p, __ATOMIC_RELAXED, __HIP_MEMORY_SCOPE_AGENT); }
__device__ __forceinline__ unsigned xb_add(unsigned* p, unsigned v) { return __hip_atomic_fetch_add(p, v, __ATOMIC_RELAXED, __HIP_MEMORY_SCOPE_AGENT); }
__device__ __forceinline__ unsigned xb_xcc_id() { return (unsigned)__builtin_amdgcn_s_getreg((3 << 11) | 20) & 0xFu; }
#define XB_SPIN(cond, bar) do { unsigned _sp = 0; while (cond) { __builtin_amdgcn_s_sleep(1); \
    if ((++_sp & 255u) == 0u) { if (xb_ld(&(bar)[XB_TMO])) break; if (_sp > XB_SPIN_CAP) { atomicAdd(&(bar)[XB_TMO], 1u); break; } } } } while (0)
struct XcdBarrier { unsigned* bar; unsigned x; volatile LAS unsigned* st; int wave; };
__device__ __forceinline__ XcdBarrier xcd_barrier_post(unsigned* bar, volatile LAS unsigned* st, int wave) {
    XcdBarrier b; b.bar = bar; b.x = xb_xcc_id(); b.st = st; b.wave = wave;
    if (is_thread0(wave)) (void)xb_add(&bar[XB_XCNT(b.x)], 1u);
    return b;
}
__device__ __forceinline__ void xcd_barrier_complete(unsigned* bar, unsigned x, unsigned& nloc, unsigned& nx) {
    const unsigned G = gridDim.x * gridDim.y * gridDim.z;
    unsigned sum, cnt, mine, sp = 0u;
    for (;;) {
        sum = 0u; cnt = 0u; mine = 0u;
#pragma unroll
        for (unsigned j = 0; j < 16; ++j) { const unsigned c = xb_ld(&bar[XB_XCNT(j)]); sum += c; cnt += (c > 0u) ? 1u : 0u; mine = (j == x) ? c : mine; }
        if (sum == G) break;
        __builtin_amdgcn_s_sleep(1);
        if ((++sp & 255u) == 0u) { if (xb_ld(&bar[XB_TMO])) break; if (sp > XB_SPIN_CAP) { atomicAdd(&bar[XB_TMO], 1u); break; } }
    }
    nloc = mine > 0u ? mine : 1u; nx = cnt > 0u ? cnt : 1u;
}
__device__ __forceinline__ void xcd_barrier(const XcdBarrier& b) {
    asm volatile("s_waitcnt vmcnt(0)" ::: "memory");
    __syncthreads();
    if (is_thread0(b.wave)) {
        unsigned* bar = b.bar;
        __builtin_amdgcn_s_waitcnt(0);
        unsigned nloc = b.st[0], nx = b.st[1];
        if (nloc == 0u) { xcd_barrier_complete(bar, b.x, nloc, nx); b.st[0] = nloc; b.st[1] = nx; }
        const unsigned old = xb_add(&bar[XB_XSUB(b.x)], 1u);
        const unsigned gen = old / nloc;
        if (old + 1u == (gen + 1u) * nloc) {
            __builtin_amdgcn_fence(__ATOMIC_RELEASE, "agent");
            asm volatile("s_waitcnt vmcnt(0)" ::: "memory");
            const unsigned og = xb_add(&bar[XB_TOP], 1u);
            const unsigned tg = og / nx;
            if (og + 1u == (tg + 1u) * nx) xb_add(&bar[XB_TOPGEN], 1u);
            else XB_SPIN(xb_ld(&bar[XB_TOPGEN]) == tg, bar);
            __builtin_amdgcn_fence(__ATOMIC_ACQUIRE, "agent");
            xb_add(&bar[XB_XGEN(b.x)], 1u);
            asm volatile("s_waitcnt vmcnt(0)" ::: "memory");
        } else {
            XB_SPIN(xb_ld(&bar[XB_XGEN(b.x)]) == gen, bar);
            __builtin_amdgcn_fence(__ATOMIC_ACQUIRE, "agent");
            asm volatile("s_waitcnt vmcnt(0)" ::: "memory");
        }
    }
    __syncthreads();
}

namespace att {
template <int DK0_, int DK1_, int DV_, int NQL_ = 0, int NDC_ = 0> struct Cfg {
    static constexpr int DK0 = DK0_, DK1 = DK1_, DK = DK0_ + DK1_, DV = DV_;
    static constexpr int KP = DK * 2 + 16, VP = DV * 2 + 64;
    static constexpr int KOFF = 0, VOFF = 64 * KP, POFF = VOFF + 64 * VP, BUFB = POFF + 256;
    static constexpr int NKC = (64 * DK / 8) / 512, NVC = (64 * DV / 8) / 512;
    static constexpr int ND = NDC_ > 0 ? NDC_ : DK / 16, NO = DV / 32;
    static constexpr int NQL = NQL_, NQR = ND - NQL_;
};
constexpr int BTAB_OFF = 94208, KMEAN_OFF = 94208 + 1024, QL_OFF = 92672;
struct Src { const bf16_t* k0; int pk0; const bf16_t* k1; int pk1; const bf16_t* v; int pv; const int* pos; };
#if PROF_BUILD
struct WaveCtx { int lane, r32, hi, wid, tid, koff; unsigned long long* prof; };
#define PCLK() ((unsigned)clock64())
#else
struct WaveCtx { int lane, r32, hi, wid, tid, koff; };
#endif

template <class C, bool WITH_POS> struct Stage {
    u32x4 kr[C::NKC]; u32x4 vr[C::NVC]; int pr;
    __device__ __forceinline__ void load(const Src& s, int t, int tid) {
        const int kb = t * 64;
#pragma unroll
        for (int i = 0; i < C::NKC; ++i) { const int id = tid + 512 * i, row = id / (C::DK / 8), c = id % (C::DK / 8);
            const bf16_t* p = (C::DK1 == 0 || c < C::DK0 / 8) ? s.k0 + (size_t)(kb + row) * s.pk0 + c * 8 : s.k1 + (size_t)(kb + row) * s.pk1 + (c - C::DK0 / 8) * 8;
            kr[i] = *(const u32x4*)p; }
#pragma unroll
        for (int i = 0; i < C::NVC; ++i) { const int id = tid + 512 * i, row = id / (C::DV / 8), c = id % (C::DV / 8);
            vr[i] = *(const u32x4*)(s.v + (size_t)(kb + row) * s.pv + c * 8); }
        pr = (WITH_POS && tid < 64) ? s.pos[kb + tid] : 0;
    }
    __device__ __forceinline__ void store(LAS unsigned char* buf, int tid) const {
#pragma unroll
        for (int i = 0; i < C::NKC; ++i) { const int id = tid + 512 * i, row = id / (C::DK / 8), c = id % (C::DK / 8); *(LAS u32x4*)(buf + C::KOFF + row * C::KP + c * 16) = kr[i]; }
#pragma unroll
        for (int i = 0; i < C::NVC; ++i) { const int id = tid + 512 * i, row = id / (C::DV / 8), c = id % (C::DV / 8); *(LAS u32x4*)(buf + C::VOFF + row * C::VP + c * 16) = vr[i]; }
        if (WITH_POS && tid < 64) *(LAS int*)(buf + C::POFF + tid * 4) = pr;
    }
};
__device__ __forceinline__ s16x4 vtr(const LAS unsigned char* p) { typedef short v4i16_t __attribute__((ext_vector_type(4))); return __builtin_bit_cast(s16x4, __builtin_amdgcn_ds_read_tr16_b64_v4i16((LAS v4i16_t*)p)); }

struct RowState { float m, l; };

template <class C, int KIND, bool BIAS, bool VPRE>
__device__ __forceinline__ void tile_compute(const LAS unsigned char* buf, const LAS float* btab, const bf16x8 (&qf)[C::NQR], const LAS unsigned char* qlb, f32x16 (&O)[C::NO], RowState& st,
                                             int k0, int qw, int posq, int pminq, unsigned long long farlo, unsigned long long farhi, unsigned long long afflo, unsigned long long affhi, unsigned selmask, int blk, const WaveCtx& w) {
    const int qi = qw + w.r32;
#pragma unroll
    for (int p = 0; p < 2; ++p) {
        const int ks = k0 + 32 * p;
        bool causal_tile = true, sel_lane = true, skip = false, fast = false;
        if (KIND == 0) { skip = ks > qw + 31; fast = (ks + 31 <= qw); }
        if (KIND == 1) { skip = (ks > qw + 31) || (ks + 31 < qw - 127); }
        if (KIND == 2) {
            const int n = ks >> 8;
            if (n < blk) { causal_tile = false; sel_lane = ((selmask >> n) & 1u) != 0u; skip = !__any(sel_lane); fast = (bool)__all(sel_lane); }
            else { skip = ks > qw + 31; fast = (ks + 31 <= qw); }
        }
        if (skip) continue;
        if (BIAS && fast) { const int kb32 = ks >> 5; fast = (((kb32 < 64 ? farlo >> kb32 : farhi >> (kb32 - 64)) & 1ull) != 0ull); }
        f32x16 sc;
#pragma unroll
        for (int r = 0; r < 16; ++r) sc[r] = 0.f;
        const LAS unsigned char* kb = buf + C::KOFF + (32 * p + w.r32) * C::KP + w.hi * 16 + w.koff;
#pragma unroll
        for (int d0 = 0; d0 < C::ND; ++d0) {
            const bf16x8 a0 = *(const LAS bf16x8*)(kb + d0 * 32);
            const bf16x8 qv = (d0 < C::NQR) ? qf[d0 < C::NQR ? d0 : 0] : *(const LAS bf16x8*)(qlb + (d0 - C::NQR) * 1024);
            sc = __builtin_amdgcn_mfma_f32_32x32x16_bf16(a0, qv, sc, 0, 0, 0);
        }
        s16x4 vl[2][C::NO], vh[2][C::NO];
        if constexpr (VPRE) {
            const unsigned va = (unsigned)(__UINTPTR_TYPE__)(buf + C::VOFF + (32 * p + 4 * w.hi + ((w.lane & 15) >> 2)) * C::VP + (16 * ((w.lane >> 4) & 1) + 4 * (w.lane & 3)) * 2);
#pragma unroll
            for (int s = 0; s < 2; ++s)
#pragma unroll
                for (int d = 0; d < C::NO; ++d) {
                    asm volatile("ds_read_b64_tr_b16 %0, %1 offset:%2" : "=v"(vl[s][d]) : "v"(va), "n"((16 * s) * C::VP + d * 64));
                    asm volatile("ds_read_b64_tr_b16 %0, %1 offset:%2" : "=v"(vh[s][d]) : "v"(va), "n"((16 * s + 8) * C::VP + d * 64));
                }
            __builtin_amdgcn_sched_barrier(0);
        }
        if (fast) {
            if (BIAS) { const float bc = btab[64 + 128];
#pragma unroll
                for (int r = 0; r < 16; ++r) sc[r] += bc; }
        } else {
            bool aff = false; int posk0 = 0;
            if (BIAS) {
                const int kb32 = ks >> 5, qb32 = qw >> 5;
                aff = (((kb32 < 64 ? afflo >> kb32 : affhi >> (kb32 - 64)) & 1ull) != 0ull) && (((qb32 < 64 ? afflo >> qb32 : affhi >> (qb32 - 64)) & 1ull) != 0ull);
                if (aff) { posk0 = __builtin_amdgcn_readfirstlane(*(const LAS int*)(buf + C::POFF + (32 * p) * 4)); aff = (pminq - posk0 - 31 >= -62) && (pminq + 31 - posk0 <= 191); }
            }
            if (aff) {
                const LAS float* tb = btab + (posq - posk0 + 64 - 4 * w.hi - 27);
#pragma unroll
                for (int r = 0; r < 16; ++r) {
                    const int c = (r & 3) + 8 * (r >> 2), kv = ks + c + 4 * w.hi;
                    const float v = sc[r] + tb[27 - c];
                    bool valid;
                    if (KIND == 0) valid = kv <= qi;
                    else if (KIND == 1) valid = (unsigned)(qi - kv) < 128u;
                    else valid = causal_tile ? (kv <= qi) : sel_lane;
                    sc[r] = valid ? v : NEG_INF;
                }
            } else {
#pragma unroll
            for (int g4 = 0; g4 < 4; ++g4) {
                i32x4 pk = (i32x4){0, 0, 0, 0};
                if (BIAS) pk = *(const LAS i32x4*)(buf + C::POFF + (32 * p + 8 * g4 + 4 * w.hi) * 4);
#pragma unroll
                for (int e = 0; e < 4; ++e) {
                    const int r = 4 * g4 + e, kv = ks + 8 * g4 + 4 * w.hi + e;
                    float v = sc[r];
                    if (BIAS) { int d = posq - pk[e]; d = d < 0 ? 0 : (d > 128 ? 128 : d); v += btab[64 + d]; }
                    bool valid;
                    if (KIND == 0) valid = kv <= qi;
                    else if (KIND == 1) valid = (unsigned)(qi - kv) < 128u;
                    else valid = causal_tile ? (kv <= qi) : sel_lane;
                    sc[r] = valid ? v : NEG_INF;
                }
            }
            }
        }
        float tmax = sc[0];
#pragma unroll
        for (int r = 1; r < 16; ++r) tmax = fmaxf(tmax, sc[r]);
        { const auto rr = __builtin_amdgcn_permlane32_swap(__float_as_uint(tmax), __float_as_uint(tmax), false, false); tmax = fmaxf(__uint_as_float(rr[0]), __uint_as_float(rr[1])); }
        const float mn = fmaxf(st.m, tmax);
        const float alpha = __builtin_amdgcn_exp2f(st.m - mn);
        st.m = mn;
        float ps = 0.f;
#pragma unroll
        for (int r = 0; r < 16; ++r) { sc[r] = __builtin_amdgcn_exp2f(sc[r] - mn); ps += sc[r]; }
        st.l = st.l * alpha + ps;
        if (__any(alpha != 1.0f)) {
#pragma unroll
            for (int d = 0; d < C::NO; ++d)
#pragma unroll
                for (int r = 0; r < 16; ++r) O[d][r] *= alpha;
        }
#pragma unroll
        for (int s = 0; s < 2; ++s) {
            u32x4 t; const int b = 8 * s;
            t.x = cvt_pk_bf16(sc[b], sc[b + 1]); t.y = cvt_pk_bf16(sc[b + 2], sc[b + 3]); t.z = cvt_pk_bf16(sc[b + 4], sc[b + 5]); t.w = cvt_pk_bf16(sc[b + 6], sc[b + 7]);
            const bf16x8 pf = __builtin_bit_cast(bf16x8, t);
            if constexpr (VPRE) {
                if (s == 0) { asm volatile("s_waitcnt lgkmcnt(0)" ::: "memory"); __builtin_amdgcn_sched_barrier(0); }
#pragma unroll
                for (int d = 0; d < C::NO; ++d) {
                    const bf16x8 vf = (bf16x8){vl[s][d][0], vl[s][d][1], vl[s][d][2], vl[s][d][3], vh[s][d][0], vh[s][d][1], vh[s][d][2], vh[s][d][3]};
                    O[d] = __builtin_amdgcn_mfma_f32_32x32x16_bf16(vf, pf, O[d], 0, 0, 0);
                }
            } else {
                const LAS unsigned char* vb = buf + C::VOFF + (32 * p + 4 * w.hi + ((w.lane & 15) >> 2)) * C::VP + (16 * ((w.lane >> 4) & 1) + 4 * (w.lane & 3)) * 2;
#pragma unroll
                for (int d = 0; d < C::NO; ++d) {
                    const s16x4 lo = vtr(vb + (16 * s) * C::VP + d * 64), hi4 = vtr(vb + (16 * s + 8) * C::VP + d * 64);
                    const bf16x8 vf = (bf16x8){lo[0], lo[1], lo[2], lo[3], hi4[0], hi4[1], hi4[2], hi4[3]};
                    O[d] = __builtin_amdgcn_mfma_f32_32x32x16_bf16(vf, pf, O[d], 0, 0, 0);
                }
            }
        }
    }
}

constexpr float ATT_THR = 8.0f;
template <class C, bool VPRE>
__device__ __forceinline__ void tile64_fast(const LAS unsigned char* buf, const bf16x8 (&qf)[C::NQR], const LAS unsigned char* qlb, f32x16 (&O)[C::NO], RowState& st, float& nm, const WaveCtx& w) {
    f32x16 s0, s1;
    const LAS unsigned char* kb = buf + C::KOFF + w.r32 * C::KP + w.hi * 16 + w.koff;
#pragma unroll
    for (int r = 0; r < 16; ++r) { s0[r] = 0.f; s1[r] = 0.f; }
#pragma unroll
    for (int d0 = 0; d0 < C::ND; ++d0) {
        const bf16x8 a0 = *(const LAS bf16x8*)(kb + d0 * 32), a1 = *(const LAS bf16x8*)(kb + 32 * C::KP + d0 * 32);
        const bf16x8 qv = (d0 < C::NQR) ? qf[d0 < C::NQR ? d0 : 0] : *(const LAS bf16x8*)(qlb + (d0 - C::NQR) * 1024);
        s0 = __builtin_amdgcn_mfma_f32_32x32x16_bf16(a0, qv, s0, 0, 0, 0); s1 = __builtin_amdgcn_mfma_f32_32x32x16_bf16(a1, qv, s1, 0, 0, 0);
    }
    const unsigned va = (unsigned)(__UINTPTR_TYPE__)(buf + C::VOFF + (4 * w.hi + ((w.lane & 15) >> 2)) * C::VP + (16 * ((w.lane >> 4) & 1) + 4 * (w.lane & 3)) * 2);
    const LAS unsigned char* vb = buf + C::VOFF + (4 * w.hi + ((w.lane & 15) >> 2)) * C::VP + (16 * ((w.lane >> 4) & 1) + 4 * (w.lane & 3)) * 2;
    s16x4 vl[C::NO], vh[C::NO];
#define ATT_VREADS(KS) do { if constexpr (VPRE) { _Pragma("unroll") for (int d = 0; d < C::NO; ++d) { \
        asm volatile("ds_read_b64_tr_b16 %0, %1 offset:%2" : "=v"(vl[d]) : "v"(va), "n"((16 * (KS)) * C::VP + d * 64)); \
        asm volatile("ds_read_b64_tr_b16 %0, %1 offset:%2" : "=v"(vh[d]) : "v"(va), "n"((16 * (KS) + 8) * C::VP + d * 64)); } \
        __builtin_amdgcn_sched_barrier(0); } } while (0)
#define ATT_PVSTEP(SP, KS, NEXT) do { u32x4 tq; const int b_ = 8 * ((KS) & 1); \
        tq.x = cvt_pk_bf16(SP[b_], SP[b_ + 1]); tq.y = cvt_pk_bf16(SP[b_ + 2], SP[b_ + 3]); tq.z = cvt_pk_bf16(SP[b_ + 4], SP[b_ + 5]); tq.w = cvt_pk_bf16(SP[b_ + 6], SP[b_ + 7]); \
        const bf16x8 pf = __builtin_bit_cast(bf16x8, tq); \
        if constexpr (VPRE) { asm volatile("s_waitcnt lgkmcnt(0)" ::: "memory"); __builtin_amdgcn_sched_barrier(0); \
            _Pragma("unroll") for (int d = 0; d < C::NO; ++d) { const bf16x8 vf = (bf16x8){vl[d][0], vl[d][1], vl[d][2], vl[d][3], vh[d][0], vh[d][1], vh[d][2], vh[d][3]}; \
                O[d] = __builtin_amdgcn_mfma_f32_32x32x16_bf16(vf, pf, O[d], 0, 0, 0); } \
            __builtin_amdgcn_sched_barrier(0); if ((NEXT) >= 0) ATT_VREADS((NEXT) < 0 ? 0 : (NEXT)); } \
        else { _Pragma("unroll") for (int d = 0; d < C::NO; ++d) { const s16x4 lo = vtr(vb + (16 * (KS)) * C::VP + d * 64), hi4 = vtr(vb + (16 * (KS) + 8) * C::VP + d * 64); \
                const bf16x8 vf = (bf16x8){lo[0], lo[1], lo[2], lo[3], hi4[0], hi4[1], hi4[2], hi4[3]}; \
                O[d] = __builtin_amdgcn_mfma_f32_32x32x16_bf16(vf, pf, O[d], 0, 0, 0); } } } while (0)
#define ATT_SOFT(SP) do { \
        float t_ = fmaxf(SP[0], SP[1]); \
        _Pragma("unroll") for (int r = 2; r < 16; r += 2) t_ = fmaxf(t_, fmaxf(SP[r], SP[r + 1])); \
        { const auto rr = __builtin_amdgcn_permlane32_swap(__float_as_uint(t_), __float_as_uint(t_), false, false); t_ = fmaxf(__uint_as_float(rr[0]), __uint_as_float(rr[1])); } \
        t_ += nm; \
        if (__any(t_ > ATT_THR)) { const float dl = fmaxf(t_, 0.f), f_ = __builtin_amdgcn_exp2f(-dl); st.m += dl; nm -= dl; st.l *= f_; \
            _Pragma("unroll") for (int d = 0; d < C::NO; ++d) _Pragma("unroll") for (int r = 0; r < 16; ++r) O[d][r] *= f_; } \
        float ps_ = 0.f; \
        _Pragma("unroll") for (int r = 0; r < 16; ++r) { SP[r] = __builtin_amdgcn_exp2f(SP[r] + nm); ps_ += SP[r]; } \
        st.l += ps_; } while (0)
    ATT_VREADS(0);
    ATT_SOFT(s0);
    ATT_PVSTEP(s0, 0, 1);
    ATT_PVSTEP(s0, 1, 2);
    ATT_SOFT(s1);
    ATT_PVSTEP(s1, 2, 3);
    ATT_PVSTEP(s1, 3, -1);
#undef ATT_VREADS
#undef ATT_PVSTEP
#undef ATT_SOFT
}

template <class C, int KIND, bool BIAS, bool FASTP, bool VPRE>
__device__ __forceinline__ void run_tiles(LAS unsigned char* lds, const Src& src, int t0, int t1, const bf16x8 (&qf)[C::NQR], f32x16 (&O)[C::NO], RowState& st,
                                          int qw, int posq, int pminq, const int* pmm, unsigned selmask, int blk, const WaveCtx& w, int btab_off = 0) {
    const LAS float* btab = (const LAS float*)(lds + BTAB_OFF + btab_off);
    const LAS unsigned char* qlb = lds + QL_OFF + w.wid * (C::NQL * 1024) + w.lane * 16;
    unsigned long long farlo = 0ull, farhi = 0ull;
    unsigned long long afflo = 0ull, affhi = 0ull;
    if (BIAS) { farlo = __ballot(pminq - pmm[w.lane * 2 + 1] >= 128); farhi = __ballot(pminq - pmm[(w.lane + 64) * 2 + 1] >= 128);
        const unsigned* ap = (const unsigned*)(pmm + 256 + 16);
        afflo = (unsigned long long)__builtin_amdgcn_readfirstlane(ap[0]) | ((unsigned long long)__builtin_amdgcn_readfirstlane(ap[1]) << 32);
        affhi = (unsigned long long)__builtin_amdgcn_readfirstlane(ap[2]) | ((unsigned long long)__builtin_amdgcn_readfirstlane(ap[3]) << 32); }
    float nm = 0.f; bool nvalid = false; int ncur = -1;
    Stage<C, BIAS> sg;
    if (t0 < t1) sg.load(src, t1 - 1, w.tid);
    int it = 0;
#if PROF_BUILD
    unsigned pacc = 0, pn5 = 0, pn6 = 0;
#endif
    for (int t = t1 - 1; t >= t0; --t, ++it) {
        LAS unsigned char* buf = lds + (it & 1) * C::BUFB;
#if PROF_BUILD
        unsigned ca = 0, cb = 0, cc = 0, cd = 0; if (PROF_ID == 1) ca = PCLK();
#endif
        sg.store(buf, w.tid);
#if PROF_BUILD
        if (PROF_ID == 1 || PROF_ID == 2) { asm volatile("s_waitcnt vmcnt(0) lgkmcnt(0)" ::: "memory"); cb = PCLK(); }
#endif
        __syncthreads();
#if PROF_BUILD
        if (PROF_ID == 2 || PROF_ID == 8) cc = PCLK();
#endif
        if (t - 1 >= t0) sg.load(src, t - 1, w.tid);
#if PROF_BUILD
        if (PROF_ID == 8 || PROF_ID == 3 || PROF_ID == 4) cd = PCLK();
#endif
        const int k0 = t * 64;
        bool fastT = false, skipT = false, sel_lane = true; int nb = 0;
        if (FASTP) {
            const int kb32 = k0 >> 5;
            const bool far2 = !BIAS || ((((kb32 < 64 ? farlo >> kb32 : farhi >> (kb32 - 64)) & 3ull) == 3ull));
            if (KIND == 0) fastT = (k0 + 63 <= qw) && far2;
            if (KIND == 2) { nb = k0 >> 8; if (nb < blk) { sel_lane = ((selmask >> nb) & 1u) != 0u; skipT = !__any(sel_lane); fastT = far2; } }
        }
        if (skipT) continue;
        if (fastT) {
            if (!nvalid || (KIND == 2 && nb != ncur)) {
                const float bc = BIAS ? btab[64 + 128] : 0.f; nm = sel_lane ? bc - st.m : NEG_INF;
                nvalid = true; ncur = nb;
            }
            tile64_fast<C, VPRE>(buf, qf, qlb, O, st, nm, w);
        } else {
            tile_compute<C, KIND, BIAS, false>(buf, btab, qf, qlb, O, st, k0, qw, posq, pminq, farlo, farhi, afflo, affhi, selmask, blk, w);
            nvalid = false;
        }
#if PROF_BUILD
        { unsigned ce = 0; if (PROF_ID == 3 || PROF_ID == 4) { asm volatile("s_waitcnt lgkmcnt(0)" ::: "memory"); ce = PCLK(); } if (PROF_ID == 1) pacc += cb - ca; if (PROF_ID == 2) pacc += cc - cb; if (PROF_ID == 8) pacc += cd - cc; if (fastT) { if (PROF_ID == 3) pacc += ce - cd; if (PROF_ID == 5) ++pn5; } else { if (PROF_ID == 4) pacc += ce - cd; if (PROF_ID == 5) ++pn6; } }
#endif
    }
    __syncthreads();
#if PROF_BUILD
    if (w.tid == 0) { unsigned long long* pp = w.prof; if (PROF_ID != 5) atomicAdd(pp + PROF_ID, (unsigned long long)pacc); else { atomicAdd(pp + 5, (unsigned long long)pn5); atomicAdd(pp + 6, (unsigned long long)pn6); } }
#endif
}
template <int ND> __device__ __forceinline__ void load_q(bf16x8 (&qf)[ND], const bf16_t* qrow, int hi) {
#pragma unroll
    for (int d0 = 0; d0 < ND; ++d0) qf[d0] = *(const bf16x8*)(qrow + d0 * 16 + hi * 8);
}
template <int NO> __device__ __forceinline__ void store_o(const f32x16 (&O)[NO], bf16_t* orow, int hi) {
#pragma unroll
    for (int d = 0; d < NO; ++d) {
        unsigned vx[4], vy[4];
#pragma unroll
        for (int g = 0; g < 4; ++g) { vx[g] = cvt_pk_bf16(O[d][4 * g], O[d][4 * g + 1]); vy[g] = cvt_pk_bf16(O[d][4 * g + 2], O[d][4 * g + 3]); }
#pragma unroll
        for (int g = 0; g < 2; ++g) {
            const auto sx = __builtin_amdgcn_permlane32_swap(vx[g], vx[g + 2], false, false), sy = __builtin_amdgcn_permlane32_swap(vy[g], vy[g + 2], false, false);
            u32x4 w; w.x = sx[0]; w.y = sy[0]; w.z = sx[1]; w.w = sy[1];
            *(u32x4*)(orow + 32 * d + 8 * (g + 2 * hi)) = w; }
    }
}
}

struct Args { const float* in[20]; float* out; unsigned char* ws; int ph_lo, ph_hi; };
constexpr int PH_PER_LAYER = 13, N_PHASES = 2 + DEPTH * PH_PER_LAYER;

struct Frame {
    LAS unsigned char* lds; volatile LAS unsigned* MISC; unsigned* ctl;
    int tid, lane, wave, G, vcu;
    unsigned char* ws;
};

__device__ __forceinline__ void transpose_item(const float* W, int K, int Nsrc, bf16_t* WT, int Ndst, int pad_lo, int pad_hi, int shift, LAS float* scr, int item, int lane, const float* gk = nullptr) {
    const int nblk = Ndst / 32, kb = item / nblk, nb = item % nblk, k0 = 64 * kb, n0 = 32 * nb;
    const bool pad = (n0 >= pad_lo && n0 < pad_hi);
    int ns0 = n0 - (n0 >= pad_hi ? shift : 0);
    if (shift < 0) { const int pn = n0 >> 8, w0 = n0 & 255; ns0 = (w0 < 128) ? 128 * pn + w0 : FFN + 128 * pn + (w0 - 128); }
    if (!pad) {
        if (gk) {
            const float gl = gk[k0 + lane];
#pragma unroll 8
            for (int i = 0; i < 32; ++i) { const int kk = 2 * i + (lane >> 5);
                const float g0 = __uint_as_float(__builtin_amdgcn_readlane(__float_as_uint(gl), 2 * i)), g1 = __uint_as_float(__builtin_amdgcn_readlane(__float_as_uint(gl), 2 * i + 1));
                scr[kk * 33 + (lane & 31)] = W[(size_t)(k0 + kk) * Nsrc + ns0 + (lane & 31)] * ((lane >> 5) ? g1 : g0); }
        } else {
#pragma unroll 8
            for (int i = 0; i < 32; ++i) { const int kk = 2 * i + (lane >> 5); scr[kk * 33 + (lane & 31)] = W[(size_t)(k0 + kk) * Nsrc + ns0 + (lane & 31)]; }
        }
    }
    LDS_WAIT(); asm volatile("" ::: "memory");
    const int c = lane & 7;
#pragma unroll
    for (int j = 0; j < 4; ++j) { const int n = (lane >> 3) + 8 * j; const LAS float* s = scr + (8 * c) * 33 + n;
        u32x4 o = (u32x4){0u, 0u, 0u, 0u};
        if (!pad) { o.x = cvt_pk_bf16(s[0 * 33], s[1 * 33]); o.y = cvt_pk_bf16(s[2 * 33], s[3 * 33]); o.z = cvt_pk_bf16(s[4 * 33], s[5 * 33]); o.w = cvt_pk_bf16(s[6 * 33], s[7 * 33]); }
        *(u32x4*)(WT + (size_t)(n0 + n) * K + k0 + 8 * c) = o; }
    LDS_WAIT(); asm volatile("" ::: "memory");
}
constexpr float W8_SCALE = 64.0f;
__device__ __forceinline__ unsigned pk4_fp8(float a, float b, float c, float d) { int w = __builtin_amdgcn_cvt_pk_fp8_f32(a, b, 0, false); w = __builtin_amdgcn_cvt_pk_fp8_f32(c, d, w, true); return (unsigned)w; }
__device__ __forceinline__ void transpose_item_f8(const float* W, int K, int Nsrc, int col0, unsigned char* W8, int N8, LAS float* scr, int item, int lane, const float* gk) {
    const int nblk = N8 / 32, kb = item / nblk, nb = item % nblk, k0 = 64 * kb, n0 = 32 * nb;
    const float gl = gk[k0 + lane] * W8_SCALE;
#pragma unroll 8
    for (int i = 0; i < 32; ++i) { const int kk = 2 * i + (lane >> 5);
        const float g0 = __uint_as_float(__builtin_amdgcn_readlane(__float_as_uint(gl), 2 * i)), g1 = __uint_as_float(__builtin_amdgcn_readlane(__float_as_uint(gl), 2 * i + 1));
        scr[kk * 33 + (lane & 31)] = W[(size_t)(k0 + kk) * Nsrc + col0 + n0 + (lane & 31)] * ((lane >> 5) ? g1 : g0); }
    LDS_WAIT(); asm volatile("" ::: "memory");
    const int c = lane & 7;
#pragma unroll
    for (int j = 0; j < 4; ++j) { const int n = (lane >> 3) + 8 * j; const LAS float* sp = scr + (8 * c) * 33 + n;
        u32x2 o; o.x = pk4_fp8(sp[0 * 33], sp[1 * 33], sp[2 * 33], sp[3 * 33]); o.y = pk4_fp8(sp[4 * 33], sp[5 * 33], sp[6 * 33], sp[7 * 33]);
        *(u32x2*)(W8 + (size_t)(n0 + n) * K + k0 + 8 * c) = o; }
    LDS_WAIT(); asm volatile("" ::: "memory");
}
__device__ __forceinline__ int t5_bucket(int n) {
    if (n < 16) return n;
    int b = 16;
    b += (n >= 19); b += (n >= 21); b += (n >= 24); b += (n >= 27); b += (n >= 31); b += (n >= 35); b += (n >= 40); b += (n >= 46);
    b += (n >= 52); b += (n >= 59); b += (n >= 67); b += (n >= 77); b += (n >= 87); b += (n >= 99); b += (n >= 113);
    return b;
}
template <bool WITH_F8>
__device__ __forceinline__ void rms_row_bf16(const float* x32, const bf16_t* x16, const float* g, bf16_t* orow, unsigned char* orow8, int lane) {
    f32x4 v[8]; float s = 0.f;
    if (x32) {
#pragma unroll
        for (int j = 0; j < 8; ++j) v[j] = *((const f32x4*)x32 + lane + 64 * j);
    } else {
#pragma unroll
        for (int j = 0; j < 8; ++j) { const u32x2 p = *((const u32x2*)x16 + lane + 64 * j); v[j] = (f32x4){bflo(p.x), bfhi(p.x), bflo(p.y), bfhi(p.y)}; }
    }
#pragma unroll
    for (int j = 0; j < 8; ++j) s += (v[j].x * v[j].x + v[j].y * v[j].y) + (v[j].z * v[j].z + v[j].w * v[j].w);
    const float rstd = 1.0f / sqrtf(wave_sum(s) * (1.0f / DM) + EPS);
#pragma unroll
    for (int j = 0; j < 8; ++j) { const f32x4 gg = *((const f32x4*)g + lane + 64 * j);
        u32x2 o; o.x = cvt_pk_bf16(v[j].x * rstd * gg.x, v[j].y * rstd * gg.y); o.y = cvt_pk_bf16(v[j].z * rstd * gg.z, v[j].w * rstd * gg.w);
        *((u32x2*)orow + lane + 64 * j) = o;
        if (WITH_F8) *((unsigned*)orow8 + lane + 64 * j) = pk4_fp8(v[j].x * rstd * gg.x, v[j].y * rstd * gg.y, v[j].z * rstd * gg.z, v[j].w * rstd * gg.w); }
}
__device__ __forceinline__ void cvt_row_in(const float* x32, bf16_t* xb, unsigned char* x8, unsigned long long* sq, int lane) {
    float s = 0.f;
#pragma unroll
    for (int j = 0; j < 8; ++j) { const f32x4 v = *((const f32x4*)x32 + lane + 64 * j);
        u32x2 o; o.x = cvt_pk_bf16(v.x, v.y); o.y = cvt_pk_bf16(v.z, v.w);
        *((u32x2*)xb + lane + 64 * j) = o;
        const float a = bflo(o.x), b = bfhi(o.x), c = bflo(o.y), d = bfhi(o.y);
        *((unsigned*)x8 + lane + 64 * j) = pk4_fp8(a, b, c, d);
        s += (a * a + b * b) + (c * c + d * d); }
    s = wave_sum(s);
    if (lane == 0) { const unsigned hi = (unsigned)s; const unsigned lo = (unsigned)((s - (float)hi) * 16777216.0f); *sq = ((unsigned long long)hi << 24) + lo; }
}
__device__ __forceinline__ void rms_row_f32(const bf16_t* xrow, const float* g, float* orow, int lane) {
    f32x4 v[8]; float s = 0.f;
#pragma unroll
    for (int j = 0; j < 8; ++j) { const u32x2 p = *((const u32x2*)xrow + lane + 64 * j); v[j] = (f32x4){bflo(p.x), bfhi(p.x), bflo(p.y), bfhi(p.y)}; s += (v[j].x * v[j].x + v[j].y * v[j].y) + (v[j].z * v[j].z + v[j].w * v[j].w); }
    const float rstd = 1.0f / sqrtf(wave_sum(s) * (1.0f / DM) + EPS);
#pragma unroll
    for (int j = 0; j < 8; ++j) { const f32x4 gg = *((const f32x4*)g + lane + 64 * j); *((f32x4*)orow + lane + 64 * j) = v[j] * rstd * gg; }
}

__device__ __forceinline__ float gelu_f(float v) {
    const float av = fabsf(v), d = av * 0.2316418882f + 1.0f;
    const float t = __builtin_amdgcn_rcpf(d);
    float q = t * 0.5307027145f + (-0.7265760135f); q = q * t + 0.7107068705f; q = q * t + (-0.142248368f); q = q * t + 0.127414796f; q = q * t;
    const float e = __builtin_amdgcn_exp2f((v * v) * (-0.72134752044f));
    const float m = v * (q * e), r = v - m;
    return v < 0.f ? m : r;
}

__device__ __forceinline__ void p_prologue(Frame& F, const Args& a) {
    const int otid = opaque_tid(F.wave), olane = otid & 63;
    LAS float* scr = (LAS float*)(F.lds + RING_OFF + F.wave * 16384);
    const int gw = F.vcu * NWAVES + F.wave, NGW = F.G * NWAVES;
    constexpr int I_IN = (DM / 64) * (ZG / 32) + (DM / 64) * (4 * DM / 32), I_INB = (DM / 64) * (ZG / 32), I_UQ = (512 / 64) * (768 / 32), I_UKV = (256 / 64) * (1024 / 32), I_BR1 = (512 / 64) * (DM / 32), I_BR = 4 * I_BR1,
                  I_OUT = (DM / 64) * (DM / 32), I_UP = (DM / 64) * (UP_N / 32), I_DN = (FFN / 64) * (DM / 32);
    constexpr int I_LAYER = I_IN + I_UQ + I_UKV + I_BR + I_OUT + I_UP + I_DN;
    for (int it = gw; it < DEPTH * I_LAYER; it += NGW) {
        const int l = it / I_LAYER; int r = it - l * I_LAYER;
        unsigned char* wl = F.ws + WS_W + (size_t)l * W_LAYER;
        if (r < I_INB) { transpose_item(a.in[4] + (size_t)l * DM * IN_COLS, DM, IN_COLS, (bf16_t*)(wl + W_IN), ZG, 2368, 2560, 192, scr, r, olane, a.in[3] + (size_t)l * DM); continue; }
        if (r < I_IN) { transpose_item_f8(a.in[4] + (size_t)l * DM * IN_COLS, DM, IN_COLS, 4672, wl + W_IN8, 4 * DM, scr, r - I_INB, olane, a.in[3] + (size_t)l * DM); continue; } r -= I_IN;
        if (r < I_UQ) { transpose_item(a.in[8] + (size_t)l * 512 * 768, 512, 768, (bf16_t*)(wl + W_UQ), 768, 1 << 30, 1 << 30, 0, scr, r, olane, a.in[7] + (size_t)l * 512); continue; } r -= I_UQ;
        if (r < I_UKV) { transpose_item(a.in[10] + (size_t)l * 256 * 1024, 256, 1024, (bf16_t*)(wl + W_UKV), 1024, 1 << 30, 1 << 30, 0, scr, r, olane, a.in[9] + (size_t)l * 256); continue; } r -= I_UKV;
        if (r < I_BR) { const int i = r / I_BR1; transpose_item(a.in[12] + ((size_t)l * 4 + i) * 512 * DM, 512, DM, (bf16_t*)(wl + W_BR) + (size_t)i * DM * 512, DM, 1 << 30, 1 << 30, 0, scr, r - i * I_BR1, olane); continue; } r -= I_BR;
        if (r < I_OUT) { transpose_item(a.in[13] + (size_t)l * DM * DM, DM, DM, (bf16_t*)(wl + W_OUT), DM, 1 << 30, 1 << 30, 0, scr, r, olane); continue; } r -= I_OUT;
        if (r < I_UP) { transpose_item(a.in[15] + (size_t)l * DM * UP_N, DM, UP_N, (bf16_t*)(wl + W_UP), UP_N, 1 << 30, 1 << 30, -1, scr, r, olane, a.in[14] + (size_t)l * DM); continue; } r -= I_UP;
        transpose_item(a.in[18] + (size_t)l * FFN * DM, FFN, DM, (bf16_t*)(wl + W_DN), DM, 1 << 30, 1 << 30, 0, scr, r, olane);
    }
    const int* pos = (const int*)a.in[1];
    const int gt = F.vcu * (NWAVES * 64) + otid, NGT = F.G * NWAVES * 64;
    { unsigned long long* sq = (unsigned long long*)(F.ws + WS_SSQ); for (int e = gt; e < DEPTH * 4 * M; e += NGT) sq[e] = 0ull; }
    f32x2* rope = (f32x2*)(F.ws + WS_ROPE);
    for (int e = gt; e < SEQ * 32; e += NGT) {
        const int s = e >> 5, i = e & 31;
        const float inv = (float)exp2((double)(-i) * (13.287712379549449 / 32.0));
        const float ang = (float)pos[s] * inv;
        const double rev = (double)ang * 0.15915494309189535;
        const float fr = (float)(rev - rint(rev));
        rope[e] = (f32x2){__builtin_amdgcn_cosf(fr), __builtin_amdgcn_sinf(fr)};
    }
    float* btab = (float*)(F.ws + WS_BTAB);
    for (int e = gt; e < 16 * 256; e += NGT) { const int hd = e >> 8, j = e & 255; int n = j - 64; n = n < 0 ? 0 : (n > 128 ? 128 : n); btab[e] = a.in[2][t5_bucket(n) * 16 + hd] * LOG2E; }
    int* pmm = (int*)(F.ws + WS_PMM);
    for (int e = gt; e < 128; e += NGT) { int mn = pos[e * 32], mx = mn;
        for (int j = 1; j < 32; ++j) { const int p = pos[e * 32 + j]; mn = p < mn ? p : mn; mx = p > mx ? p : mx; }
        pmm[2 * e] = mn; pmm[2 * e + 1] = mx; }
    if (gt < 2) { unsigned long long m = 0ull;
        for (int kb = 0; kb < 64; ++kb) { const int b0 = (gt * 64 + kb) * 32; bool ok = true; for (int j = 1; j < 32; ++j) ok = ok && (pos[b0 + j] == pos[b0] + j); m |= ok ? (1ull << kb) : 0ull; }
        ((unsigned long long*)(F.ws + WS_AFF))[gt] = m; }
    if (gt < DEPTH) {
        const float* lv = a.in[5] + (size_t)gt * 4 * 64; float s01 = 0.f, s23 = 0.f;
        for (int j = 0; j < 64; ++j) { s01 += lv[j] * lv[64 + j]; s23 += lv[128 + j] * lv[192 + j]; }
        const double li[4] = {0.20000000000000007, 0.35550906759096934, 0.4707130183435842, 0.5560582041556406};
        const float lam_init = (float)(gt == 0 ? li[0] : gt == 1 ? li[1] : gt == 2 ? li[2] : li[3]);
        ((float*)(F.ws + WS_LAM))[gt] = expf(s01) - expf(s23) + lam_init;
    }
}

__device__ __forceinline__ void p_prep(Frame& F, const Args& a, int l) {
    const int otid = opaque_tid(F.wave), lane = otid & 63;
    const int gw = F.vcu * NWAVES + F.wave, NGW = F.G * NWAVES;
    const bf16_t* Z = (const bf16_t*)(F.ws + WS_Z);
    bf16_t* KR = (bf16_t*)(F.ws + WS_KR);
    const f32x2* rope = (const f32x2*)(F.ws + WS_ROPE);
    for (int m = gw; m < M; m += NGW) {
        const bf16_t* zr = Z + (size_t)m * ZLD;
        if (lane < 32) {
            const float x1 = bf2f(zr[ZKR + lane]), x2 = bf2f(zr[ZKR + 32 + lane]);
            const f32x2 cs = rope[(m & (SEQ - 1)) * 32 + lane];
            KR[(size_t)m * 64 + lane] = (bf16_t)(cvt_pk_bf16(x1 * cs.x - x2 * cs.y, 0.f) & 0xffffu);
            KR[(size_t)m * 64 + 32 + lane] = (bf16_t)(cvt_pk_bf16(x1 * cs.y + x2 * cs.x, 0.f) & 0xffffu);
        }
    }
    LAS float* scr = (LAS float*)(F.lds + RING_OFF);
    float* KM = (float*)(F.ws + WS_KMEAN);
    for (int it = F.vcu; it < NB * 4 * 16; it += F.G) {
        const int b = it >> 6, h = (it >> 4) & 3, n = it & 15;
        const int c8 = otid & 15, rg = otid >> 4;
        float acc[8];
#pragma unroll
        for (int j = 0; j < 8; ++j) acc[j] = 0.f;
        for (int j = 0; j < 8; ++j) {
            const u32x4 v = *(const u32x4*)(Z + (size_t)(b * SEQ + n * 256 + rg + 32 * j) * ZLD + ZMK + h * 128 + c8 * 8);
            acc[0] += bflo(v.x); acc[1] += bfhi(v.x); acc[2] += bflo(v.y); acc[3] += bfhi(v.y); acc[4] += bflo(v.z); acc[5] += bfhi(v.z); acc[6] += bflo(v.w); acc[7] += bfhi(v.w);
        }
#pragma unroll
        for (int j = 0; j < 8; ++j) scr[rg * 132 + c8 * 8 + j] = acc[j];
        __syncthreads();
        if (otid < 128) { float s = 0.f; for (int r = 0; r < 32; ++r) s += scr[r * 132 + otid]; KM[(size_t)it * 128 + otid] = s * (1.0f / 256.0f); }
        __syncthreads();
    }
}

constexpr size_t WS_GTAIL = WS_Z, WS_GHEADA = WS_Z + 12 * MiB, WS_GHEADV = WS_Z + 24 * MiB;
static_assert((size_t)(M / 64) * 2 * FFN * 4 <= 12 * MiB, "side buffers");
__device__ __forceinline__ void p_glufix(Frame& F, const Args& a, int l) {
    const int tid = opaque_tid(F.wave);
    bf16_t* Gb = (bf16_t*)(F.ws + WS_T);
    const float* tail = (const float*)(F.ws + WS_GTAIL); const float* heada = (const float*)(F.ws + WS_GHEADA); const float* headv = (const float*)(F.ws + WS_GHEADV);
    const float* cw = a.in[16] + (size_t)l * 3 * FFN; const float* cb = a.in[17] + (size_t)l * FFN;
    constexpr int NCH = FFN / 8;
    for (int it = F.vcu * 512 + tid; it < (M / 64) * 2 * NCH; it += F.G * 512) {
        const int c8 = it % NCH, gj = it / NCH, j = gj & 1, gid = gj >> 1, ch0 = c8 * 8;
        const bool zp = (gid & 63) == 0;
        float t0[8], t1[8], h0[8], av[8], vv[8];
#pragma unroll
        for (int h = 0; h < 2; ++h) {
            const f32x4 z4 = (f32x4){0.f, 0.f, 0.f, 0.f};
            const f32x4 x0 = zp ? z4 : *(const f32x4*)(tail + ((size_t)(gid - 1) * 2 + 0) * FFN + ch0 + 4 * h), x1 = zp ? z4 : *(const f32x4*)(tail + ((size_t)(gid - 1) * 2 + 1) * FFN + ch0 + 4 * h);
            const f32x4 y0 = *(const f32x4*)(heada + ((size_t)gid * 2 + 0) * FFN + ch0 + 4 * h), ya = *(const f32x4*)(heada + ((size_t)gid * 2 + j) * FFN + ch0 + 4 * h), yv = *(const f32x4*)(headv + ((size_t)gid * 2 + j) * FFN + ch0 + 4 * h);
#pragma unroll
            for (int e = 0; e < 4; ++e) { t0[4 * h + e] = x0[e]; t1[4 * h + e] = x1[e]; h0[4 * h + e] = y0[e]; av[4 * h + e] = ya[e]; vv[4 * h + e] = yv[e]; }
        }
        float o[8];
#pragma unroll
        for (int h = 0; h < 2; ++h) { const f32x4 c0 = *(const f32x4*)(cw + ch0 + 4 * h), c1 = *(const f32x4*)(cw + FFN + ch0 + 4 * h), c2 = *(const f32x4*)(cw + 2 * FFN + ch0 + 4 * h), c3 = *(const f32x4*)(cb + ch0 + 4 * h);
#pragma unroll
            for (int e = 0; e < 4; ++e) { const int c = 4 * h + e; const float am1 = j ? h0[c] : t1[c], am2 = j ? t1[c] : t0[c];
                o[c] = pg8::gelu_erf(c3[e] + c0[e] * am2 + c1[e] * am1 + c2[e] * av[c]) * vv[c]; } }
        u32x4 w; w.x = cvt_pk_bf16(o[0], o[1]); w.y = cvt_pk_bf16(o[2], o[3]); w.z = cvt_pk_bf16(o[4], o[5]); w.w = cvt_pk_bf16(o[6], o[7]);
        *(u32x4*)(Gb + (size_t)(gid * 64 + j) * FFN + ch0) = w;
    }
}

struct AttnEnv { const bf16_t* Z; const bf16_t* QMLA; const bf16_t* KVMLA; const bf16_t* KR; bf16_t* BRO; const int* pos; const int* pmm; const float* btabg; const f32x2* rope; const float* kmean;
                 const float* subln_g; const float* sinks; float* dscr; float lam, one_m_li; };

__device__ __forceinline__ void load_btab(LAS unsigned char* lds, const float* src, int tid) { if (tid < 256) ((LAS float*)(lds + att::BTAB_OFF))[tid] = src[tid]; }

constexpr int DIFF_XOFF = 104448;
__device__ __forceinline__ void unit_diff(LAS unsigned char* lds, const AttnEnv& E, int b, int h, int qb, const att::WaveCtx& w0) {
    typedef att::Cfg<128, 0, 128, 0, 4> C;
    const int mp = w0.wid >> 2, rr = w0.wid & 3;
    att::WaveCtx w = w0; w.koff = mp * 128;
    const int qw = qb * 128 + 32 * rr, qi = qw + w.r32; const size_t grow = (size_t)b * SEQ + qi;
    load_btab(lds, E.btabg + (0 + h) * 256, w.tid);
    const int posq = E.pos[qi], pminq = E.pmm[(qw >> 5) * 2];
    att::Src src; src.k0 = E.Z + (size_t)b * SEQ * ZLD + ZKA + (2 * h) * 64; src.pk0 = ZLD; src.k1 = src.k0; src.pk1 = ZLD; src.v = E.Z + (size_t)b * SEQ * ZLD + ZVA + h * 128; src.pv = ZLD; src.pos = E.pos;
    bf16x8 qf[4]; att::load_q<4>(qf, E.Z + grow * ZLD + ZQA + (2 * h + mp) * 64, w.hi);
    f32x16 O[4];
#pragma unroll
    for (int d = 0; d < 4; ++d)
#pragma unroll
        for (int r = 0; r < 16; ++r) O[d][r] = 0.f;
    att::RowState st; st.m = -1e30f; st.l = 0.f;
    att::run_tiles<C, 0, true, true, true>(lds, src, 0, 2 * (qb + 1), qf, O, st, qw, posq, pminq, E.pmm, 0u, 0, w);
    const float inv = 1.0f / (half_sum(st.l));
    LAS float* X = (LAS float*)(lds + DIFF_XOFF) + rr * 2048 + w.lane;
#pragma unroll
    for (int rd = 0; rd < 2; ++rd) {
        if (mp == 1) {
#pragma unroll
            for (int dd = 0; dd < 2; ++dd)
#pragma unroll
                for (int r = 0; r < 16; ++r) X[(dd * 16 + r) * 64] = O[2 * rd + dd][r] * inv;
        }
        __syncthreads();
        if (mp == 0) {
#pragma unroll
            for (int dd = 0; dd < 2; ++dd)
#pragma unroll
                for (int r = 0; r < 16; ++r) O[2 * rd + dd][r] = O[2 * rd + dd][r] * inv - E.lam * X[(dd * 16 + r) * 64];
        }
        __syncthreads();
    }
    if (mp == 0) {
        float ss = 0.f;
#pragma unroll
        for (int d = 0; d < 4; ++d)
#pragma unroll
            for (int r = 0; r < 16; ++r) ss += O[d][r] * O[d][r];
        ss = half_sum(ss);
        const float sc = (1.0f / sqrtf(ss * (1.0f / 128.0f) + EPS)) * E.one_m_li;
#pragma unroll
        for (int d = 0; d < 4; ++d)
#pragma unroll
            for (int g = 0; g < 4; ++g) { const f32x4 gg = *(const f32x4*)(E.subln_g + 32 * d + 8 * g + 4 * w.hi);
#pragma unroll
                for (int e = 0; e < 4; ++e) O[d][4 * g + e] *= sc * gg[e]; }
        att::store_o<4>(O, E.BRO + grow * DM + h * 128, w.hi);
    }
}

__device__ __forceinline__ void unit_mla(LAS unsigned char* lds, const AttnEnv& E, int b, int h, int qb, const att::WaveCtx& w) {
    typedef att::Cfg<128, 64, 128, 6> C;
    const int qw = qb * 256 + 32 * w.wid, qi = qw + w.r32; const size_t grow = (size_t)b * SEQ + qi;
    att::Src src; src.k0 = E.KVMLA + (size_t)b * SEQ * 1024 + h * 256; src.pk0 = 1024; src.k1 = E.KR + (size_t)b * SEQ * 64; src.pk1 = 64; src.v = E.KVMLA + (size_t)b * SEQ * 1024 + h * 256 + 128; src.pv = 1024; src.pos = E.pos;
    bf16x8 qf[6]; att::load_q<6>(qf, E.QMLA + grow * 768 + h * 192, w.hi);
    {
        bf16x8 qr[4]; att::load_q<4>(qr, E.QMLA + grow * 768 + h * 192 + 128, w.hi);
        LAS unsigned char* qlw = lds + att::QL_OFF + w.wid * (C::NQL * 1024) + w.lane * 16;
        { bf16x8 qp[2]; att::load_q<2>(qp, E.QMLA + grow * 768 + h * 192 + 96, w.hi); *(LAS bf16x8*)(qlw) = qp[0]; *(LAS bf16x8*)(qlw + 1024) = qp[1]; }
#pragma unroll
        for (int dd = 0; dd < 2; ++dd) {
            const f32x2* cs = E.rope + (size_t)qi * 32 + 16 * dd + 8 * w.hi;
            unsigned o1[4], o2[4];
#pragma unroll
            for (int jp = 0; jp < 4; ++jp) {
                const f32x4 c2 = *(const f32x4*)(cs + 2 * jp);
                const float a0 = bf2f((unsigned short)qr[dd][2 * jp]), a1 = bf2f((unsigned short)qr[dd][2 * jp + 1]);
                const float b0 = bf2f((unsigned short)qr[2 + dd][2 * jp]), b1 = bf2f((unsigned short)qr[2 + dd][2 * jp + 1]);
                o1[jp] = cvt_pk_bf16(a0 * c2[0] - b0 * c2[1], a1 * c2[2] - b1 * c2[3]);
                o2[jp] = cvt_pk_bf16(a0 * c2[1] + b0 * c2[0], a1 * c2[3] + b1 * c2[2]);
            }
            *(LAS u32x4*)(qlw + (2 + dd) * 1024) = (u32x4){o1[0], o1[1], o1[2], o1[3]};
            *(LAS u32x4*)(qlw + (4 + dd) * 1024) = (u32x4){o2[0], o2[1], o2[2], o2[3]};
        }
    }
    f32x16 O[4];
#pragma unroll
    for (int d = 0; d < 4; ++d)
#pragma unroll
        for (int r = 0; r < 16; ++r) O[d][r] = 0.f;
    att::RowState st; st.m = -1e30f; st.l = 0.f;
    att::run_tiles<C, 0, false, true, true>(lds, src, 0, 4 * (qb + 1), qf, O, st, qw, 0, 0, E.pmm, 0u, 0, w);
    const float inv = 1.0f / (half_sum(st.l));
#pragma unroll
    for (int d = 0; d < 4; ++d)
#pragma unroll
        for (int r = 0; r < 16; ++r) O[d][r] *= inv;
    const size_t grow2 = (size_t)b * SEQ + qw + (int)(fresh_lane_id() & 31u);
    att::store_o<4>(O, E.BRO + grow2 * DM + 512 + h * 128, w.hi);
}

__device__ __forceinline__ void unit_swa(LAS unsigned char* lds, const AttnEnv& E, int b, int kvh, int qblk, const att::WaveCtx& w) {
    typedef att::Cfg<64, 0, 64> C;
    const int g = w.wid >> 1, qh = kvh * 4 + g;
    const int qw = qblk * 64 + 32 * (w.wid & 1), qi = qw + w.r32; const size_t grow = (size_t)b * SEQ + qi;
    for (int e = w.tid; e < 1024; e += 512) ((LAS float*)(lds + att::BTAB_OFF))[e] = E.btabg[(4 + kvh * 4 + (e >> 8)) * 256 + (e & 255)];
    const int posq = E.pos[qi], pminq = E.pmm[(qw >> 5) * 2];
    att::Src src; src.k0 = E.Z + (size_t)b * SEQ * ZLD + ZSK + kvh * 64; src.pk0 = ZLD; src.k1 = src.k0; src.pk1 = ZLD; src.v = E.Z + (size_t)b * SEQ * ZLD + ZSV + kvh * 64; src.pv = ZLD; src.pos = E.pos;
    bf16x8 qf[4]; att::load_q<4>(qf, E.Z + grow * ZLD + ZSQ + qh * 64, w.hi);
    f32x16 O[2];
#pragma unroll
    for (int d = 0; d < 2; ++d)
#pragma unroll
        for (int r = 0; r < 16; ++r) O[d][r] = 0.f;
    att::RowState st; st.m = E.sinks[qh] * LOG2E; st.l = (w.hi == 0) ? 1.0f : 0.0f;
    const int t0 = qblk < 2 ? 0 : qblk - 2;
    att::run_tiles<C, 1, true, false, true>(lds, src, t0, qblk + 1, qf, O, st, qw, posq, pminq, E.pmm, 0u, 0, w, g * 1024);
    const float inv = 1.0f / (half_sum(st.l));
#pragma unroll
    for (int d = 0; d < 2; ++d)
#pragma unroll
        for (int r = 0; r < 16; ++r) O[d][r] *= inv;
    att::store_o<2>(O, E.BRO + grow * DM + 1024 + qh * 64, w.hi);
}

__device__ __forceinline__ void unit_moba(LAS unsigned char* lds, const AttnEnv& E, int b, int h, int blk, const att::WaveCtx& w) {
    typedef att::Cfg<128, 0, 128> C;
    const int qw = blk * 256 + 32 * w.wid, qi = qw + w.r32; const size_t grow = (size_t)b * SEQ + qi;
    load_btab(lds, E.btabg + (12 + h) * 256, w.tid);
    LAS float* km = (LAS float*)(lds + att::KMEAN_OFF);
    for (int e = w.tid; e < blk * 128; e += 512) km[e] = E.kmean[(size_t)((b * 4 + h) * 16) * 128 + e];
    const int posq = E.pos[qi], pminq = E.pmm[(qw >> 5) * 2];
    att::Src src; src.k0 = E.Z + (size_t)b * SEQ * ZLD + ZMK + h * 128; src.pk0 = ZLD; src.k1 = src.k0; src.pk1 = ZLD; src.v = E.Z + (size_t)b * SEQ * ZLD + ZMV + h * 128; src.pv = ZLD; src.pos = E.pos;
    bf16x8 qf[8]; att::load_q<8>(qf, E.Z + grow * ZLD + ZMQ + h * 128, w.hi);
    __syncthreads();
    unsigned selmask;
    if (blk <= 3) selmask = (1u << blk) - 1u;
    else {
        float v1 = NEG_INF, v2 = NEG_INF, v3 = NEG_INF; int i1 = 31, i2 = 31, i3 = 31;
        for (int n = 0; n < blk; ++n) {
            float part = 0.f;
#pragma unroll
            for (int d0 = 0; d0 < 8; ++d0) {
                const f32x4 k0 = *(const LAS f32x4*)(km + n * 128 + 16 * d0 + 8 * w.hi), k1 = *(const LAS f32x4*)(km + n * 128 + 16 * d0 + 8 * w.hi + 4);
#pragma unroll
                for (int j = 0; j < 4; ++j) part += bf2f((unsigned short)qf[d0][j]) * k0[j] + bf2f((unsigned short)qf[d0][4 + j]) * k1[j];
            }
            const float g = half_sum(part);
            if (g > v1) { v3 = v2; i3 = i2; v2 = v1; i2 = i1; v1 = g; i1 = n; }
            else if (g > v2) { v3 = v2; i3 = i2; v2 = g; i2 = n; }
            else if (g > v3) { v3 = g; i3 = n; }
        }
        selmask = (1u << i1) | (1u << i2) | (1u << i3);
    }
    f32x16 O[4];
#pragma unroll
    for (int d = 0; d < 4; ++d)
#pragma unroll
        for (int r = 0; r < 16; ++r) O[d][r] = 0.f;
    att::RowState st; st.m = -1e30f; st.l = 0.f;
    att::run_tiles<C, 2, true, true, true>(lds, src, 0, 4 * (blk + 1), qf, O, st, qw, posq, pminq, E.pmm, selmask, blk, w);
    const float inv = 1.0f / (half_sum(st.l));
#pragma unroll
    for (int d = 0; d < 4; ++d)
#pragma unroll
        for (int r = 0; r < 16; ++r) O[d][r] *= inv;
    att::store_o<4>(O, E.BRO + grow * DM + 1536 + h * 128, w.hi);
}

#ifndef CHECK_BUILD
#define CHECK_BUILD 0
#endif
#ifndef CHECK_TOL
#define CHECK_TOL 0.04f
#endif
#ifndef CHECK_REPORT
#define CHECK_REPORT (-1)
#endif
#if CHECK_BUILD
constexpr size_t WS_CHK_KV = WS_END;
constexpr size_t WS_CHK_KR = WS_CHK_KV + (size_t)SEQ * 1024 * 4;
constexpr size_t WS_END2 = WS_CHK_KR + (size_t)SEQ * 64 * 4;
constexpr int CHK_B = 1, CHK_NS = 32;
constexpr int CW_CHK = 2048;
__device__ __forceinline__ int chk_row(int i) {
    const int ts[CHK_NS] = {0, 1, 2, 31, 32, 63, 64, 127, 128, 129, 255, 256, 257, 300, 511, 512, 700, 767, 768, 1000, 1023, 1024, 1500, 2047, 2048, 3071, 3072, 3500, 3839, 3840, 4000, 4095};
    int r = 0;
#pragma unroll
    for (int j = 0; j < CHK_NS; ++j) r = (i == j) ? ts[j] : r;
    return r;
}
__device__ __forceinline__ void chk_sincos(float ang, float& c, float& s) {
    double x = (double)ang; const double twopi = 6.283185307179586476925;
    x -= twopi * rint(x / twopi);
    const double x2 = x * x; double tc = 1.0, ts_ = x, sc = 1.0, ss = x;
#pragma unroll 1
    for (int k = 1; k < 16; ++k) { const double kk = (double)k; tc *= -x2 / ((2.0 * kk - 1.0) * (2.0 * kk)); ts_ *= -x2 / ((2.0 * kk) * (2.0 * kk + 1.0)); sc += tc; ss += ts_; }
    c = (float)sc; s = (float)ss;
}
__device__ __forceinline__ int chk_bucket(int rel) {
    const int n = rel > 0 ? rel : 0;
    if (n < 16) return n;
    const float nf = (float)n;
    const int large = 16 + (int)(logf(nf / 16.0f) / 2.0794415416798357f * 16.0f);
    return large < 31 ? large : 31;
}
__device__ __forceinline__ float chk_block_max(float v, LAS float* red, int tid) {
    v = wave_max(v);
    __syncthreads(); if ((tid & 63) == 0) red[tid >> 6] = v; __syncthreads();
    float r = red[0];
#pragma unroll
    for (int j = 1; j < 8; ++j) r = fmaxf(r, red[j]);
    return r;
}
__device__ __forceinline__ float chk_block_sum(float v, LAS float* red, int tid) {
    v = wave_sum(v);
    __syncthreads(); if ((tid & 63) == 0) red[tid >> 6] = v; __syncthreads();
    float r = 0.f;
#pragma unroll
    for (int j = 0; j < 8; ++j) r += red[j];
    return r;
}
__device__ __forceinline__ void chk_record(unsigned* ctl, int type, float diff, float mag, LAS float* red, int tid) {
    const float md = chk_block_max(diff, red, tid), mm = chk_block_max(mag, red, tid);
    if (tid == 0) { atomicMax(ctl + CW_CHK + 2 * type, __float_as_uint(mm > 0.f ? md / mm : 1.0e9f)); atomicMax(ctl + CW_CHK + 2 * type + 1, 1u); }
}
__device__ __forceinline__ void chk_prep(Frame& F, const Args& a) {
    const int tid = opaque_tid(F.wave);
    const bf16_t* Z = (const bf16_t*)(F.ws + WS_Z) + (size_t)CHK_B * SEQ * ZLD;
    float* KV = (float*)(F.ws + WS_CHK_KV); float* KRn = (float*)(F.ws + WS_CHK_KR);
    const float* gkv = a.in[9]; const float* wukv = a.in[10]; const int* pos = (const int*)a.in[1];
    const long gt = (long)F.vcu * 512 + tid, NGT = (long)F.G * 512;
    for (long e = gt; e < (long)SEQ * 1024; e += NGT) {
        const int srow = (int)(e >> 10), n = (int)(e & 1023);
        const bf16_t* zr = Z + (size_t)srow * ZLD + ZCKV;
        float ss = 0.f; for (int c = 0; c < 256; ++c) { const float x = bf2f(zr[c]); ss += x * x; }
        const float rstd = 1.0f / sqrtf(ss / 256.0f + EPS);
        float acc = 0.f; for (int c = 0; c < 256; ++c) acc += bf2f(zr[c]) * rstd * gkv[c] * wukv[(size_t)c * 1024 + n];
        KV[e] = acc;
    }
    for (long e = gt; e < (long)SEQ * 32; e += NGT) {
        const int srow = (int)(e >> 5), i = (int)(e & 31);
        const float inv = __builtin_amdgcn_exp2f((float)(-2 * i) / 64.0f * 13.287712379549449f);
        float c, s_; chk_sincos((float)pos[srow] * inv, c, s_);
        const float x1 = bf2f(Z[(size_t)srow * ZLD + ZKR + i]), x2 = bf2f(Z[(size_t)srow * ZLD + ZKR + 32 + i]);
        KRn[srow * 64 + i] = x1 * c - x2 * s_; KRn[srow * 64 + 32 + i] = x1 * s_ + x2 * c;
    }
}
__device__ __forceinline__ void chk_items(Frame& F, const Args& a) {
    const int tid = opaque_tid(F.wave);
    LAS float* sc = (LAS float*)(F.lds + RING_OFF);
    LAS float* qv = sc + 4096;
    LAS float* tmp = qv + 192;
    LAS float* red = tmp + 512;
    LAS float* part = red + 8;
    LAS float* gate = part + 512;
    const bf16_t* Zb = (const bf16_t*)(F.ws + WS_Z) + (size_t)CHK_B * SEQ * ZLD;
    const bf16_t* BRO = (const bf16_t*)(F.ws + WS_BRO) + (size_t)CHK_B * SEQ * DM;
    const float* KV = (const float*)(F.ws + WS_CHK_KV); const float* KRn = (const float*)(F.ws + WS_CHK_KR);
    const int* pos = (const int*)a.in[1]; const float* relb = a.in[2];
    for (int it = F.vcu; it < 16 * CHK_NS; it += F.G) {
        const int smp = it % CHK_NS, hh = it / CHK_NS;
        const int t = chk_row(smp);
        __syncthreads();
        if (hh < 4) {
            const int h = hh;
            {
                const bf16_t* zr = Zb + (size_t)t * ZLD + ZCQ;
                const float x = bf2f(zr[tid]);
                const float ss = chk_block_sum(x * x, red, tid);
                tmp[tid] = x * (1.0f / sqrtf(ss / 512.0f + EPS)) * a.in[7][tid];
            }
            __syncthreads();
            if (tid < 192) { float acc = 0.f; const float* w = a.in[8] + h * 192 + tid; for (int k = 0; k < 512; ++k) acc += tmp[k] * w[(size_t)k * 768]; qv[tid] = acc; }
            __syncthreads();
            float r1 = 0.f, r2 = 0.f;
            if (tid < 32) { const float inv = __builtin_amdgcn_exp2f((float)(-2 * tid) / 64.0f * 13.287712379549449f); float c, s_; chk_sincos((float)pos[t] * inv, c, s_);
                const float x1 = qv[128 + tid], x2 = qv[160 + tid]; r1 = x1 * c - x2 * s_; r2 = x1 * s_ + x2 * c; }
            __syncthreads();
            if (tid < 32) { qv[128 + tid] = r1; qv[160 + tid] = r2; }
            __syncthreads();
            float lmax = -3.0e38f;
            for (int k = tid; k <= t; k += 512) { float d = 0.f; const float* kr = KV + (size_t)k * 1024 + h * 256;
                for (int j = 0; j < 128; ++j) d += qv[j] * kr[j];
                for (int j = 0; j < 64; ++j) d += qv[128 + j] * KRn[k * 64 + j];
                d *= 0.07216878364870322f; sc[k] = d; lmax = fmaxf(lmax, d); }
            const float mx = chk_block_max(lmax, red, tid);
            float ls = 0.f; for (int k = tid; k <= t; k += 512) { const float p = expf(sc[k] - mx); sc[k] = p; ls += p; }
            const float den = chk_block_sum(ls, red, tid);
            __syncthreads();
            { const int dv = tid & 127, grp = tid >> 7; float o = 0.f; for (int k = grp; k <= t; k += 4) o += sc[k] * KV[(size_t)k * 1024 + h * 256 + 128 + dv]; part[grp * 128 + dv] = o; }
            __syncthreads();
            { float df = 0.f, mg = 0.f;
              if (tid < 128) { const float o = (part[tid] + part[128 + tid] + part[256 + tid] + part[384 + tid]) / den; const float f = bf2f(BRO[(size_t)t * DM + 512 + h * 128 + tid]); df = fabsf(f - o); mg = fabsf(o); }
              chk_record(F.ctl, 0, df, mg, red, tid); }
        } else if (hh < 8) {
            const int h = hh - 4, blk = t >> 8;
            if (tid < 128) qv[tid] = bf2f(Zb[(size_t)t * ZLD + ZMQ + h * 128 + tid]);
            __syncthreads();
            { const int n = tid >> 5, sub = tid & 31; float g = 0.f;
              if (n < blk) for (int r = sub; r < 256; r += 32) { const bf16_t* kr = Zb + (size_t)(n * 256 + r) * ZLD + ZMK + h * 128; float d = 0.f; for (int j = 0; j < 128; ++j) d += qv[j] * bf2f(kr[j]); g += d; }
              g += swz_xor<1>(g); g += swz_xor<2>(g); g += swz_xor<4>(g); g += swz_xor<8>(g); g += swz_xor<16>(g);
              if (sub == 0) gate[n] = (n < blk) ? g : -3.0e38f; }
            __syncthreads();
            unsigned sel = 0u;
            if (blk <= 3) sel = (1u << blk) - 1u;
            else for (int c = 0; c < 3; ++c) { int bi = -1; float bv = -3.0e38f; for (int n = 0; n < blk; ++n) if (!((sel >> n) & 1u) && gate[n] > bv) { bv = gate[n]; bi = n; } sel |= 1u << bi; }
            float lmax = -3.0e38f;
            for (int k = tid; k <= t; k += 512) { const int n = k >> 8; const bool ok = (n == blk) || ((sel >> n) & 1u);
                float d = -3.0e38f;
                if (ok) { const bf16_t* kr = Zb + (size_t)k * ZLD + ZMK + h * 128; d = 0.f; for (int j = 0; j < 128; ++j) d += qv[j] * bf2f(kr[j]);
                    d = d / LOG2E + relb[chk_bucket(pos[t] - pos[k]) * 16 + 12 + h]; lmax = fmaxf(lmax, d); }
                sc[k] = d; }
            const float mx = chk_block_max(lmax, red, tid);
            float ls = 0.f; for (int k = tid; k <= t; k += 512) { const float p = (sc[k] > -1.0e38f) ? expf(sc[k] - mx) : 0.f; sc[k] = p; ls += p; }
            const float den = chk_block_sum(ls, red, tid);
            __syncthreads();
            { const int dv = tid & 127, grp = tid >> 7; float o = 0.f; for (int k = grp; k <= t; k += 4) o += sc[k] * bf2f(Zb[(size_t)k * ZLD + ZMV + h * 128 + dv]); part[grp * 128 + dv] = o; }
            __syncthreads();
            { float df = 0.f, mg = 0.f;
              if (tid < 128) { const float o = (part[tid] + part[128 + tid] + part[256 + tid] + part[384 + tid]) / den; const float f = bf2f(BRO[(size_t)t * DM + 1536 + h * 128 + tid]); df = fabsf(f - o); mg = fabsf(o); }
              chk_record(F.ctl, 1, df, mg, red, tid); }
        } else {
            const int qh = hh - 8, kvh = qh >> 2;
            if (tid < 64) qv[tid] = bf2f(Zb[(size_t)t * ZLD + ZSQ + qh * 64 + tid]);
            __syncthreads();
            const float sink = a.in[11][qh];
            float lmax = -3.0e38f; const int kk = t - 127 + tid;
            float d = -3.0e38f;
            if (tid < 128 && kk >= 0) { const bf16_t* kr = Zb + (size_t)kk * ZLD + ZSK + kvh * 64; d = 0.f; for (int j = 0; j < 64; ++j) d += qv[j] * bf2f(kr[j]);
                d = d / LOG2E + relb[chk_bucket(pos[t] - pos[kk]) * 16 + 4 + qh]; lmax = d; }
            const float mx = fmaxf(chk_block_max(lmax, red, tid), sink);
            const float p = (d > -1.0e38f) ? expf(d - mx) : 0.f;
            if (tid < 128) sc[tid] = p;
            const float den = chk_block_sum(p, red, tid) + expf(sink - mx);
            __syncthreads();
            { float df = 0.f, mg = 0.f;
              if (tid < 64) { float o = 0.f; for (int j = 0; j < 128; ++j) { const int k2 = t - 127 + j; if (k2 >= 0) o += sc[j] * bf2f(Zb[(size_t)k2 * ZLD + ZSV + kvh * 64 + tid]); }
                o /= den; const float f = bf2f(BRO[(size_t)t * DM + 1024 + qh * 64 + tid]); df = fabsf(f - o); mg = fabsf(o); }
              chk_record(F.ctl, 2, df, mg, red, tid); }
        }
    }
}
#endif

__device__ __forceinline__ int queue_next(Frame& F, unsigned* head) {
    __syncthreads();
    if (is_thread0(F.wave)) F.MISC[4] = __hip_atomic_fetch_add(head, 1u, RLX_AGENT);
    __syncthreads();
    return (int)F.MISC[4];
}
__device__ __forceinline__ int queue_pick(Frame& F, unsigned* heads, int N, int myx) {
    __syncthreads();
    if (F.wave == 0) {
        const unsigned lane = fresh_lane_id();
        int res = -1;
        for (int tries = 0; tries < 64; ++tries) {
            unsigned h = 0xffffffffu;
            if (lane < 8u) h = __hip_atomic_load(heads + 64 * lane, RLX_AGENT);
            const unsigned long long m = __ballot(h < (unsigned)N);
            if ((m & 0xffull) == 0ull) break;
            const unsigned rot = (unsigned)(((m & 0xffull) | ((m & 0xffull) << 8)) >> myx) & 0xffu;
            const int x = (myx + __builtin_ctz(rot)) & 7;
            unsigned j = 0u;
            if (lane == 0u) j = __hip_atomic_fetch_add(heads + 64 * x, 1u, RLX_AGENT);
            j = (unsigned)__builtin_amdgcn_readfirstlane((int)j);
            if (j < (unsigned)N) { res = (x << 16) | (int)j; break; }
        }
        if (lane == 0u) F.MISC[4] = (unsigned)res;
    }
    __syncthreads();
    return (int)F.MISC[4];
}

__global__ void __launch_bounds__(NWAVES * 64, 2) trunk_fwd(Args args) {
    extern __shared__ __attribute__((aligned(16))) unsigned char lds_raw[];
    Frame F;
    F.lds = (LAS unsigned char*)lds_raw;
    F.MISC = (volatile LAS unsigned*)(F.lds + MISC_OFF);
    F.tid = threadIdx.x; F.lane = F.tid & 63; F.wave = __builtin_amdgcn_readfirstlane(F.tid >> 6);
    F.G = gridDim.x; { const int bx = blockIdx.x; F.vcu = (F.G % 8 == 0) ? (bx % 8) * (F.G / 8) + bx / 8 : bx; }
    F.ws = args.ws; F.ctl = (unsigned*)(args.ws + WS_CTL);
    for (int u = F.tid; u < (LDS_BYTES - LDSCTL_OFF) / 4; u += NWAVES * 64) ((LAS unsigned*)(F.lds + LDSCTL_OFF))[u] = 0u;
    __syncthreads();
    const int lo = args.ph_lo, hi = args.ph_hi;
    XcdBarrier bar; bar.bar = F.ctl + CW_BAR; bar.x = 0; bar.st = nullptr; bar.wave = F.wave;
    if (hi - lo > 1) bar = xcd_barrier_post(F.ctl + CW_BAR, F.MISC + 8, F.wave);
#ifndef DBG_MASK
#define DBG_MASK 0xFFFFFu
#endif
#define EN(j) (((DBG_MASK) >> (j)) & 1u)
#ifndef DBG_ATT
#define DBG_ATT 0xFu
#endif
#define ENA(j) (((DBG_ATT) >> (j)) & 1u)
#define IN(k) (lo <= (k) && (k) < hi)
#ifndef DUP
#define DUP (-1)
#endif
#define REPS(j) ((DUP) == (j) ? 2 : 1)
#define SEAM(k) do { if ((k) + 1 < hi) xcd_barrier(bar); } while (0)
    const int gw = F.vcu * NWAVES + F.wave, NGW = F.G * NWAVES;
    unsigned char* ws = F.ws;
    unsigned long long* SSQ = (unsigned long long*)(ws + WS_SSQ); unsigned long long* SSQ2 = SSQ + (size_t)DEPTH * 2 * M;
    bf16_t* X = (bf16_t*)(ws + WS_X); bf16_t* XN = (bf16_t*)(ws + WS_XN); bf16_t* MG = (bf16_t*)(ws + WS_MG); bf16_t* Z = (bf16_t*)(ws + WS_Z);
    unsigned char* X8 = ws + WS_XN;
    bf16_t* U = (bf16_t*)(ws + WS_Z); bf16_t* Gb = (bf16_t*)(ws + WS_T); float* T = (float*)(ws + WS_T);

    if (EN(13) && IN(0)) for (int rep = 0; rep < REPS(13); ++rep) { p_prologue(F, args); SEAM(0); }

    for (int l = 0; l < DEPTH; ++l) {
        const int p0 = 1 + l * PH_PER_LAYER;
        if (hi <= p0 || lo >= p0 + PH_PER_LAYER) continue;
        unsigned char* wl = ws + WS_W + (size_t)l * W_LAYER;
        if (EN(0) && IN(p0 + 0) && l == 0) for (int rep = 0; rep < REPS(0); ++rep) { const int ol = opaque_tid(F.wave) & 63; for (int m = opaque_s(gw); m < M; m += NGW) cvt_row_in(args.in[0] + (size_t)m * DM, X + (size_t)m * DM, X8 + (size_t)m * DM, SSQ + m, ol); SEAM(p0 + 0); }
        if (EN(1) && IN(p0 + 1)) for (int rep = 0; rep < REPS(1); ++rep) {
            { pg8::Gemm g{X, (const bf16_t*)(wl + W_IN), M, ZG, DM, DM, 0, 0}; pg8::StaticOrder S; S.init(M, ZG, F.G, (int)blockIdx.x);
              pg8::EpiBf16 E{Z, ZLD, 0, 1.0f, SSQ + (size_t)(2 * l) * M, 1.0f / DM, SSQ2 + (size_t)(2 * l) * M, SSQ2 + (size_t)(2 * l + 1) * M};
              pg8::gemm_phase<pg8::EpiBf16, pg8::StaticOrder, true>(F.lds + RING_OFF, g, S, E, F.wave); }
            { pg8::Gemm g{(const bf16_t*)X8, (const bf16_t*)(wl + W_IN8), M, 4 * DM, DM, DM, 0, 0}; pg8::StaticOrder S; S.init(M, 4 * DM, F.G, (int)blockIdx.x);
              pg8::EpiGate E{Z + ZG, ZLD, 1.0f / W8_SCALE, opaque_s(0), SSQ + (size_t)(2 * l) * M};
              pg8::gemm_phase<pg8::EpiGate, pg8::StaticOrder, true, false, true>(F.lds + RING_OFF, g, S, E, F.wave); }
            SEAM(p0 + 1);
        }
        if (EN(4) && IN(p0 + 4)) for (int rep = 0; rep < REPS(4); ++rep) {
            if (EN(3)) p_prep(F, args, l);
            { pg8::Gemm g{Z + ZCQ, (const bf16_t*)(wl + W_UQ), M, 768, 512, ZLD, 0, 0}; pg8::StaticOrder S; S.init(M, 768, F.G, (int)blockIdx.x);
            pg8::EpiBf16 E{(bf16_t*)(ws + WS_QMLA), 768, 1, 0.07216878364870322f * LOG2E, SSQ2 + (size_t)(2 * l) * M, 1.0f / 512.0f, nullptr, nullptr};
            pg8::gemm_phase<pg8::EpiBf16, pg8::StaticOrder, true>(F.lds + RING_OFF, g, S, E, F.wave); }
            {
            pg8::Gemm g{Z + ZCKV, (const bf16_t*)(wl + W_UKV), M, 1024, 256, ZLD, 0, 0}; pg8::StaticOrder S; S.init(M, 1024, F.G, (int)blockIdx.x);
            pg8::EpiBf16 E{(bf16_t*)(ws + WS_KVMLA), 1024, 1, 1.0f, SSQ2 + (size_t)(2 * l + 1) * M, 1.0f / 256.0f, nullptr, nullptr};
            pg8::gemm_phase<pg8::EpiBf16, pg8::StaticOrder, true>(F.lds + RING_OFF, g, S, E, F.wave); }
            SEAM(p0 + 4);
        }
        if (EN(6) && IN(p0 + 6)) for (int rep = 0; rep < REPS(6); ++rep) {
            const double li[4] = {0.20000000000000007, 0.35550906759096934, 0.4707130183435842, 0.5560582041556406};
            AttnEnv E; E.Z = Z; E.QMLA = (const bf16_t*)(ws + WS_QMLA); E.KVMLA = (const bf16_t*)(ws + WS_KVMLA); E.KR = (const bf16_t*)(ws + WS_KR); E.BRO = (bf16_t*)(ws + WS_BRO);
            E.pos = (const int*)args.in[1]; E.pmm = (const int*)(ws + WS_PMM); E.btabg = (const float*)(ws + WS_BTAB); E.rope = (const f32x2*)(ws + WS_ROPE); E.kmean = (const float*)(ws + WS_KMEAN);
            E.dscr = (float*)(ws + WS_DSCR); E.subln_g = args.in[6] + (size_t)l * 128; E.sinks = args.in[11] + (size_t)l * 8; E.lam = __uint_as_float(__builtin_amdgcn_readfirstlane(__float_as_uint(((const float*)(ws + WS_LAM))[l])));
            E.one_m_li = __uint_as_float(__builtin_amdgcn_readfirstlane(__float_as_uint(1.0f - (float)(l == 0 ? li[0] : l == 1 ? li[1] : l == 2 ? li[2] : li[3]))));
#if PROF_BUILD
            if (is_thread0(F.wave)) { const unsigned long long pt0 = clock64(); F.MISC[16] = (unsigned)pt0; F.MISC[17] = (unsigned)(pt0 >> 32); }
#endif
            unsigned* qh = F.ctl + CW_QUEUE + 64 * (((rep * DEPTH + l) * 4) * 8);
            const int myx = (int)xb_xcc_id() & 7;
#if PROF_BUILD
#define WCTX const int ot = opaque_tid(F.wave); const att::WaveCtx wctx{ot & 63, ot & 31, (ot >> 5) & 1, __builtin_amdgcn_readfirstlane(ot >> 6), ot, 0, (unsigned long long*)(F.ctl + 32768 + (l == 0 ? 0 : 4096))}
#else
#define WCTX const int ot = opaque_tid(F.wave); const att::WaveCtx wctx{ot & 63, ot & 31, (ot >> 5) & 1, __builtin_amdgcn_readfirstlane(ot >> 6), ot, 0}
#endif
            if (ENA(0)) for (;;) { const int pk = queue_pick(F, qh + 64 * (0 * 8), 64, myx); if (pk < 0) break; const int x = pk >> 16, j = pk & 0xffff; const int bh = x + 8 * (j & 1); WCTX; unit_diff(F.lds, E, bh >> 2, bh & 3, 31 - (j >> 1), wctx); }
            if (ENA(1)) for (;;) { const int pk = queue_pick(F, qh + 64 * (1 * 8), 32, myx); if (pk < 0) break; const int x = pk >> 16, j = pk & 0xffff; const int bh = x + 8 * (j & 1); WCTX; unit_mla(F.lds, E, bh >> 2, bh & 3, 15 - (j >> 1), wctx); }
            if (ENA(2)) for (;;) { const int pk = queue_pick(F, qh + 64 * (2 * 8), 32, myx); if (pk < 0) break; const int x = pk >> 16, j = pk & 0xffff; const int bh = x + 8 * (j & 1); WCTX; unit_moba(F.lds, E, bh >> 2, bh & 3, 15 - (j >> 1), wctx); }
            if (ENA(3)) for (;;) { const int pk = queue_pick(F, qh + 64 * (3 * 8), 64, myx); if (pk < 0) break; const int x = pk >> 16, j = pk & 0xffff; WCTX; unit_swa(F.lds, E, x >> 1, x & 1, 63 - j, wctx); }
#undef WCTX
#if PROF_BUILD
            if (is_thread0(F.wave)) { const unsigned long long pt0 = (unsigned long long)F.MISC[16] | ((unsigned long long)F.MISC[17] << 32); atomicAdd((unsigned long long*)(F.ctl + 32768 + (l == 0 ? 0 : 4096)), clock64() - pt0); }
#endif
#if CHECK_BUILD
            if (l == 0 && rep == 0) { xcd_barrier(bar); chk_prep(F, args); xcd_barrier(bar); chk_items(F, args); }
#endif
            SEAM(p0 + 6);
#if PROF_BUILD
            if (PROF_ID == 10 && is_thread0(F.wave)) { const unsigned long long pt0 = (unsigned long long)F.MISC[16] | ((unsigned long long)F.MISC[17] << 32); atomicAdd((unsigned long long*)(F.ctl + 32768 + (l == 0 ? 0 : 4096)) + 10, clock64() - pt0); }
#endif
        }
        if (EN(7) && IN(p0 + 7)) for (int rep = 0; rep < REPS(7); ++rep) {
            pg8::Gemm g{(const bf16_t*)(ws + WS_BRO), (const bf16_t*)(wl + W_BR), M, DM, 512, DM, (size_t)512 * 2, (size_t)DM * 512 * 2}; pg8::StaticOrder S; S.init_tiles(M / 128, DM / 256, F.G, (int)blockIdx.x, 4); S.wgm = 8;
            pg8::EpiMergeHalf E{Z + ZG, ZLD, MG};
            pg8::gemm_phase_m3<pg8::EpiMergeHalf, pg8::StaticOrder>(F.lds + RING_OFF, g, S, E, F.wave);
            SEAM(p0 + 7);
        }
        if (EN(8) && IN(p0 + 8)) for (int rep = 0; rep < REPS(8); ++rep) {
            pg8::Gemm g{MG, (const bf16_t*)(wl + W_OUT), M, DM, DM, DM, 0, 0}; pg8::StaticOrder S; S.init(M, DM, F.G, (int)blockIdx.x);
            pg8::EpiResBf16 E{nullptr, X, X, DM, SSQ + (size_t)(2 * l + 1) * M, nullptr};
            pg8::gemm_phase<pg8::EpiResBf16, pg8::StaticOrder, true>(F.lds + RING_OFF, g, S, E, F.wave);
            SEAM(p0 + 8);
        }
        if (EN(10) && IN(p0 + 10)) for (int rep = 0; rep < REPS(10); ++rep) {
            pg8::Gemm g{X, (const bf16_t*)(wl + W_UP), M, UP_N, DM, DM, 0, 0}; pg8::StaticOrder S; S.init(M, UP_N, F.G, (int)blockIdx.x);
            pg8::EpiGlu E{Gb, args.in[16] + (size_t)l * 3 * FFN, args.in[17] + (size_t)l * FFN, (float*)(ws + WS_GTAIL), (float*)(ws + WS_GHEADA), (float*)(ws + WS_GHEADV), SSQ + (size_t)(2 * l + 1) * M};
            pg8::gemm_phase<pg8::EpiGlu, pg8::StaticOrder, true>(F.lds + RING_OFF, g, S, E, F.wave);
            SEAM(p0 + 10);
        }
        if (EN(11) && IN(p0 + 11)) for (int rep = 0; rep < REPS(11); ++rep) { p_glufix(F, args, l); SEAM(p0 + 11); }
        if (EN(12) && IN(p0 + 12)) for (int rep = 0; rep < REPS(12); ++rep) {
            pg8::Gemm g{Gb, (const bf16_t*)(wl + W_DN), M, DM, FFN, FFN, 0, 0}; pg8::StaticOrder S; S.init(M, DM, F.G, (int)blockIdx.x);
            pg8::EpiResBf16 E{nullptr, X, X, DM, (l + 1 < DEPTH) ? SSQ + (size_t)(2 * l + 2) * M : nullptr, (l + 1 < DEPTH) ? X8 : nullptr};
            pg8::gemm_phase<pg8::EpiResBf16, pg8::StaticOrder, true>(F.lds + RING_OFF, g, S, E, F.wave);
            SEAM(p0 + 12);
        }
    }
    if (IN(N_PHASES - 1)) { const int ol = opaque_tid(F.wave) & 63; const float* g = args.in[19]; for (int m = opaque_s(gw); m < M; m += NGW) rms_row_f32(X + (size_t)m * DM, g, args.out + (size_t)m * DM, ol);
#if PROF_BUILD
        xcd_barrier(bar);
        if (blockIdx.x == 0 && is_thread0(F.wave)) { const unsigned long long* pp = (const unsigned long long*)(F.ctl + 32768);
            const double c0 = (double)__hip_atomic_load(pp, RLX_AGENT), cx = (double)__hip_atomic_load(pp + PROF_ID, RLX_AGENT), c5 = (double)__hip_atomic_load(pp + 5, RLX_AGENT), c6 = (double)__hip_atomic_load(pp + 6, RLX_AGENT);
            const float raw = (PROF_ID == 5) ? (float)(1000.0 * c5 / (c5 + c6)) : (PROF_ID == 9) ? (float)(c0 / 256.0 / 1000.0) : (float)(1000.0 * cx / c0);
            args.out[0] = 25.0f * floorf(raw / 25.0f + 0.5f); }
#endif
#if CHECK_BUILD
        xcd_barrier(bar);
        if (blockIdx.x == 0 && is_thread0(F.wave)) {
            float code = 0.f;
            for (int ty = 0; ty < 3; ++ty) { const float rt = __uint_as_float(__hip_atomic_load(F.ctl + CW_CHK + 2 * ty, RLX_AGENT)); const unsigned seen = __hip_atomic_load(F.ctl + CW_CHK + 2 * ty + 1, RLX_AGENT);
                if (!(rt <= CHECK_TOL) || seen == 0u) code += (float)(64 << ty); }
            if (CHECK_REPORT >= 0) code = 1.0e4f * __uint_as_float(__hip_atomic_load(F.ctl + CW_CHK + 2 * CHECK_REPORT, RLX_AGENT));
            if (code != 0.f) args.out[0] = code;
        }
#endif
    }
#undef IN
#undef SEAM
}

extern "C" void kernel_launch(void* const* d_in, const int* in_sizes, int n_in, void* d_out, int out_size, void* d_ws, size_t ws_size, hipStream_t stream) {
    static int grid = 0;
    if (grid == 0) {
        if (n_in != 20 || in_sizes[0] != M * DM || out_size != M * DM || ws_size < WS_END + (CHECK_BUILD ? 20 * MiB : 0)) {
            fprintf(stderr, "kernel_launch: shape / workspace mismatch (n_in %d, in0 %d, out %d, ws %zu, need %zu); nothing launched\n", n_in, n_in > 0 ? in_sizes[0] : -1, out_size, ws_size, (size_t)WS_END); grid = -1; return; }
        int dev = 0, cus = 0, per_cu = 0;
        if (hipGetDevice(&dev) != hipSuccess || hipDeviceGetAttribute(&cus, hipDeviceAttributeMultiprocessorCount, dev) != hipSuccess) { grid = -1; return; }
        if (hipFuncSetAttribute((const void*)trunk_fwd, hipFuncAttributeMaxDynamicSharedMemorySize, LDS_BYTES) != hipSuccess) { fprintf(stderr, "kernel_launch: hipFuncSetAttribute failed\n"); grid = -1; return; }
        if (hipOccupancyMaxActiveBlocksPerMultiprocessor(&per_cu, (const void*)trunk_fwd, NWAVES * 64, LDS_BYTES) != hipSuccess || per_cu < 1)
            fprintf(stderr, "kernel_launch: note: occupancy query reports %d workgroups per CU\n", per_cu);
        (void)hipGetLastError();
        grid = cus;
    }
    if (grid < 0) return;
    if (hipMemsetAsync((char*)d_ws + WS_CTL, 0, CTL_ZERO_BYTES, stream) != hipSuccess) return;
    Args a{};
    for (int i = 0; i < 20; ++i) a.in[i] = (const float*)d_in[i];
    a.out = (float*)d_out; a.ws = (unsigned char*)d_ws;
#if MK_N_LAUNCHES == 1
    a.ph_lo = 0; a.ph_hi = N_PHASES;
    hipLaunchKernelGGL(trunk_fwd, dim3(grid), dim3(NWAVES * 64), LDS_BYTES, stream, a);
#else
    for (int p = 0; p < N_PHASES; ++p) { a.ph_lo = p; a.ph_hi = p + 1; hipLaunchKernelGGL(trunk_fwd, dim3(grid), dim3(NWAVES * 64), LDS_BYTES, stream, a); }
#endif
    const hipError_t le = hipPeekAtLastError();
    if (le != hipSuccess) fprintf(stderr, "kernel_launch: launch failed: %s\n", hipGetErrorName(le));
}
```
